# Optimizing an MI355X kernel written in HIP

```python
import jax, jax.numpy as jnp
from jax import lax
import numpy as np

D_MODEL = 2048
BATCH = 2
SEQ = 8192
DEPTH = 1

GDN_HEADS = 8
GDN_DK = D_MODEL // 16
GDN_DV = D_MODEL // GDN_HEADS
GDN_QK = GDN_HEADS * GDN_DK
GDN_V = GDN_HEADS * GDN_DV
CONV_WIDTH = 4
RET_HEADS = 8
RET_DK = D_MODEL // 16
RET_DV = D_MODEL // RET_HEADS
RET_QK = RET_HEADS * RET_DK
RET_V = RET_HEADS * RET_DV
ROPE_BASE = 10000.0
CHUNK = 64
D_FF = ((8 * D_MODEL // 3 + 255) // 256) * 256
EPS = 1e-6
IN_SPLITS = (2 * GDN_QK + GDN_V, GDN_V, GDN_HEADS, GDN_HEADS,
             RET_QK, RET_QK, RET_V, RET_V, D_MODEL, D_MODEL)
N_IN = sum(IN_SPLITS)

kernel_name = "hybrid_gdn_retention_gated_merge"


def rmsnorm(x, w):
    xf = x.astype(jnp.float32)
    xf = xf * lax.rsqrt(jnp.mean(xf * xf, axis=-1, keepdims=True) + EPS)
    return xf.astype(x.dtype) * w


def group_norm_heads(o, w):
    mu = jnp.mean(o, axis=-1, keepdims=True)
    var = jnp.mean(jnp.square(o - mu), axis=-1, keepdims=True)
    return (o - mu) * lax.rsqrt(var + EPS) * w.reshape(o.shape[2], o.shape[3]).astype(jnp.float32)


def l2norm(x):
    return x * lax.rsqrt(jnp.sum(x * x, axis=-1, keepdims=True) + EPS)


def split_cols(p):
    offs = [int(o) for o in np.cumsum(IN_SPLITS)[:-1]]
    return jnp.split(p, offs, axis=-1)


def causal_conv(x, w):
    width, s = w.shape[0], x.shape[1]
    xp = jnp.pad(x, ((0, 0), (width - 1, 0), (0, 0)))
    out = xp[:, 0:s] * w[0]
    for j in range(1, width):
        out = out + xp[:, j:j + s] * w[j]
    return out


def rotary(x):
    d, s = x.shape[-1], x.shape[1]
    inv = ROPE_BASE ** (-jnp.arange(0, d, 2, dtype=jnp.float32) / d)
    ang = jnp.arange(s, dtype=jnp.float32)[:, None] * inv[None, :]
    cos = jnp.cos(ang)[None, :, None, :]
    sin = jnp.sin(ang)[None, :, None, :]
    x1, x2 = x[..., : d // 2], x[..., d // 2:]
    return jnp.concatenate([x1 * cos - x2 * sin, x2 * cos + x1 * sin], axis=-1)


def to_chunks(t):
    b, s, h, d = t.shape
    return t.reshape(b, s // CHUNK, CHUNK, h, d).transpose(0, 3, 1, 2, 4)


def to_chunks_scalar(t):
    b, s, h = t.shape
    return t.reshape(b, s // CHUNK, CHUNK, h).transpose(0, 3, 1, 2)


def from_scan(o):
    n, b, h, c, d = o.shape
    return o.transpose(1, 0, 3, 2, 4).reshape(b, n * c, h, d)


def gated_delta_rule(q, k, v, beta, g):
    c = q.shape[-2]
    incl = jnp.tril(jnp.ones((c, c), dtype=bool))
    strict = jnp.tril(jnp.ones((c, c), dtype=bool), -1)
    g = jnp.cumsum(g, axis=-1)
    decay = jnp.exp(jnp.where(incl, g[..., :, None] - g[..., None, :], -jnp.inf))
    kb = k * beta[..., None]
    a = jnp.where(strict, jnp.einsum('bhnid,bhnjd->bhnij', kb, k) * decay, 0.0)
    t = a + jnp.eye(c, dtype=a.dtype)
    u = lax.linalg.triangular_solve(t, v * beta[..., None], left_side=True, lower=True, unit_diagonal=True)
    w = lax.linalg.triangular_solve(t, kb * jnp.exp(g)[..., None], left_side=True, lower=True, unit_diagonal=True)
    attn = jnp.einsum('bhnid,bhnjd->bhnij', q, k) * decay

    def step(state, xs):
        q_c, k_c, u_c, w_c, g_c, attn_c = xs
        v_new = u_c - jnp.einsum('bhcd,bhde->bhce', w_c, state)
        o_c = (jnp.einsum('bhcd,bhde->bhce', q_c * jnp.exp(g_c)[..., None], state)
               + jnp.einsum('bhij,bhje->bhie', attn_c, v_new))
        g_last = g_c[..., -1:]
        state = (state * jnp.exp(g_last)[..., None]
                 + jnp.einsum('bhcd,bhce->bhde', k_c * jnp.exp(g_last - g_c)[..., None], v_new))
        return state, o_c

    b, h, _, _, dk = q.shape
    dv = v.shape[-1]
    s0 = jnp.zeros((b, h, dk, dv), jnp.float32)
    xs = tuple(jnp.moveaxis(z, 2, 0) for z in (q, k, u, w, g, attn))
    _, o = lax.scan(step, s0, xs)
    return from_scan(o)


def retention_chunked(q, k, v, log_gamma):
    c = q.shape[-2]
    pos = jnp.arange(c, dtype=jnp.float32)
    dist = pos[:, None] - pos[None, :]
    dmat = jnp.exp(jnp.where(dist >= 0, dist * log_gamma[:, None, None], -jnp.inf))
    scores = jnp.einsum('bhnid,bhnjd->bhnij', q, k) * dmat[:, None]
    intra = jnp.einsum('bhnij,bhnje->bhnie', scores, v)
    xi = jnp.exp((pos + 1.0) * log_gamma[:, None])[:, :, None]
    zeta = jnp.exp((c - 1.0 - pos) * log_gamma[:, None])[:, :, None]
    gamma_c = jnp.exp(c * log_gamma)[:, None, None]

    def step(state, xs):
        q_c, k_c, v_c = xs
        o_c = jnp.einsum('bhcd,bhde->bhce', q_c, state) * xi
        state = state * gamma_c + jnp.einsum('bhcd,bhce->bhde', k_c * zeta, v_c)
        return state, o_c

    b, h, _, _, dk = q.shape
    dv = v.shape[-1]
    s0 = jnp.zeros((b, h, dk, dv), jnp.float32)
    xs = tuple(jnp.moveaxis(z, 2, 0) for z in (q, k, v))
    _, inter = lax.scan(step, s0, xs)
    return from_scan(jnp.moveaxis(intra, 2, 0) + inter)


def setup_inputs(seed: int = 0) -> dict:
    key = jax.random.key(seed)
    ks = jax.random.split(key, 16)
    f32 = jnp.float32
    x = jax.random.normal(ks[0], (BATCH, SEQ, D_MODEL), f32)
    norm1_w = 1.0 + 0.02 * jax.random.normal(ks[1], (DEPTH, D_MODEL), f32)
    w_in = jax.random.normal(ks[2], (DEPTH, D_MODEL, N_IN), f32) * D_MODEL ** -0.5
    conv_w = jax.random.normal(ks[3], (DEPTH, CONV_WIDTH, 2 * GDN_QK + GDN_V), f32) * CONV_WIDTH ** -0.5
    a_log = jnp.log(jax.random.uniform(ks[4], (DEPTH, GDN_HEADS), f32, 1.0, 16.0))
    dt = jnp.exp(jax.random.uniform(ks[5], (DEPTH, GDN_HEADS), f32, float(np.log(1e-3)), float(np.log(1e-1))))
    dt_bias = dt + jnp.log(-jnp.expm1(-dt))
    gdn_norm_w = 1.0 + 0.02 * jax.random.normal(ks[6], (DEPTH, GDN_DV), f32)
    ret_norm_w = 1.0 + 0.02 * jax.random.normal(ks[7], (DEPTH, RET_V), f32)
    w_out = jax.random.normal(ks[8], (DEPTH, D_MODEL, D_MODEL), f32) * D_MODEL ** -0.5
    norm2_w = 1.0 + 0.02 * jax.random.normal(ks[9], (DEPTH, D_MODEL), f32)
    w_gate = jax.random.normal(ks[10], (DEPTH, D_MODEL, D_FF), f32) * D_MODEL ** -0.5
    w_up = jax.random.normal(ks[11], (DEPTH, D_MODEL, D_FF), f32) * D_MODEL ** -0.5
    w_down = jax.random.normal(ks[12], (DEPTH, D_FF, D_MODEL), f32) * D_FF ** -0.5
    norm_f_w = 1.0 + 0.02 * jax.random.normal(ks[13], (D_MODEL,), f32)
    return {"x": x, "norm1_w": norm1_w, "w_in": w_in, "conv_w": conv_w, "a_log": a_log,
            "dt_bias": dt_bias, "gdn_norm_w": gdn_norm_w, "ret_norm_w": ret_norm_w,
            "w_out": w_out, "norm2_w": norm2_w, "w_gate": w_gate, "w_up": w_up,
            "w_down": w_down, "norm_f_w": norm_f_w}


def reference(x, norm1_w, w_in, conv_w, a_log, dt_bias, gdn_norm_w, ret_norm_w,
              w_out, norm2_w, w_gate, w_up, w_down, norm_f_w):
    b, s, _ = x.shape
    f32 = jnp.float32
    log_gamma = jnp.log1p(-jnp.exp2(-5.0 - jnp.arange(RET_HEADS, dtype=f32)))
    h = x
    for l in range(DEPTH):
        u = rmsnorm(h, norm1_w[l])
        proj = u @ w_in[l]
        a_qkv, a_z, a_b, a_a, r_q, r_k, r_v, r_g, gate_a, gate_b = split_cols(proj)

        qkv = jax.nn.silu(causal_conv(a_qkv, conv_w[l])).astype(f32)
        q_a = l2norm(qkv[..., :GDN_QK].reshape(b, s, GDN_HEADS, GDN_DK)) * GDN_DK ** -0.5
        k_a = l2norm(qkv[..., GDN_QK:2 * GDN_QK].reshape(b, s, GDN_HEADS, GDN_DK))
        v_a = qkv[..., 2 * GDN_QK:].reshape(b, s, GDN_HEADS, GDN_DV)
        beta = jax.nn.sigmoid(a_b.astype(f32))
        g = -jnp.exp(a_log[l].astype(f32)) * jax.nn.softplus(a_a.astype(f32) + dt_bias[l].astype(f32))
        o_a = gated_delta_rule(to_chunks(q_a), to_chunks(k_a), to_chunks(v_a),
                               to_chunks_scalar(beta), to_chunks_scalar(g))
        o_a = rmsnorm(o_a, gdn_norm_w[l].astype(f32)) * jax.nn.silu(a_z.astype(f32).reshape(b, s, GDN_HEADS, GDN_DV))
        o_a = o_a.reshape(b, s, GDN_V).astype(x.dtype)

        q_b = rotary(r_q.astype(f32).reshape(b, s, RET_HEADS, RET_DK))
        k_b = rotary(r_k.astype(f32).reshape(b, s, RET_HEADS, RET_DK)) * RET_DK ** -0.5
        v_b = r_v.astype(f32).reshape(b, s, RET_HEADS, RET_DV)
        o_b = retention_chunked(to_chunks(q_b), to_chunks(k_b), to_chunks(v_b), log_gamma)
        o_b = group_norm_heads(o_b, ret_norm_w[l]).reshape(b, s, RET_V) * jax.nn.silu(r_g.astype(f32))
        o_b = o_b.astype(x.dtype)

        mixed = jax.nn.sigmoid(gate_a) * o_a + jax.nn.sigmoid(gate_b) * o_b
        h = h + mixed @ w_out[l]

        hn = rmsnorm(h, norm2_w[l])
        h = h + (jax.nn.silu(hn @ w_gate[l]) * (hn @ w_up[l])) @ w_down[l]
    return rmsnorm(h, norm_f_w)
```

```cpp
#include <hip/hip_runtime.h>
#include <cstdio>
#include <cstdint>
namespace pg8 {
#define PG8_LAS __attribute__((address_space(3)))
typedef unsigned short bf16_t;
typedef short bf16x8 __attribute__((ext_vector_type(8)));
typedef float f32x4 __attribute__((ext_vector_type(4)));
typedef unsigned u32x4 __attribute__((ext_vector_type(4)));
constexpr int BM = 256, BK = 64, HALF = 128, HTB = HALF * BK * 2  , STAGE_BYTES = 8 * HTB, NXCD = 8, WGM = 8;

__host__ __device__ __forceinline__ int lds_byte(int r, int c) { const int st = (r >> 4) * 2 + (c >> 5), rr = r & 15, cc = c & 31, ob = rr * 64 + cc * 2; return st * 1024 + (ob ^ (((ob >> 9) & 1) << 5)); }
__host__ __device__ __forceinline__ void stage_rc(int b, int& R, int& C) { const int st = b / 1024, sb = b % 1024, swz = sb ^ (((sb >> 9) & 1) << 5); R = (st >> 1) * 16 + swz / 64; C = (st & 1) * 32 + (swz % 64) / 2; }
__host__ __device__ __forceinline__ int perm32(int rho) { const int n = rho >> 4, i = rho & 15; return 8 * (i >> 2) + 4 * n + (i & 3); }

struct Unit { int pm, pn; };
struct Gemm { const bf16_t* A; const bf16_t* Bt; int M, N, K; };

struct StaticOrder {
    int nM, nN, nwg, G, c;
    __host__ __device__ void init(int M, int N, int G_, int c_) { nM = M / BM; nN = N / BM; nwg = nM * nN; G = G_; c = c_; }
    __host__ __device__ bool next(int i, Unit& u) const {
        const long L = (long)i * G + c; if (L >= nwg) return false;
        int wgid = (int)L; { const int q = nwg / NXCD, r = nwg % NXCD, xcd = wgid % NXCD, off = wgid / NXCD; wgid = (xcd < r ? xcd * (q + 1) : r * (q + 1) + (xcd - r) * q) + off; }
        const int nig = WGM * nN, gid = wgid / nig, fm = gid * WGM, gsz = (nM - fm) < WGM ? (nM - fm) : WGM;
        u.pm = fm + ((wgid % nig) % gsz); u.pn = (wgid % nig) / gsz; return true;
    }
    __device__ __forceinline__ void a_ready(const Unit&) const {}
    __device__ __forceinline__ void done(const Unit&) const {}
};
__device__ __forceinline__ unsigned cvt_pk_bf16(float lo, float hi) { unsigned r; asm volatile("v_cvt_pk_bf16_f32 %0, %1, %2" : "=v"(r) : "v"(lo), "v"(hi)); return r; }
typedef float f32x2 __attribute__((ext_vector_type(2)));
__device__ __forceinline__ u32x4 pack8(const f32x4& a, const f32x4& b) { u32x4 w; w.x = cvt_pk_bf16(a[0], a[1]); w.y = cvt_pk_bf16(a[2], a[3]); w.z = cvt_pk_bf16(b[0], b[1]); w.w = cvt_pk_bf16(b[2], b[3]); return w; }
__device__ __forceinline__ float fsigmoid(float x) { return __builtin_amdgcn_rcpf(1.0f + __expf(-x)); }
__device__ __forceinline__ float fsilu(float x) { return x * fsigmoid(x); }

struct EpiInProj {
    static constexpr bool PERM = true, AFTER_DRAIN = false;
    bf16_t *QKV, *RQ, *RK, *RV, *GZA, *GZB; const float *cosT, *sinT;
    __device__ __forceinline__ void operator()(const f32x4 (&acc)[2][2][4][2], const Unit& u, int wr, int wc, int fr, int fq) const {
        const int row0 = u.pm * BM + wr * 64 + fr, pn = u.pn, cw = wc * 32 + 8 * fq;
        if (pn < 16 || (pn >= 24 && pn < 32)) {
            bf16_t* base; int ldc, col0;
            if (pn < 16) { base = QKV; ldc = 4096; col0 = pn * 256 + cw; } else { base = RV; ldc = 2048; col0 = (pn - 24) * 256 + cw; }
#pragma unroll
            for (int ai = 0; ai < 2; ++ai)
#pragma unroll
                for (int m = 0; m < 4; ++m) { bf16_t* rowp = base + (size_t)(row0 + ai * HALF + m * 16) * ldc + col0;
#pragma unroll
                    for (int bj = 0; bj < 2; ++bj) *(u32x4*)(rowp + bj * HALF) = pack8(acc[ai][bj][m][0], acc[ai][bj][m][1]); }
        } else if (pn < 24) {
            const bool isk = pn >= 20; bf16_t* base = isk ? RK : RQ; const float sc = isk ? 0.08838834764831845f : 1.0f;
            const int tile = (pn - 16) & 3, head = 2 * tile + (cw >> 6), i0 = cw & 63;
#pragma unroll
            for (int ai = 0; ai < 2; ++ai)
#pragma unroll
                for (int m = 0; m < 4; ++m) { const int row = row0 + ai * HALF + m * 16, t = row & 8191;
                    const float* cp = cosT + t * 64 + i0; const float* sp = sinT + t * 64 + i0;
                    const f32x4 c0 = *(const f32x4*)cp, c1 = *(const f32x4*)(cp + 4), s0 = *(const f32x4*)sp, s1 = *(const f32x4*)(sp + 4);
                    const f32x4 x1a = acc[ai][0][m][0], x1b = acc[ai][0][m][1], x2a = acc[ai][1][m][0], x2b = acc[ai][1][m][1];
                    const f32x4 o1a = (x1a * c0 - x2a * s0) * sc, o1b = (x1b * c1 - x2b * s1) * sc, o2a = (x2a * c0 + x1a * s0) * sc, o2b = (x2b * c1 + x1b * s1) * sc;
                    bf16_t* rowp = base + (size_t)row * 1024 + head * 128 + i0;
                    *(u32x4*)(rowp) = pack8(o1a, o1b); *(u32x4*)(rowp + 64) = pack8(o2a, o2b); }
        } else {
            bf16_t* base = pn < 48 ? GZA : GZB; const int col0 = ((pn - 32) & 15) * 128 + cw;
#pragma unroll
            for (int ai = 0; ai < 2; ++ai)
#pragma unroll
                for (int m = 0; m < 4; ++m) { bf16_t* rowp = base + (size_t)(row0 + ai * HALF + m * 16) * 2048 + col0; f32x4 o[2];
#pragma unroll
                    for (int n = 0; n < 2; ++n)
#pragma unroll
                        for (int j = 0; j < 4; ++j) o[n][j] = fsilu(acc[ai][0][m][n][j]) * fsigmoid(acc[ai][1][m][n][j]);
                    *(u32x4*)rowp = pack8(o[0], o[1]); }
        }
    }
};
struct EpiGateUp {
    static constexpr bool PERM = true, AFTER_DRAIN = false;
    bf16_t* ACT; int ldc; const float* rstd;
    __device__ __forceinline__ void operator()(const f32x4 (&acc)[2][2][4][2], const Unit& u, int wr, int wc, int fr, int fq) const {
        const int row0 = u.pm * BM + wr * 64 + fr, col0 = u.pn * 128 + wc * 32 + 8 * fq;
#pragma unroll
        for (int ai = 0; ai < 2; ++ai)
#pragma unroll
            for (int m = 0; m < 4; ++m) { const int row = row0 + ai * HALF + m * 16; const float rs = rstd ? rstd[row] : 1.0f; f32x4 o[2];
#pragma unroll
                for (int n = 0; n < 2; ++n)
#pragma unroll
                    for (int j = 0; j < 4; ++j) o[n][j] = fsilu(acc[ai][0][m][n][j] * rs) * (acc[ai][1][m][n][j] * rs);
                *(u32x4*)(ACT + (size_t)row * ldc + col0) = pack8(o[0], o[1]); }
    }
};
struct EpiResF32 {
    static constexpr bool PERM = false, AFTER_DRAIN = false;
    const float* res; float* out; int ldc;
    __device__ __forceinline__ void operator()(const f32x4 (&acc)[2][2][4][2], const Unit& u, int wr, int wc, int fr, int fq) const {
        const int row0 = u.pm * BM + wr * 64 + fr, col0 = u.pn * BM + wc * 32 + 4 * fq;
#pragma unroll
        for (int ai = 0; ai < 2; ++ai)
#pragma unroll
            for (int m = 0; m < 4; ++m) { const size_t off = (size_t)(row0 + ai * HALF + m * 16) * ldc + col0;
#pragma unroll
                for (int bj = 0; bj < 2; ++bj)
#pragma unroll
                    for (int n = 0; n < 2; ++n) { const f32x4 r = *(const f32x4*)(res + off + bj * HALF + n * 16); *(f32x4*)(out + off + bj * HALF + n * 16) = r + acc[ai][bj][m][n]; } }
    }
};
template <class Epi, class Sched, bool ALIGN_EPI = false, bool SP2 = false>
__device__ __forceinline__ void gemm_phase(PG8_LAS unsigned char* lds, const Gemm g, const Sched& S, const Epi& E) {
    const int tid = threadIdx.x, wid = __builtin_amdgcn_readfirstlane(tid >> 6), lane = tid & 63, wr = wid >> 2, wc = wid & 3, fr = lane & 15, fq = lane >> 4;
    const int K = g.K, nt = K / BK;
    unsigned voffA[2], voffB[2];
#pragma unroll
    for (int i = 0; i < 2; ++i) { int R, C; stage_rc(tid * 16 + i * 8192, R, C); const int Rb = Epi::PERM ? ((R & ~31) + perm32(R & 31)) : R;
        voffA[i] = (unsigned)(R * K + C) * 2u; voffB[i] = (unsigned)(Rb * K + C) * 2u; }
    const size_t kstep = (size_t)(BK * 2);
    const size_t hstep = (size_t)HALF * K * 2;
    const size_t tstep = 2 * hstep;
    const unsigned ldsw = (unsigned)wid * 1024u;
    const int aoff = lds_byte(wr * 64 + fr, fq * 8), boff = lds_byte(wc * 32 + fr, fq * 8);
#define PG8_SA(b, h) (((b) * 2 + (h)) * HTB)
#define PG8_SB(b, h) ((4 + (b) * 2 + (h)) * HTB)
#define PG8_STAGE(bufoff, gbase, voff) do { _Pragma("unroll") for (int _i = 0; _i < 2; ++_i) \
        __builtin_amdgcn_global_load_lds((const unsigned*)((const char*)(gbase) + (voff)[_i]), (PG8_LAS unsigned*)(lds + (bufoff) + ldsw + _i * 8192), 16, 0, 0); } while (0)
#define PG8_LDA(dst, b, h) do { _Pragma("unroll") for (int m = 0; m < 4; ++m) _Pragma("unroll") for (int k = 0; k < 2; ++k) dst[m][k] = *(const PG8_LAS bf16x8*)(lds + PG8_SA(b, h) + aoff + m * 2048 + k * 1024); } while (0)
#define PG8_LDB(dst, b, h) do { _Pragma("unroll") for (int n = 0; n < 2; ++n) _Pragma("unroll") for (int k = 0; k < 2; ++k) dst[n][k] = *(const PG8_LAS bf16x8*)(lds + PG8_SB(b, h) + boff + n * 2048 + k * 1024); } while (0)
#define PG8_MMA(ai, bj, At, Bt) do { __builtin_amdgcn_s_setprio(1); _Pragma("unroll") for (int m = 0; m < 4; ++m) _Pragma("unroll") for (int n = 0; n < 2; ++n) _Pragma("unroll") for (int k = 0; k < 2; ++k) \
        acc[ai][bj][m][n] = __builtin_amdgcn_mfma_f32_16x16x32_bf16(Bt[n][k], At[m][k], acc[ai][bj][m][n], 0, 0, 0); __builtin_amdgcn_s_setprio(0); } while (0)
#define PG8_WAIT_V(n) asm volatile("s_waitcnt vmcnt(" #n ")" ::: "memory")
#define PG8_WAIT_L(n) asm volatile("s_waitcnt lgkmcnt(" #n ")" ::: "memory")
#define PG8_BAR __builtin_amdgcn_s_barrier()
#define PG8_SCHED __builtin_amdgcn_sched_barrier(0)
    Unit cur, nxt; int ui = 0;
    if (!S.next(0, cur)) return;
    f32x4 acc[2][2][4][2];
#pragma unroll
    for (int a = 0; a < 2; ++a)
#pragma unroll
        for (int b = 0; b < 2; ++b)
#pragma unroll
            for (int m = 0; m < 4; ++m)
#pragma unroll
                for (int n = 0; n < 2; ++n) acc[a][b][m][n] = (f32x4){0.f, 0.f, 0.f, 0.f};
    bf16x8 At[4][2], B0[2][2], B1[2][2];
    const char* cA = (const char*)g.A + (size_t)cur.pm * tstep; const char* cB = (const char*)g.Bt + (size_t)cur.pn * tstep;
    S.a_ready(cur);
    if constexpr (SP2) {
        PG8_STAGE(PG8_SB(0, 0), cB, voffB); PG8_STAGE(PG8_SB(0, 1), cB + hstep, voffB); PG8_STAGE(PG8_SA(0, 0), cA, voffA); PG8_STAGE(PG8_SA(0, 1), cA + hstep, voffA);
        if (wr == 1) PG8_BAR;
        PG8_WAIT_V(2); PG8_BAR;
        PG8_STAGE(PG8_SB(1, 0), cB + kstep, voffB); PG8_STAGE(PG8_SA(1, 0), cA + kstep, voffA); PG8_STAGE(PG8_SB(1, 1), cB + hstep + kstep, voffB);
        PG8_WAIT_V(6); PG8_BAR;
    } else {
        PG8_STAGE(PG8_SB(0, 0), cB, voffB); PG8_STAGE(PG8_SA(0, 0), cA, voffA); PG8_STAGE(PG8_SB(0, 1), cB + hstep, voffB); PG8_STAGE(PG8_SA(0, 1), cA + hstep, voffA);
        if (wr == 1) PG8_BAR;
        PG8_WAIT_V(4); PG8_BAR;
        PG8_STAGE(PG8_SB(1, 0), cB + kstep, voffB); PG8_STAGE(PG8_SA(1, 0), cA + kstep, voffA); PG8_STAGE(PG8_SB(1, 1), cB + hstep + kstep, voffB);
        PG8_WAIT_V(6); PG8_BAR;
    }
    for (;;) {
        const bool has_next = S.next(ui + 1, nxt);
        const char* nA = has_next ? (const char*)g.A + (size_t)nxt.pm * tstep : cA; const char* nB = has_next ? (const char*)g.Bt + (size_t)nxt.pn * tstep : cB;
        for (int t = 0; t < nt; t += 2) {
            const bool last = (t == nt - 2);
            const char* a1 = cA + (size_t)(t + 1) * kstep;
            const char* a2 = last ? nA : cA + (size_t)(t + 2) * kstep; const char* b2 = last ? nB : cB + (size_t)(t + 2) * kstep;
            const char* a3 = a2 + kstep; const char* b3 = b2 + kstep;
            if (last && has_next) S.a_ready(nxt);
            if constexpr (SP2) {
            PG8_LDB(B0, 0, 0); PG8_LDB(B1, 0, 1); PG8_SCHED; PG8_LDA(At, 0, 0); PG8_STAGE(PG8_SA(1, 1), a1 + hstep, voffA);
            PG8_WAIT_V(8); PG8_WAIT_L(0); PG8_BAR; PG8_MMA(0, 0, At, B0); PG8_MMA(0, 1, At, B1); PG8_BAR; PG8_SCHED;
            PG8_LDA(At, 0, 1); PG8_STAGE(PG8_SB(0, 0), b2, voffB); PG8_STAGE(PG8_SB(0, 1), b2 + hstep, voffB); PG8_STAGE(PG8_SA(0, 0), a2, voffA);
            PG8_WAIT_V(8); PG8_WAIT_L(0); PG8_BAR; PG8_MMA(1, 0, At, B0); PG8_MMA(1, 1, At, B1); PG8_BAR; PG8_SCHED;
            PG8_LDB(B0, 1, 0); PG8_LDB(B1, 1, 1); PG8_SCHED; PG8_LDA(At, 1, 0); PG8_STAGE(PG8_SA(0, 1), a2 + hstep, voffA);
            PG8_WAIT_V(8); PG8_WAIT_L(0); PG8_BAR; PG8_MMA(0, 0, At, B0); PG8_MMA(0, 1, At, B1); PG8_BAR; PG8_SCHED;
            PG8_LDA(At, 1, 1); PG8_STAGE(PG8_SB(1, 0), b3, voffB); PG8_STAGE(PG8_SB(1, 1), b3 + hstep, voffB); PG8_STAGE(PG8_SA(1, 0), a3, voffA);
            PG8_WAIT_V(8); PG8_WAIT_L(0); PG8_BAR; PG8_MMA(1, 0, At, B0); PG8_MMA(1, 1, At, B1); PG8_BAR; PG8_SCHED;
            } else {
            PG8_LDB(B0, 0, 0); PG8_SCHED; PG8_LDA(At, 0, 0); PG8_STAGE(PG8_SA(1, 1), a1 + hstep, voffA);
            PG8_WAIT_L(8); PG8_BAR; PG8_WAIT_L(0); PG8_MMA(0, 0, At, B0); PG8_BAR; PG8_SCHED;
            PG8_LDB(B1, 0, 1); PG8_STAGE(PG8_SB(0, 0), b2, voffB);
            PG8_BAR; PG8_WAIT_L(0); PG8_MMA(0, 1, At, B1); PG8_BAR;
            PG8_LDA(At, 0, 1); PG8_STAGE(PG8_SA(0, 0), a2, voffA);
            PG8_BAR; PG8_WAIT_L(0); PG8_MMA(1, 0, At, B0); PG8_BAR; PG8_SCHED;
            PG8_STAGE(PG8_SB(0, 1), b2 + hstep, voffB);
            PG8_WAIT_V(6); PG8_BAR; PG8_MMA(1, 1, At, B1); PG8_BAR;
            PG8_LDB(B0, 1, 0); PG8_SCHED; PG8_LDA(At, 1, 0); PG8_STAGE(PG8_SA(0, 1), a2 + hstep, voffA);
            PG8_WAIT_L(8); PG8_BAR; PG8_WAIT_L(0); PG8_MMA(0, 0, At, B0); PG8_BAR; PG8_SCHED;
            PG8_LDB(B1, 1, 1); PG8_STAGE(PG8_SB(1, 0), b3, voffB);
            PG8_BAR; PG8_WAIT_L(0); PG8_MMA(0, 1, At, B1); PG8_BAR;
            PG8_LDA(At, 1, 1); PG8_STAGE(PG8_SA(1, 0), a3, voffA);
            PG8_BAR; PG8_WAIT_L(0); PG8_MMA(1, 0, At, B0); PG8_BAR; PG8_SCHED;
            PG8_STAGE(PG8_SB(1, 1), b3 + hstep, voffB);
            PG8_WAIT_V(6); PG8_BAR; PG8_MMA(1, 1, At, B1); PG8_BAR;
            }
        }
        if constexpr (ALIGN_EPI) { if (wr == 0) PG8_BAR; }
        if constexpr (!Epi::AFTER_DRAIN) { E(acc, cur, wr, wc, fr, fq); S.done(cur); }
        if (!has_next) break;
#pragma unroll
        for (int a = 0; a < 2; ++a)
#pragma unroll
            for (int b = 0; b < 2; ++b)
#pragma unroll
                for (int m = 0; m < 4; ++m)
#pragma unroll
                    for (int n = 0; n < 2; ++n) acc[a][b][m][n] = (f32x4){0.f, 0.f, 0.f, 0.f};
        cur = nxt; cA = nA; cB = nB; ++ui;
        if constexpr (ALIGN_EPI) { if (wr == 1) PG8_BAR; }
    }
    PG8_WAIT_V(0);
    if constexpr (!ALIGN_EPI) { if (wr == 0) PG8_BAR; }
    PG8_BAR;
    if constexpr (Epi::AFTER_DRAIN) { E.fused(acc, cur, wr, wc, fr, fq, lds, wid, lane); S.done(cur); }
#undef PG8_SA
#undef PG8_SB
#undef PG8_STAGE
#undef PG8_LDA
#undef PG8_LDB
#undef PG8_MMA
#undef PG8_WAIT_V
#undef PG8_WAIT_L
#undef PG8_BAR
#undef PG8_SCHED
}
}
#define GAS __attribute__((address_space(1)))
#define LAS __attribute__((address_space(3)))
#define XB_TMO      128
#define XB_XCNT(j)  (256  + 64 * (j))
#define XB_XSUB(j)  (1280 + 64 * (j))
#define XB_XGEN(j)  (2304 + 64 * (j))
#define XB_TOP      3328
#define XB_TOPGEN   3392
#define XCD_BAR_WORDS 3456
#define XB_SPIN_CAP (1u << 18)

__device__ __forceinline__ unsigned xb_ld(unsigned* p)              { return __hip_atomic_load(p, __ATOMIC_RELAXED, __HIP_MEMORY_SCOPE_AGENT); }
__device__ __forceinline__ unsigned xb_add(unsigned* p, unsigned v) { return __hip_atomic_fetch_add(p, v, __ATOMIC_RELAXED, __HIP_MEMORY_SCOPE_AGENT); }
__device__ __forceinline__ unsigned xb_xcc_id() { return (unsigned)__builtin_amdgcn_s_getreg((3 << 11) | 20) & 0xFu; }
#define XB_SPIN(cond, bar) do { unsigned _sp = 0; while (cond) { __builtin_amdgcn_s_sleep(1); \
    if ((++_sp & 255u) == 0u) { if (xb_ld(&(bar)[XB_TMO])) break; if (_sp > XB_SPIN_CAP) { atomicAdd(&(bar)[XB_TMO], 1u); break; } } } } while (0)

struct XcdBarrier {
    unsigned* bar; unsigned x;
    volatile LAS unsigned* st;
};

__device__ __forceinline__ XcdBarrier xcd_barrier_post(unsigned* bar, volatile LAS unsigned* st) {
    XcdBarrier b; b.bar = bar; b.x = xb_xcc_id(); b.st = st;
    if (threadIdx.x == 0) (void)xb_add(&bar[XB_XCNT(b.x)], 1u);
    return b;
}
__device__ __forceinline__ void xcd_barrier_complete(unsigned* bar, unsigned x, unsigned& nloc, unsigned& nx) {
    const unsigned G = gridDim.x * gridDim.y * gridDim.z;
    unsigned sum, cnt, mine, sp = 0u;
    for (;;) {
        sum = 0u; cnt = 0u; mine = 0u;
#pragma unroll
        for (unsigned j = 0; j < 16; ++j) { const unsigned c = xb_ld(&bar[XB_XCNT(j)]); sum += c; cnt += (c > 0u) ? 1u : 0u; mine = (j == x) ? c : mine; }
        if (sum == G) break;
        __builtin_amdgcn_s_sleep(1);
        if ((++sp & 255u) == 0u) { if (xb_ld(&bar[XB_TMO])) break; if (sp > XB_SPIN_CAP) { atomicAdd(&bar[XB_TMO], 1u); break; } }
    }
    nloc = mine > 0u ? mine : 1u; nx = cnt > 0u ? cnt : 1u;
}

__device__ __forceinline__ void xcd_barrier(const XcdBarrier& b) {
    asm volatile("s_waitcnt vmcnt(0)" ::: "memory");
    __syncthreads();
    if (threadIdx.x == 0) {
        unsigned* bar = b.bar;
        __builtin_amdgcn_s_waitcnt(0);
        unsigned nloc = b.st[0], nx = b.st[1];
        if (nloc == 0u) { xcd_barrier_complete(bar, b.x, nloc, nx); b.st[0] = nloc; b.st[1] = nx; }
        const unsigned old = xb_add(&bar[XB_XSUB(b.x)], 1u);
        const unsigned gen = old / nloc;
        if (old + 1u == (gen + 1u) * nloc) {
            __builtin_amdgcn_fence(__ATOMIC_RELEASE, "agent");
            asm volatile("s_waitcnt vmcnt(0)" ::: "memory");
            const unsigned og = xb_add(&bar[XB_TOP], 1u);
            const unsigned tg = og / nx;
            if (og + 1u == (tg + 1u) * nx) xb_add(&bar[XB_TOPGEN], 1u);
            else XB_SPIN(xb_ld(&bar[XB_TOPGEN]) == tg, bar);
            __builtin_amdgcn_fence(__ATOMIC_ACQUIRE, "agent");
            xb_add(&bar[XB_XGEN(b.x)], 1u);
            asm volatile("s_waitcnt vmcnt(0)" ::: "memory");
        } else {
            XB_SPIN(xb_ld(&bar[XB_XGEN(b.x)]) == gen, bar);
            __builtin_amdgcn_fence(__ATOMIC_ACQUIRE, "agent");
            asm volatile("s_waitcnt vmcnt(0)" ::: "memory");
        }
    }
    __syncthreads();
}
#ifndef MK_N_LAUNCHES
#define MK_N_LAUNCHES 1
#endif
constexpr int NWAVES = 8;
constexpr int NPHASES = 9;
constexpr int BATCH = 2, SEQ = 8192, D = 2048, T = BATCH * SEQ;
constexpr int NH = 8, DK = 128, DV = 256;
constexpr int NIN = 16400;
constexpr int OFF_AZ = 4096, OFF_AB = 6144, OFF_RQ = 6160, OFF_RK = 7184, OFF_RV = 8208, OFF_RG = 10256, OFF_GA = 12304, OFF_GB = 14352;
constexpr int N1 = 16384;
constexpr int FF = 5632, NGU = 2 * FF;
constexpr float EPS = 1e-6f;
constexpr size_t MiB = 1u << 20;
constexpr size_t WS_CTL = 0, CTL_ZERO_BYTES = 1 * MiB;
constexpr size_t WS_BETA = 1 * MiB, WS_G = 1 * MiB + 512 * 1024;
constexpr size_t WS_COS = 2 * MiB, WS_SIN = 4 * MiB;
constexpr size_t WS_RSTD = 6 * MiB;
constexpr size_t WS_WOT = 8 * MiB, WS_WGUT = 16 * MiB, WS_WDT = 60 * MiB, WS_W1T = 82 * MiB;
constexpr size_t WS_U = 146 * MiB, WS_QKV = 210 * MiB, WS_RQ = 338 * MiB, WS_RK = 370 * MiB, WS_RV = 402 * MiB, WS_END = 466 * MiB;
constexpr size_t WS_OA = WS_U, WS_OB = WS_W1T;
constexpr size_t WS_MIXED = WS_QKV, WS_HNB = WS_QKV + 64 * MiB;
constexpr size_t WS_ACT = WS_W1T;
static_assert(WS_ACT + (size_t)T * FF * 2 <= WS_HNB, "ACT overlay");
constexpr int CW_BAR = 4096;
constexpr int RING_BYTES = 131072, LDSCTL_OFF = RING_BYTES, MISC_OFF = LDSCTL_OFF + 320, LDS_BYTES = 147456;

typedef unsigned short bf16;
typedef unsigned v4u __attribute__((ext_vector_type(4)));
typedef unsigned v2u __attribute__((ext_vector_type(2)));
typedef float f32x4 __attribute__((ext_vector_type(4)));
#define LDS_WAIT() asm volatile("s_waitcnt lgkmcnt(0)" ::: "memory")
__device__ __forceinline__ unsigned f2bf(float f) { unsigned u = __builtin_bit_cast(unsigned, f); return (u + 0x7fffu + ((u >> 16) & 1u)) >> 16; }
__device__ __forceinline__ unsigned pk2(float lo, float hi) { return f2bf(lo) | (f2bf(hi) << 16); }
__device__ __forceinline__ float bf2f(unsigned b) { return __builtin_bit_cast(float, b << 16); }
__device__ __forceinline__ float bflo(unsigned w) { return __builtin_bit_cast(float, w << 16); }
__device__ __forceinline__ float bfhi(unsigned w) { return __builtin_bit_cast(float, w & 0xffff0000u); }
__device__ __forceinline__ float wave_sum(float v) {
#pragma unroll
    for (int o = 1; o < 64; o <<= 1) v += __shfl_xor(v, o);
    return v;
}

struct Args { const float* in[14]; float* out; unsigned char* ws; int ph_lo, ph_hi; };
struct Frame {
    LAS unsigned char* lds; int tid, lane, wave, vcu, G;
    const float *x, *norm1_w, *w_in, *conv_w, *a_log, *dt_bias, *gdn_norm_w, *ret_norm_w, *w_out, *norm2_w, *w_gate, *w_up, *w_down, *norm_f_w;
    float* out; unsigned char* ws;
};

__device__ __forceinline__ void transpose_blk(const float* src, int ld, int k0, int sc0, bf16* dst, int K, int dr0, LAS float* scr, int lane) {
#pragma unroll 8
    for (int i = 0; i < 32; ++i) { const int kk = 2 * i + (lane >> 5); scr[kk * 33 + (lane & 31)] = src[(size_t)(k0 + kk) * ld + sc0 + (lane & 31)]; }
    LDS_WAIT(); asm volatile("" ::: "memory");
    const int c = lane & 7;
#pragma unroll
    for (int j = 0; j < 4; ++j) { const int n = (lane >> 3) + 8 * j; const LAS float* s = scr + (8 * c) * 33 + n;
        v4u o; o.x = pk2(s[0 * 33], s[1 * 33]); o.y = pk2(s[2 * 33], s[3 * 33]); o.z = pk2(s[4 * 33], s[5 * 33]); o.w = pk2(s[6 * 33], s[7 * 33]);
        *(v4u*)(dst + (size_t)(dr0 + n) * K + k0 + 8 * c) = o; }
    LDS_WAIT(); asm volatile("" ::: "memory");
}
__device__ __forceinline__ int w1_src_col(int n) {
    if (n < 4096) return n;
    if (n < 6144) { const int isk = n >= 5120, lt = (n - 4096) & 1023, tile = lt >> 8, c = lt & 255, bj = c >> 7, p = c & 127; return (isk ? OFF_RK : OFF_RQ) + (2 * tile + (p >> 6)) * 128 + bj * 64 + (p & 63); }
    if (n < 8192) return OFF_RV + (n - 6144);
    { const int isb = n >= 12288, lt = (n - 8192) & 4095, j = lt >> 8, c = lt & 255, bj = c >> 7, p = c & 127;
      return (isb ? (bj ? OFF_GB : OFF_RG) : (bj ? OFF_GA : OFF_AZ)) + 128 * j + p; }
}
__device__ __forceinline__ void p0_prologue(Frame& F) {
    const int gw = F.vcu * NWAVES + F.wave, NGW = F.G * NWAVES, lane = F.lane;
    {
        LAS float* scr = (LAS float*)(F.lds + F.wave * 16384);
        constexpr int I_1 = (D / 64) * (N1 / 32), I_O = (D / 64) * (D / 32), I_G = (D / 64) * (FF / 32), I_D = (FF / 64) * (D / 32);
        constexpr int NITEMS = I_1 + I_O + 2 * I_G + I_D;
        bf16* W1T = (bf16*)(F.ws + WS_W1T); bf16* WOT = (bf16*)(F.ws + WS_WOT); bf16* WGUT = (bf16*)(F.ws + WS_WGUT); bf16* WDT = (bf16*)(F.ws + WS_WDT);
        for (int it = gw; it < NITEMS; it += NGW) {
            int r = it;
            if (r < I_1) { const int nb = r % (N1 / 32), kb = r / (N1 / 32); transpose_blk(F.w_in, NIN, 64 * kb, w1_src_col(32 * nb), W1T, D, 32 * nb, scr, lane); continue; } r -= I_1;
            if (r < I_O) { const int nb = r % (D / 32), kb = r / (D / 32); transpose_blk(F.w_out, D, 64 * kb, 32 * nb, WOT, D, 32 * nb, scr, lane); continue; } r -= I_O;
            if (r < 2 * I_G) { const int up = r >= I_G; if (up) r -= I_G; const int nb = r % (FF / 32), kb = r / (FF / 32), c0 = 32 * nb;
                transpose_blk(up ? F.w_up : F.w_gate, FF, 64 * kb, c0, WGUT, D, 256 * (c0 >> 7) + 128 * up + (c0 & 127), scr, lane); continue; } r -= 2 * I_G;
            { const int nb = r % (D / 32), kb = r / (D / 32); transpose_blk(F.w_down, D, 64 * kb, 32 * nb, WDT, FF, 32 * nb, scr, lane); }
        }
    }
    {
        float* cosT = (float*)(F.ws + WS_COS); float* sinT = (float*)(F.ws + WS_SIN);
        for (int idx = (F.vcu * 512 + F.tid); idx < SEQ * 64; idx += F.G * 512) { const int t = idx >> 6, i = idx & 63;
            const float inv = (float)exp2(-(double)i * (13.287712379549449 / 64.0));
            const float ang = (float)t * inv; const double a = (double)ang; cosT[idx] = (float)cos(a); sinT[idx] = (float)sin(a); }
    }
    __syncthreads();
    {
        LAS float* wT = (LAS float*)F.lds;
        for (int idx = F.tid; idx < 2048 * 16; idx += 512) { const int k = idx >> 4, c = idx & 15; wT[c * 2048 + k] = F.w_in[(size_t)k * NIN + OFF_AB + c]; }
        __syncthreads();
        bf16* U = (bf16*)(F.ws + WS_U); float* BETA = (float*)(F.ws + WS_BETA); float* GG = (float*)(F.ws + WS_G);
        f32x4 nw[8];
#pragma unroll
        for (int j = 0; j < 8; ++j) nw[j] = ((const f32x4*)F.norm1_w)[64 * j + lane];
        for (int row = gw; row < T; row += NGW) {
            asm volatile("" ::: "memory");
            const f32x4* xr = (const f32x4*)(F.x + (size_t)row * D) + lane;
            f32x4 v[8]; float ss = 0.f;
#pragma unroll
            for (int j = 0; j < 8; ++j) { v[j] = xr[64 * j]; ss += (v[j].x * v[j].x + v[j].y * v[j].y) + (v[j].z * v[j].z + v[j].w * v[j].w); }
            const float rstd = rsqrtf(wave_sum(ss) * (1.0f / D) + EPS);
            v2u* o8 = (v2u*)(U + (size_t)row * D) + lane;
#pragma unroll
            for (int j = 0; j < 8; ++j) { v[j] = (v[j] * rstd) * nw[j]; v2u w; w.x = pk2(v[j].x, v[j].y); w.y = pk2(v[j].z, v[j].w); o8[64 * j] = w; }
            float mb = 0.f, ma = 0.f;
#pragma unroll
            for (int c = 0; c < 16; ++c) { float s = 0.f;
#pragma unroll
                for (int j = 0; j < 8; ++j) { const f32x4 w = *(const LAS f32x4*)(wT + c * 2048 + 256 * j + 4 * lane); s += (v[j].x * w.x + v[j].y * w.y) + (v[j].z * w.z + v[j].w * w.w); }
                s = wave_sum(s);
                if (c < 8) mb = (lane == c) ? s : mb; else ma = (lane == c - 8) ? s : ma; }
            if (lane < 8) { const float bt = 1.0f / (1.0f + expf(-mb)); const float xa = ma + F.dt_bias[lane]; const float sp = xa > 20.f ? xa : log1pf(expf(xa));
                BETA[(size_t)row * 8 + lane] = bt; GG[(size_t)row * 8 + lane] = -expf(F.a_log[lane]) * sp; }
        }
    }
}

__device__ __forceinline__ void gdn_naive(Frame& F, int bh) {
    const int b = bh >> 3, h = bh & 7, tid = F.tid, c = tid & 255, hh = tid >> 8;
    LAS float* sq = (LAS float*)F.lds; LAS float* sk = sq + 128; LAS float* sv = sq + 256; LAS float* sp = sq + 512; LAS float* sred = sq + 1024;
    const int ch = tid < 128 ? h * 128 + tid : (tid < 256 ? 1024 + h * 128 + (tid - 128) : 2048 + h * 256 + (tid - 256));
    const float cw0 = F.conv_w[0 * 4096 + ch], cw1 = F.conv_w[1 * 4096 + ch], cw2 = F.conv_w[2 * 4096 + ch], cw3 = F.conv_w[3 * 4096 + ch];
    const bf16* raw = (const bf16*)(F.ws + WS_QKV) + (size_t)(b * SEQ) * 4096 + ch;
    const float* BETA = (const float*)(F.ws + WS_BETA) + (size_t)(b * SEQ) * 8 + h; const float* GG = (const float*)(F.ws + WS_G) + (size_t)(b * SEQ) * 8 + h;
    bf16* OA = (bf16*)(F.ws + WS_OA) + (size_t)(b * SEQ) * 2048 + h * 256 + c;
    float S[64];
#pragma unroll
    for (int d = 0; d < 64; ++d) S[d] = 0.f;
    float r0 = 0.f, r1 = 0.f, r2 = 0.f;
    float nraw = bf2f(raw[0]), nbeta = BETA[0], ng = GG[0];
    for (int t = 0; t < SEQ; ++t) {
        const float r3 = nraw, beta = nbeta, eg = expf(ng);
        if (t + 1 < SEQ) { nraw = bf2f(raw[(size_t)(t + 1) * 4096]); nbeta = BETA[(size_t)(t + 1) * 8]; ng = GG[(size_t)(t + 1) * 8]; }
        const float a = r0 * cw0 + r1 * cw1 + r2 * cw2 + r3 * cw3; r0 = r1; r1 = r2; r2 = r3;
        float val = a / (1.0f + expf(-a));
        const float ws_ = wave_sum(val * val);
        if (F.lane == 0) sred[F.wave] = ws_;
        __syncthreads();
        if (tid < 128) { val = val * rsqrtf(sred[0] + sred[1] + EPS) * 0.08838834764831845f; sq[tid] = val; }
        else if (tid < 256) { val = val * rsqrtf(sred[2] + sred[3] + EPS); sk[tid - 128] = val; }
        else sv[tid - 256] = val;
        __syncthreads();
        float p = 0.f;
#pragma unroll
        for (int d = 0; d < 64; ++d) p += sk[hh * 64 + d] * S[d];
        sp[hh * 256 + c] = p;
        __syncthreads();
        const float kS = sp[c] + sp[256 + c];
        const float delta = beta * (sv[c] - eg * kS);
        float o = 0.f;
#pragma unroll
        for (int d = 0; d < 64; ++d) { S[d] = eg * S[d] + sk[hh * 64 + d] * delta; o += sq[hh * 64 + d] * S[d]; }
        __syncthreads();
        sp[hh * 256 + c] = o;
        __syncthreads();
        if (hh == 0) OA[(size_t)t * 2048] = (bf16)f2bf(sp[c] + sp[256 + c]);
    }
}
__device__ __forceinline__ void ret_naive(Frame& F, int bh) {
    const int b = bh >> 3, h = bh & 7, tid = F.tid, c = tid & 255, hh = tid >> 8;
    LAS float* sq = (LAS float*)F.lds; LAS float* sk = sq + 128; LAS float* sv = sq + 256; LAS float* sp = sq + 512;
    const bf16* src = tid < 128 ? (const bf16*)(F.ws + WS_RQ) + (size_t)(b * SEQ) * 1024 + h * 128 + tid
                    : (tid < 256 ? (const bf16*)(F.ws + WS_RK) + (size_t)(b * SEQ) * 1024 + h * 128 + (tid - 128)
                                 : (const bf16*)(F.ws + WS_RV) + (size_t)(b * SEQ) * 2048 + h * 256 + (tid - 256));
    const size_t sstride = tid < 256 ? 1024 : 2048;
    bf16* OB = (bf16*)(F.ws + WS_OB) + (size_t)(b * SEQ) * 2048 + h * 256 + c;
    const float gamma = 1.0f - exp2f(-5.0f - (float)h);
    float S[64];
#pragma unroll
    for (int d = 0; d < 64; ++d) S[d] = 0.f;
    float nv = bf2f(src[0]);
    for (int t = 0; t < SEQ; ++t) {
        const float val = nv;
        if (t + 1 < SEQ) nv = bf2f(src[(size_t)(t + 1) * sstride]);
        if (tid < 128) sq[tid] = val; else if (tid < 256) sk[tid - 128] = val; else sv[tid - 256] = val;
        __syncthreads();
        const float vc = sv[c]; float o = 0.f;
#pragma unroll
        for (int d = 0; d < 64; ++d) { S[d] = gamma * S[d] + sk[hh * 64 + d] * vc; o += sq[hh * 64 + d] * S[d]; }
        sp[hh * 256 + c] = o;
        __syncthreads();
        if (hh == 0) OB[(size_t)t * 2048] = (bf16)f2bf(sp[c] + sp[256 + c]);
        __syncthreads();
    }
}

__device__ __forceinline__ void p3_mixed(Frame& F) {
    const int gw = F.vcu * NWAVES + F.wave, NGW = F.G * NWAVES, lane = F.lane;
    const bf16* OA = (const bf16*)(F.ws + WS_OA); const bf16* OB = (const bf16*)(F.ws + WS_OB);
    const bf16* GZA = (const bf16*)F.out; const bf16* GZB = GZA + (size_t)T * 2048; bf16* MIX = (bf16*)(F.ws + WS_MIXED);
    for (int row = gw; row < T; row += NGW) {
        const size_t off = (size_t)row * 2048 + 32 * lane;
        v4u a4[4], b4[4], ga[4], gb[4];
#pragma unroll
        for (int q = 0; q < 4; ++q) { a4[q] = *(const v4u*)(OA + off + 8 * q); b4[q] = *(const v4u*)(OB + off + 8 * q); ga[q] = *(const v4u*)(GZA + off + 8 * q); gb[q] = *(const v4u*)(GZB + off + 8 * q); }
        float a[32], bb[32];
#pragma unroll
        for (int q = 0; q < 4; ++q)
#pragma unroll
            for (int e = 0; e < 4; ++e) { a[8 * q + 2 * e] = bflo(a4[q][e]); a[8 * q + 2 * e + 1] = bfhi(a4[q][e]); bb[8 * q + 2 * e] = bflo(b4[q][e]); bb[8 * q + 2 * e + 1] = bfhi(b4[q][e]); }
        float sa = 0.f, sb = 0.f;
#pragma unroll
        for (int i = 0; i < 32; ++i) { sa += a[i] * a[i]; sb += bb[i]; }
        sa += __shfl_xor(sa, 1); sa += __shfl_xor(sa, 2); sa += __shfl_xor(sa, 4);
        sb += __shfl_xor(sb, 1); sb += __shfl_xor(sb, 2); sb += __shfl_xor(sb, 4);
        const float rsa = rsqrtf(sa * (1.0f / 256.0f) + EPS), mu = sb * (1.0f / 256.0f);
        float vb = 0.f;
#pragma unroll
        for (int i = 0; i < 32; ++i) { bb[i] -= mu; vb += bb[i] * bb[i]; }
        vb += __shfl_xor(vb, 1); vb += __shfl_xor(vb, 2); vb += __shfl_xor(vb, 4);
        const float rsb = rsqrtf(vb * (1.0f / 256.0f) + EPS);
        const float* wa = F.gdn_norm_w + ((32 * lane) & 255); const float* wb = F.ret_norm_w + 32 * lane;
#pragma unroll
        for (int q = 0; q < 4; ++q) { v4u o;
#pragma unroll
            for (int e = 0; e < 4; ++e) { const int i = 8 * q + 2 * e;
                const float m0 = a[i] * rsa * wa[i] * bflo(ga[q][e]) + bb[i] * rsb * wb[i] * bflo(gb[q][e]);
                const float m1 = a[i + 1] * rsa * wa[i + 1] * bfhi(ga[q][e]) + bb[i + 1] * rsb * wb[i + 1] * bfhi(gb[q][e]);
                o[e] = pk2(m0, m1); }
            *(v4u*)(MIX + off + 8 * q) = o; }
    }
}
__device__ __forceinline__ void row_rmsnorm(Frame& F, const float* src, const float* w, bf16* dst16, float* dst32) {
    const int gw = F.vcu * NWAVES + F.wave, NGW = F.G * NWAVES, lane = F.lane;
    f32x4 nw[8];
#pragma unroll
    for (int j = 0; j < 8; ++j) nw[j] = ((const f32x4*)w)[64 * j + lane];
    for (int row = gw; row < T; row += NGW) {
        const f32x4* xr = (const f32x4*)(src + (size_t)row * D) + lane;
        f32x4 v[8]; float ss = 0.f;
#pragma unroll
        for (int j = 0; j < 8; ++j) { v[j] = xr[64 * j]; ss += (v[j].x * v[j].x + v[j].y * v[j].y) + (v[j].z * v[j].z + v[j].w * v[j].w); }
        const float rstd = rsqrtf(wave_sum(ss) * (1.0f / D) + EPS);
        if (dst16) { v2u* o8 = (v2u*)(dst16 + (size_t)row * D) + lane;
#pragma unroll
            for (int j = 0; j < 8; ++j) { const f32x4 y = (v[j] * rstd) * nw[j]; v2u o; o.x = pk2(y.x, y.y); o.y = pk2(y.z, y.w); o8[64 * j] = o; } }
        else { f32x4* o = (f32x4*)(dst32 + (size_t)row * D) + lane;
#pragma unroll
            for (int j = 0; j < 8; ++j) o[64 * j] = (v[j] * rstd) * nw[j]; }
    }
}

__global__ void __launch_bounds__(NWAVES * 64, 2) fwd_kernel(Args args) {
    extern __shared__ __attribute__((aligned(16))) unsigned char lds[];
    Frame F;
    F.lds = (LAS unsigned char*)lds;
    F.tid = threadIdx.x; F.lane = F.tid & 63; F.wave = __builtin_amdgcn_readfirstlane(F.tid >> 6);
    F.G = gridDim.x; { const int bx = blockIdx.x; F.vcu = (F.G % 8 == 0) ? (bx % 8) * (F.G / 8) + bx / 8 : bx; }
    F.x = args.in[0]; F.norm1_w = args.in[1]; F.w_in = args.in[2]; F.conv_w = args.in[3]; F.a_log = args.in[4]; F.dt_bias = args.in[5]; F.gdn_norm_w = args.in[6];
    F.ret_norm_w = args.in[7]; F.w_out = args.in[8]; F.norm2_w = args.in[9]; F.w_gate = args.in[10]; F.w_up = args.in[11]; F.w_down = args.in[12]; F.norm_f_w = args.in[13];
    F.out = args.out; F.ws = args.ws;
    volatile LAS unsigned* MISC = (volatile LAS unsigned*)(F.lds + MISC_OFF);
    for (int u = F.tid; u < (LDS_BYTES - LDSCTL_OFF) / 4; u += NWAVES * 64) ((LAS unsigned*)(F.lds + LDSCTL_OFF))[u] = 0u;
    __syncthreads();
    const int lo = args.ph_lo, hi = args.ph_hi;
    const bool use_bar = (hi - lo) > 1;
    XcdBarrier bar; bar.bar = (unsigned*)(F.ws + WS_CTL) + CW_BAR; bar.x = 0; bar.st = nullptr;
    if (use_bar) bar = xcd_barrier_post((unsigned*)(F.ws + WS_CTL) + CW_BAR, MISC + 8);
#define IN(k) (lo <= (k) && (k) < hi)
#define SEAM(k) do { if (IN(k) && IN((k) + 1)) xcd_barrier(bar); } while (0)

    if (IN(0)) { p0_prologue(F); } SEAM(0);
    if (IN(1)) {
        pg8::Gemm g{(const pg8::bf16_t*)(F.ws + WS_U), (const pg8::bf16_t*)(F.ws + WS_W1T), T, N1, D}; pg8::StaticOrder S; S.init(T, N1, F.G, (int)blockIdx.x);
        pg8::EpiInProj E{(pg8::bf16_t*)(F.ws + WS_QKV), (pg8::bf16_t*)(F.ws + WS_RQ), (pg8::bf16_t*)(F.ws + WS_RK), (pg8::bf16_t*)(F.ws + WS_RV),
                         (pg8::bf16_t*)F.out, (pg8::bf16_t*)F.out + (size_t)T * 2048, (const float*)(F.ws + WS_COS), (const float*)(F.ws + WS_SIN)};
        pg8::gemm_phase<pg8::EpiInProj, pg8::StaticOrder, true, true>(F.lds, g, S, E);
    } SEAM(1);
    if (IN(2)) {
        const int bx = blockIdx.x;
        if (bx < 16) gdn_naive(F, bx); else if (bx < 32) ret_naive(F, bx - 16);
    } SEAM(2);
    if (IN(3)) { p3_mixed(F); } SEAM(3);
    if (IN(4)) {
        pg8::Gemm g{(const pg8::bf16_t*)(F.ws + WS_MIXED), (const pg8::bf16_t*)(F.ws + WS_WOT), T, D, D}; pg8::StaticOrder S; S.init(T, D, F.G, (int)blockIdx.x);
        pg8::EpiResF32 E{F.x, F.out, D};
        pg8::gemm_phase<pg8::EpiResF32, pg8::StaticOrder, true, true>(F.lds, g, S, E);
    } SEAM(4);
    if (IN(5)) { row_rmsnorm(F, F.out, F.norm2_w, (bf16*)(F.ws + WS_HNB), nullptr); } SEAM(5);
    if (IN(6)) {
        pg8::Gemm g{(const pg8::bf16_t*)(F.ws + WS_HNB), (const pg8::bf16_t*)(F.ws + WS_WGUT), T, NGU, D}; pg8::StaticOrder S; S.init(T, NGU, F.G, (int)blockIdx.x);
        pg8::EpiGateUp E{(pg8::bf16_t*)(F.ws + WS_ACT), FF, nullptr};
        pg8::gemm_phase<pg8::EpiGateUp, pg8::StaticOrder, true, true>(F.lds, g, S, E);
    } SEAM(6);
    if (IN(7)) {
        pg8::Gemm g{(const pg8::bf16_t*)(F.ws + WS_ACT), (const pg8::bf16_t*)(F.ws + WS_WDT), T, D, FF}; pg8::StaticOrder S; S.init(T, D, F.G, (int)blockIdx.x);
        pg8::EpiResF32 E{F.out, F.out, D};
        pg8::gemm_phase<pg8::EpiResF32, pg8::StaticOrder, true, true>(F.lds, g, S, E);
    } SEAM(7);
    if (IN(8)) { row_rmsnorm(F, F.out, F.norm_f_w, nullptr, F.out); }
#undef IN
#undef SEAM
}

extern "C" void kernel_launch(void* const* d_in, const int* in_sizes, int n_in, void* d_out, int out_size, void* d_ws, size_t ws_size, hipStream_t stream) {
    static int grid = 0;
    if (grid == 0) {
        if (n_in != 14 || in_sizes[0] != T * D || out_size != T * D || ws_size < WS_END) { fprintf(stderr, "kernel_launch: unexpected shapes: n_in %d in0 %d out %d ws %zu (need %zu)\n", n_in, n_in > 0 ? in_sizes[0] : -1, out_size, ws_size, (size_t)WS_END); grid = -1; return; }
        int dev = 0, cus = 0, per_cu = 0;
        if (hipGetDevice(&dev) != hipSuccess || hipDeviceGetAttribute(&cus, hipDeviceAttributeMultiprocessorCount, dev) != hipSuccess) { grid = -1; return; }
        if (hipFuncSetAttribute((const void*)fwd_kernel, hipFuncAttributeMaxDynamicSharedMemorySize, LDS_BYTES) != hipSuccess) { fprintf(stderr, "kernel_launch: hipFuncSetAttribute failed\n"); grid = -1; return; }
        if (hipOccupancyMaxActiveBlocksPerMultiprocessor(&per_cu, (const void*)fwd_kernel, NWAVES * 64, LDS_BYTES) != hipSuccess || per_cu < 1) { fprintf(stderr, "kernel_launch: occupancy query says %d blocks per CU\n", per_cu); per_cu = 1; }
        (void)hipGetLastError();
        grid = cus;
        if (grid > 256) grid = 256;
    }
    if (grid < 0) return;
    (void)hipMemsetAsync((char*)d_ws + WS_CTL, 0, CTL_ZERO_BYTES, stream);
    Args a{};
    for (int i = 0; i < 14; ++i) a.in[i] = (const float*)d_in[i];
    a.out = (float*)d_out; a.ws = (unsigned char*)d_ws;
#if MK_N_LAUNCHES == 1
    a.ph_lo = 0; a.ph_hi = NPHASES;
    hipLaunchKernelGGL(fwd_kernel, dim3(grid), dim3(NWAVES * 64), LDS_BYTES, stream, a);
#else
    for (int p = 0; p < NPHASES; ++p) { a.ph_lo = p; a.ph_hi = p + 1; hipLaunchKernelGGL(fwd_kernel, dim3(grid), dim3(NWAVES * 64), LDS_BYTES, stream, a); }
#endif
}
```

```cpp
#include <hip/hip_runtime.h>
#include <cstdio>
#include <cstdint>
namespace pg8 {
#define PG8_LAS __attribute__((address_space(3)))
typedef unsigned short bf16_t;
typedef short bf16x8 __attribute__((ext_vector_type(8)));
typedef float f32x4 __attribute__((ext_vector_type(4)));
typedef unsigned u32x4 __attribute__((ext_vector_type(4)));
constexpr int BM = 256, BK = 64, HALF = 128, HTB = HALF * BK * 2  , STAGE_BYTES = 8 * HTB, NXCD = 8, WGM = 8;

__host__ __device__ __forceinline__ int lds_byte(int r, int c) { const int st = (r >> 4) * 2 + (c >> 5), rr = r & 15, cc = c & 31, ob = rr * 64 + cc * 2; return st * 1024 + (ob ^ (((ob >> 9) & 1) << 5)); }
__host__ __device__ __forceinline__ void stage_rc(int b, int& R, int& C) { const int st = b / 1024, sb = b % 1024, swz = sb ^ (((sb >> 9) & 1) << 5); R = (st >> 1) * 16 + swz / 64; C = (st & 1) * 32 + (swz % 64) / 2; }
__host__ __device__ __forceinline__ int perm32(int rho) { const int n = rho >> 4, i = rho & 15; return 8 * (i >> 2) + 4 * n + (i & 3); }

struct Unit { int pm, pn, sw; };
struct Gemm { const bf16_t* A; const bf16_t* Bt; int M, N, K; };

struct StaticOrder {
    int nM, nN, nwg, G, c;
    __host__ __device__ void init(int M, int N, int G_, int c_) { nM = M / BM; nN = N / BM; nwg = nM * nN; G = G_; c = c_; }
    __host__ __device__ bool next(int i, Unit& u) const {
        const long L = (long)i * G + c; if (L >= nwg) return false;
        int wgid = (int)L; { const int q = nwg / NXCD, r = nwg % NXCD, xcd = wgid % NXCD, off = wgid / NXCD; wgid = (xcd < r ? xcd * (q + 1) : r * (q + 1) + (xcd - r) * q) + off; }
        const int nig = WGM * nN, gid = wgid / nig, fm = gid * WGM, gsz = (nM - fm) < WGM ? (nM - fm) : WGM;
        u.pm = fm + ((wgid % nig) % gsz); u.pn = (wgid % nig) / gsz; u.sw = 0; return true;
    }
    __device__ __forceinline__ void a_ready(const Unit&) const {}
    __device__ __forceinline__ void done(const Unit&) const {}
};
__device__ __forceinline__ unsigned cvt_pk_bf16(float lo, float hi) { unsigned r; asm volatile("v_cvt_pk_bf16_f32 %0, %1, %2" : "=v"(r) : "v"(lo), "v"(hi)); return r; }
typedef float f32x2 __attribute__((ext_vector_type(2)));
__device__ __forceinline__ u32x4 pack8(const f32x4& a, const f32x4& b) { u32x4 w; w.x = cvt_pk_bf16(a[0], a[1]); w.y = cvt_pk_bf16(a[2], a[3]); w.z = cvt_pk_bf16(b[0], b[1]); w.w = cvt_pk_bf16(b[2], b[3]); return w; }
typedef unsigned u32x2 __attribute__((ext_vector_type(2)));
__device__ __forceinline__ float fsigmoid(float x) { return __builtin_amdgcn_rcpf(1.0f + __expf(-x)); }
__device__ __forceinline__ float fsilu(float x) { return x * fsigmoid(x); }

struct InProjOrder : StaticOrder {
    __host__ __device__ bool next(int i, Unit& u) const { if (!StaticOrder::next(i, u)) return false; u.sw = ((u.pn >= 24 && u.pn < 32) || u.pn >= 64) ? 1 : 0; return true; }
};
struct EpiInProj {
    static constexpr bool PERM = true, AFTER_DRAIN = false;
    unsigned char* ws; bf16_t* gz;
    size_t oQKV, oRQf, oRKf, oRKTf, oRVTf, oCOS, oSIN, oCOS2, oSIN2;
    __device__ __forceinline__ void operator()(const f32x4 (&acc)[2][2][4][2], const Unit& u, int wr, int wc, int fr, int fq) const {
        asm volatile("" : "+v"(fr), "+v"(fq));
        bf16_t* const QKV = (bf16_t*)(ws + oQKV); bf16_t* const RQf = (bf16_t*)(ws + oRQf); bf16_t* const RKf = (bf16_t*)(ws + oRKf); bf16_t* const RKTf = (bf16_t*)(ws + oRKTf); bf16_t* const RVTf = (bf16_t*)(ws + oRVTf);
        bf16_t* const GZA = gz; bf16_t* const GZB = gz + (size_t)16384 * 2048;
        const float* const cosT = (const float*)(ws + oCOS); const float* const sinT = (const float*)(ws + oSIN); const float* const cosT2 = (const float*)(ws + oCOS2); const float* const sinT2 = (const float*)(ws + oSIN2);
        const int pn = u.pn, cw = wc * 32 + 8 * fq;
        if (pn < 16) {
            const int row0 = u.pm * BM + wr * 64 + fr, col0 = pn * 256 + cw;
#pragma unroll
            for (int ai = 0; ai < 2; ++ai)
#pragma unroll
                for (int m = 0; m < 4; ++m) { bf16_t* rowp = QKV + (size_t)(row0 + ai * HALF + m * 16) * 4096 + col0;
#pragma unroll
                    for (int bj = 0; bj < 2; ++bj) *(u32x4*)(rowp + bj * HALF) = pack8(acc[ai][bj][m][0], acc[ai][bj][m][1]); }
        } else if (pn < 24) {
            const bool isk = pn >= 20; bf16_t* base = isk ? RKf : RQf;
            const int row0 = u.pm * BM + wr * 64 + fr, tile = (pn - 16) & 3, head = 2 * tile + (cw >> 6), i0 = cw & 63;
            const float l2g = log2f(1.0f - exp2f(-5.0f - (float)head));
            const int td1 = i0 >> 5, s1 = (i0 >> 4) & 1, eg = (i0 >> 3) & 1;
#pragma unroll
            for (int ai = 0; ai < 2; ++ai)
#pragma unroll
                for (int m = 0; m < 4; ++m) { const int row = row0 + ai * HALF + m * 16, b = row >> 13, t = row & 8191, n = t >> 6, pos = t & 63;
                    const float sc = isk ? 0.08838834764831845f * exp2f(-(float)(pos + 1) * l2g) : exp2f((float)(pos + 1) * l2g);
                    const float* cp = cosT + t * 64 + i0; const float* sp = sinT + t * 64 + i0;
                    const f32x4 c0 = *(const f32x4*)cp, c1 = *(const f32x4*)(cp + 4), s0 = *(const f32x4*)sp, s1v = *(const f32x4*)(sp + 4);
                    const f32x4 x1a = acc[ai][0][m][0], x1b = acc[ai][0][m][1], x2a = acc[ai][1][m][0], x2b = acc[ai][1][m][1];
                    const f32x4 o1a = (x1a * c0 - x2a * s0) * sc, o1b = (x1b * c1 - x2b * s1v) * sc, o2a = (x2a * c0 + x1a * s0) * sc, o2b = (x2b * c1 + x1b * s1v) * sc;
                    const size_t f1 = ((((size_t)(b * 8 + head) * 128 + n) * 2 + (pos >> 5)) * 4 + td1) * 2 + s1;
                    bf16_t* p1 = base + f1 * 512 + (pos & 31) * 8 + eg * 4;
                    u32x2 w;
                    w.x = cvt_pk_bf16(o1a[0], o1a[1]); w.y = cvt_pk_bf16(o1a[2], o1a[3]); *(u32x2*)(p1) = w;
                    w.x = cvt_pk_bf16(o1b[0], o1b[1]); w.y = cvt_pk_bf16(o1b[2], o1b[3]); *(u32x2*)(p1 + 256) = w;
                    w.x = cvt_pk_bf16(o2a[0], o2a[1]); w.y = cvt_pk_bf16(o2a[2], o2a[3]); *(u32x2*)(p1 + 4 * 512) = w;
                    w.x = cvt_pk_bf16(o2b[0], o2b[1]); w.y = cvt_pk_bf16(o2b[2], o2b[3]); *(u32x2*)(p1 + 4 * 512 + 256) = w; }
        } else if (pn < 32) {
            const int head = pn - 24, b = u.pm >> 5, nbase = (u.pm & 31) * 4;
            const int tj = wc & 1, s1 = (fq >> 1) & 1, eg = fq & 1;
#pragma unroll
            for (int ai = 0; ai < 2; ++ai)
#pragma unroll
                for (int m = 0; m < 4; ++m) { const int dv = ai * HALF + wr * 64 + m * 16 + fr, sl = dv >> 5, col = dv & 31;
#pragma unroll
                    for (int bj = 0; bj < 2; ++bj) { const int n = nbase + 2 * bj + (wc >> 1);
                        const size_t f = ((((size_t)(b * 8 + head) * 128 + n) * 8 + sl) * 2 + tj) * 2 + s1;
                        bf16_t* p = RVTf + f * 512 + col * 8 + eg * 4;
#pragma unroll
                        for (int nn = 0; nn < 2; ++nn) { u32x2 w; w.x = cvt_pk_bf16(acc[ai][bj][m][nn][0], acc[ai][bj][m][nn][1]); w.y = cvt_pk_bf16(acc[ai][bj][m][nn][2], acc[ai][bj][m][nn][3]); *(u32x2*)(p + nn * 256) = w; } } }
        } else if (pn < 64) {
            const int row0 = u.pm * BM + wr * 64 + fr;
            bf16_t* base = pn < 48 ? GZA : GZB; const int col0 = ((pn - 32) & 15) * 128 + cw;
#pragma unroll
            for (int ai = 0; ai < 2; ++ai)
#pragma unroll
                for (int m = 0; m < 4; ++m) { bf16_t* rowp = base + (size_t)(row0 + ai * HALF + m * 16) * 2048 + col0; f32x4 o[2];
#pragma unroll
                    for (int n = 0; n < 2; ++n)
#pragma unroll
                        for (int j = 0; j < 4; ++j) o[n][j] = fsilu(acc[ai][0][m][n][j]) * fsigmoid(acc[ai][1][m][n][j]);
                    *(u32x4*)rowp = pack8(o[0], o[1]); }
        } else {
            const int tile = pn - 64, head = 2 * tile + wr, b = u.pm >> 5, nbase = (u.pm & 31) * 4, tbase = (u.pm & 31) * 256;
            const int tj = wc & 1, s1 = (fq >> 1) & 1, eg = fq & 1;
            const float l2g = log2f(1.0f - exp2f(-5.0f - (float)head));
#pragma unroll
            for (int bj = 0; bj < 2; ++bj) { const int n = nbase + 2 * bj + (wc >> 1), c0 = bj * HALF + wc * 32 + 8 * fq;
#pragma unroll
                for (int nn = 0; nn < 2; ++nn) { const int pos0 = (c0 + 4 * nn) & 63; f32x4 sc;
#pragma unroll
                    for (int j = 0; j < 4; ++j) sc[j] = 0.08838834764831845f * exp2f((float)(63 - pos0 - j) * l2g);
#pragma unroll
                    for (int m = 0; m < 4; ++m) { const int i = 16 * m + fr;
                        const f32x4 c = *(const f32x4*)(cosT2 + (size_t)i * 8192 + tbase + c0 + 4 * nn), s = *(const f32x4*)(sinT2 + (size_t)i * 8192 + tbase + c0 + 4 * nn);
                        const f32x4 x1 = acc[0][bj][m][nn], x2 = acc[1][bj][m][nn];
                        const f32x4 o1 = (x1 * c - x2 * s) * sc, o2 = (x2 * c + x1 * s) * sc;
                        const size_t f = ((((size_t)(b * 8 + head) * 128 + n) * 4 + (m >> 1)) * 2 + tj) * 2 + s1;
                        bf16_t* p = RKTf + f * 512 + (nn * 32 + 16 * (m & 1) + fr) * 8 + eg * 4;
                        u32x2 w; w.x = cvt_pk_bf16(o1[0], o1[1]); w.y = cvt_pk_bf16(o1[2], o1[3]); *(u32x2*)p = w;
                        w.x = cvt_pk_bf16(o2[0], o2[1]); w.y = cvt_pk_bf16(o2[2], o2[3]); *(u32x2*)(p + 8 * 512) = w; } } }
        }
    }
};
struct EpiGateUp {
    static constexpr bool PERM = true, AFTER_DRAIN = false;
    bf16_t* ACT; int ldc; const float* rstd;
    __device__ __forceinline__ void operator()(const f32x4 (&acc)[2][2][4][2], const Unit& u, int wr, int wc, int fr, int fq) const {
        const int row0 = u.pm * BM + wr * 64 + fr, col0 = u.pn * 128 + wc * 32 + 8 * fq;
#pragma unroll
        for (int ai = 0; ai < 2; ++ai)
#pragma unroll
            for (int m = 0; m < 4; ++m) { const int row = row0 + ai * HALF + m * 16; const float rs = rstd ? rstd[row] : 1.0f; f32x4 o[2];
#pragma unroll
                for (int n = 0; n < 2; ++n)
#pragma unroll
                    for (int j = 0; j < 4; ++j) o[n][j] = fsilu(acc[ai][0][m][n][j] * rs) * (acc[ai][1][m][n][j] * rs);
                *(u32x4*)(ACT + (size_t)row * ldc + col0) = pack8(o[0], o[1]); }
    }
};
struct EpiResF32 {
    static constexpr bool PERM = false, AFTER_DRAIN = false;
    const float* res; float* out; int ldc;
    __device__ __forceinline__ void operator()(const f32x4 (&acc)[2][2][4][2], const Unit& u, int wr, int wc, int fr, int fq) const {
        const int row0 = u.pm * BM + wr * 64 + fr, col0 = u.pn * BM + wc * 32 + 4 * fq;
#pragma unroll
        for (int ai = 0; ai < 2; ++ai)
#pragma unroll
            for (int m = 0; m < 4; ++m) { const size_t off = (size_t)(row0 + ai * HALF + m * 16) * ldc + col0;
#pragma unroll
                for (int bj = 0; bj < 2; ++bj)
#pragma unroll
                    for (int n = 0; n < 2; ++n) { const f32x4 r = *(const f32x4*)(res + off + bj * HALF + n * 16); *(f32x4*)(out + off + bj * HALF + n * 16) = r + acc[ai][bj][m][n]; } }
    }
};
template <class Epi, class Sched, bool ALIGN_EPI = false, bool SP2 = false>
__device__ __forceinline__ void gemm_phase(PG8_LAS unsigned char* lds, const Gemm g, const Sched& S, const Epi& E) {
    const int tid = threadIdx.x, wid = __builtin_amdgcn_readfirstlane(tid >> 6), lane = tid & 63, wr = wid >> 2, wc = wid & 3, fr = lane & 15, fq = lane >> 4;
    const int K = g.K, nt = K / BK;
    unsigned voffA[2], voffB[2];
#pragma unroll
    for (int i = 0; i < 2; ++i) { int R, C; stage_rc(tid * 16 + i * 8192, R, C); const int Rb = Epi::PERM ? ((R & ~31) + perm32(R & 31)) : R;
        voffA[i] = (unsigned)(R * K + C) * 2u; voffB[i] = (unsigned)(Rb * K + C) * 2u; }
    const size_t kstep = (size_t)(BK * 2);
    const size_t hstep = (size_t)HALF * K * 2;
    const size_t tstep = 2 * hstep;
    const unsigned ldsw = (unsigned)wid * 1024u;
    const int aoff = lds_byte(wr * 64 + fr, fq * 8), boff = lds_byte(wc * 32 + fr, fq * 8);
#define PG8_SA(b, h) (((b) * 2 + (h)) * HTB)
#define PG8_SB(b, h) ((4 + (b) * 2 + (h)) * HTB)
#define PG8_STAGE(bufoff, gbase, voff) do { _Pragma("unroll") for (int _i = 0; _i < 2; ++_i) \
        __builtin_amdgcn_global_load_lds((const unsigned*)((const char*)(gbase) + (voff)[_i]), (PG8_LAS unsigned*)(lds + (bufoff) + ldsw + _i * 8192), 16, 0, 0); } while (0)
#define PG8_LDA(dst, b, h) do { _Pragma("unroll") for (int m = 0; m < 4; ++m) _Pragma("unroll") for (int k = 0; k < 2; ++k) dst[m][k] = *(const PG8_LAS bf16x8*)(lds + PG8_SA(b, h) + aoff + m * 2048 + k * 1024); } while (0)
#define PG8_LDB(dst, b, h) do { _Pragma("unroll") for (int n = 0; n < 2; ++n) _Pragma("unroll") for (int k = 0; k < 2; ++k) dst[n][k] = *(const PG8_LAS bf16x8*)(lds + PG8_SB(b, h) + boff + n * 2048 + k * 1024); } while (0)
#define PG8_MMA(ai, bj, At, Bt) do { __builtin_amdgcn_s_setprio(1); _Pragma("unroll") for (int m = 0; m < 4; ++m) _Pragma("unroll") for (int n = 0; n < 2; ++n) _Pragma("unroll") for (int k = 0; k < 2; ++k) \
        acc[ai][bj][m][n] = __builtin_amdgcn_mfma_f32_16x16x32_bf16(Bt[n][k], At[m][k], acc[ai][bj][m][n], 0, 0, 0); __builtin_amdgcn_s_setprio(0); } while (0)
#define PG8_WAIT_V(n) asm volatile("s_waitcnt vmcnt(" #n ")" ::: "memory")
#define PG8_WAIT_L(n) asm volatile("s_waitcnt lgkmcnt(" #n ")" ::: "memory")
#define PG8_BAR __builtin_amdgcn_s_barrier()
#define PG8_SCHED __builtin_amdgcn_sched_barrier(0)
    Unit cur, nxt; int ui = 0;
    if (!S.next(0, cur)) return;
    f32x4 acc[2][2][4][2];
#pragma unroll
    for (int a = 0; a < 2; ++a)
#pragma unroll
        for (int b = 0; b < 2; ++b)
#pragma unroll
            for (int m = 0; m < 4; ++m)
#pragma unroll
                for (int n = 0; n < 2; ++n) acc[a][b][m][n] = (f32x4){0.f, 0.f, 0.f, 0.f};
    bf16x8 At[4][2], B0[2][2], B1[2][2];
#define PG8_UA(u) ((u).sw ? (const char*)g.Bt + (size_t)(u).pn * tstep : (const char*)g.A + (size_t)(u).pm * tstep)
#define PG8_UB(u) ((u).sw ? (const char*)g.A + (size_t)(u).pm * tstep : (const char*)g.Bt + (size_t)(u).pn * tstep)
    const char* cA = PG8_UA(cur); const char* cB = PG8_UB(cur);
    S.a_ready(cur);
    if constexpr (SP2) {
        PG8_STAGE(PG8_SB(0, 0), cB, voffB); PG8_STAGE(PG8_SB(0, 1), cB + hstep, voffB); PG8_STAGE(PG8_SA(0, 0), cA, voffA); PG8_STAGE(PG8_SA(0, 1), cA + hstep, voffA);
        if (wr == 1) PG8_BAR;
        PG8_WAIT_V(2); PG8_BAR;
        PG8_STAGE(PG8_SB(1, 0), cB + kstep, voffB); PG8_STAGE(PG8_SA(1, 0), cA + kstep, voffA); PG8_STAGE(PG8_SB(1, 1), cB + hstep + kstep, voffB);
        PG8_WAIT_V(6); PG8_BAR;
    } else {
        PG8_STAGE(PG8_SB(0, 0), cB, voffB); PG8_STAGE(PG8_SA(0, 0), cA, voffA); PG8_STAGE(PG8_SB(0, 1), cB + hstep, voffB); PG8_STAGE(PG8_SA(0, 1), cA + hstep, voffA);
        if (wr == 1) PG8_BAR;
        PG8_WAIT_V(4); PG8_BAR;
        PG8_STAGE(PG8_SB(1, 0), cB + kstep, voffB); PG8_STAGE(PG8_SA(1, 0), cA + kstep, voffA); PG8_STAGE(PG8_SB(1, 1), cB + hstep + kstep, voffB);
        PG8_WAIT_V(6); PG8_BAR;
    }
    for (;;) {
        const bool has_next = S.next(ui + 1, nxt);
        const char* nA = has_next ? PG8_UA(nxt) : cA; const char* nB = has_next ? PG8_UB(nxt) : cB;
        for (int t = 0; t < nt; t += 2) {
            const bool last = (t == nt - 2);
            const char* a1 = cA + (size_t)(t + 1) * kstep;
            const char* a2 = last ? nA : cA + (size_t)(t + 2) * kstep; const char* b2 = last ? nB : cB + (size_t)(t + 2) * kstep;
            const char* a3 = a2 + kstep; const char* b3 = b2 + kstep;
            if (last && has_next) S.a_ready(nxt);
            if constexpr (SP2) {
            PG8_LDB(B0, 0, 0); PG8_LDB(B1, 0, 1); PG8_SCHED; PG8_LDA(At, 0, 0); PG8_STAGE(PG8_SA(1, 1), a1 + hstep, voffA);
            PG8_WAIT_V(8); PG8_WAIT_L(0); PG8_BAR; PG8_MMA(0, 0, At, B0); PG8_MMA(0, 1, At, B1); PG8_BAR; PG8_SCHED;
            PG8_LDA(At, 0, 1); PG8_STAGE(PG8_SB(0, 0), b2, voffB); PG8_STAGE(PG8_SB(0, 1), b2 + hstep, voffB); PG8_STAGE(PG8_SA(0, 0), a2, voffA);
            PG8_WAIT_V(8); PG8_WAIT_L(0); PG8_BAR; PG8_MMA(1, 0, At, B0); PG8_MMA(1, 1, At, B1); PG8_BAR; PG8_SCHED;
            PG8_LDB(B0, 1, 0); PG8_LDB(B1, 1, 1); PG8_SCHED; PG8_LDA(At, 1, 0); PG8_STAGE(PG8_SA(0, 1), a2 + hstep, voffA);
            PG8_WAIT_V(8); PG8_WAIT_L(0); PG8_BAR; PG8_MMA(0, 0, At, B0); PG8_MMA(0, 1, At, B1); PG8_BAR; PG8_SCHED;
            PG8_LDA(At, 1, 1); PG8_STAGE(PG8_SB(1, 0), b3, voffB); PG8_STAGE(PG8_SB(1, 1), b3 + hstep, voffB); PG8_STAGE(PG8_SA(1, 0), a3, voffA);
            PG8_WAIT_V(8); PG8_WAIT_L(0); PG8_BAR; PG8_MMA(1, 0, At, B0); PG8_MMA(1, 1, At, B1); PG8_BAR; PG8_SCHED;
            } else {
            PG8_LDB(B0, 0, 0); PG8_SCHED; PG8_LDA(At, 0, 0); PG8_STAGE(PG8_SA(1, 1), a1 + hstep, voffA);
            PG8_WAIT_L(8); PG8_BAR; PG8_WAIT_L(0); PG8_MMA(0, 0, At, B0); PG8_BAR; PG8_SCHED;
            PG8_LDB(B1, 0, 1); PG8_STAGE(PG8_SB(0, 0), b2, voffB);
            PG8_BAR; PG8_WAIT_L(0); PG8_MMA(0, 1, At, B1); PG8_BAR;
            PG8_LDA(At, 0, 1); PG8_STAGE(PG8_SA(0, 0), a2, voffA);
            PG8_BAR; PG8_WAIT_L(0); PG8_MMA(1, 0, At, B0); PG8_BAR; PG8_SCHED;
            PG8_STAGE(PG8_SB(0, 1), b2 + hstep, voffB);
            PG8_WAIT_V(6); PG8_BAR; PG8_MMA(1, 1, At, B1); PG8_BAR;
            PG8_LDB(B0, 1, 0); PG8_SCHED; PG8_LDA(At, 1, 0); PG8_STAGE(PG8_SA(0, 1), a2 + hstep, voffA);
            PG8_WAIT_L(8); PG8_BAR; PG8_WAIT_L(0); PG8_MMA(0, 0, At, B0); PG8_BAR; PG8_SCHED;
            PG8_LDB(B1, 1, 1); PG8_STAGE(PG8_SB(1, 0), b3, voffB);
            PG8_BAR; PG8_WAIT_L(0); PG8_MMA(0, 1, At, B1); PG8_BAR;
            PG8_LDA(At, 1, 1); PG8_STAGE(PG8_SA(1, 0), a3, voffA);
            PG8_BAR; PG8_WAIT_L(0); PG8_MMA(1, 0, At, B0); PG8_BAR; PG8_SCHED;
            PG8_STAGE(PG8_SB(1, 1), b3 + hstep, voffB);
            PG8_WAIT_V(6); PG8_BAR; PG8_MMA(1, 1, At, B1); PG8_BAR;
            }
        }
        if constexpr (ALIGN_EPI) { if (wr == 0) PG8_BAR; }
        if constexpr (!Epi::AFTER_DRAIN) { E(acc, cur, wr, wc, fr, fq); S.done(cur); }
        if (!has_next) break;
#pragma unroll
        for (int a = 0; a < 2; ++a)
#pragma unroll
            for (int b = 0; b < 2; ++b)
#pragma unroll
                for (int m = 0; m < 4; ++m)
#pragma unroll
                    for (int n = 0; n < 2; ++n) acc[a][b][m][n] = (f32x4){0.f, 0.f, 0.f, 0.f};
        cur = nxt; cA = nA; cB = nB; ++ui;
        if constexpr (ALIGN_EPI) { if (wr == 1) PG8_BAR; }
    }
    PG8_WAIT_V(0);
    if constexpr (!ALIGN_EPI) { if (wr == 0) PG8_BAR; }
    PG8_BAR;
    if constexpr (Epi::AFTER_DRAIN) { E.fused(acc, cur, wr, wc, fr, fq, lds, wid, lane); S.done(cur); }
#undef PG8_UA
#undef PG8_UB
#undef PG8_SA
#undef PG8_SB
#undef PG8_STAGE
#undef PG8_LDA
#undef PG8_LDB
#undef PG8_MMA
#undef PG8_WAIT_V
#undef PG8_WAIT_L
#undef PG8_BAR
#undef PG8_SCHED
}
}
#define GAS __attribute__((address_space(1)))
#define LAS __attribute__((address_space(3)))
#define XB_TMO      128
#define XB_XCNT(j)  (256  + 64 * (j))
#define XB_XSUB(j)  (1280 + 64 * (j))
#define XB_XGEN(j)  (2304 + 64 * (j))
#define XB_TOP      3328
#define XB_TOPGEN   3392
#define XCD_BAR_WORDS 3456
#define XB_SPIN_CAP (1u << 18)

__device__ __forceinline__ unsigned xb_ld(unsigned* p)              { return __hip_atomic_load(p, __ATOMIC_RELAXED, __HIP_MEMORY_SCOPE_AGENT); }
__device__ __forceinline__ unsigned xb_add(unsigned* p, unsigned v) { return __hip_atomic_fetch_add(p, v, __ATOMIC_RELAXED, __HIP_MEMORY_SCOPE_AGENT); }
__device__ __forceinline__ unsigned xb_xcc_id() { return (unsigned)__builtin_amdgcn_s_getreg((3 << 11) | 20) & 0xFu; }
#define XB_SPIN(cond, bar) do { unsigned _sp = 0; while (cond) { __builtin_amdgcn_s_sleep(1); \
    if ((++_sp & 255u) == 0u) { if (xb_ld(&(bar)[XB_TMO])) break; if (_sp > XB_SPIN_CAP) { atomicAdd(&(bar)[XB_TMO], 1u); break; } } } } while (0)

struct XcdBarrier {
    unsigned* bar; unsigned x;
    volatile LAS unsigned* st;
};

__device__ __forceinline__ XcdBarrier xcd_barrier_post(unsigned* bar, volatile LAS unsigned* st) {
    XcdBarrier b; b.bar = bar; b.x = xb_xcc_id(); b.st = st;
    if (threadIdx.x == 0) (void)xb_add(&bar[XB_XCNT(b.x)], 1u);
    return b;
}
__device__ __forceinline__ void xcd_barrier_complete(unsigned* bar, unsigned x, unsigned& nloc, unsigned& nx) {
    const unsigned G = gridDim.x * gridDim.y * gridDim.z;
    unsigned sum, cnt, mine, sp = 0u;
    for (;;) {
        sum = 0u; cnt = 0u; mine = 0u;
#pragma unroll
        for (unsigned j = 0; j < 16; ++j) { const unsigned c = xb_ld(&bar[XB_XCNT(j)]); sum += c; cnt += (c > 0u) ? 1u : 0u; mine = (j == x) ? c : mine; }
        if (sum == G) break;
        __builtin_amdgcn_s_sleep(1);
        if ((++sp & 255u) == 0u) { if (xb_ld(&bar[XB_TMO])) break; if (sp > XB_SPIN_CAP) { atomicAdd(&bar[XB_TMO], 1u); break; } }
    }
    nloc = mine > 0u ? mine : 1u; nx = cnt > 0u ? cnt : 1u;
}

__device__ __forceinline__ void xcd_barrier(const XcdBarrier& b) {
    asm volatile("s_waitcnt vmcnt(0)" ::: "memory");
    __syncthreads();
    if (threadIdx.x == 0) {
        unsigned* bar = b.bar;
        __builtin_amdgcn_s_waitcnt(0);
        unsigned nloc = b.st[0], nx = b.st[1];
        if (nloc == 0u) { xcd_barrier_complete(bar, b.x, nloc, nx); b.st[0] = nloc; b.st[1] = nx; }
        const unsigned old = xb_add(&bar[XB_XSUB(b.x)], 1u);
        const unsigned gen = old / nloc;
        if (old + 1u == (gen + 1u) * nloc) {
            __builtin_amdgcn_fence(__ATOMIC_RELEASE, "agent");
            asm volatile("s_waitcnt vmcnt(0)" ::: "memory");
            const unsigned og = xb_add(&bar[XB_TOP], 1u);
            const unsigned tg = og / nx;
            if (og + 1u == (tg + 1u) * nx) xb_add(&bar[XB_TOPGEN], 1u);
            else XB_SPIN(xb_ld(&bar[XB_TOPGEN]) == tg, bar);
            __builtin_amdgcn_fence(__ATOMIC_ACQUIRE, "agent");
            xb_add(&bar[XB_XGEN(b.x)], 1u);
            asm volatile("s_waitcnt vmcnt(0)" ::: "memory");
        } else {
            XB_SPIN(xb_ld(&bar[XB_XGEN(b.x)]) == gen, bar);
            __builtin_amdgcn_fence(__ATOMIC_ACQUIRE, "agent");
            asm volatile("s_waitcnt vmcnt(0)" ::: "memory");
        }
    }
    __syncthreads();
}
#ifndef MK_N_LAUNCHES
#define MK_N_LAUNCHES 1
#endif
constexpr int NWAVES = 8;
constexpr int NPHASES = 10;
constexpr int BATCH = 2, SEQ = 8192, D = 2048, T = BATCH * SEQ;
constexpr int NH = 8, DK = 128, DV = 256;
constexpr int NIN = 16400;
constexpr int OFF_AZ = 4096, OFF_AB = 6144, OFF_RQ = 6160, OFF_RK = 7184, OFF_RV = 8208, OFF_RG = 10256, OFF_GA = 12304, OFF_GB = 14352;
constexpr int N1 = 17408;
constexpr int FF = 5632, NGU = 2 * FF;
constexpr float EPS = 1e-6f;
constexpr size_t MiB = 1u << 20;
constexpr size_t WS_CTL = 0, CTL_ZERO_BYTES = 1 * MiB;
constexpr size_t WS_BETA = 1 * MiB, WS_G = 1 * MiB + 512 * 1024;
constexpr size_t WS_COS = 2 * MiB, WS_SIN = 4 * MiB;
constexpr size_t WS_COS2 = 6 * MiB, WS_SIN2 = 8 * MiB;
constexpr size_t WS_DL = 10 * MiB, WS_RSTD = 11 * MiB;
constexpr size_t WS_WOT = 12 * MiB;
constexpr size_t WS_WGUT = 20 * MiB, WS_WDT = 64 * MiB;
constexpr size_t WS_W1T = 20 * MiB, WS_U = 88 * MiB;
constexpr size_t WS_GW = 20 * MiB, WS_GQ = 52 * MiB, WS_GK = 84 * MiB, WS_GA = 116 * MiB, WS_GU = 132 * MiB;
constexpr size_t WS_QKV = 196 * MiB;
constexpr size_t WS_RQF = 324 * MiB, WS_RKF = 356 * MiB, WS_RKTF = 388 * MiB, WS_RVTF = 420 * MiB, WS_END = 484 * MiB;
constexpr size_t WS_OA = 196 * MiB;
constexpr size_t WS_OB = 260 * MiB;
constexpr size_t WS_MIXED = 132 * MiB;
constexpr size_t WS_HNB = 324 * MiB;
constexpr size_t WS_ACT = 88 * MiB;
static_assert(WS_ACT + (size_t)T * FF * 2 <= WS_HNB, "ACT overlay");
constexpr int CW_BAR = 4096;
constexpr int RING_BYTES = 131072, LDSCTL_OFF = RING_BYTES, MISC_OFF = LDSCTL_OFF + 320, LDS_BYTES = 147456;

typedef unsigned short bf16;
typedef unsigned v4u __attribute__((ext_vector_type(4)));
typedef unsigned v2u __attribute__((ext_vector_type(2)));
typedef float f32x4 __attribute__((ext_vector_type(4)));
#define LDS_WAIT() asm volatile("s_waitcnt lgkmcnt(0)" ::: "memory")
__device__ __forceinline__ unsigned f2bf(float f) { unsigned u = __builtin_bit_cast(unsigned, f); return (u + 0x7fffu + ((u >> 16) & 1u)) >> 16; }
__device__ __forceinline__ unsigned pk2(float lo, float hi) { return f2bf(lo) | (f2bf(hi) << 16); }
__device__ __forceinline__ float bf2f(unsigned b) { return __builtin_bit_cast(float, b << 16); }
__device__ __forceinline__ float bflo(unsigned w) { return __builtin_bit_cast(float, w << 16); }
__device__ __forceinline__ float bfhi(unsigned w) { return __builtin_bit_cast(float, w & 0xffff0000u); }
__device__ __forceinline__ float silu_f(float a) { return a * __builtin_amdgcn_rcpf(1.0f + __expf(-a)); }
__device__ __forceinline__ float wave_sum(float v) {
#pragma unroll
    for (int o = 1; o < 64; o <<= 1) v += __shfl_xor(v, o);
    return v;
}

struct Args { const float* in[14]; float* out; unsigned char* ws; int ph_lo, ph_hi; };
struct Frame {
    LAS unsigned char* lds; int tid, lane, wave, vcu, G;
    const float *x, *norm1_w, *w_in, *conv_w, *a_log, *dt_bias, *gdn_norm_w, *ret_norm_w, *w_out, *norm2_w, *w_gate, *w_up, *w_down, *norm_f_w;
    float* out; unsigned char* ws;
};

__device__ __forceinline__ void transpose_blk(const float* src, int ld, int k0, int sc0, bf16* dst, int K, int dr0, LAS float* scr, int lane) {
#pragma unroll 8
    for (int i = 0; i < 32; ++i) { const int kk = 2 * i + (lane >> 5); scr[kk * 33 + (lane & 31)] = src[(size_t)(k0 + kk) * ld + sc0 + (lane & 31)]; }
    LDS_WAIT(); asm volatile("" ::: "memory");
    const int c = lane & 7;
#pragma unroll
    for (int j = 0; j < 4; ++j) { const int n = (lane >> 3) + 8 * j; const LAS float* s = scr + (8 * c) * 33 + n;
        v4u o; o.x = pk2(s[0 * 33], s[1 * 33]); o.y = pk2(s[2 * 33], s[3 * 33]); o.z = pk2(s[4 * 33], s[5 * 33]); o.w = pk2(s[6 * 33], s[7 * 33]);
        *(v4u*)(dst + (size_t)(dr0 + n) * K + k0 + 8 * c) = o; }
    LDS_WAIT(); asm volatile("" ::: "memory");
}
__device__ __forceinline__ int w1_src_col(int n) {
    if (n < 4096) return n;
    if (n >= 16384) n = n - 16384 + 5120;
    if (n < 6144) { const int isk = n >= 5120, lt = (n - 4096) & 1023, tile = lt >> 8, c = lt & 255, bj = c >> 7, p = c & 127; return (isk ? OFF_RK : OFF_RQ) + (2 * tile + (p >> 6)) * 128 + bj * 64 + (p & 63); }
    if (n < 8192) return OFF_RV + (n - 6144);
    { const int isb = n >= 12288, lt = (n - 8192) & 4095, j = lt >> 8, c = lt & 255, bj = c >> 7, p = c & 127;
      return (isb ? (bj ? OFF_GB : OFF_RG) : (bj ? OFF_GA : OFF_AZ)) + 128 * j + p; }
}
__device__ __forceinline__ void p0_prologue(Frame& F) {
    const int gw = F.vcu * NWAVES + F.wave, NGW = F.G * NWAVES, lane = F.lane;
    {
        LAS float* scr = (LAS float*)(F.lds + F.wave * 16384);
        constexpr int I_1 = (D / 64) * (N1 / 32), I_O = (D / 64) * (D / 32);
        constexpr int NITEMS = I_1 + I_O;
        bf16* W1T = (bf16*)(F.ws + WS_W1T); bf16* WOT = (bf16*)(F.ws + WS_WOT);
        for (int it = gw; it < NITEMS; it += NGW) {
            int r = it;
            if (r < I_1) { const int nb = r % (N1 / 32), kb = r / (N1 / 32); transpose_blk(F.w_in, NIN, 64 * kb, w1_src_col(32 * nb), W1T, D, 32 * nb, scr, lane); continue; } r -= I_1;
            { const int nb = r % (D / 32), kb = r / (D / 32); transpose_blk(F.w_out, D, 64 * kb, 32 * nb, WOT, D, 32 * nb, scr, lane); }
        }
    }
    {
        float* cosT = (float*)(F.ws + WS_COS); float* sinT = (float*)(F.ws + WS_SIN); float* cosT2 = (float*)(F.ws + WS_COS2); float* sinT2 = (float*)(F.ws + WS_SIN2);
        for (int idx = (F.vcu * 512 + F.tid); idx < SEQ * 64; idx += F.G * 512) { const int t = idx >> 6, i = idx & 63;
            const float inv = (float)exp2(-(double)i * (13.287712379549449 / 64.0));
            const float ang = (float)t * inv; const double a = (double)ang; const float cv = (float)cos(a), sv = (float)sin(a);
            cosT[idx] = cv; sinT[idx] = sv; cosT2[i * SEQ + t] = cv; sinT2[i * SEQ + t] = sv; }
    }
    __syncthreads();
    {
        LAS float* wT = (LAS float*)F.lds;
        for (int idx = F.tid; idx < 2048 * 16; idx += 512) { const int k = idx >> 4, c = idx & 15; wT[c * 2048 + k] = F.w_in[(size_t)k * NIN + OFF_AB + c]; }
        __syncthreads();
        bf16* U = (bf16*)(F.ws + WS_U); float* BETA = (float*)(F.ws + WS_BETA); float* GG = (float*)(F.ws + WS_G);
        f32x4 nw[8];
#pragma unroll
        for (int j = 0; j < 8; ++j) nw[j] = ((const f32x4*)F.norm1_w)[64 * j + lane];
        for (int row = gw; row < T; row += NGW) {
            asm volatile("" ::: "memory");
            const f32x4* xr = (const f32x4*)(F.x + (size_t)row * D) + lane;
            f32x4 v[8]; float ss = 0.f;
#pragma unroll
            for (int j = 0; j < 8; ++j) { v[j] = xr[64 * j]; ss += (v[j].x * v[j].x + v[j].y * v[j].y) + (v[j].z * v[j].z + v[j].w * v[j].w); }
            const float rstd = rsqrtf(wave_sum(ss) * (1.0f / D) + EPS);
            v2u* o8 = (v2u*)(U + (size_t)row * D) + lane;
#pragma unroll
            for (int j = 0; j < 8; ++j) { v[j] = (v[j] * rstd) * nw[j]; v2u w; w.x = pk2(v[j].x, v[j].y); w.y = pk2(v[j].z, v[j].w); o8[64 * j] = w; }
            float mb = 0.f, ma = 0.f;
#pragma unroll
            for (int c = 0; c < 16; ++c) { float s = 0.f;
#pragma unroll
                for (int j = 0; j < 8; ++j) { const f32x4 w = *(const LAS f32x4*)(wT + c * 2048 + 256 * j + 4 * lane); s += (v[j].x * w.x + v[j].y * w.y) + (v[j].z * w.z + v[j].w * w.w); }
                s = wave_sum(s);
                if (c < 8) mb = (lane == c) ? s : mb; else ma = (lane == c - 8) ? s : ma; }
            if (lane < 8) { const float bt = 1.0f / (1.0f + expf(-mb)); const float xa = ma + F.dt_bias[lane]; const float sp = xa > 20.f ? xa : log1pf(expf(xa));
                BETA[(size_t)row * 8 + lane] = bt; GG[(size_t)row * 8 + lane] = -expf(F.a_log[lane]) * sp; }
        }
    }
}

__device__ __forceinline__ void gdn_naive(Frame& F, int bh) {
    const int b = bh >> 3, h = bh & 7, tid = F.tid, c = tid & 255, hh = tid >> 8;
    LAS float* sq = (LAS float*)F.lds; LAS float* sk = sq + 128; LAS float* sv = sq + 256; LAS float* sp = sq + 512; LAS float* sred = sq + 1024;
    const int ch = tid < 128 ? h * 128 + tid : (tid < 256 ? 1024 + h * 128 + (tid - 128) : 2048 + h * 256 + (tid - 256));
    const float cw0 = F.conv_w[0 * 4096 + ch], cw1 = F.conv_w[1 * 4096 + ch], cw2 = F.conv_w[2 * 4096 + ch], cw3 = F.conv_w[3 * 4096 + ch];
    const bf16* raw = (const bf16*)(F.ws + WS_QKV) + (size_t)(b * SEQ) * 4096 + ch;
    const float* BETA = (const float*)(F.ws + WS_BETA) + (size_t)(b * SEQ) * 8 + h; const float* GG = (const float*)(F.ws + WS_G) + (size_t)(b * SEQ) * 8 + h;
    bf16* OA = (bf16*)(F.ws + WS_OA) + (size_t)(b * SEQ) * 2048 + h * 256 + c;
    float S[64];
#pragma unroll
    for (int d = 0; d < 64; ++d) S[d] = 0.f;
    float r0 = 0.f, r1 = 0.f, r2 = 0.f;
    float nraw = bf2f(raw[0]), nbeta = BETA[0], ng = GG[0];
    for (int t = 0; t < SEQ; ++t) {
        const float r3 = nraw, beta = nbeta, eg = expf(ng);
        if (t + 1 < SEQ) { nraw = bf2f(raw[(size_t)(t + 1) * 4096]); nbeta = BETA[(size_t)(t + 1) * 8]; ng = GG[(size_t)(t + 1) * 8]; }
        const float a = r0 * cw0 + r1 * cw1 + r2 * cw2 + r3 * cw3; r0 = r1; r1 = r2; r2 = r3;
        float val = a / (1.0f + expf(-a));
        const float ws_ = wave_sum(val * val);
        if (F.lane == 0) sred[F.wave] = ws_;
        __syncthreads();
        if (tid < 128) { val = val * rsqrtf(sred[0] + sred[1] + EPS) * 0.08838834764831845f; sq[tid] = val; }
        else if (tid < 256) { val = val * rsqrtf(sred[2] + sred[3] + EPS); sk[tid - 128] = val; }
        else sv[tid - 256] = val;
        __syncthreads();
        float p = 0.f;
#pragma unroll
        for (int d = 0; d < 64; ++d) p += sk[hh * 64 + d] * S[d];
        sp[hh * 256 + c] = p;
        __syncthreads();
        const float kS = sp[c] + sp[256 + c];
        const float delta = beta * (sv[c] - eg * kS);
        float o = 0.f;
#pragma unroll
        for (int d = 0; d < 64; ++d) { S[d] = eg * S[d] + sk[hh * 64 + d] * delta; o += sq[hh * 64 + d] * S[d]; }
        __syncthreads();
        sp[hh * 256 + c] = o;
        __syncthreads();
        if (hh == 0) OA[(size_t)t * 2048] = (bf16)f2bf(sp[c] + sp[256 + c]);
    }
}
__device__ __forceinline__ void ffn_weight_copies(Frame& F) {
    const int gw = F.vcu * NWAVES + F.wave, NGW = F.G * NWAVES, lane = F.lane;
    LAS float* scr = (LAS float*)(F.lds + F.wave * 16384);
    constexpr int I_G = (D / 64) * (FF / 32), I_D = (FF / 64) * (D / 32);
    bf16* WGUT = (bf16*)(F.ws + WS_WGUT); bf16* WDT = (bf16*)(F.ws + WS_WDT);
    for (int it = gw; it < 2 * I_G + I_D; it += NGW) {
        int r = it;
        if (r < 2 * I_G) { const int up = r >= I_G; if (up) r -= I_G; const int nb = r % (FF / 32), kb = r / (FF / 32), c0 = 32 * nb;
            transpose_blk(up ? F.w_up : F.w_gate, FF, 64 * kb, c0, WGUT, D, 256 * (c0 >> 7) + 128 * up + (c0 & 127), scr, lane); continue; } r -= 2 * I_G;
        { const int nb = r % (D / 32), kb = r / (D / 32); transpose_blk(F.w_down, D, 64 * kb, 32 * nb, WDT, FF, 32 * nb, scr, lane); }
    }
}

typedef float f32x16 __attribute__((ext_vector_type(16)));
typedef short bf16x8 __attribute__((ext_vector_type(8)));
typedef float f32x2_t __attribute__((ext_vector_type(2))); typedef __bf16 bf16x2_t __attribute__((ext_vector_type(2)));
#define MFMA32(a, b, c) __builtin_amdgcn_mfma_f32_32x32x16_bf16((a), (b), (c), 0, 0, 0)
__device__ __forceinline__ unsigned cvtpk_s(float lo, float hi) { f32x2_t v = {lo, hi}; bf16x2_t b = __builtin_convertvector(v, bf16x2_t); return __builtin_bit_cast(unsigned, b); }
#define PACK_STEP(x, s) __builtin_bit_cast(bf16x8, (v4u){cvtpk_s((x)[8 * (s)], (x)[8 * (s) + 1]), cvtpk_s((x)[8 * (s) + 2], (x)[8 * (s) + 3]), cvtpk_s((x)[8 * (s) + 4], (x)[8 * (s) + 5]), cvtpk_s((x)[8 * (s) + 6], (x)[8 * (s) + 7])})
__device__ __forceinline__ bf16x8 ldfrag(const bf16* base, size_t f, int lane) { return *(const bf16x8*)(base + f * 512 + lane * 8); }
__device__ __forceinline__ f32x16 zero16() { f32x16 z; for (int i = 0; i < 16; ++i) z[i] = 0.f; return z; }

__device__ __forceinline__ void ret_scan(Frame& F, int item) {
    const int lane = F.lane, sl = item & 7, bh = item >> 3, b = bh >> 3, h = bh & 7, col = lane & 31, hh = lane >> 5;
    const bf16* RQf = (const bf16*)(F.ws + WS_RQF); const bf16* RKf = (const bf16*)(F.ws + WS_RKF); const bf16* RKTf = (const bf16*)(F.ws + WS_RKTF); const bf16* RVTf = (const bf16*)(F.ws + WS_RVTF);
    bf16* OB = (bf16*)(F.ws + WS_OB) + (size_t)(b * SEQ) * 2048 + h * 256 + sl * 32 + col;
    const float g64 = exp2f(64.0f * log2f(1.0f - exp2f(-5.0f - (float)h)));
    f32x16 S[4];
#pragma unroll
    for (int td = 0; td < 4; ++td) S[td] = zero16();
    for (int n = 0; n < 128; ++n) {
        const size_t cq = (size_t)bh * 128 + n;
        bf16x8 vt[2][2];
#pragma unroll
        for (int tj = 0; tj < 2; ++tj)
#pragma unroll
            for (int s = 0; s < 2; ++s) vt[tj][s] = ldfrag(RVTf, ((cq * 8 + sl) * 2 + tj) * 2 + s, lane);
        f32x16 P00 = zero16(), P01 = zero16(), P11 = zero16();
#pragma unroll
        for (int td = 0; td < 4; ++td)
#pragma unroll
            for (int s = 0; s < 2; ++s) {
                const bf16x8 k0 = ldfrag(RKf, ((cq * 2 + 0) * 4 + td) * 2 + s, lane), k1 = ldfrag(RKf, ((cq * 2 + 1) * 4 + td) * 2 + s, lane);
                const bf16x8 q0 = ldfrag(RQf, ((cq * 2 + 0) * 4 + td) * 2 + s, lane), q1 = ldfrag(RQf, ((cq * 2 + 1) * 4 + td) * 2 + s, lane);
                P00 = MFMA32(k0, q0, P00); P01 = MFMA32(k0, q1, P01); P11 = MFMA32(k1, q1, P11); }
#pragma unroll
        for (int r = 0; r < 16; ++r) { const int j = (r & 3) + 8 * (r >> 2) + 4 * hh; if (col < j) { P00[r] = 0.f; P11[r] = 0.f; } }
        asm volatile("" ::: "memory");
        f32x16 o0 = zero16(), o1 = zero16();
#pragma unroll
        for (int td = 0; td < 4; ++td) {
            const bf16x8 sb0 = PACK_STEP(S[td], 0), sb1 = PACK_STEP(S[td], 1);
            const bf16x8 q00 = ldfrag(RQf, ((cq * 2 + 0) * 4 + td) * 2 + 0, lane), q01 = ldfrag(RQf, ((cq * 2 + 0) * 4 + td) * 2 + 1, lane);
            const bf16x8 q10 = ldfrag(RQf, ((cq * 2 + 1) * 4 + td) * 2 + 0, lane), q11 = ldfrag(RQf, ((cq * 2 + 1) * 4 + td) * 2 + 1, lane);
            o0 = MFMA32(q00, sb0, o0); o0 = MFMA32(q01, sb1, o0); o1 = MFMA32(q10, sb0, o1); o1 = MFMA32(q11, sb1, o1); }
        asm volatile("" ::: "memory");
        { const bf16x8 a0 = PACK_STEP(P00, 0), a1 = PACK_STEP(P00, 1); o0 = MFMA32(a0, vt[0][0], o0); o0 = MFMA32(a1, vt[0][1], o0); }
        { const bf16x8 a0 = PACK_STEP(P01, 0), a1 = PACK_STEP(P01, 1); o1 = MFMA32(a0, vt[0][0], o1); o1 = MFMA32(a1, vt[0][1], o1); }
        { const bf16x8 a0 = PACK_STEP(P11, 0), a1 = PACK_STEP(P11, 1); o1 = MFMA32(a0, vt[1][0], o1); o1 = MFMA32(a1, vt[1][1], o1); }
        asm volatile("" ::: "memory");
        bf16* orow = OB + (size_t)(64 * n) * 2048;
#pragma unroll
        for (int r = 0; r < 16; ++r) { const int pos = (r & 3) + 8 * (r >> 2) + 4 * hh; orow[(size_t)pos * 2048] = (bf16)f2bf(o0[r]); orow[(size_t)(32 + pos) * 2048] = (bf16)f2bf(o1[r]); }
        asm volatile("" ::: "memory");
#pragma unroll
        for (int td = 0; td < 4; ++td) { S[td] = S[td] * g64;
#pragma unroll
            for (int tj = 0; tj < 2; ++tj)
#pragma unroll
                for (int s = 0; s < 2; ++s) S[td] = MFMA32(ldfrag(RKTf, ((cq * 4 + td) * 2 + tj) * 2 + s, lane), vt[tj][s], S[td]); }
    }
}

constexpr int GP_QH = 0, GP_KH = 17408, GP_AM = 34816, GP_RK = 51200, GP_GC = 83968, GP_BT = 84224, GP_WL = GP_RK;
__device__ __forceinline__ void gdn_prep(Frame& F, int ci) {
    int tid_ = F.tid; asm volatile("" : "+v"(tid_));
    const int tid = tid_, lane = tid & 63, w = __builtin_amdgcn_readfirstlane(tid >> 6), bh = ci >> 7, n = ci & 127, b = bh >> 3, h = bh & 7;
    const size_t trow0 = (size_t)b * SEQ + 64 * n;
    LAS unsigned char* L = F.lds;
    LAS float* gcs = (LAS float*)(L + GP_GC); LAS float* bet = (LAS float*)(L + GP_BT); LAS float* Am = (LAS float*)(L + GP_AM); LAS float* Rk = (LAS float*)(L + GP_RK);
    const bf16* QKV = (const bf16*)(F.ws + WS_QKV);
    bf16* GW = (bf16*)(F.ws + WS_GW); bf16* GQ = (bf16*)(F.ws + WS_GQ); bf16* GK = (bf16*)(F.ws + WS_GK); bf16* GA = (bf16*)(F.ws + WS_GA); bf16* GU = (bf16*)(F.ws + WS_GU);
    if (w == 0) {
        float g = ((const float*)(F.ws + WS_G))[(trow0 + lane) * 8 + h];
#pragma unroll
        for (int o = 1; o < 64; o <<= 1) { const float t = __shfl_up(g, o); if (lane >= o) g += t; }
        gcs[lane] = g; bet[lane] = ((const float*)(F.ws + WS_BETA))[(trow0 + lane) * 8 + h];
        if (lane == 63) ((float*)(F.ws + WS_DL))[ci] = expf(g);
    }
    __syncthreads();
    {
        const int cg = lane & 31, rh = lane >> 5, isk = cg >> 4, dk0 = 8 * (cg & 15), row0 = 8 * w + 4 * rh;
        const int ch = (isk ? 1024 : 0) + h * 128 + dk0;
        float cw[4][8];
#pragma unroll
        for (int j = 0; j < 4; ++j) { const f32x4 a = *(const f32x4*)(F.conv_w + j * 4096 + ch), c = *(const f32x4*)(F.conv_w + j * 4096 + ch + 4);
            cw[j][0] = a.x; cw[j][1] = a.y; cw[j][2] = a.z; cw[j][3] = a.w; cw[j][4] = c.x; cw[j][5] = c.y; cw[j][6] = c.z; cw[j][7] = c.w; }
        float raw[7][8];
#pragma unroll
        for (int rr = 0; rr < 7; ++rr) { const int row = row0 - 3 + rr;
            v4u v = {0u, 0u, 0u, 0u};
            if (n > 0 || row >= 0) v = *(const v4u*)(QKV + (trow0 + row) * 4096 + ch);
#pragma unroll
            for (int e = 0; e < 4; ++e) { raw[rr][2 * e] = bflo(v[e]); raw[rr][2 * e + 1] = bfhi(v[e]); } }
        const float g63 = gcs[63];
#pragma unroll
        for (int r = 0; r < 4; ++r) { asm volatile("" ::: "memory"); const int row = row0 + r; float val[8]; float ss = 0.f;
#pragma unroll
            for (int e = 0; e < 8; ++e) { const float a = raw[r][e] * cw[0][e] + raw[r + 1][e] * cw[1][e] + raw[r + 2][e] * cw[2][e] + raw[r + 3][e] * cw[3][e];
                val[e] = silu_f(a); ss += val[e] * val[e]; }
            ss += __shfl_xor(ss, 1); ss += __shfl_xor(ss, 2); ss += __shfl_xor(ss, 4); ss += __shfl_xor(ss, 8);
            const float rn = rsqrtf(ss + EPS) * (isk ? 1.0f : 0.08838834764831845f);
            const float gc = gcs[row], eg = __expf(gc);
#pragma unroll
            for (int e = 0; e < 8; ++e) val[e] *= rn;
            v4u pk; pk.x = pk2(val[0], val[1]); pk.y = pk2(val[2], val[3]); pk.z = pk2(val[4], val[5]); pk.w = pk2(val[6], val[7]);
            *(LAS v4u*)(L + (isk ? GP_KH : GP_QH) + row * 272 + dk0 * 2) = pk;
            if (!isk) {
                const size_t f = (((size_t)ci * 2 + (row >> 5)) * 4 + (dk0 >> 5)) * 2 + ((dk0 >> 4) & 1);
                bf16* p = GQ + f * 512 + (row & 31) * 8 + ((dk0 >> 3) & 1) * 4;
                v2u a; a.x = pk2(val[0] * eg, val[1] * eg); a.y = pk2(val[2] * eg, val[3] * eg); *(v2u*)p = a;
                a.x = pk2(val[4] * eg, val[5] * eg); a.y = pk2(val[6] * eg, val[7] * eg); *(v2u*)(p + 256) = a;
            } else {
                const float bt = bet[row] * eg;
                f32x4 r0 = {val[0] * bt, val[1] * bt, val[2] * bt, val[3] * bt}, r1 = {val[4] * bt, val[5] * bt, val[6] * bt, val[7] * bt};
                *(LAS f32x4*)(Rk + row * 128 + dk0) = r0; *(LAS f32x4*)(Rk + row * 128 + dk0 + 4) = r1;
                const float ek = __expf(g63 - gc);
#pragma unroll
                for (int e = 0; e < 8; ++e) raw[r][e] = val[e] * ek;
            }
        }
        if (isk) {
            const int tj = w >> 2, s1 = (w >> 1) & 1;
#pragma unroll
            for (int e = 0; e < 8; ++e) { const int dk = dk0 + e;
                const size_t f = (((size_t)ci * 4 + (dk >> 5)) * 2 + tj) * 2 + s1;
                v2u a; a.x = pk2(raw[0][e], raw[1][e]); a.y = pk2(raw[2][e], raw[3][e]);
                *(v2u*)(GK + f * 512 + (rh * 32 + (dk & 31)) * 8 + (w & 1) * 4) = a; }
        }
    }
    __syncthreads();
    if (w < 6) {
        const int tsel = w % 3, ti = tsel == 0 ? 0 : 1, tj = tsel == 2 ? 1 : 0;
        const int r = lane & 31, hh = lane >> 5;
        f32x16 acc = zero16();
        if (w < 3) {
#pragma unroll
            for (int kb = 0; kb < 8; ++kb) { const bf16x8 a = *(const LAS bf16x8*)(L + GP_KH + (32 * ti + r) * 272 + (16 * kb + 8 * hh) * 2), bb = *(const LAS bf16x8*)(L + GP_KH + (32 * tj + r) * 272 + (16 * kb + 8 * hh) * 2);
                acc = MFMA32(a, bb, acc); }
            const int j = 32 * tj + r; const float gj = gcs[j];
#pragma unroll
            for (int q = 0; q < 16; ++q) { const int i = 32 * ti + (q & 3) + 8 * (q >> 2) + 4 * hh;
                const float v = (i > j) ? bet[i] * acc[q] * __expf(fminf(gcs[i] - gj, 0.f)) : 0.f; Am[i * 64 + j] = v; }
        } else {
#pragma unroll
            for (int kb = 0; kb < 8; ++kb) { const bf16x8 a = *(const LAS bf16x8*)(L + GP_KH + (32 * tj + r) * 272 + (16 * kb + 8 * hh) * 2), bb = *(const LAS bf16x8*)(L + GP_QH + (32 * ti + r) * 272 + (16 * kb + 8 * hh) * 2);
                acc = MFMA32(a, bb, acc); }
            const int i = 32 * ti + r; const float gi = gcs[i];
#pragma unroll
            for (int q = 0; q < 16; ++q) { const int j = 32 * tj + (q & 3) + 8 * (q >> 2) + 4 * hh;
                acc[q] = (i >= j) ? acc[q] * __expf(fminf(gi - gcs[j], 0.f)) : 0.f; }
            const bf16x8 f0 = PACK_STEP(acc, 0), f1 = PACK_STEP(acc, 1);
            const size_t f = (((size_t)ci * 2 + ti) * 2 + tj) * 2;
            *(bf16x8*)(GA + f * 512 + lane * 8) = f0; *(bf16x8*)(GA + (f + 1) * 512 + lane * 8) = f1;
        }
    }
    __syncthreads();
    float x[64];
    if (tid < 384) {
        if (tid < 256) {
            const int ch = 2048 + h * 256 + tid;
            const float c0 = F.conv_w[ch], c1 = F.conv_w[4096 + ch], c2 = F.conv_w[2 * 4096 + ch], c3 = F.conv_w[3 * 4096 + ch];
            const bf16* src = QKV + trow0 * 4096 + ch;
            float r0 = 0.f, r1 = 0.f, r2 = 0.f;
            if (n > 0) { r0 = bf2f(src[-3 * 4096]); r1 = bf2f(src[-2 * 4096]); r2 = bf2f(src[-1 * 4096]); }
#pragma unroll
            for (int i = 0; i < 64; ++i) { const float r3 = bf2f(src[(size_t)i * 4096]); const float a = r0 * c0 + r1 * c1 + r2 * c2 + r3 * c3; r0 = r1; r1 = r2; r2 = r3;
                x[i] = bet[i] * silu_f(a); }
        } else {
#pragma unroll
            for (int i = 0; i < 64; ++i) x[i] = Rk[i * 128 + (tid - 256)];
        }
#pragma unroll
        for (int i = 1; i < 64; ++i) { float s0 = 0.f, s1 = 0.f, s2 = 0.f, s3 = 0.f;
            asm volatile("" ::: "memory");
#pragma unroll
            for (int q = 0; q < (i + 3) / 4; ++q) { const f32x4 a = *(const LAS f32x4*)(Am + i * 64 + 4 * q);
                if (4 * q + 0 < i) s0 += a.x * x[4 * q + 0];
                if (4 * q + 1 < i) s1 += a.y * x[4 * q + 1];
                if (4 * q + 2 < i) s2 += a.z * x[4 * q + 2];
                if (4 * q + 3 < i) s3 += a.w * x[4 * q + 3]; }
            x[i] -= (s0 + s1) + (s2 + s3);
            asm volatile("" : "+v"(x[i])); }
        if (tid < 256) {
            const int sl = tid >> 5, col = tid & 31;
#pragma unroll
            for (int ti = 0; ti < 2; ++ti)
#pragma unroll
                for (int hh = 0; hh < 2; ++hh) { v4u a, c;
#define XR(q) x[32 * ti + ((q) & 3) + 8 * ((q) >> 2) + 4 * hh]
                    a.x = pk2(XR(0), XR(1)); a.y = pk2(XR(2), XR(3)); a.z = pk2(XR(4), XR(5)); a.w = pk2(XR(6), XR(7));
                    c.x = pk2(XR(8), XR(9)); c.y = pk2(XR(10), XR(11)); c.z = pk2(XR(12), XR(13)); c.w = pk2(XR(14), XR(15));
#undef XR
                    bf16* p = GU + (((size_t)ci * 8 + sl) * 2 + ti) * 1024 + (hh * 32 + col) * 16;
                    *(v4u*)p = a; *(v4u*)(p + 8) = c; }
        }
    }
    __syncthreads();
    if (tid >= 256 && tid < 384) { const int dk = tid - 256;
#pragma unroll
        for (int i = 0; i < 64; ++i) *(LAS unsigned short*)(L + GP_WL + i * 272 + dk * 2) = (unsigned short)f2bf(-x[i]); }
    __syncthreads();
#pragma unroll
    for (int k = 0; k < 2; ++k) { const int idx = tid + 512 * k, row = idx >> 4, dk0 = 8 * (idx & 15);
        const v4u v = *(const LAS v4u*)(L + GP_WL + row * 272 + dk0 * 2);
        const size_t f = (((size_t)ci * 2 + (row >> 5)) * 4 + (dk0 >> 5)) * 2 + ((dk0 >> 4) & 1);
        bf16* p = GW + f * 512 + (row & 31) * 8 + ((dk0 >> 3) & 1) * 4;
        v2u a; a.x = v.x; a.y = v.y; *(v2u*)p = a; a.x = v.z; a.y = v.w; *(v2u*)(p + 256) = a; }
    __syncthreads();
}

__device__ __forceinline__ void gdn_scan(Frame& F, int item) {
    const int lane = F.lane, sl = item & 7, bh = item >> 3, b = bh >> 3, h = bh & 7, col = lane & 31, hh = lane >> 5;
    const bf16* GW = (const bf16*)(F.ws + WS_GW); const bf16* GQ = (const bf16*)(F.ws + WS_GQ); const bf16* GK = (const bf16*)(F.ws + WS_GK); const bf16* GA = (const bf16*)(F.ws + WS_GA); const bf16* GU = (const bf16*)(F.ws + WS_GU);
    const float* DL = (const float*)(F.ws + WS_DL);
    bf16* OA = (bf16*)(F.ws + WS_OA) + (size_t)(b * SEQ) * 2048 + h * 256 + sl * 32 + col;
    f32x16 S[4];
#pragma unroll
    for (int td = 0; td < 4; ++td) S[td] = zero16();
    for (int n = 0; n < 128; ++n) {
        const size_t ci = (size_t)bh * 128 + n;
        f32x16 vn[2];
#pragma unroll
        for (int ti = 0; ti < 2; ++ti) { const bf16* p = GU + ((ci * 8 + sl) * 2 + ti) * 1024 + lane * 16; const v4u a = *(const v4u*)p, c = *(const v4u*)(p + 8);
#pragma unroll
            for (int e = 0; e < 4; ++e) { vn[ti][2 * e] = bflo(a[e]); vn[ti][2 * e + 1] = bfhi(a[e]); vn[ti][8 + 2 * e] = bflo(c[e]); vn[ti][8 + 2 * e + 1] = bfhi(c[e]); } }
        const float dl = DL[ci];
        f32x16 o0 = zero16(), o1 = zero16();
#pragma unroll
        for (int td = 0; td < 4; ++td) {
            const bf16x8 sb0 = PACK_STEP(S[td], 0), sb1 = PACK_STEP(S[td], 1);
            const size_t f0 = ((ci * 2 + 0) * 4 + td) * 2, f1 = ((ci * 2 + 1) * 4 + td) * 2;
            vn[0] = MFMA32(ldfrag(GW, f0, lane), sb0, vn[0]); vn[0] = MFMA32(ldfrag(GW, f0 + 1, lane), sb1, vn[0]);
            vn[1] = MFMA32(ldfrag(GW, f1, lane), sb0, vn[1]); vn[1] = MFMA32(ldfrag(GW, f1 + 1, lane), sb1, vn[1]);
            o0 = MFMA32(ldfrag(GQ, f0, lane), sb0, o0); o0 = MFMA32(ldfrag(GQ, f0 + 1, lane), sb1, o0);
            o1 = MFMA32(ldfrag(GQ, f1, lane), sb0, o1); o1 = MFMA32(ldfrag(GQ, f1 + 1, lane), sb1, o1); }
        asm volatile("" ::: "memory");
        const bf16x8 vb00 = PACK_STEP(vn[0], 0), vb01 = PACK_STEP(vn[0], 1), vb10 = PACK_STEP(vn[1], 0), vb11 = PACK_STEP(vn[1], 1);
        { const size_t f = ((ci * 2 + 0) * 2 + 0) * 2; o0 = MFMA32(ldfrag(GA, f, lane), vb00, o0); o0 = MFMA32(ldfrag(GA, f + 1, lane), vb01, o0); }
        { const size_t f = ((ci * 2 + 1) * 2 + 0) * 2; o1 = MFMA32(ldfrag(GA, f, lane), vb00, o1); o1 = MFMA32(ldfrag(GA, f + 1, lane), vb01, o1); }
        { const size_t f = ((ci * 2 + 1) * 2 + 1) * 2; o1 = MFMA32(ldfrag(GA, f, lane), vb10, o1); o1 = MFMA32(ldfrag(GA, f + 1, lane), vb11, o1); }
        asm volatile("" ::: "memory");
        bf16* orow = OA + (size_t)(64 * n) * 2048;
#pragma unroll
        for (int r = 0; r < 16; ++r) { const int pos = (r & 3) + 8 * (r >> 2) + 4 * hh; orow[(size_t)pos * 2048] = (bf16)f2bf(o0[r]); orow[(size_t)(32 + pos) * 2048] = (bf16)f2bf(o1[r]); }
        asm volatile("" ::: "memory");
#pragma unroll
        for (int td = 0; td < 4; ++td) { S[td] = S[td] * dl; const size_t f = ((ci * 4 + td) * 2) * 2;
            S[td] = MFMA32(ldfrag(GK, f, lane), vb00, S[td]); S[td] = MFMA32(ldfrag(GK, f + 1, lane), vb01, S[td]);
            S[td] = MFMA32(ldfrag(GK, f + 2, lane), vb10, S[td]); S[td] = MFMA32(ldfrag(GK, f + 3, lane), vb11, S[td]); }
    }
}

__device__ __forceinline__ void p3_mixed(Frame& F) {
    const int gw = F.vcu * NWAVES + F.wave, NGW = F.G * NWAVES, lane = F.lane;
    const bf16* OA = (const bf16*)(F.ws + WS_OA); const bf16* OB = (const bf16*)(F.ws + WS_OB);
    const bf16* GZA = (const bf16*)F.out; const bf16* GZB = GZA + (size_t)T * 2048; bf16* MIX = (bf16*)(F.ws + WS_MIXED);
    for (int row = gw; row < T; row += NGW) {
        const size_t off = (size_t)row * 2048 + 32 * lane;
        v4u a4[4], b4[4], ga[4], gb[4];
#pragma unroll
        for (int q = 0; q < 4; ++q) { a4[q] = *(const v4u*)(OA + off + 8 * q); b4[q] = *(const v4u*)(OB + off + 8 * q); ga[q] = *(const v4u*)(GZA + off + 8 * q); gb[q] = *(const v4u*)(GZB + off + 8 * q); }
        float a[32], bb[32];
#pragma unroll
        for (int q = 0; q < 4; ++q)
#pragma unroll
            for (int e = 0; e < 4; ++e) { a[8 * q + 2 * e] = bflo(a4[q][e]); a[8 * q + 2 * e + 1] = bfhi(a4[q][e]); bb[8 * q + 2 * e] = bflo(b4[q][e]); bb[8 * q + 2 * e + 1] = bfhi(b4[q][e]); }
        float sa = 0.f, sb = 0.f;
#pragma unroll
        for (int i = 0; i < 32; ++i) { sa += a[i] * a[i]; sb += bb[i]; }
        sa += __shfl_xor(sa, 1); sa += __shfl_xor(sa, 2); sa += __shfl_xor(sa, 4);
        sb += __shfl_xor(sb, 1); sb += __shfl_xor(sb, 2); sb += __shfl_xor(sb, 4);
        const float rsa = rsqrtf(sa * (1.0f / 256.0f) + EPS), mu = sb * (1.0f / 256.0f);
        float vb = 0.f;
#pragma unroll
        for (int i = 0; i < 32; ++i) { bb[i] -= mu; vb += bb[i] * bb[i]; }
        vb += __shfl_xor(vb, 1); vb += __shfl_xor(vb, 2); vb += __shfl_xor(vb, 4);
        const float rsb = rsqrtf(vb * (1.0f / 256.0f) + EPS);
        const float* wa = F.gdn_norm_w + ((32 * lane) & 255); const float* wb = F.ret_norm_w + 32 * lane;
#pragma unroll
        for (int q = 0; q < 4; ++q) { v4u o;
#pragma unroll
            for (int e = 0; e < 4; ++e) { const int i = 8 * q + 2 * e;
                const float m0 = a[i] * rsa * wa[i] * bflo(ga[q][e]) + bb[i] * rsb * wb[i] * bflo(gb[q][e]);
                const float m1 = a[i + 1] * rsa * wa[i + 1] * bfhi(ga[q][e]) + bb[i + 1] * rsb * wb[i + 1] * bfhi(gb[q][e]);
                o[e] = pk2(m0, m1); }
            *(v4u*)(MIX + off + 8 * q) = o; }
    }
}
__device__ __forceinline__ void row_rmsnorm(Frame& F, const float* src, const float* w, bf16* dst16, float* dst32) {
    const int gw = F.vcu * NWAVES + F.wave, NGW = F.G * NWAVES, lane = F.lane;
    f32x4 nw[8];
#pragma unroll
    for (int j = 0; j < 8; ++j) nw[j] = ((const f32x4*)w)[64 * j + lane];
    for (int row = gw; row < T; row += NGW) {
        const f32x4* xr = (const f32x4*)(src + (size_t)row * D) + lane;
        f32x4 v[8]; float ss = 0.f;
#pragma unroll
        for (int j = 0; j < 8; ++j) { v[j] = xr[64 * j]; ss += (v[j].x * v[j].x + v[j].y * v[j].y) + (v[j].z * v[j].z + v[j].w * v[j].w); }
        const float rstd = rsqrtf(wave_sum(ss) * (1.0f / D) + EPS);
        if (dst16) { v2u* o8 = (v2u*)(dst16 + (size_t)row * D) + lane;
#pragma unroll
            for (int j = 0; j < 8; ++j) { const f32x4 y = (v[j] * rstd) * nw[j]; v2u o; o.x = pk2(y.x, y.y); o.y = pk2(y.z, y.w); o8[64 * j] = o; } }
        else { f32x4* o = (f32x4*)(dst32 + (size_t)row * D) + lane;
#pragma unroll
            for (int j = 0; j < 8; ++j) o[64 * j] = (v[j] * rstd) * nw[j]; }
    }
}

__global__ void __launch_bounds__(NWAVES * 64, 2) fwd_kernel(Args args) {
    extern __shared__ __attribute__((aligned(16))) unsigned char lds[];
    Frame F;
    F.lds = (LAS unsigned char*)lds;
    F.tid = threadIdx.x; F.lane = F.tid & 63; F.wave = __builtin_amdgcn_readfirstlane(F.tid >> 6);
    F.G = gridDim.x; { const int bx = blockIdx.x; F.vcu = (F.G % 8 == 0) ? (bx % 8) * (F.G / 8) + bx / 8 : bx; }
    F.x = args.in[0]; F.norm1_w = args.in[1]; F.w_in = args.in[2]; F.conv_w = args.in[3]; F.a_log = args.in[4]; F.dt_bias = args.in[5]; F.gdn_norm_w = args.in[6];
    F.ret_norm_w = args.in[7]; F.w_out = args.in[8]; F.norm2_w = args.in[9]; F.w_gate = args.in[10]; F.w_up = args.in[11]; F.w_down = args.in[12]; F.norm_f_w = args.in[13];
    F.out = args.out; F.ws = args.ws;
    volatile LAS unsigned* MISC = (volatile LAS unsigned*)(F.lds + MISC_OFF);
    for (int u = F.tid; u < (LDS_BYTES - LDSCTL_OFF) / 4; u += NWAVES * 64) ((LAS unsigned*)(F.lds + LDSCTL_OFF))[u] = 0u;
    __syncthreads();
    const int lo = args.ph_lo, hi = args.ph_hi;
    const bool use_bar = (hi - lo) > 1;
    XcdBarrier bar; bar.bar = (unsigned*)(F.ws + WS_CTL) + CW_BAR; bar.x = 0; bar.st = nullptr;
    if (use_bar) bar = xcd_barrier_post((unsigned*)(F.ws + WS_CTL) + CW_BAR, MISC + 8);
#define IN(k) (lo <= (k) && (k) < hi)
#define SEAM(k) do { if (IN(k) && IN((k) + 1)) xcd_barrier(bar); } while (0)

    if (IN(0)) { p0_prologue(F); } SEAM(0);
    if (IN(1)) {
        pg8::Gemm g{(const pg8::bf16_t*)(F.ws + WS_U), (const pg8::bf16_t*)(F.ws + WS_W1T), T, N1, D}; pg8::InProjOrder S; S.init(T, N1, F.G, (int)blockIdx.x);
        pg8::EpiInProj E{F.ws, (pg8::bf16_t*)F.out, WS_QKV, WS_RQF, WS_RKF, WS_RKTF, WS_RVTF, WS_COS, WS_SIN, WS_COS2, WS_SIN2};
        pg8::gemm_phase<pg8::EpiInProj, pg8::InProjOrder, true, true>(F.lds, g, S, E);
    } SEAM(1);
    if (IN(2)) { for (int ci = blockIdx.x; ci < BATCH * NH * 128; ci += F.G) gdn_prep(F, ci); } SEAM(2);
    if (IN(3)) {
        const int bx = blockIdx.x;
        if (bx < 128 && F.wave < 2) { const int x = bx & 63, xc = x & 7, y = x >> 3, bh = xc + 8 * (y >> 2), q = y & 3, item = bh * 8 + 2 * q + F.wave;
            if (bx < 64) ret_scan(F, item); else gdn_scan(F, item); }
    } SEAM(3);
    if (IN(4)) { p3_mixed(F); ffn_weight_copies(F); } SEAM(4);
    if (IN(5)) {
        pg8::Gemm g{(const pg8::bf16_t*)(F.ws + WS_MIXED), (const pg8::bf16_t*)(F.ws + WS_WOT), T, D, D}; pg8::StaticOrder S; S.init(T, D, F.G, (int)blockIdx.x);
        pg8::EpiResF32 E{F.x, F.out, D};
        pg8::gemm_phase<pg8::EpiResF32, pg8::StaticOrder, true, true>(F.lds, g, S, E);
    } SEAM(5);
    if (IN(6)) { row_rmsnorm(F, F.out, F.norm2_w, (bf16*)(F.ws + WS_HNB), nullptr); } SEAM(6);
    if (IN(7)) {
        pg8::Gemm g{(const pg8::bf16_t*)(F.ws + WS_HNB), (const pg8::bf16_t*)(F.ws + WS_WGUT), T, NGU, D}; pg8::StaticOrder S; S.init(T, NGU, F.G, (int)blockIdx.x);
        pg8::EpiGateUp E{(pg8::bf16_t*)(F.ws + WS_ACT), FF, nullptr};
        pg8::gemm_phase<pg8::EpiGateUp, pg8::StaticOrder, true, true>(F.lds, g, S, E);
    } SEAM(7);
    if (IN(8)) {
        pg8::Gemm g{(const pg8::bf16_t*)(F.ws + WS_ACT), (const pg8::bf16_t*)(F.ws + WS_WDT), T, D, FF}; pg8::StaticOrder S; S.init(T, D, F.G, (int)blockIdx.x);
        pg8::EpiResF32 E{F.out, F.out, D};
        pg8::gemm_phase<pg8::EpiResF32, pg8::StaticOrder, true, true>(F.lds, g, S, E);
    } SEAM(8);
    if (IN(9)) { row_rmsnorm(F, F.out, F.norm_f_w, nullptr, F.out); }
#undef IN
#undef SEAM
}

extern "C" void kernel_launch(void* const* d_in, const int* in_sizes, int n_in, void* d_out, int out_size, void* d_ws, size_t ws_size, hipStream_t stream) {
    static int grid = 0;
    if (grid == 0) {
        if (n_in != 14 || in_sizes[0] != T * D || out_size != T * D || ws_size < WS_END) { fprintf(stderr, "kernel_launch: unexpected shapes: n_in %d in0 %d out %d ws %zu (need %zu)\n", n_in, n_in > 0 ? in_sizes[0] : -1, out_size, ws_size, (size_t)WS_END); grid = -1; return; }
        int dev = 0, cus = 0, per_cu = 0;
        if (hipGetDevice(&dev) != hipSuccess || hipDeviceGetAttribute(&cus, hipDeviceAttributeMultiprocessorCount, dev) != hipSuccess) { grid = -1; return; }
        if (hipFuncSetAttribute((const void*)fwd_kernel, hipFuncAttributeMaxDynamicSharedMemorySize, LDS_BYTES) != hipSuccess) { fprintf(stderr, "kernel_launch: hipFuncSetAttribute failed\n"); grid = -1; return; }
        if (hipOccupancyMaxActiveBlocksPerMultiprocessor(&per_cu, (const void*)fwd_kernel, NWAVES * 64, LDS_BYTES) != hipSuccess || per_cu < 1) { fprintf(stderr, "kernel_launch: occupancy query says %d blocks per CU\n", per_cu); per_cu = 1; }
        (void)hipGetLastError();
        grid = cus;
        if (grid > 256) grid = 256;
    }
    if (grid < 0) return;
    (void)hipMemsetAsync((char*)d_ws + WS_CTL, 0, CTL_ZERO_BYTES, stream);
    Args a{};
    for (int i = 0; i < 14; ++i) a.in[i] = (const float*)d_in[i];
    a.out = (float*)d_out; a.ws = (unsigned char*)d_ws;
#if MK_N_LAUNCHES == 1
    a.ph_lo = 0; a.ph_hi = NPHASES;
    hipLaunchKernelGGL(fwd_kernel, dim3(grid), dim3(NWAVES * 64), LDS_BYTES, stream, a);
#else
    for (int p = 0; p < NPHASES; ++p) { a.ph_lo = p; a.ph_hi = p + 1; hipLaunchKernelGGL(fwd_kernel, dim3(grid), dim3(NWAVES * 64), LDS_BYTES, stream, a); }
#endif
}
```

```cpp
#include <hip/hip_runtime.h>
#include <cstdio>
#include <cstdint>
namespace pg8 {
#define PG8_LAS __attribute__((address_space(3)))
typedef unsigned short bf16_t;
typedef short bf16x8 __attribute__((ext_vector_type(8)));
typedef float f32x4 __attribute__((ext_vector_type(4)));
typedef unsigned u32x4 __attribute__((ext_vector_type(4)));
constexpr int BM = 256, BK = 64, HALF = 128, HTB = HALF * BK * 2  , STAGE_BYTES = 8 * HTB, NXCD = 8, WGM = 8;

__host__ __device__ __forceinline__ int lds_byte(int r, int c) { const int st = (r >> 4) * 2 + (c >> 5), rr = r & 15, cc = c & 31, ob = rr * 64 + cc * 2; return st * 1024 + (ob ^ (((ob >> 9) & 1) << 5)); }
__host__ __device__ __forceinline__ void stage_rc(int b, int& R, int& C) { const int st = b / 1024, sb = b % 1024, swz = sb ^ (((sb >> 9) & 1) << 5); R = (st >> 1) * 16 + swz / 64; C = (st & 1) * 32 + (swz % 64) / 2; }
__host__ __device__ __forceinline__ int perm32(int rho) { const int n = rho >> 4, i = rho & 15; return 8 * (i >> 2) + 4 * n + (i & 3); }

struct Unit { int pm, pn, sw; };
struct Gemm { const bf16_t* A; const bf16_t* Bt; int M, N, K; };

struct StaticOrder {
    int nM, nN, nwg, G, c;
    __host__ __device__ void init(int M, int N, int G_, int c_) { nM = M / BM; nN = N / BM; nwg = nM * nN; G = G_; c = c_; }
    __host__ __device__ bool next(int i, Unit& u) const {
        const long L = (long)i * G + c; if (L >= nwg) return false;
        int wgid = (int)L; { const int q = nwg / NXCD, r = nwg % NXCD, xcd = wgid % NXCD, off = wgid / NXCD; wgid = (xcd < r ? xcd * (q + 1) : r * (q + 1) + (xcd - r) * q) + off; }
        const int nig = WGM * nN, gid = wgid / nig, fm = gid * WGM, gsz = (nM - fm) < WGM ? (nM - fm) : WGM;
        u.pm = fm + ((wgid % nig) % gsz); u.pn = (wgid % nig) / gsz; u.sw = 0; return true;
    }
    __device__ __forceinline__ void a_ready(const Unit&) const {}
    __device__ __forceinline__ void done(const Unit&) const {}
};
__device__ __forceinline__ unsigned cvt_pk_bf16(float lo, float hi) { unsigned r; asm volatile("v_cvt_pk_bf16_f32 %0, %1, %2" : "=v"(r) : "v"(lo), "v"(hi)); return r; }
typedef float f32x2 __attribute__((ext_vector_type(2)));
__device__ __forceinline__ u32x4 pack8(const f32x4& a, const f32x4& b) { u32x4 w; w.x = cvt_pk_bf16(a[0], a[1]); w.y = cvt_pk_bf16(a[2], a[3]); w.z = cvt_pk_bf16(b[0], b[1]); w.w = cvt_pk_bf16(b[2], b[3]); return w; }
typedef unsigned u32x2 __attribute__((ext_vector_type(2)));
__device__ __forceinline__ float fsigmoid(float x) { return __builtin_amdgcn_rcpf(1.0f + __expf(-x)); }
__device__ __forceinline__ float fsilu(float x) { return x * fsigmoid(x); }

struct InProjOrder : StaticOrder {
    __host__ __device__ bool next(int i, Unit& u) const { if (!StaticOrder::next(i, u)) return false; u.sw = ((u.pn >= 24 && u.pn < 32) || u.pn >= 64) ? 1 : 0; return true; }
};
struct EpiInProj {
    static constexpr bool PERM = true, AFTER_DRAIN = false;
    unsigned char* ws; bf16_t* gz;
    size_t oQKV, oRQf, oRKf, oRKTf, oRVTf, oCOS, oSIN, oCOS2, oSIN2;
    __device__ __forceinline__ void operator()(const f32x4 (&acc)[2][2][4][2], const Unit& u, int wr, int wc, int fr, int fq) const {
        asm volatile("" : "+v"(fr), "+v"(fq));
        bf16_t* const QKV = (bf16_t*)(ws + oQKV); bf16_t* const RQf = (bf16_t*)(ws + oRQf); bf16_t* const RKf = (bf16_t*)(ws + oRKf); bf16_t* const RKTf = (bf16_t*)(ws + oRKTf); bf16_t* const RVTf = (bf16_t*)(ws + oRVTf);
        bf16_t* const GZA = gz; bf16_t* const GZB = gz + (size_t)16384 * 2048;
        const float* const cosT = (const float*)(ws + oCOS); const float* const sinT = (const float*)(ws + oSIN); const float* const cosT2 = (const float*)(ws + oCOS2); const float* const sinT2 = (const float*)(ws + oSIN2);
        const int pn = u.pn, cw = wc * 32 + 8 * fq;
        if (pn < 16) {
            const int row0 = u.pm * BM + wr * 64 + fr, col0 = pn * 256 + cw;
#pragma unroll
            for (int ai = 0; ai < 2; ++ai)
#pragma unroll
                for (int m = 0; m < 4; ++m) { bf16_t* rowp = QKV + (size_t)(row0 + ai * HALF + m * 16) * 4096 + col0;
#pragma unroll
                    for (int bj = 0; bj < 2; ++bj) *(u32x4*)(rowp + bj * HALF) = pack8(acc[ai][bj][m][0], acc[ai][bj][m][1]); }
        } else if (pn < 24) {
            const bool isk = pn >= 20; bf16_t* base = isk ? RKf : RQf;
            const int row0 = u.pm * BM + wr * 64 + fr, tile = (pn - 16) & 3, head = 2 * tile + (cw >> 6), i0 = cw & 63;
            const float l2g = log2f(1.0f - exp2f(-5.0f - (float)head));
            const int td1 = i0 >> 5, s1 = (i0 >> 4) & 1, eg = (i0 >> 3) & 1;
#pragma unroll
            for (int ai = 0; ai < 2; ++ai)
#pragma unroll
                for (int m = 0; m < 4; ++m) { const int row = row0 + ai * HALF + m * 16, b = row >> 13, t = row & 8191, n = t >> 6, pos = t & 63;
                    const float sc = isk ? 0.08838834764831845f * exp2f(-(float)(pos + 1) * l2g) : exp2f((float)(pos + 1) * l2g);
                    const float* cp = cosT + t * 64 + i0; const float* sp = sinT + t * 64 + i0;
                    const f32x4 c0 = *(const f32x4*)cp, c1 = *(const f32x4*)(cp + 4), s0 = *(const f32x4*)sp, s1v = *(const f32x4*)(sp + 4);
                    const f32x4 x1a = acc[ai][0][m][0], x1b = acc[ai][0][m][1], x2a = acc[ai][1][m][0], x2b = acc[ai][1][m][1];
                    const f32x4 o1a = (x1a * c0 - x2a * s0) * sc, o1b = (x1b * c1 - x2b * s1v) * sc, o2a = (x2a * c0 + x1a * s0) * sc, o2b = (x2b * c1 + x1b * s1v) * sc;
                    const size_t f1 = ((((size_t)(b * 8 + head) * 128 + n) * 2 + (pos >> 5)) * 4 + td1) * 2 + s1;
                    bf16_t* p1 = base + f1 * 512 + (pos & 31) * 8 + eg * 4;
                    u32x2 w;
                    w.x = cvt_pk_bf16(o1a[0], o1a[1]); w.y = cvt_pk_bf16(o1a[2], o1a[3]); *(u32x2*)(p1) = w;
                    w.x = cvt_pk_bf16(o1b[0], o1b[1]); w.y = cvt_pk_bf16(o1b[2], o1b[3]); *(u32x2*)(p1 + 256) = w;
                    w.x = cvt_pk_bf16(o2a[0], o2a[1]); w.y = cvt_pk_bf16(o2a[2], o2a[3]); *(u32x2*)(p1 + 4 * 512) = w;
                    w.x = cvt_pk_bf16(o2b[0], o2b[1]); w.y = cvt_pk_bf16(o2b[2], o2b[3]); *(u32x2*)(p1 + 4 * 512 + 256) = w; }
        } else if (pn < 32) {
            const int head = pn - 24, b = u.pm >> 5, nbase = (u.pm & 31) * 4;
            const int tj = wc & 1, s1 = (fq >> 1) & 1, eg = fq & 1;
#pragma unroll
            for (int ai = 0; ai < 2; ++ai)
#pragma unroll
                for (int m = 0; m < 4; ++m) { const int dv = ai * HALF + wr * 64 + m * 16 + fr, sl = dv >> 5, col = dv & 31;
#pragma unroll
                    for (int bj = 0; bj < 2; ++bj) { const int n = nbase + 2 * bj + (wc >> 1);
                        const size_t f = ((((size_t)(b * 8 + head) * 128 + n) * 8 + sl) * 2 + tj) * 2 + s1;
                        bf16_t* p = RVTf + f * 512 + col * 8 + eg * 4;
#pragma unroll
                        for (int nn = 0; nn < 2; ++nn) { u32x2 w; w.x = cvt_pk_bf16(acc[ai][bj][m][nn][0], acc[ai][bj][m][nn][1]); w.y = cvt_pk_bf16(acc[ai][bj][m][nn][2], acc[ai][bj][m][nn][3]); *(u32x2*)(p + nn * 256) = w; } } }
        } else if (pn < 64) {
            const int row0 = u.pm * BM + wr * 64 + fr;
            bf16_t* base = pn < 48 ? GZA : GZB; const int col0 = ((pn - 32) & 15) * 128 + cw;
#pragma unroll
            for (int ai = 0; ai < 2; ++ai)
#pragma unroll
                for (int m = 0; m < 4; ++m) { bf16_t* rowp = base + (size_t)(row0 + ai * HALF + m * 16) * 2048 + col0; f32x4 o[2];
#pragma unroll
                    for (int n = 0; n < 2; ++n)
#pragma unroll
                        for (int j = 0; j < 4; ++j) o[n][j] = fsilu(acc[ai][0][m][n][j]) * fsigmoid(acc[ai][1][m][n][j]);
                    *(u32x4*)rowp = pack8(o[0], o[1]); }
        } else {
            const int tile = pn - 64, head = 2 * tile + wr, b = u.pm >> 5, nbase = (u.pm & 31) * 4, tbase = (u.pm & 31) * 256;
            const int tj = wc & 1, s1 = (fq >> 1) & 1, eg = fq & 1;
            const float l2g = log2f(1.0f - exp2f(-5.0f - (float)head));
#pragma unroll
            for (int bj = 0; bj < 2; ++bj) { const int n = nbase + 2 * bj + (wc >> 1), c0 = bj * HALF + wc * 32 + 8 * fq;
#pragma unroll
                for (int nn = 0; nn < 2; ++nn) { const int pos0 = (c0 + 4 * nn) & 63; f32x4 sc;
#pragma unroll
                    for (int j = 0; j < 4; ++j) sc[j] = 0.08838834764831845f * exp2f((float)(63 - pos0 - j) * l2g);
#pragma unroll
                    for (int m = 0; m < 4; ++m) { const int i = 16 * m + fr;
                        const f32x4 c = *(const f32x4*)(cosT2 + (size_t)i * 8192 + tbase + c0 + 4 * nn), s = *(const f32x4*)(sinT2 + (size_t)i * 8192 + tbase + c0 + 4 * nn);
                        const f32x4 x1 = acc[0][bj][m][nn], x2 = acc[1][bj][m][nn];
                        const f32x4 o1 = (x1 * c - x2 * s) * sc, o2 = (x2 * c + x1 * s) * sc;
                        const size_t f = ((((size_t)(b * 8 + head) * 128 + n) * 4 + (m >> 1)) * 2 + tj) * 2 + s1;
                        bf16_t* p = RKTf + f * 512 + (nn * 32 + 16 * (m & 1) + fr) * 8 + eg * 4;
                        u32x2 w; w.x = cvt_pk_bf16(o1[0], o1[1]); w.y = cvt_pk_bf16(o1[2], o1[3]); *(u32x2*)p = w;
                        w.x = cvt_pk_bf16(o2[0], o2[1]); w.y = cvt_pk_bf16(o2[2], o2[3]); *(u32x2*)(p + 8 * 512) = w; } } }
        }
    }
};
struct EpiGateUp {
    static constexpr bool PERM = true, AFTER_DRAIN = false;
    bf16_t* ACT; int ldc; const float* rstd;
    __device__ __forceinline__ void operator()(const f32x4 (&acc)[2][2][4][2], const Unit& u, int wr, int wc, int fr, int fq) const {
        const int row0 = u.pm * BM + wr * 64 + fr, col0 = u.pn * 128 + wc * 32 + 8 * fq;
#pragma unroll
        for (int ai = 0; ai < 2; ++ai)
#pragma unroll
            for (int m = 0; m < 4; ++m) { const int row = row0 + ai * HALF + m * 16; const float rs = rstd ? rstd[row] : 1.0f; f32x4 o[2];
#pragma unroll
                for (int n = 0; n < 2; ++n)
#pragma unroll
                    for (int j = 0; j < 4; ++j) o[n][j] = fsilu(acc[ai][0][m][n][j] * rs) * (acc[ai][1][m][n][j] * rs);
                *(u32x4*)(ACT + (size_t)row * ldc + col0) = pack8(o[0], o[1]); }
    }
};
struct EpiResF32 {
    static constexpr bool PERM = false, AFTER_DRAIN = false;
    const float* res; float* out; int ldc;
    __device__ __forceinline__ void operator()(const f32x4 (&acc)[2][2][4][2], const Unit& u, int wr, int wc, int fr, int fq) const {
        const int row0 = u.pm * BM + wr * 64 + fr, col0 = u.pn * BM + wc * 32 + 4 * fq;
#pragma unroll
        for (int ai = 0; ai < 2; ++ai)
#pragma unroll
            for (int m = 0; m < 4; ++m) { const size_t off = (size_t)(row0 + ai * HALF + m * 16) * ldc + col0;
#pragma unroll
                for (int bj = 0; bj < 2; ++bj)
#pragma unroll
                    for (int n = 0; n < 2; ++n) { const f32x4 r = *(const f32x4*)(res + off + bj * HALF + n * 16); *(f32x4*)(out + off + bj * HALF + n * 16) = r + acc[ai][bj][m][n]; } }
    }
};
template <class Epi, class Sched, bool ALIGN_EPI = false, bool SP2 = false>
__device__ __forceinline__ void gemm_phase(PG8_LAS unsigned char* lds, const Gemm g, const Sched& S, const Epi& E) {
    const int tid = threadIdx.x, wid = __builtin_amdgcn_readfirstlane(tid >> 6), lane = tid & 63, wr = wid >> 2, wc = wid & 3, fr = lane & 15, fq = lane >> 4;
    const int K = g.K, nt = K / BK;
    unsigned voffA[2], voffB[2];
#pragma unroll
    for (int i = 0; i < 2; ++i) { int R, C; stage_rc(tid * 16 + i * 8192, R, C); const int Rb = Epi::PERM ? ((R & ~31) + perm32(R & 31)) : R;
        voffA[i] = (unsigned)(R * K + C) * 2u; voffB[i] = (unsigned)(Rb * K + C) * 2u; }
    const size_t kstep = (size_t)(BK * 2);
    const size_t hstep = (size_t)HALF * K * 2;
    const size_t tstep = 2 * hstep;
    const unsigned ldsw = (unsigned)wid * 1024u;
    const int aoff = lds_byte(wr * 64 + fr, fq * 8), boff = lds_byte(wc * 32 + fr, fq * 8);
#define PG8_SA(b, h) (((b) * 2 + (h)) * HTB)
#define PG8_SB(b, h) ((4 + (b) * 2 + (h)) * HTB)
#define PG8_STAGE(bufoff, gbase, voff) do { _Pragma("unroll") for (int _i = 0; _i < 2; ++_i) \
        __builtin_amdgcn_global_load_lds((const unsigned*)((const char*)(gbase) + (voff)[_i]), (PG8_LAS unsigned*)(lds + (bufoff) + ldsw + _i * 8192), 16, 0, 0); } while (0)
#define PG8_LDA(dst, b, h) do { _Pragma("unroll") for (int m = 0; m < 4; ++m) _Pragma("unroll") for (int k = 0; k < 2; ++k) dst[m][k] = *(const PG8_LAS bf16x8*)(lds + PG8_SA(b, h) + aoff + m * 2048 + k * 1024); } while (0)
#define PG8_LDB(dst, b, h) do { _Pragma("unroll") for (int n = 0; n < 2; ++n) _Pragma("unroll") for (int k = 0; k < 2; ++k) dst[n][k] = *(const PG8_LAS bf16x8*)(lds + PG8_SB(b, h) + boff + n * 2048 + k * 1024); } while (0)
#define PG8_MMA(ai, bj, At, Bt) do { __builtin_amdgcn_s_setprio(1); _Pragma("unroll") for (int m = 0; m < 4; ++m) _Pragma("unroll") for (int n = 0; n < 2; ++n) _Pragma("unroll") for (int k = 0; k < 2; ++k) \
        acc[ai][bj][m][n] = __builtin_amdgcn_mfma_f32_16x16x32_bf16(Bt[n][k], At[m][k], acc[ai][bj][m][n], 0, 0, 0); __builtin_amdgcn_s_setprio(0); } while (0)
#define PG8_WAIT_V(n) asm volatile("s_waitcnt vmcnt(" #n ")" ::: "memory")
#define PG8_WAIT_L(n) asm volatile("s_waitcnt lgkmcnt(" #n ")" ::: "memory")
#define PG8_BAR __builtin_amdgcn_s_barrier()
#define PG8_SCHED __builtin_amdgcn_sched_barrier(0)
    Unit cur, nxt; int ui = 0;
    if (!S.next(0, cur)) return;
    f32x4 acc[2][2][4][2];
#pragma unroll
    for (int a = 0; a < 2; ++a)
#pragma unroll
        for (int b = 0; b < 2; ++b)
#pragma unroll
            for (int m = 0; m < 4; ++m)
#pragma unroll
                for (int n = 0; n < 2; ++n) acc[a][b][m][n] = (f32x4){0.f, 0.f, 0.f, 0.f};
    bf16x8 At[4][2], B0[2][2], B1[2][2];
#define PG8_UA(u) ((u).sw ? (const char*)g.Bt + (size_t)(u).pn * tstep : (const char*)g.A + (size_t)(u).pm * tstep)
#define PG8_UB(u) ((u).sw ? (const char*)g.A + (size_t)(u).pm * tstep : (const char*)g.Bt + (size_t)(u).pn * tstep)
    const char* cA = PG8_UA(cur); const char* cB = PG8_UB(cur);
    S.a_ready(cur);
    if constexpr (SP2) {
        PG8_STAGE(PG8_SB(0, 0), cB, voffB); PG8_STAGE(PG8_SB(0, 1), cB + hstep, voffB); PG8_STAGE(PG8_SA(0, 0), cA, voffA); PG8_STAGE(PG8_SA(0, 1), cA + hstep, voffA);
        if (wr == 1) PG8_BAR;
        PG8_WAIT_V(2); PG8_BAR;
        PG8_STAGE(PG8_SB(1, 0), cB + kstep, voffB); PG8_STAGE(PG8_SA(1, 0), cA + kstep, voffA); PG8_STAGE(PG8_SB(1, 1), cB + hstep + kstep, voffB);
        PG8_WAIT_V(6); PG8_BAR;
    } else {
        PG8_STAGE(PG8_SB(0, 0), cB, voffB); PG8_STAGE(PG8_SA(0, 0), cA, voffA); PG8_STAGE(PG8_SB(0, 1), cB + hstep, voffB); PG8_STAGE(PG8_SA(0, 1), cA + hstep, voffA);
        if (wr == 1) PG8_BAR;
        PG8_WAIT_V(4); PG8_BAR;
        PG8_STAGE(PG8_SB(1, 0), cB + kstep, voffB); PG8_STAGE(PG8_SA(1, 0), cA + kstep, voffA); PG8_STAGE(PG8_SB(1, 1), cB + hstep + kstep, voffB);
        PG8_WAIT_V(6); PG8_BAR;
    }
    for (;;) {
        const bool has_next = S.next(ui + 1, nxt);
        const char* nA = has_next ? PG8_UA(nxt) : cA; const char* nB = has_next ? PG8_UB(nxt) : cB;
        for (int t = 0; t < nt; t += 2) {
            const bool last = (t == nt - 2);
            const char* a1 = cA + (size_t)(t + 1) * kstep;
            const char* a2 = last ? nA : cA + (size_t)(t + 2) * kstep; const char* b2 = last ? nB : cB + (size_t)(t + 2) * kstep;
            const char* a3 = a2 + kstep; const char* b3 = b2 + kstep;
            if (last && has_next) S.a_ready(nxt);
            if constexpr (SP2) {
            PG8_LDB(B0, 0, 0); PG8_LDB(B1, 0, 1); PG8_SCHED; PG8_LDA(At, 0, 0); PG8_STAGE(PG8_SA(1, 1), a1 + hstep, voffA);
            PG8_WAIT_V(8); PG8_WAIT_L(0); PG8_BAR; PG8_MMA(0, 0, At, B0); PG8_MMA(0, 1, At, B1); PG8_BAR; PG8_SCHED;
            PG8_LDA(At, 0, 1); PG8_STAGE(PG8_SB(0, 0), b2, voffB); PG8_STAGE(PG8_SB(0, 1), b2 + hstep, voffB); PG8_STAGE(PG8_SA(0, 0), a2, voffA);
            PG8_WAIT_V(8); PG8_WAIT_L(0); PG8_BAR; PG8_MMA(1, 0, At, B0); PG8_MMA(1, 1, At, B1); PG8_BAR; PG8_SCHED;
            PG8_LDB(B0, 1, 0); PG8_LDB(B1, 1, 1); PG8_SCHED; PG8_LDA(At, 1, 0); PG8_STAGE(PG8_SA(0, 1), a2 + hstep, voffA);
            PG8_WAIT_V(8); PG8_WAIT_L(0); PG8_BAR; PG8_MMA(0, 0, At, B0); PG8_MMA(0, 1, At, B1); PG8_BAR; PG8_SCHED;
            PG8_LDA(At, 1, 1); PG8_STAGE(PG8_SB(1, 0), b3, voffB); PG8_STAGE(PG8_SB(1, 1), b3 + hstep, voffB); PG8_STAGE(PG8_SA(1, 0), a3, voffA);
            PG8_WAIT_V(8); PG8_WAIT_L(0); PG8_BAR; PG8_MMA(1, 0, At, B0); PG8_MMA(1, 1, At, B1); PG8_BAR; PG8_SCHED;
            } else {
            PG8_LDB(B0, 0, 0); PG8_SCHED; PG8_LDA(At, 0, 0); PG8_STAGE(PG8_SA(1, 1), a1 + hstep, voffA);
            PG8_WAIT_L(8); PG8_BAR; PG8_WAIT_L(0); PG8_MMA(0, 0, At, B0); PG8_BAR; PG8_SCHED;
            PG8_LDB(B1, 0, 1); PG8_STAGE(PG8_SB(0, 0), b2, voffB);
            PG8_BAR; PG8_WAIT_L(0); PG8_MMA(0, 1, At, B1); PG8_BAR;
            PG8_LDA(At, 0, 1); PG8_STAGE(PG8_SA(0, 0), a2, voffA);
            PG8_BAR; PG8_WAIT_L(0); PG8_MMA(1, 0, At, B0); PG8_BAR; PG8_SCHED;
            PG8_STAGE(PG8_SB(0, 1), b2 + hstep, voffB);
            PG8_WAIT_V(6); PG8_BAR; PG8_MMA(1, 1, At, B1); PG8_BAR;
            PG8_LDB(B0, 1, 0); PG8_SCHED; PG8_LDA(At, 1, 0); PG8_STAGE(PG8_SA(0, 1), a2 + hstep, voffA);
            PG8_WAIT_L(8); PG8_BAR; PG8_WAIT_L(0); PG8_MMA(0, 0, At, B0); PG8_BAR; PG8_SCHED;
            PG8_LDB(B1, 1, 1); PG8_STAGE(PG8_SB(1, 0), b3, voffB);
            PG8_BAR; PG8_WAIT_L(0); PG8_MMA(0, 1, At, B1); PG8_BAR;
            PG8_LDA(At, 1, 1); PG8_STAGE(PG8_SA(1, 0), a3, voffA);
            PG8_BAR; PG8_WAIT_L(0); PG8_MMA(1, 0, At, B0); PG8_BAR; PG8_SCHED;
            PG8_STAGE(PG8_SB(1, 1), b3 + hstep, voffB);
            PG8_WAIT_V(6); PG8_BAR; PG8_MMA(1, 1, At, B1); PG8_BAR;
            }
        }
        if constexpr (ALIGN_EPI) { if (wr == 0) PG8_BAR; }
        if constexpr (!Epi::AFTER_DRAIN) { E(acc, cur, wr, wc, fr, fq); S.done(cur); }
        if (!has_next) break;
#pragma unroll
        for (int a = 0; a < 2; ++a)
#pragma unroll
            for (int b = 0; b < 2; ++b)
#pragma unroll
                for (int m = 0; m < 4; ++m)
#pragma unroll
                    for (int n = 0; n < 2; ++n) acc[a][b][m][n] = (f32x4){0.f, 0.f, 0.f, 0.f};
        cur = nxt; cA = nA; cB = nB; ++ui;
        if constexpr (ALIGN_EPI) { if (wr == 1) PG8_BAR; }
    }
    PG8_WAIT_V(0);
    if constexpr (!ALIGN_EPI) { if (wr == 0) PG8_BAR; }
    PG8_BAR;
    if constexpr (Epi::AFTER_DRAIN) { E.fused(acc, cur, wr, wc, fr, fq, lds, wid, lane); S.done(cur); }
#undef PG8_UA
#undef PG8_UB
#undef PG8_SA
#undef PG8_SB
#undef PG8_STAGE
#undef PG8_LDA
#undef PG8_LDB
#undef PG8_MMA
#undef PG8_WAIT_V
#undef PG8_WAIT_L
#undef PG8_BAR
#undef PG8_SCHED
}
}
#define GAS __attribute__((address_space(1)))
#define LAS __attribute__((address_space(3)))
#define XB_TMO      128
#define XB_XCNT(j)  (256  + 64 * (j))
#define XB_XSUB(j)  (1280 + 64 * (j))
#define XB_XGEN(j)  (2304 + 64 * (j))
#define XB_TOP      3328
#define XB_TOPGEN   3392
#define XCD_BAR_WORDS 3456
#define XB_SPIN_CAP (1u << 18)

__device__ __forceinline__ unsigned xb_ld(unsigned* p)              { return __hip_atomic_load(p, __ATOMIC_RELAXED, __HIP_MEMORY_SCOPE_AGENT); }
__device__ __forceinline__ unsigned xb_add(unsigned* p, unsigned v) { return __hip_atomic_fetch_add(p, v, __ATOMIC_RELAXED, __HIP_MEMORY_SCOPE_AGENT); }
__device__ __forceinline__ unsigned xb_xcc_id() { return (unsigned)__builtin_amdgcn_s_getreg((3 << 11) | 20) & 0xFu; }
#define XB_SPIN(cond, bar) do { unsigned _sp = 0; while (cond) { __builtin_amdgcn_s_sleep(1); \
    if ((++_sp & 255u) == 0u) { if (xb_ld(&(bar)[XB_TMO])) break; if (_sp > XB_SPIN_CAP) { atomicAdd(&(bar)[XB_TMO], 1u); break; } } } } while (0)

struct XcdBarrier {
    unsigned* bar; unsigned x;
    volatile LAS unsigned* st;
};

__device__ __forceinline__ XcdBarrier xcd_barrier_post(unsigned* bar, volatile LAS unsigned* st) {
    XcdBarrier b; b.bar = bar; b.x = xb_xcc_id(); b.st = st;
    if (threadIdx.x == 0) (void)xb_add(&bar[XB_XCNT(b.x)], 1u);
    return b;
}
__device__ __forceinline__ void xcd_barrier_complete(unsigned* bar, unsigned x, unsigned& nloc, unsigned& nx) {
    const unsigned G = gridDim.x * gridDim.y * gridDim.z;
    unsigned sum, cnt, mine, sp = 0u;
    for (;;) {
        sum = 0u; cnt = 0u; mine = 0u;
#pragma unroll
        for (unsigned j = 0; j < 16; ++j) { const unsigned c = xb_ld(&bar[XB_XCNT(j)]); sum += c; cnt += (c > 0u) ? 1u : 0u; mine = (j == x) ? c : mine; }
        if (sum == G) break;
        __builtin_amdgcn_s_sleep(1);
        if ((++sp & 255u) == 0u) { if (xb_ld(&bar[XB_TMO])) break; if (sp > XB_SPIN_CAP) { atomicAdd(&bar[XB_TMO], 1u); break; } }
    }
    nloc = mine > 0u ? mine : 1u; nx = cnt > 0u ? cnt : 1u;
}

__device__ __forceinline__ void xcd_barrier(const XcdBarrier& b) {
    asm volatile("s_waitcnt vmcnt(0)" ::: "memory");
    __syncthreads();
    if (threadIdx.x == 0) {
        unsigned* bar = b.bar;
        __builtin_amdgcn_s_waitcnt(0);
        unsigned nloc = b.st[0], nx = b.st[1];
        if (nloc == 0u) { xcd_barrier_complete(bar, b.x, nloc, nx); b.st[0] = nloc; b.st[1] = nx; }
        const unsigned old = xb_add(&bar[XB_XSUB(b.x)], 1u);
        const unsigned gen = old / nloc;
        if (old + 1u == (gen + 1u) * nloc) {
            __builtin_amdgcn_fence(__ATOMIC_RELEASE, "agent");
            asm volatile("s_waitcnt vmcnt(0)" ::: "memory");
            const unsigned og = xb_add(&bar[XB_TOP], 1u);
            const unsigned tg = og / nx;
            if (og + 1u == (tg + 1u) * nx) xb_add(&bar[XB_TOPGEN], 1u);
            else XB_SPIN(xb_ld(&bar[XB_TOPGEN]) == tg, bar);
            __builtin_amdgcn_fence(__ATOMIC_ACQUIRE, "agent");
            xb_add(&bar[XB_XGEN(b.x)], 1u);
            asm volatile("s_waitcnt vmcnt(0)" ::: "memory");
        } else {
            XB_SPIN(xb_ld(&bar[XB_XGEN(b.x)]) == gen, bar);
            __builtin_amdgcn_fence(__ATOMIC_ACQUIRE, "agent");
            asm volatile("s_waitcnt vmcnt(0)" ::: "memory");
        }
    }
    __syncthreads();
}
#ifndef MK_N_LAUNCHES
#define MK_N_LAUNCHES 1
#endif
constexpr int NWAVES = 8;
constexpr int NPHASES = 10;
constexpr int BATCH = 2, SEQ = 8192, D = 2048, T = BATCH * SEQ;
constexpr int NH = 8, DK = 128, DV = 256;
constexpr int NIN = 16400;
constexpr int OFF_AZ = 4096, OFF_AB = 6144, OFF_RQ = 6160, OFF_RK = 7184, OFF_RV = 8208, OFF_RG = 10256, OFF_GA = 12304, OFF_GB = 14352;
constexpr int N1 = 17408;
constexpr int FF = 5632, NGU = 2 * FF;
constexpr float EPS = 1e-6f;
constexpr size_t MiB = 1u << 20;
constexpr size_t WS_CTL = 0, CTL_ZERO_BYTES = 1 * MiB;
constexpr size_t WS_BETA = 1 * MiB, WS_G = 1 * MiB + 512 * 1024;
constexpr size_t WS_COS = 2 * MiB, WS_SIN = 4 * MiB;
constexpr size_t WS_COS2 = 6 * MiB, WS_SIN2 = 8 * MiB;
constexpr size_t WS_DL = 10 * MiB, WS_RSTD = 11 * MiB;
constexpr size_t WS_WOT = 12 * MiB;
constexpr size_t WS_WGUT = 20 * MiB, WS_WDT = 64 * MiB;
constexpr size_t WS_W1T = 20 * MiB, WS_U = 88 * MiB;
constexpr size_t WS_GW = 20 * MiB, WS_GQ = 52 * MiB, WS_GK = 84 * MiB, WS_GA = 116 * MiB, WS_GU = 132 * MiB;
constexpr size_t WS_QKV = 196 * MiB;
constexpr size_t WS_RQF = 324 * MiB, WS_RKF = 356 * MiB, WS_RKTF = 388 * MiB, WS_RVTF = 420 * MiB, WS_END = 484 * MiB;
constexpr size_t WS_OA = 196 * MiB;
constexpr size_t WS_OB = 260 * MiB;
constexpr size_t WS_MIXED = 132 * MiB;
constexpr size_t WS_HNB = 324 * MiB;
constexpr size_t WS_ACT = 88 * MiB;
static_assert(WS_ACT + (size_t)T * FF * 2 <= WS_HNB, "ACT overlay");
constexpr int CW_BAR = 4096;
constexpr int RING_BYTES = 131072, LDSCTL_OFF = RING_BYTES, MISC_OFF = LDSCTL_OFF + 320, LDS_BYTES = 147456;

typedef unsigned short bf16;
typedef unsigned v4u __attribute__((ext_vector_type(4)));
typedef unsigned v2u __attribute__((ext_vector_type(2)));
typedef float f32x4 __attribute__((ext_vector_type(4)));
#define LDS_WAIT() asm volatile("s_waitcnt lgkmcnt(0)" ::: "memory")
__device__ __forceinline__ unsigned f2bf(float f) { unsigned u = __builtin_bit_cast(unsigned, f); return (u + 0x7fffu + ((u >> 16) & 1u)) >> 16; }
__device__ __forceinline__ unsigned pk2(float lo, float hi) { return f2bf(lo) | (f2bf(hi) << 16); }
__device__ __forceinline__ float bf2f(unsigned b) { return __builtin_bit_cast(float, b << 16); }
__device__ __forceinline__ float bflo(unsigned w) { return __builtin_bit_cast(float, w << 16); }
__device__ __forceinline__ float bfhi(unsigned w) { return __builtin_bit_cast(float, w & 0xffff0000u); }
__device__ __forceinline__ float silu_f(float a) { return a * __builtin_amdgcn_rcpf(1.0f + __expf(-a)); }
__device__ __forceinline__ float wave_sum(float v) {
#pragma unroll
    for (int o = 1; o < 64; o <<= 1) v += __shfl_xor(v, o);
    return v;
}

struct Args { const float* in[14]; float* out; unsigned char* ws; int ph_lo, ph_hi; };
struct Frame {
    LAS unsigned char* lds; int tid, lane, wave, vcu, G;
    const float *x, *norm1_w, *w_in, *conv_w, *a_log, *dt_bias, *gdn_norm_w, *ret_norm_w, *w_out, *norm2_w, *w_gate, *w_up, *w_down, *norm_f_w;
    float* out; unsigned char* ws;
};

__device__ __forceinline__ void transpose_blk(const float* src, int ld, int k0, int sc0, bf16* dst, int K, int dr0, LAS float* scr, int lane) {
#pragma unroll 8
    for (int i = 0; i < 32; ++i) { const int kk = 2 * i + (lane >> 5); scr[kk * 33 + (lane & 31)] = src[(size_t)(k0 + kk) * ld + sc0 + (lane & 31)]; }
    LDS_WAIT(); asm volatile("" ::: "memory");
    const int c = lane & 7;
#pragma unroll
    for (int j = 0; j < 4; ++j) { const int n = (lane >> 3) + 8 * j; const LAS float* s = scr + (8 * c) * 33 + n;
        v4u o; o.x = pk2(s[0 * 33], s[1 * 33]); o.y = pk2(s[2 * 33], s[3 * 33]); o.z = pk2(s[4 * 33], s[5 * 33]); o.w = pk2(s[6 * 33], s[7 * 33]);
        *(v4u*)(dst + (size_t)(dr0 + n) * K + k0 + 8 * c) = o; }
    LDS_WAIT(); asm volatile("" ::: "memory");
}
__device__ __forceinline__ int w1_src_col(int n) {
    if (n < 4096) return n;
    if (n >= 16384) n = n - 16384 + 5120;
    if (n < 6144) { const int isk = n >= 5120, lt = (n - 4096) & 1023, tile = lt >> 8, c = lt & 255, bj = c >> 7, p = c & 127; return (isk ? OFF_RK : OFF_RQ) + (2 * tile + (p >> 6)) * 128 + bj * 64 + (p & 63); }
    if (n < 8192) return OFF_RV + (n - 6144);
    { const int isb = n >= 12288, lt = (n - 8192) & 4095, j = lt >> 8, c = lt & 255, bj = c >> 7, p = c & 127;
      return (isb ? (bj ? OFF_GB : OFF_RG) : (bj ? OFF_GA : OFF_AZ)) + 128 * j + p; }
}
__device__ __forceinline__ void p0_prologue(Frame& F) {
    __syncthreads();
    const int gw = F.vcu * NWAVES + F.wave, NGW = F.G * NWAVES, lane = F.lane;
    {
        LAS float* scr = (LAS float*)(F.lds + F.wave * 16384);
        constexpr int I_1 = (D / 64) * (N1 / 32), I_O = (D / 64) * (D / 32);
        constexpr int NITEMS = I_1 + I_O;
        bf16* W1T = (bf16*)(F.ws + WS_W1T); bf16* WOT = (bf16*)(F.ws + WS_WOT);
        for (int it = gw; it < NITEMS; it += NGW) {
            int r = it;
            if (r < I_1) { const int nb = r % (N1 / 32), kb = r / (N1 / 32); transpose_blk(F.w_in, NIN, 64 * kb, w1_src_col(32 * nb), W1T, D, 32 * nb, scr, lane); continue; } r -= I_1;
            { const int nb = r % (D / 32), kb = r / (D / 32); transpose_blk(F.w_out, D, 64 * kb, 32 * nb, WOT, D, 32 * nb, scr, lane); }
        }
    }
    {
        float* cosT = (float*)(F.ws + WS_COS); float* sinT = (float*)(F.ws + WS_SIN); float* cosT2 = (float*)(F.ws + WS_COS2); float* sinT2 = (float*)(F.ws + WS_SIN2);
        for (int idx = (F.vcu * 512 + F.tid); idx < SEQ * 64; idx += F.G * 512) { const int t = idx >> 6, i = idx & 63;
            const float inv = (float)exp2(-(double)i * (13.287712379549449 / 64.0));
            const float ang = (float)t * inv; const double a = (double)ang; const float cv = (float)cos(a), sv = (float)sin(a);
            cosT[idx] = cv; sinT[idx] = sv; cosT2[i * SEQ + t] = cv; sinT2[i * SEQ + t] = sv; }
    }
    __syncthreads();
    {
        LAS float* wT = (LAS float*)F.lds;
        for (int idx = F.tid; idx < 2048 * 16; idx += 512) { const int k = idx >> 4, c = idx & 15; wT[c * 2048 + k] = F.w_in[(size_t)k * NIN + OFF_AB + c]; }
        __syncthreads();
        bf16* U = (bf16*)(F.ws + WS_U); float* BETA = (float*)(F.ws + WS_BETA); float* GG = (float*)(F.ws + WS_G);
        f32x4 nw[8];
#pragma unroll
        for (int j = 0; j < 8; ++j) nw[j] = ((const f32x4*)F.norm1_w)[64 * j + lane];
        for (int row = gw; row < T; row += NGW) {
            asm volatile("" ::: "memory");
            const f32x4* xr = (const f32x4*)(F.x + (size_t)row * D) + lane;
            f32x4 v[8]; float ss = 0.f;
#pragma unroll
            for (int j = 0; j < 8; ++j) { v[j] = xr[64 * j]; ss += (v[j].x * v[j].x + v[j].y * v[j].y) + (v[j].z * v[j].z + v[j].w * v[j].w); }
            const float rstd = rsqrtf(wave_sum(ss) * (1.0f / D) + EPS);
            v2u* o8 = (v2u*)(U + (size_t)row * D) + lane;
#pragma unroll
            for (int j = 0; j < 8; ++j) { v[j] = (v[j] * rstd) * nw[j]; v2u w; w.x = pk2(v[j].x, v[j].y); w.y = pk2(v[j].z, v[j].w); o8[64 * j] = w; }
            float mb = 0.f, ma = 0.f;
#pragma unroll
            for (int c = 0; c < 16; ++c) { float s = 0.f;
#pragma unroll
                for (int j = 0; j < 8; ++j) { const f32x4 w = *(const LAS f32x4*)(wT + c * 2048 + 256 * j + 4 * lane); s += (v[j].x * w.x + v[j].y * w.y) + (v[j].z * w.z + v[j].w * w.w); }
                s = wave_sum(s);
                if (c < 8) mb = (lane == c) ? s : mb; else ma = (lane == c - 8) ? s : ma; }
            if (lane < 8) { const float bt = 1.0f / (1.0f + expf(-mb)); const float xa = ma + F.dt_bias[lane]; const float sp = xa > 20.f ? xa : log1pf(expf(xa));
                BETA[(size_t)row * 8 + lane] = bt; GG[(size_t)row * 8 + lane] = -expf(F.a_log[lane]) * sp; }
        }
    }
}

__device__ __forceinline__ void gdn_naive(Frame& F, int bh) {
    const int b = bh >> 3, h = bh & 7, tid = F.tid, c = tid & 255, hh = tid >> 8;
    LAS float* sq = (LAS float*)F.lds; LAS float* sk = sq + 128; LAS float* sv = sq + 256; LAS float* sp = sq + 512; LAS float* sred = sq + 1024;
    const int ch = tid < 128 ? h * 128 + tid : (tid < 256 ? 1024 + h * 128 + (tid - 128) : 2048 + h * 256 + (tid - 256));
    const float cw0 = F.conv_w[0 * 4096 + ch], cw1 = F.conv_w[1 * 4096 + ch], cw2 = F.conv_w[2 * 4096 + ch], cw3 = F.conv_w[3 * 4096 + ch];
    const bf16* raw = (const bf16*)(F.ws + WS_QKV) + (size_t)(b * SEQ) * 4096 + ch;
    const float* BETA = (const float*)(F.ws + WS_BETA) + (size_t)(b * SEQ) * 8 + h; const float* GG = (const float*)(F.ws + WS_G) + (size_t)(b * SEQ) * 8 + h;
    bf16* OA = (bf16*)(F.ws + WS_OA) + (size_t)(b * SEQ) * 2048 + h * 256 + c;
    float S[64];
#pragma unroll
    for (int d = 0; d < 64; ++d) S[d] = 0.f;
    float r0 = 0.f, r1 = 0.f, r2 = 0.f;
    float nraw = bf2f(raw[0]), nbeta = BETA[0], ng = GG[0];
    for (int t = 0; t < SEQ; ++t) {
        const float r3 = nraw, beta = nbeta, eg = expf(ng);
        if (t + 1 < SEQ) { nraw = bf2f(raw[(size_t)(t + 1) * 4096]); nbeta = BETA[(size_t)(t + 1) * 8]; ng = GG[(size_t)(t + 1) * 8]; }
        const float a = r0 * cw0 + r1 * cw1 + r2 * cw2 + r3 * cw3; r0 = r1; r1 = r2; r2 = r3;
        float val = a / (1.0f + expf(-a));
        const float ws_ = wave_sum(val * val);
        if (F.lane == 0) sred[F.wave] = ws_;
        __syncthreads();
        if (tid < 128) { val = val * rsqrtf(sred[0] + sred[1] + EPS) * 0.08838834764831845f; sq[tid] = val; }
        else if (tid < 256) { val = val * rsqrtf(sred[2] + sred[3] + EPS); sk[tid - 128] = val; }
        else sv[tid - 256] = val;
        __syncthreads();
        float p = 0.f;
#pragma unroll
        for (int d = 0; d < 64; ++d) p += sk[hh * 64 + d] * S[d];
        sp[hh * 256 + c] = p;
        __syncthreads();
        const float kS = sp[c] + sp[256 + c];
        const float delta = beta * (sv[c] - eg * kS);
        float o = 0.f;
#pragma unroll
        for (int d = 0; d < 64; ++d) { S[d] = eg * S[d] + sk[hh * 64 + d] * delta; o += sq[hh * 64 + d] * S[d]; }
        __syncthreads();
        sp[hh * 256 + c] = o;
        __syncthreads();
        if (hh == 0) OA[(size_t)t * 2048] = (bf16)f2bf(sp[c] + sp[256 + c]);
    }
}
__device__ __forceinline__ void ffn_weight_copies(Frame& F) {
    const int gw = F.vcu * NWAVES + F.wave, NGW = F.G * NWAVES, lane = F.lane;
    LAS float* scr = (LAS float*)(F.lds + F.wave * 16384);
    constexpr int I_G = (D / 64) * (FF / 32), I_D = (FF / 64) * (D / 32);
    bf16* WGUT = (bf16*)(F.ws + WS_WGUT); bf16* WDT = (bf16*)(F.ws + WS_WDT);
    for (int it = gw; it < 2 * I_G + I_D; it += NGW) {
        int r = it;
        if (r < 2 * I_G) { const int up = r >= I_G; if (up) r -= I_G; const int nb = r % (FF / 32), kb = r / (FF / 32), c0 = 32 * nb;
            transpose_blk(up ? F.w_up : F.w_gate, FF, 64 * kb, c0, WGUT, D, 256 * (c0 >> 7) + 128 * up + (c0 & 127), scr, lane); continue; } r -= 2 * I_G;
        { const int nb = r % (D / 32), kb = r / (D / 32); transpose_blk(F.w_down, D, 64 * kb, 32 * nb, WDT, FF, 32 * nb, scr, lane); }
    }
}

typedef float f32x16 __attribute__((ext_vector_type(16)));
typedef short bf16x8 __attribute__((ext_vector_type(8)));
typedef float f32x2_t __attribute__((ext_vector_type(2))); typedef __bf16 bf16x2_t __attribute__((ext_vector_type(2)));
#define MFMA32(a, b, c) __builtin_amdgcn_mfma_f32_32x32x16_bf16((a), (b), (c), 0, 0, 0)
__device__ __forceinline__ unsigned cvtpk_s(float lo, float hi) { f32x2_t v = {lo, hi}; bf16x2_t b = __builtin_convertvector(v, bf16x2_t); return __builtin_bit_cast(unsigned, b); }
#define PACK_STEP(x, s) __builtin_bit_cast(bf16x8, (v4u){cvtpk_s((x)[8 * (s)], (x)[8 * (s) + 1]), cvtpk_s((x)[8 * (s) + 2], (x)[8 * (s) + 3]), cvtpk_s((x)[8 * (s) + 4], (x)[8 * (s) + 5]), cvtpk_s((x)[8 * (s) + 6], (x)[8 * (s) + 7])})
__device__ __forceinline__ bf16x8 ldfrag(const bf16* base, size_t f, int lane) { return *(const bf16x8*)(base + f * 512 + lane * 8); }
__device__ __forceinline__ f32x16 zero16() { f32x16 z; for (int i = 0; i < 16; ++i) z[i] = 0.f; return z; }

#define SCAN_BAR_C() do { asm volatile("s_waitcnt lgkmcnt(0)" ::: "memory"); __builtin_amdgcn_s_barrier(); asm volatile("" ::: "memory"); } while (0)
#define SCAN_BAR() do { asm volatile("s_waitcnt vmcnt(0) lgkmcnt(0)" ::: "memory"); __builtin_amdgcn_s_barrier(); asm volatile("" ::: "memory"); } while (0)
__device__ __forceinline__ void glds1k(const bf16* gsrc_frag, LAS unsigned char* dst, int lane) {
    __builtin_amdgcn_global_load_lds((const unsigned*)(gsrc_frag + lane * 8), (LAS unsigned*)dst, 16, 0, 0);
}
__device__ __forceinline__ bf16x8 ldsfrag(const LAS unsigned char* buf, int slot, int lane) { return *(const LAS bf16x8*)(buf + slot * 1024 + lane * 16); }

constexpr int RS_BUF = 48 * 1024;
__device__ __forceinline__ void ret_scan_wg(Frame& F, int bh, int half) {
    int lane_ = F.lane; asm volatile("" : "+v"(lane_));
    const int lane = lane_, w = F.wave, b = bh >> 3, h = bh & 7, col = lane & 31, hh = lane >> 5;
    const bf16* RQf = (const bf16*)(F.ws + WS_RQF); const bf16* RKf = (const bf16*)(F.ws + WS_RKF); const bf16* RKTf = (const bf16*)(F.ws + WS_RKTF); const bf16* RVTf = (const bf16*)(F.ws + WS_RVTF);
    LAS unsigned char* L = F.lds;
    if (w >= 4) {
        const int lw = w - 4;
        for (int n = -1; n < 128; ++n) {
            if (n + 1 < 128) { const size_t cq = (size_t)bh * 128 + (n + 1); LAS unsigned char* dst = L + ((n + 1) & 1) * RS_BUF;
#pragma unroll
                for (int q = 0; q < 12; ++q) { const int f = 4 * q + lw;
                    const bf16* src = f < 16 ? RQf + (cq * 16 + f) * 512 : (f < 32 ? RKf + (cq * 16 + (f - 16)) * 512 : RKTf + (cq * 16 + (f - 32)) * 512);
                    glds1k(src, dst + f * 1024, lane); } }
            SCAN_BAR();
        }
        return;
    }
    const int sl = 4 * half + w;
    bf16* OB = (bf16*)(F.ws + WS_OB) + (size_t)(b * SEQ) * 2048 + h * 256 + sl * 32;
    const unsigned loff = (unsigned)(hh * 4 * 2048 + col);
    const float g64 = exp2f(64.0f * log2f(1.0f - exp2f(-5.0f - (float)h)));
    f32x16 S[4];
#pragma unroll
    for (int td = 0; td < 4; ++td) S[td] = zero16();
    SCAN_BAR_C();
    for (int n = 0; n < 128; ++n) {
        const LAS unsigned char* B = L + (n & 1) * RS_BUF;
        bf16x8 vt[2][2];
        { const size_t cq = (size_t)bh * 128 + n;
#pragma unroll
          for (int tj = 0; tj < 2; ++tj)
#pragma unroll
            for (int s2 = 0; s2 < 2; ++s2) vt[tj][s2] = ldfrag(RVTf, ((cq * 8 + sl) * 2 + tj) * 2 + s2, lane); }
        f32x16 P00 = zero16(), P01 = zero16(), P11 = zero16();
#pragma unroll
        for (int td = 0; td < 4; ++td)
#pragma unroll
            for (int s2 = 0; s2 < 2; ++s2) {
                if (s2 == 0) asm volatile("" ::: "memory");
                const bf16x8 k0 = ldsfrag(B, 16 + (0 * 4 + td) * 2 + s2, lane), k1 = ldsfrag(B, 16 + (1 * 4 + td) * 2 + s2, lane);
                const bf16x8 q0 = ldsfrag(B, (0 * 4 + td) * 2 + s2, lane), q1 = ldsfrag(B, (1 * 4 + td) * 2 + s2, lane);
                P00 = MFMA32(k0, q0, P00); P01 = MFMA32(k0, q1, P01); P11 = MFMA32(k1, q1, P11); }
#pragma unroll
        for (int r = 0; r < 16; ++r) { const int j = (r & 3) + 8 * (r >> 2) + 4 * hh; if (col < j) { P00[r] = 0.f; P11[r] = 0.f; } }
        f32x16 o0 = zero16(), o1 = zero16();
#pragma unroll
        for (int td = 0; td < 4; ++td) {
            asm volatile("" ::: "memory");
            const bf16x8 sb0 = PACK_STEP(S[td], 0), sb1 = PACK_STEP(S[td], 1);
            o0 = MFMA32(ldsfrag(B, (0 * 4 + td) * 2 + 0, lane), sb0, o0); o0 = MFMA32(ldsfrag(B, (0 * 4 + td) * 2 + 1, lane), sb1, o0);
            o1 = MFMA32(ldsfrag(B, (1 * 4 + td) * 2 + 0, lane), sb0, o1); o1 = MFMA32(ldsfrag(B, (1 * 4 + td) * 2 + 1, lane), sb1, o1); }
        { const bf16x8 a0 = PACK_STEP(P00, 0), a1 = PACK_STEP(P00, 1); o0 = MFMA32(a0, vt[0][0], o0); o0 = MFMA32(a1, vt[0][1], o0); }
        { const bf16x8 a0 = PACK_STEP(P01, 0), a1 = PACK_STEP(P01, 1); o1 = MFMA32(a0, vt[0][0], o1); o1 = MFMA32(a1, vt[0][1], o1); }
        { const bf16x8 a0 = PACK_STEP(P11, 0), a1 = PACK_STEP(P11, 1); o1 = MFMA32(a0, vt[1][0], o1); o1 = MFMA32(a1, vt[1][1], o1); }
        bf16* orow = OB + (size_t)(64 * n) * 2048;
#pragma unroll
        for (int r = 0; r < 16; ++r) { const unsigned ro = (unsigned)(((r & 3) + 8 * (r >> 2)) * 2048); orow[loff + ro] = (bf16)f2bf(o0[r]); orow[loff + ro + 32u * 2048u] = (bf16)f2bf(o1[r]); }
#pragma unroll
        for (int td = 0; td < 4; ++td) { S[td] = S[td] * g64;
#pragma unroll
            for (int tj = 0; tj < 2; ++tj)
#pragma unroll
                for (int s2 = 0; s2 < 2; ++s2) S[td] = MFMA32(ldsfrag(B, 32 + (td * 2 + tj) * 2 + s2, lane), vt[tj][s2], S[td]); }
        SCAN_BAR_C();
    }
}

constexpr int GP_QH = 0, GP_KH = 17408, GP_AM = 34816, GP_RK = 51200, GP_GC = 83968, GP_BT = 84224, GP_WL = GP_RK;
__device__ __forceinline__ void gdn_prep(Frame& F, int ci) {
    int tid_ = F.tid; asm volatile("" : "+v"(tid_));
    const int tid = tid_, lane = tid & 63, w = __builtin_amdgcn_readfirstlane(tid >> 6), bh = ci >> 7, n = ci & 127, b = bh >> 3, h = bh & 7;
    const size_t trow0 = (size_t)b * SEQ + 64 * n;
    LAS unsigned char* L = F.lds;
    LAS float* gcs = (LAS float*)(L + GP_GC); LAS float* bet = (LAS float*)(L + GP_BT); LAS float* Am = (LAS float*)(L + GP_AM); LAS float* Rk = (LAS float*)(L + GP_RK);
    const bf16* QKV = (const bf16*)(F.ws + WS_QKV);
    bf16* GW = (bf16*)(F.ws + WS_GW); bf16* GQ = (bf16*)(F.ws + WS_GQ); bf16* GK = (bf16*)(F.ws + WS_GK); bf16* GA = (bf16*)(F.ws + WS_GA); bf16* GU = (bf16*)(F.ws + WS_GU);
    if (w == 0) {
        float g = ((const float*)(F.ws + WS_G))[(trow0 + lane) * 8 + h];
#pragma unroll
        for (int o = 1; o < 64; o <<= 1) { const float t = __shfl_up(g, o); if (lane >= o) g += t; }
        gcs[lane] = g; bet[lane] = ((const float*)(F.ws + WS_BETA))[(trow0 + lane) * 8 + h];
        if (lane == 63) ((float*)(F.ws + WS_DL))[ci] = expf(g);
    }
    __syncthreads();
    {
        const int cg = lane & 31, rh = lane >> 5, isk = cg >> 4, dk0 = 8 * (cg & 15), row0 = 8 * w + 4 * rh;
        const int ch = (isk ? 1024 : 0) + h * 128 + dk0;
        float cw[4][8];
#pragma unroll
        for (int j = 0; j < 4; ++j) { const f32x4 a = *(const f32x4*)(F.conv_w + j * 4096 + ch), c = *(const f32x4*)(F.conv_w + j * 4096 + ch + 4);
            cw[j][0] = a.x; cw[j][1] = a.y; cw[j][2] = a.z; cw[j][3] = a.w; cw[j][4] = c.x; cw[j][5] = c.y; cw[j][6] = c.z; cw[j][7] = c.w; }
        float raw[7][8];
#pragma unroll
        for (int rr = 0; rr < 7; ++rr) { const int row = row0 - 3 + rr;
            v4u v = {0u, 0u, 0u, 0u};
            if (n > 0 || row >= 0) v = *(const v4u*)(QKV + (trow0 + row) * 4096 + ch);
#pragma unroll
            for (int e = 0; e < 4; ++e) { raw[rr][2 * e] = bflo(v[e]); raw[rr][2 * e + 1] = bfhi(v[e]); } }
        const float g63 = gcs[63];
#pragma unroll
        for (int r = 0; r < 4; ++r) { asm volatile("" ::: "memory"); const int row = row0 + r; float val[8]; float ss = 0.f;
#pragma unroll
            for (int e = 0; e < 8; ++e) { const float a = raw[r][e] * cw[0][e] + raw[r + 1][e] * cw[1][e] + raw[r + 2][e] * cw[2][e] + raw[r + 3][e] * cw[3][e];
                val[e] = silu_f(a); ss += val[e] * val[e]; }
            ss += __shfl_xor(ss, 1); ss += __shfl_xor(ss, 2); ss += __shfl_xor(ss, 4); ss += __shfl_xor(ss, 8);
            const float rn = rsqrtf(ss + EPS) * (isk ? 1.0f : 0.08838834764831845f);
            const float gc = gcs[row], eg = __expf(gc);
#pragma unroll
            for (int e = 0; e < 8; ++e) val[e] *= rn;
            v4u pk; pk.x = pk2(val[0], val[1]); pk.y = pk2(val[2], val[3]); pk.z = pk2(val[4], val[5]); pk.w = pk2(val[6], val[7]);
            *(LAS v4u*)(L + (isk ? GP_KH : GP_QH) + row * 272 + dk0 * 2) = pk;
            if (!isk) {
                const size_t f = (((size_t)ci * 2 + (row >> 5)) * 4 + (dk0 >> 5)) * 2 + ((dk0 >> 4) & 1);
                bf16* p = GQ + f * 512 + (row & 31) * 8 + ((dk0 >> 3) & 1) * 4;
                v2u a; a.x = pk2(val[0] * eg, val[1] * eg); a.y = pk2(val[2] * eg, val[3] * eg); *(v2u*)p = a;
                a.x = pk2(val[4] * eg, val[5] * eg); a.y = pk2(val[6] * eg, val[7] * eg); *(v2u*)(p + 256) = a;
            } else {
                const float bt = bet[row] * eg;
                f32x4 r0 = {val[0] * bt, val[1] * bt, val[2] * bt, val[3] * bt}, r1 = {val[4] * bt, val[5] * bt, val[6] * bt, val[7] * bt};
                *(LAS f32x4*)(Rk + row * 128 + dk0) = r0; *(LAS f32x4*)(Rk + row * 128 + dk0 + 4) = r1;
                const float ek = __expf(g63 - gc);
#pragma unroll
                for (int e = 0; e < 8; ++e) raw[r][e] = val[e] * ek;
            }
        }
        if (isk) {
            const int tj = w >> 2, s1 = (w >> 1) & 1;
#pragma unroll
            for (int e = 0; e < 8; ++e) { const int dk = dk0 + e;
                const size_t f = (((size_t)ci * 4 + (dk >> 5)) * 2 + tj) * 2 + s1;
                v2u a; a.x = pk2(raw[0][e], raw[1][e]); a.y = pk2(raw[2][e], raw[3][e]);
                *(v2u*)(GK + f * 512 + (rh * 32 + (dk & 31)) * 8 + (w & 1) * 4) = a; }
        }
    }
    __syncthreads();
    if (w < 6) {
        const int tsel = w % 3, ti = tsel == 0 ? 0 : 1, tj = tsel == 2 ? 1 : 0;
        const int r = lane & 31, hh = lane >> 5;
        f32x16 acc = zero16();
        if (w < 3) {
#pragma unroll
            for (int kb = 0; kb < 8; ++kb) { const bf16x8 a = *(const LAS bf16x8*)(L + GP_KH + (32 * ti + r) * 272 + (16 * kb + 8 * hh) * 2), bb = *(const LAS bf16x8*)(L + GP_KH + (32 * tj + r) * 272 + (16 * kb + 8 * hh) * 2);
                acc = MFMA32(a, bb, acc); }
            const int j = 32 * tj + r; const float gj = gcs[j];
#pragma unroll
            for (int q = 0; q < 16; ++q) { const int i = 32 * ti + (q & 3) + 8 * (q >> 2) + 4 * hh;
                const float v = (i > j) ? bet[i] * acc[q] * __expf(fminf(gcs[i] - gj, 0.f)) : 0.f; Am[i * 64 + j] = v; }
        } else {
#pragma unroll
            for (int kb = 0; kb < 8; ++kb) { const bf16x8 a = *(const LAS bf16x8*)(L + GP_KH + (32 * tj + r) * 272 + (16 * kb + 8 * hh) * 2), bb = *(const LAS bf16x8*)(L + GP_QH + (32 * ti + r) * 272 + (16 * kb + 8 * hh) * 2);
                acc = MFMA32(a, bb, acc); }
            const int i = 32 * ti + r; const float gi = gcs[i];
#pragma unroll
            for (int q = 0; q < 16; ++q) { const int j = 32 * tj + (q & 3) + 8 * (q >> 2) + 4 * hh;
                acc[q] = (i >= j) ? acc[q] * __expf(fminf(gi - gcs[j], 0.f)) : 0.f; }
            const bf16x8 f0 = PACK_STEP(acc, 0), f1 = PACK_STEP(acc, 1);
            const size_t f = (((size_t)ci * 2 + ti) * 2 + tj) * 2;
            *(bf16x8*)(GA + f * 512 + lane * 8) = f0; *(bf16x8*)(GA + (f + 1) * 512 + lane * 8) = f1;
        }
    }
    __syncthreads();
    float x[64];
    if (tid < 384) {
        if (tid < 256) {
            const int ch = 2048 + h * 256 + tid;
            const float c0 = F.conv_w[ch], c1 = F.conv_w[4096 + ch], c2 = F.conv_w[2 * 4096 + ch], c3 = F.conv_w[3 * 4096 + ch];
            const bf16* src = QKV + trow0 * 4096 + ch;
            float r0 = 0.f, r1 = 0.f, r2 = 0.f;
            if (n > 0) { r0 = bf2f(src[-3 * 4096]); r1 = bf2f(src[-2 * 4096]); r2 = bf2f(src[-1 * 4096]); }
#pragma unroll
            for (int i = 0; i < 64; ++i) { const float r3 = bf2f(src[(size_t)i * 4096]); const float a = r0 * c0 + r1 * c1 + r2 * c2 + r3 * c3; r0 = r1; r1 = r2; r2 = r3;
                x[i] = bet[i] * silu_f(a); }
        } else {
#pragma unroll
            for (int i = 0; i < 64; ++i) x[i] = Rk[i * 128 + (tid - 256)];
        }
#pragma unroll
        for (int i = 1; i < 64; ++i) { float s0 = 0.f, s1 = 0.f, s2 = 0.f, s3 = 0.f;
            asm volatile("" ::: "memory");
#pragma unroll
            for (int q = 0; q < (i + 3) / 4; ++q) { const f32x4 a = *(const LAS f32x4*)(Am + i * 64 + 4 * q);
                if (4 * q + 0 < i) s0 += a.x * x[4 * q + 0];
                if (4 * q + 1 < i) s1 += a.y * x[4 * q + 1];
                if (4 * q + 2 < i) s2 += a.z * x[4 * q + 2];
                if (4 * q + 3 < i) s3 += a.w * x[4 * q + 3]; }
            x[i] -= (s0 + s1) + (s2 + s3);
            asm volatile("" : "+v"(x[i])); }
        if (tid < 256) {
            const int sl = tid >> 5, col = tid & 31;
#pragma unroll
            for (int ti = 0; ti < 2; ++ti)
#pragma unroll
                for (int hh = 0; hh < 2; ++hh) { v4u a, c;
#define XR(q) x[32 * ti + ((q) & 3) + 8 * ((q) >> 2) + 4 * hh]
                    a.x = pk2(XR(0), XR(1)); a.y = pk2(XR(2), XR(3)); a.z = pk2(XR(4), XR(5)); a.w = pk2(XR(6), XR(7));
                    c.x = pk2(XR(8), XR(9)); c.y = pk2(XR(10), XR(11)); c.z = pk2(XR(12), XR(13)); c.w = pk2(XR(14), XR(15));
#undef XR
                    bf16* p = GU + (((size_t)ci * 8 + sl) * 2 + ti) * 1024 + (hh * 32 + col) * 16;
                    *(v4u*)p = a; *(v4u*)(p + 8) = c; }
        }
    }
    __syncthreads();
    if (tid >= 256 && tid < 384) { const int dk = tid - 256;
#pragma unroll
        for (int i = 0; i < 64; ++i) *(LAS unsigned short*)(L + GP_WL + i * 272 + dk * 2) = (unsigned short)f2bf(-x[i]); }
    __syncthreads();
#pragma unroll
    for (int k = 0; k < 2; ++k) { const int idx = tid + 512 * k, row = idx >> 4, dk0 = 8 * (idx & 15);
        const v4u v = *(const LAS v4u*)(L + GP_WL + row * 272 + dk0 * 2);
        const size_t f = (((size_t)ci * 2 + (row >> 5)) * 4 + (dk0 >> 5)) * 2 + ((dk0 >> 4) & 1);
        bf16* p = GW + f * 512 + (row & 31) * 8 + ((dk0 >> 3) & 1) * 4;
        v2u a; a.x = v.x; a.y = v.y; *(v2u*)p = a; a.x = v.z; a.y = v.w; *(v2u*)(p + 256) = a; }
    __syncthreads();
}

constexpr int GS_BUF = 54 * 1024;
__device__ __forceinline__ void gdn_scan_wg(Frame& F, int bh, int half) {
    int lane_ = F.lane; asm volatile("" : "+v"(lane_));
    const int lane = lane_, w = F.wave, b = bh >> 3, h = bh & 7, col = lane & 31, hh = lane >> 5;
    const bf16* GW = (const bf16*)(F.ws + WS_GW); const bf16* GQ = (const bf16*)(F.ws + WS_GQ); const bf16* GK = (const bf16*)(F.ws + WS_GK); const bf16* GA = (const bf16*)(F.ws + WS_GA); const bf16* GU = (const bf16*)(F.ws + WS_GU);
    LAS unsigned char* L = F.lds;
    if (w >= 4) {
        const int lw = w - 4;
        for (int n = -1; n < 128; ++n) {
            if (n + 1 < 128) { const size_t ci = (size_t)bh * 128 + (n + 1); LAS unsigned char* dst = L + ((n + 1) & 1) * GS_BUF;
#pragma unroll
                for (int q = 0; q < 14; ++q) { const int f = 4 * q + lw;
                    if (f < 54) { const int ga = f - 48, gaf = ga < 2 ? ga : ga + 2;
                        const bf16* src = f < 16 ? GW + (ci * 16 + f) * 512 : (f < 32 ? GQ + (ci * 16 + (f - 16)) * 512 : (f < 48 ? GK + (ci * 16 + (f - 32)) * 512 : GA + (ci * 8 + gaf) * 512));
                        glds1k(src, dst + f * 1024, lane); } } }
            SCAN_BAR();
        }
        return;
    }
    const int sl = 4 * half + w;
    const float* DL = (const float*)(F.ws + WS_DL);
    bf16* OA = (bf16*)(F.ws + WS_OA) + (size_t)(b * SEQ) * 2048 + h * 256 + sl * 32;
    const unsigned loff = (unsigned)(hh * 4 * 2048 + col);
    f32x16 S[4];
#pragma unroll
    for (int td = 0; td < 4; ++td) S[td] = zero16();
    v4u un[2][2]; float dln;
    { const size_t ci = (size_t)bh * 128; dln = DL[ci];
#pragma unroll
      for (int ti = 0; ti < 2; ++ti) { const bf16* p = GU + ((ci * 8 + sl) * 2 + ti) * 1024 + lane * 16; un[ti][0] = *(const v4u*)p; un[ti][1] = *(const v4u*)(p + 8); } }
    SCAN_BAR_C();
    for (int n = 0; n < 128; ++n) {
        const LAS unsigned char* B = L + (n & 1) * GS_BUF;
        f32x16 vn[2]; const float dl = dln;
#pragma unroll
        for (int ti = 0; ti < 2; ++ti)
#pragma unroll
            for (int e = 0; e < 4; ++e) { vn[ti][2 * e] = bflo(un[ti][0][e]); vn[ti][2 * e + 1] = bfhi(un[ti][0][e]); vn[ti][8 + 2 * e] = bflo(un[ti][1][e]); vn[ti][8 + 2 * e + 1] = bfhi(un[ti][1][e]); }
        if (n + 1 < 128) { const size_t ci = (size_t)bh * 128 + n + 1; dln = DL[ci];
#pragma unroll
            for (int ti = 0; ti < 2; ++ti) { const bf16* p = GU + ((ci * 8 + sl) * 2 + ti) * 1024 + lane * 16; un[ti][0] = *(const v4u*)p; un[ti][1] = *(const v4u*)(p + 8); } }
        f32x16 o0 = zero16(), o1 = zero16();
#pragma unroll
        for (int td = 0; td < 4; ++td) {
            const bf16x8 sb0 = PACK_STEP(S[td], 0), sb1 = PACK_STEP(S[td], 1);
            const int f0 = (0 * 4 + td) * 2, f1 = (1 * 4 + td) * 2;
            vn[0] = MFMA32(ldsfrag(B, f0, lane), sb0, vn[0]); vn[0] = MFMA32(ldsfrag(B, f0 + 1, lane), sb1, vn[0]);
            vn[1] = MFMA32(ldsfrag(B, f1, lane), sb0, vn[1]); vn[1] = MFMA32(ldsfrag(B, f1 + 1, lane), sb1, vn[1]);
            o0 = MFMA32(ldsfrag(B, 16 + f0, lane), sb0, o0); o0 = MFMA32(ldsfrag(B, 16 + f0 + 1, lane), sb1, o0);
            o1 = MFMA32(ldsfrag(B, 16 + f1, lane), sb0, o1); o1 = MFMA32(ldsfrag(B, 16 + f1 + 1, lane), sb1, o1); }
        const bf16x8 vb00 = PACK_STEP(vn[0], 0), vb01 = PACK_STEP(vn[0], 1), vb10 = PACK_STEP(vn[1], 0), vb11 = PACK_STEP(vn[1], 1);
        o0 = MFMA32(ldsfrag(B, 48, lane), vb00, o0); o0 = MFMA32(ldsfrag(B, 49, lane), vb01, o0);
        o1 = MFMA32(ldsfrag(B, 50, lane), vb00, o1); o1 = MFMA32(ldsfrag(B, 51, lane), vb01, o1);
        o1 = MFMA32(ldsfrag(B, 52, lane), vb10, o1); o1 = MFMA32(ldsfrag(B, 53, lane), vb11, o1);
        bf16* orow = OA + (size_t)(64 * n) * 2048;
#pragma unroll
        for (int r = 0; r < 16; ++r) { const unsigned ro = (unsigned)(((r & 3) + 8 * (r >> 2)) * 2048); orow[loff + ro] = (bf16)f2bf(o0[r]); orow[loff + ro + 32u * 2048u] = (bf16)f2bf(o1[r]); }
#pragma unroll
        for (int td = 0; td < 4; ++td) { S[td] = S[td] * dl; const int f = 32 + (td * 2) * 2;
            S[td] = MFMA32(ldsfrag(B, f, lane), vb00, S[td]); S[td] = MFMA32(ldsfrag(B, f + 1, lane), vb01, S[td]);
            S[td] = MFMA32(ldsfrag(B, f + 2, lane), vb10, S[td]); S[td] = MFMA32(ldsfrag(B, f + 3, lane), vb11, S[td]); }
        SCAN_BAR_C();
    }
}

__device__ __forceinline__ void p3_mixed(Frame& F) {
    const int gw = F.vcu * NWAVES + F.wave, NGW = F.G * NWAVES, lane = F.lane;
    const bf16* OA = (const bf16*)(F.ws + WS_OA); const bf16* OB = (const bf16*)(F.ws + WS_OB);
    const bf16* GZA = (const bf16*)F.out; const bf16* GZB = GZA + (size_t)T * 2048; bf16* MIX = (bf16*)(F.ws + WS_MIXED);
    for (int row = gw; row < T; row += NGW) {
        const size_t off = (size_t)row * 2048 + 32 * lane;
        v4u a4[4], b4[4], ga[4], gb[4];
#pragma unroll
        for (int q = 0; q < 4; ++q) { a4[q] = *(const v4u*)(OA + off + 8 * q); b4[q] = *(const v4u*)(OB + off + 8 * q); ga[q] = *(const v4u*)(GZA + off + 8 * q); gb[q] = *(const v4u*)(GZB + off + 8 * q); }
        float a[32], bb[32];
#pragma unroll
        for (int q = 0; q < 4; ++q)
#pragma unroll
            for (int e = 0; e < 4; ++e) { a[8 * q + 2 * e] = bflo(a4[q][e]); a[8 * q + 2 * e + 1] = bfhi(a4[q][e]); bb[8 * q + 2 * e] = bflo(b4[q][e]); bb[8 * q + 2 * e + 1] = bfhi(b4[q][e]); }
        float sa = 0.f, sb = 0.f;
#pragma unroll
        for (int i = 0; i < 32; ++i) { sa += a[i] * a[i]; sb += bb[i]; }
        sa += __shfl_xor(sa, 1); sa += __shfl_xor(sa, 2); sa += __shfl_xor(sa, 4);
        sb += __shfl_xor(sb, 1); sb += __shfl_xor(sb, 2); sb += __shfl_xor(sb, 4);
        const float rsa = rsqrtf(sa * (1.0f / 256.0f) + EPS), mu = sb * (1.0f / 256.0f);
        float vb = 0.f;
#pragma unroll
        for (int i = 0; i < 32; ++i) { bb[i] -= mu; vb += bb[i] * bb[i]; }
        vb += __shfl_xor(vb, 1); vb += __shfl_xor(vb, 2); vb += __shfl_xor(vb, 4);
        const float rsb = rsqrtf(vb * (1.0f / 256.0f) + EPS);
        const float* wa = F.gdn_norm_w + ((32 * lane) & 255); const float* wb = F.ret_norm_w + 32 * lane;
#pragma unroll
        for (int q = 0; q < 4; ++q) { v4u o;
#pragma unroll
            for (int e = 0; e < 4; ++e) { const int i = 8 * q + 2 * e;
                const float m0 = a[i] * rsa * wa[i] * bflo(ga[q][e]) + bb[i] * rsb * wb[i] * bflo(gb[q][e]);
                const float m1 = a[i + 1] * rsa * wa[i + 1] * bfhi(ga[q][e]) + bb[i + 1] * rsb * wb[i + 1] * bfhi(gb[q][e]);
                o[e] = pk2(m0, m1); }
            *(v4u*)(MIX + off + 8 * q) = o; }
    }
}
__device__ __forceinline__ void row_rmsnorm(Frame& F, const float* src, const float* w, bf16* dst16, float* dst32) {
    const int gw = F.vcu * NWAVES + F.wave, NGW = F.G * NWAVES, lane = F.lane;
    f32x4 nw[8];
#pragma unroll
    for (int j = 0; j < 8; ++j) nw[j] = ((const f32x4*)w)[64 * j + lane];
    for (int row = gw; row < T; row += NGW) {
        const f32x4* xr = (const f32x4*)(src + (size_t)row * D) + lane;
        f32x4 v[8]; float ss = 0.f;
#pragma unroll
        for (int j = 0; j < 8; ++j) { v[j] = xr[64 * j]; ss += (v[j].x * v[j].x + v[j].y * v[j].y) + (v[j].z * v[j].z + v[j].w * v[j].w); }
        const float rstd = rsqrtf(wave_sum(ss) * (1.0f / D) + EPS);
        if (dst16) { v2u* o8 = (v2u*)(dst16 + (size_t)row * D) + lane;
#pragma unroll
            for (int j = 0; j < 8; ++j) { const f32x4 y = (v[j] * rstd) * nw[j]; v2u o; o.x = pk2(y.x, y.y); o.y = pk2(y.z, y.w); o8[64 * j] = o; } }
        else { f32x4* o = (f32x4*)(dst32 + (size_t)row * D) + lane;
#pragma unroll
            for (int j = 0; j < 8; ++j) o[64 * j] = (v[j] * rstd) * nw[j]; }
    }
}

__global__ void __launch_bounds__(NWAVES * 64, 2) fwd_kernel(Args args) {
    extern __shared__ __attribute__((aligned(16))) unsigned char lds[];
    Frame F;
    F.lds = (LAS unsigned char*)lds;
    F.tid = threadIdx.x; F.lane = F.tid & 63; F.wave = __builtin_amdgcn_readfirstlane(F.tid >> 6);
    F.G = gridDim.x; { const int bx = blockIdx.x; F.vcu = (F.G % 8 == 0) ? (bx % 8) * (F.G / 8) + bx / 8 : bx; }
    F.x = args.in[0]; F.norm1_w = args.in[1]; F.w_in = args.in[2]; F.conv_w = args.in[3]; F.a_log = args.in[4]; F.dt_bias = args.in[5]; F.gdn_norm_w = args.in[6];
    F.ret_norm_w = args.in[7]; F.w_out = args.in[8]; F.norm2_w = args.in[9]; F.w_gate = args.in[10]; F.w_up = args.in[11]; F.w_down = args.in[12]; F.norm_f_w = args.in[13];
    F.out = args.out; F.ws = args.ws;
    volatile LAS unsigned* MISC = (volatile LAS unsigned*)(F.lds + MISC_OFF);
    for (int u = F.tid; u < (LDS_BYTES - LDSCTL_OFF) / 4; u += NWAVES * 64) ((LAS unsigned*)(F.lds + LDSCTL_OFF))[u] = 0u;
    __syncthreads();
    const int lo = args.ph_lo, hi = args.ph_hi;
    const bool use_bar = (hi - lo) > 1;
    XcdBarrier bar; bar.bar = (unsigned*)(F.ws + WS_CTL) + CW_BAR; bar.x = 0; bar.st = nullptr;
    if (use_bar) bar = xcd_barrier_post((unsigned*)(F.ws + WS_CTL) + CW_BAR, MISC + 8);
#ifndef PROBE_REP
#define PROBE_REP -1
#endif
#define NREP(k) ((PROBE_REP) == (k) ? 2 : 1)
#define IN(k) (lo <= (k) && (k) < hi)
#define SEAM(k) do { if (IN(k) && IN((k) + 1)) xcd_barrier(bar); } while (0)

    if (IN(0)) for (int rep_ = 0; rep_ < NREP(0); ++rep_) { p0_prologue(F); } SEAM(0);
    if (IN(1)) for (int rep_ = 0; rep_ < NREP(1); ++rep_) {
        pg8::Gemm g{(const pg8::bf16_t*)(F.ws + WS_U), (const pg8::bf16_t*)(F.ws + WS_W1T), T, N1, D}; pg8::InProjOrder S; S.init(T, N1, F.G, (int)blockIdx.x);
        pg8::EpiInProj E{F.ws, (pg8::bf16_t*)F.out, WS_QKV, WS_RQF, WS_RKF, WS_RKTF, WS_RVTF, WS_COS, WS_SIN, WS_COS2, WS_SIN2};
        pg8::gemm_phase<pg8::EpiInProj, pg8::InProjOrder, true, true>(F.lds, g, S, E);
    } SEAM(1);
    if (IN(2)) for (int rep_ = 0; rep_ < NREP(2); ++rep_) { for (int ci = blockIdx.x; ci < BATCH * NH * 128; ci += F.G) gdn_prep(F, ci); } SEAM(2);
    if (IN(3)) for (int rep_ = 0; rep_ < NREP(3); ++rep_) {
        const int bx = blockIdx.x;
        if (bx < 64) { const int x = bx & 31, xc = x & 7, y = x >> 3, bh = xc + 8 * (y >> 1), half = y & 1;
            if (bx < 32) ret_scan_wg(F, bh, half); else gdn_scan_wg(F, bh, half); }
    } SEAM(3);
    if (IN(4)) for (int rep_ = 0; rep_ < NREP(4); ++rep_) { p3_mixed(F); ffn_weight_copies(F); } SEAM(4);
    if (IN(5)) for (int rep_ = 0; rep_ < NREP(5); ++rep_) {
        pg8::Gemm g{(const pg8::bf16_t*)(F.ws + WS_MIXED), (const pg8::bf16_t*)(F.ws + WS_WOT), T, D, D}; pg8::StaticOrder S; S.init(T, D, F.G, (int)blockIdx.x);
        pg8::EpiResF32 E{F.x, F.out, D};
        pg8::gemm_phase<pg8::EpiResF32, pg8::StaticOrder, true, true>(F.lds, g, S, E);
    } SEAM(5);
    if (IN(6)) for (int rep_ = 0; rep_ < NREP(6); ++rep_) { row_rmsnorm(F, F.out, F.norm2_w, (bf16*)(F.ws + WS_HNB), nullptr); } SEAM(6);
    if (IN(7)) for (int rep_ = 0; rep_ < NREP(7); ++rep_) {
        pg8::Gemm g{(const pg8::bf16_t*)(F.ws + WS_HNB), (const pg8::bf16_t*)(F.ws + WS_WGUT), T, NGU, D}; pg8::StaticOrder S; S.init(T, NGU, F.G, (int)blockIdx.x);
        pg8::EpiGateUp E{(pg8::bf16_t*)(F.ws + WS_ACT), FF, nullptr};
        pg8::gemm_phase<pg8::EpiGateUp, pg8::StaticOrder, true, true>(F.lds, g, S, E);
    } SEAM(7);
    if (IN(8)) {
        pg8::Gemm g{(const pg8::bf16_t*)(F.ws + WS_ACT), (const pg8::bf16_t*)(F.ws + WS_WDT), T, D, FF}; pg8::StaticOrder S; S.init(T, D, F.G, (int)blockIdx.x);
        pg8::EpiResF32 E{F.out, F.out, D};
        pg8::gemm_phase<pg8::EpiResF32, pg8::StaticOrder, true, true>(F.lds, g, S, E);
    } SEAM(8);
    if (IN(9)) { row_rmsnorm(F, F.out, F.norm_f_w, nullptr, F.out); }
#undef IN
#undef SEAM
}

extern "C" void kernel_launch(void* const* d_in, const int* in_sizes, int n_in, void* d_out, int out_size, void* d_ws, size_t ws_size, hipStream_t stream) {
    static int grid = 0;
    if (grid == 0) {
        if (n_in != 14 || in_sizes[0] != T * D || out_size != T * D || ws_size < WS_END) { fprintf(stderr, "kernel_launch: unexpected shapes: n_in %d in0 %d out %d ws %zu (need %zu)\n", n_in, n_in > 0 ? in_sizes[0] : -1, out_size, ws_size, (size_t)WS_END); grid = -1; return; }
        int dev = 0, cus = 0, per_cu = 0;
        if (hipGetDevice(&dev) != hipSuccess || hipDeviceGetAttribute(&cus, hipDeviceAttributeMultiprocessorCount, dev) != hipSuccess) { grid = -1; return; }
        if (hipFuncSetAttribute((const void*)fwd_kernel, hipFuncAttributeMaxDynamicSharedMemorySize, LDS_BYTES) != hipSuccess) { fprintf(stderr, "kernel_launch: hipFuncSetAttribute failed\n"); grid = -1; return; }
        if (hipOccupancyMaxActiveBlocksPerMultiprocessor(&per_cu, (const void*)fwd_kernel, NWAVES * 64, LDS_BYTES) != hipSuccess || per_cu < 1) { fprintf(stderr, "kernel_launch: occupancy query says %d blocks per CU\n", per_cu); per_cu = 1; }
        (void)hipGetLastError();
        grid = cus;
        if (grid > 256) grid = 256;
    }
    if (grid < 0) return;
    (void)hipMemsetAsync((char*)d_ws + WS_CTL, 0, CTL_ZERO_BYTES, stream);
    Args a{};
    for (int i = 0; i < 14; ++i) a.in[i] = (const float*)d_in[i];
    a.out = (float*)d_out; a.ws = (unsigned char*)d_ws;
#if MK_N_LAUNCHES == 1
    a.ph_lo = 0; a.ph_hi = NPHASES;
    hipLaunchKernelGGL(fwd_kernel, dim3(grid), dim3(NWAVES * 64), LDS_BYTES, stream, a);
#else
    for (int p = 0; p < NPHASES; ++p) { a.ph_lo = p; a.ph_hi = p + 1; hipLaunchKernelGGL(fwd_kernel, dim3(grid), dim3(NWAVES * 64), LDS_BYTES, stream, a); }
#endif
}
```

```cpp
#include <hip/hip_runtime.h>
#include <cstdio>
#include <cstdint>
namespace pg8 {
#define PG8_LAS __attribute__((address_space(3)))
typedef unsigned short bf16_t;
typedef short bf16x8 __attribute__((ext_vector_type(8)));
typedef float f32x4 __attribute__((ext_vector_type(4)));
typedef unsigned u32x4 __attribute__((ext_vector_type(4)));
constexpr int BM = 256, BK = 64, HALF = 128, HTB = HALF * BK * 2  , STAGE_BYTES = 8 * HTB, NXCD = 8, WGM = 8;

__host__ __device__ __forceinline__ int lds_byte(int r, int c) { const int st = (r >> 4) * 2 + (c >> 5), rr = r & 15, cc = c & 31, ob = rr * 64 + cc * 2; return st * 1024 + (ob ^ (((ob >> 9) & 1) << 5)); }
__host__ __device__ __forceinline__ void stage_rc(int b, int& R, int& C) { const int st = b / 1024, sb = b % 1024, swz = sb ^ (((sb >> 9) & 1) << 5); R = (st >> 1) * 16 + swz / 64; C = (st & 1) * 32 + (swz % 64) / 2; }
__host__ __device__ __forceinline__ int perm32(int rho) { const int n = rho >> 4, i = rho & 15; return 8 * (i >> 2) + 4 * n + (i & 3); }

__device__ __forceinline__ int pg8_lane_id() { int l; asm volatile("v_mbcnt_lo_u32_b32 %0, -1, 0\n\tv_mbcnt_hi_u32_b32 %0, -1, %0" : "=v"(l)); return l; }
struct Unit { int pm, pn, sw; };
struct Gemm { const bf16_t* A; const bf16_t* Bt; int M, N, K; };

struct StaticOrder {
    int nM, nN, nwg, G, c;
    __host__ __device__ void init(int M, int N, int G_, int c_) { nM = M / BM; nN = N / BM; nwg = nM * nN; G = G_; c = c_; }
    __host__ __device__ bool next(int i, Unit& u) const {
        const long L = (long)i * G + c; if (L >= nwg) return false;
        int wgid = (int)L; { const int q = nwg / NXCD, r = nwg % NXCD, xcd = wgid % NXCD, off = wgid / NXCD; wgid = (xcd < r ? xcd * (q + 1) : r * (q + 1) + (xcd - r) * q) + off; }
        const int nig = WGM * nN, gid = wgid / nig, fm = gid * WGM, gsz = (nM - fm) < WGM ? (nM - fm) : WGM;
        u.pm = fm + ((wgid % nig) % gsz); u.pn = (wgid % nig) / gsz; u.sw = 0; return true;
    }
    __device__ __forceinline__ void a_ready(const Unit&) const {}
    __device__ __forceinline__ void done(const Unit&) const {}
};
__device__ __forceinline__ unsigned cvt_pk_bf16(float lo, float hi) { unsigned r; asm volatile("v_cvt_pk_bf16_f32 %0, %1, %2" : "=v"(r) : "v"(lo), "v"(hi)); return r; }
typedef float f32x2 __attribute__((ext_vector_type(2)));
__device__ __forceinline__ u32x4 pack8(const f32x4& a, const f32x4& b) { u32x4 w; w.x = cvt_pk_bf16(a[0], a[1]); w.y = cvt_pk_bf16(a[2], a[3]); w.z = cvt_pk_bf16(b[0], b[1]); w.w = cvt_pk_bf16(b[2], b[3]); return w; }
typedef unsigned u32x2 __attribute__((ext_vector_type(2)));
__device__ __forceinline__ float fsigmoid(float x) { return __builtin_amdgcn_rcpf(1.0f + __expf(-x)); }
__device__ __forceinline__ float fsilu(float x) { return x * fsigmoid(x); }

struct InProjOrder : StaticOrder {
    __host__ __device__ bool next(int i, Unit& u) const { if (!StaticOrder::next(i, u)) return false; u.sw = ((u.pn >= 24 && u.pn < 32) || u.pn >= 64) ? 1 : 0; return true; }
};
struct EpiInProj {
    static constexpr bool PERM = true, AFTER_DRAIN = false;
    unsigned char* ws; bf16_t* gz;
    size_t oQKV, oRQf, oRKf, oRKTf, oRVTf, oCOS, oSIN, oCOS2, oSIN2;
    __device__ __forceinline__ void operator()(const f32x4 (&acc)[2][2][4][2], const Unit& u, int wr, int wc, int fr, int fq) const {
        asm volatile("" : "+v"(fr), "+v"(fq));
        bf16_t* const QKV = (bf16_t*)(ws + oQKV); bf16_t* const RQf = (bf16_t*)(ws + oRQf); bf16_t* const RKf = (bf16_t*)(ws + oRKf); bf16_t* const RKTf = (bf16_t*)(ws + oRKTf); bf16_t* const RVTf = (bf16_t*)(ws + oRVTf);
        bf16_t* const GZA = gz; bf16_t* const GZB = gz + (size_t)16384 * 2048;
        const float* const cosT = (const float*)(ws + oCOS); const float* const sinT = (const float*)(ws + oSIN); const float* const cosT2 = (const float*)(ws + oCOS2); const float* const sinT2 = (const float*)(ws + oSIN2);
        const int pn = u.pn, cw = wc * 32 + 8 * fq;
        if (pn < 16) {
            const int row0 = u.pm * BM + wr * 64 + fr, col0 = pn * 256 + cw;
#pragma unroll
            for (int ai = 0; ai < 2; ++ai)
#pragma unroll
                for (int m = 0; m < 4; ++m) { bf16_t* rowp = QKV + (size_t)(row0 + ai * HALF + m * 16) * 4096 + col0;
#pragma unroll
                    for (int bj = 0; bj < 2; ++bj) *(u32x4*)(rowp + bj * HALF) = pack8(acc[ai][bj][m][0], acc[ai][bj][m][1]); }
        } else if (pn < 24) {
            const bool isk = pn >= 20; bf16_t* base = isk ? RKf : RQf;
            const int row0 = u.pm * BM + wr * 64 + fr, tile = (pn - 16) & 3, head = 2 * tile + (cw >> 6), i0 = cw & 63;
            const float l2g = log2f(1.0f - exp2f(-5.0f - (float)head));
            const int td1 = i0 >> 5, s1 = (i0 >> 4) & 1, eg = (i0 >> 3) & 1;
#pragma unroll
            for (int ai = 0; ai < 2; ++ai)
#pragma unroll
                for (int m = 0; m < 4; ++m) { const int row = row0 + ai * HALF + m * 16, b = row >> 13, t = row & 8191, n = t >> 6, pos = t & 63;
                    const float sc = isk ? 0.08838834764831845f * exp2f(-(float)(pos + 1) * l2g) : exp2f((float)(pos + 1) * l2g);
                    const float* cp = cosT + t * 64 + i0; const float* sp = sinT + t * 64 + i0;
                    const f32x4 c0 = *(const f32x4*)cp, c1 = *(const f32x4*)(cp + 4), s0 = *(const f32x4*)sp, s1v = *(const f32x4*)(sp + 4);
                    const f32x4 x1a = acc[ai][0][m][0], x1b = acc[ai][0][m][1], x2a = acc[ai][1][m][0], x2b = acc[ai][1][m][1];
                    const f32x4 o1a = (x1a * c0 - x2a * s0) * sc, o1b = (x1b * c1 - x2b * s1v) * sc, o2a = (x2a * c0 + x1a * s0) * sc, o2b = (x2b * c1 + x1b * s1v) * sc;
                    const size_t f1 = ((((size_t)(b * 8 + head) * 128 + n) * 2 + (pos >> 5)) * 4 + td1) * 2 + s1;
                    bf16_t* p1 = base + f1 * 512 + (pos & 31) * 8 + eg * 4;
                    u32x2 w;
                    w.x = cvt_pk_bf16(o1a[0], o1a[1]); w.y = cvt_pk_bf16(o1a[2], o1a[3]); *(u32x2*)(p1) = w;
                    w.x = cvt_pk_bf16(o1b[0], o1b[1]); w.y = cvt_pk_bf16(o1b[2], o1b[3]); *(u32x2*)(p1 + 256) = w;
                    w.x = cvt_pk_bf16(o2a[0], o2a[1]); w.y = cvt_pk_bf16(o2a[2], o2a[3]); *(u32x2*)(p1 + 4 * 512) = w;
                    w.x = cvt_pk_bf16(o2b[0], o2b[1]); w.y = cvt_pk_bf16(o2b[2], o2b[3]); *(u32x2*)(p1 + 4 * 512 + 256) = w; }
        } else if (pn < 32) {
            const int head = pn - 24, b = u.pm >> 5, nbase = (u.pm & 31) * 4;
            const int tj = wc & 1, s1 = (fq >> 1) & 1, eg = fq & 1;
#pragma unroll
            for (int ai = 0; ai < 2; ++ai)
#pragma unroll
                for (int m = 0; m < 4; ++m) { const int dv = ai * HALF + wr * 64 + m * 16 + fr, sl = dv >> 5, col = dv & 31;
#pragma unroll
                    for (int bj = 0; bj < 2; ++bj) { const int n = nbase + 2 * bj + (wc >> 1);
                        const size_t f = ((((size_t)(b * 8 + head) * 128 + n) * 8 + sl) * 2 + tj) * 2 + s1;
                        bf16_t* p = RVTf + f * 512 + col * 8 + eg * 4;
#pragma unroll
                        for (int nn = 0; nn < 2; ++nn) { u32x2 w; w.x = cvt_pk_bf16(acc[ai][bj][m][nn][0], acc[ai][bj][m][nn][1]); w.y = cvt_pk_bf16(acc[ai][bj][m][nn][2], acc[ai][bj][m][nn][3]); *(u32x2*)(p + nn * 256) = w; } } }
        } else if (pn < 64) {
            const int row0 = u.pm * BM + wr * 64 + fr;
            bf16_t* base = pn < 48 ? GZA : GZB; const int col0 = ((pn - 32) & 15) * 128 + cw;
#pragma unroll
            for (int ai = 0; ai < 2; ++ai)
#pragma unroll
                for (int m = 0; m < 4; ++m) { bf16_t* rowp = base + (size_t)(row0 + ai * HALF + m * 16) * 2048 + col0; f32x4 o[2];
#pragma unroll
                    for (int n = 0; n < 2; ++n)
#pragma unroll
                        for (int j = 0; j < 4; ++j) o[n][j] = fsilu(acc[ai][0][m][n][j]) * fsigmoid(acc[ai][1][m][n][j]);
                    *(u32x4*)rowp = pack8(o[0], o[1]); }
        } else {
            const int tile = pn - 64, head = 2 * tile + wr, b = u.pm >> 5, nbase = (u.pm & 31) * 4, tbase = (u.pm & 31) * 256;
            const int tj = wc & 1, s1 = (fq >> 1) & 1, eg = fq & 1;
            const float l2g = log2f(1.0f - exp2f(-5.0f - (float)head));
#pragma unroll
            for (int bj = 0; bj < 2; ++bj) { const int n = nbase + 2 * bj + (wc >> 1), c0 = bj * HALF + wc * 32 + 8 * fq;
#pragma unroll
                for (int nn = 0; nn < 2; ++nn) { const int pos0 = (c0 + 4 * nn) & 63; f32x4 sc;
#pragma unroll
                    for (int j = 0; j < 4; ++j) sc[j] = 0.08838834764831845f * exp2f((float)(63 - pos0 - j) * l2g);
#pragma unroll
                    for (int m = 0; m < 4; ++m) { const int i = 16 * m + fr;
                        const f32x4 c = *(const f32x4*)(cosT2 + (size_t)i * 8192 + tbase + c0 + 4 * nn), s = *(const f32x4*)(sinT2 + (size_t)i * 8192 + tbase + c0 + 4 * nn);
                        const f32x4 x1 = acc[0][bj][m][nn], x2 = acc[1][bj][m][nn];
                        const f32x4 o1 = (x1 * c - x2 * s) * sc, o2 = (x2 * c + x1 * s) * sc;
                        const size_t f = ((((size_t)(b * 8 + head) * 128 + n) * 4 + (m >> 1)) * 2 + tj) * 2 + s1;
                        bf16_t* p = RKTf + f * 512 + (nn * 32 + 16 * (m & 1) + fr) * 8 + eg * 4;
                        u32x2 w; w.x = cvt_pk_bf16(o1[0], o1[1]); w.y = cvt_pk_bf16(o1[2], o1[3]); *(u32x2*)p = w;
                        w.x = cvt_pk_bf16(o2[0], o2[1]); w.y = cvt_pk_bf16(o2[2], o2[3]); *(u32x2*)(p + 8 * 512) = w; } } }
        }
    }
};
struct EpiGateUp {
    static constexpr bool PERM = true, AFTER_DRAIN = false;
    bf16_t* ACT; int ldc; const float* rstd;
    __device__ __forceinline__ void operator()(const f32x4 (&acc)[2][2][4][2], const Unit& u, int wr, int wc, int fr, int fq) const {
        const int row0 = u.pm * BM + wr * 64 + fr, col0 = u.pn * 128 + wc * 32 + 8 * fq;
#pragma unroll
        for (int ai = 0; ai < 2; ++ai)
#pragma unroll
            for (int m = 0; m < 4; ++m) { const int row = row0 + ai * HALF + m * 16; const float rs = rstd ? rstd[row] : 1.0f; f32x4 o[2];
#pragma unroll
                for (int n = 0; n < 2; ++n)
#pragma unroll
                    for (int j = 0; j < 4; ++j) o[n][j] = fsilu(acc[ai][0][m][n][j] * rs) * (acc[ai][1][m][n][j] * rs);
                *(u32x4*)(ACT + (size_t)row * ldc + col0) = pack8(o[0], o[1]); }
    }
};
struct EpiResF32 {
    static constexpr bool PERM = false, AFTER_DRAIN = false;
    const float* res; float* out; int ldc;
    __device__ __forceinline__ void operator()(const f32x4 (&acc)[2][2][4][2], const Unit& u, int wr, int wc, int fr, int fq) const {
        const int row0 = u.pm * BM + wr * 64 + fr, col0 = u.pn * BM + wc * 32 + 4 * fq;
#pragma unroll
        for (int ai = 0; ai < 2; ++ai)
#pragma unroll
            for (int m = 0; m < 4; ++m) { const size_t off = (size_t)(row0 + ai * HALF + m * 16) * ldc + col0;
#pragma unroll
                for (int bj = 0; bj < 2; ++bj)
#pragma unroll
                    for (int n = 0; n < 2; ++n) { const f32x4 r = *(const f32x4*)(res + off + bj * HALF + n * 16); *(f32x4*)(out + off + bj * HALF + n * 16) = r + acc[ai][bj][m][n]; } }
    }
};
template <class Epi, class Sched, bool ALIGN_EPI = false, bool SP2 = false>
__device__ __forceinline__ void gemm_phase(PG8_LAS unsigned char* lds, const Gemm g, const Sched& S, const Epi& E, const int wave_in) {
    const int lane = pg8_lane_id(), wid = wave_in, tid = wid * 64 + lane, wr = wid >> 2, wc = wid & 3, fr = lane & 15, fq = lane >> 4;
    const int K = g.K, nt = K / BK;
    unsigned voffA[2], voffB[2];
#pragma unroll
    for (int i = 0; i < 2; ++i) { int R, C; stage_rc(tid * 16 + i * 8192, R, C); const int Rb = Epi::PERM ? ((R & ~31) + perm32(R & 31)) : R;
        voffA[i] = (unsigned)(R * K + C) * 2u; voffB[i] = (unsigned)(Rb * K + C) * 2u; }
    const size_t kstep = (size_t)(BK * 2);
    const size_t hstep = (size_t)HALF * K * 2;
    const size_t tstep = 2 * hstep;
    const unsigned ldsw = (unsigned)wid * 1024u;
    const int aoff = lds_byte(wr * 64 + fr, fq * 8), boff = lds_byte(wc * 32 + fr, fq * 8);
#define PG8_SA(b, h) (((b) * 2 + (h)) * HTB)
#define PG8_SB(b, h) ((4 + (b) * 2 + (h)) * HTB)
#define PG8_STAGE(bufoff, gbase, voff) do { _Pragma("unroll") for (int _i = 0; _i < 2; ++_i) \
        __builtin_amdgcn_global_load_lds((const unsigned*)((const char*)(gbase) + (voff)[_i]), (PG8_LAS unsigned*)(lds + (bufoff) + ldsw + _i * 8192), 16, 0, 0); } while (0)
#define PG8_LDA(dst, b, h) do { _Pragma("unroll") for (int m = 0; m < 4; ++m) _Pragma("unroll") for (int k = 0; k < 2; ++k) dst[m][k] = *(const PG8_LAS bf16x8*)(lds + PG8_SA(b, h) + aoff + m * 2048 + k * 1024); } while (0)
#define PG8_LDB(dst, b, h) do { _Pragma("unroll") for (int n = 0; n < 2; ++n) _Pragma("unroll") for (int k = 0; k < 2; ++k) dst[n][k] = *(const PG8_LAS bf16x8*)(lds + PG8_SB(b, h) + boff + n * 2048 + k * 1024); } while (0)
#define PG8_MMA(ai, bj, At, Bt) do { __builtin_amdgcn_s_setprio(1); _Pragma("unroll") for (int m = 0; m < 4; ++m) _Pragma("unroll") for (int n = 0; n < 2; ++n) _Pragma("unroll") for (int k = 0; k < 2; ++k) \
        acc[ai][bj][m][n] = __builtin_amdgcn_mfma_f32_16x16x32_bf16(Bt[n][k], At[m][k], acc[ai][bj][m][n], 0, 0, 0); __builtin_amdgcn_s_setprio(0); } while (0)
#define PG8_WAIT_V(n) asm volatile("s_waitcnt vmcnt(" #n ")" ::: "memory")
#define PG8_WAIT_L(n) asm volatile("s_waitcnt lgkmcnt(" #n ")" ::: "memory")
#define PG8_BAR __builtin_amdgcn_s_barrier()
#define PG8_SCHED __builtin_amdgcn_sched_barrier(0)
    Unit cur, nxt; int ui = 0;
    if (!S.next(0, cur)) return;
    f32x4 acc[2][2][4][2];
#pragma unroll
    for (int a = 0; a < 2; ++a)
#pragma unroll
        for (int b = 0; b < 2; ++b)
#pragma unroll
            for (int m = 0; m < 4; ++m)
#pragma unroll
                for (int n = 0; n < 2; ++n) acc[a][b][m][n] = (f32x4){0.f, 0.f, 0.f, 0.f};
    bf16x8 At[4][2], B0[2][2], B1[2][2];
#define PG8_UA(u) ((u).sw ? (const char*)g.Bt + (size_t)(u).pn * tstep : (const char*)g.A + (size_t)(u).pm * tstep)
#define PG8_UB(u) ((u).sw ? (const char*)g.A + (size_t)(u).pm * tstep : (const char*)g.Bt + (size_t)(u).pn * tstep)
    const char* cA = PG8_UA(cur); const char* cB = PG8_UB(cur);
    S.a_ready(cur);
    if constexpr (SP2) {
        PG8_STAGE(PG8_SB(0, 0), cB, voffB); PG8_STAGE(PG8_SB(0, 1), cB + hstep, voffB); PG8_STAGE(PG8_SA(0, 0), cA, voffA); PG8_STAGE(PG8_SA(0, 1), cA + hstep, voffA);
        if (wr == 1) PG8_BAR;
        PG8_WAIT_V(2); PG8_BAR;
        PG8_STAGE(PG8_SB(1, 0), cB + kstep, voffB); PG8_STAGE(PG8_SA(1, 0), cA + kstep, voffA); PG8_STAGE(PG8_SB(1, 1), cB + hstep + kstep, voffB);
        PG8_WAIT_V(6); PG8_BAR;
    } else {
        PG8_STAGE(PG8_SB(0, 0), cB, voffB); PG8_STAGE(PG8_SA(0, 0), cA, voffA); PG8_STAGE(PG8_SB(0, 1), cB + hstep, voffB); PG8_STAGE(PG8_SA(0, 1), cA + hstep, voffA);
        if (wr == 1) PG8_BAR;
        PG8_WAIT_V(4); PG8_BAR;
        PG8_STAGE(PG8_SB(1, 0), cB + kstep, voffB); PG8_STAGE(PG8_SA(1, 0), cA + kstep, voffA); PG8_STAGE(PG8_SB(1, 1), cB + hstep + kstep, voffB);
        PG8_WAIT_V(6); PG8_BAR;
    }
    for (;;) {
        const bool has_next = S.next(ui + 1, nxt);
        const char* nA = has_next ? PG8_UA(nxt) : cA; const char* nB = has_next ? PG8_UB(nxt) : cB;
        for (int t = 0; t < nt; t += 2) {
            const bool last = (t == nt - 2);
            const char* a1 = cA + (size_t)(t + 1) * kstep;
            const char* a2 = last ? nA : cA + (size_t)(t + 2) * kstep; const char* b2 = last ? nB : cB + (size_t)(t + 2) * kstep;
            const char* a3 = a2 + kstep; const char* b3 = b2 + kstep;
            if (last && has_next) S.a_ready(nxt);
            if constexpr (SP2) {
            PG8_LDB(B0, 0, 0); PG8_LDB(B1, 0, 1); PG8_SCHED; PG8_LDA(At, 0, 0); PG8_STAGE(PG8_SA(1, 1), a1 + hstep, voffA);
            PG8_WAIT_V(8); PG8_WAIT_L(0); PG8_BAR; PG8_MMA(0, 0, At, B0); PG8_MMA(0, 1, At, B1); PG8_BAR; PG8_SCHED;
            PG8_LDA(At, 0, 1); PG8_STAGE(PG8_SB(0, 0), b2, voffB); PG8_STAGE(PG8_SB(0, 1), b2 + hstep, voffB); PG8_STAGE(PG8_SA(0, 0), a2, voffA);
            PG8_WAIT_V(8); PG8_WAIT_L(0); PG8_BAR; PG8_MMA(1, 0, At, B0); PG8_MMA(1, 1, At, B1); PG8_BAR; PG8_SCHED;
            PG8_LDB(B0, 1, 0); PG8_LDB(B1, 1, 1); PG8_SCHED; PG8_LDA(At, 1, 0); PG8_STAGE(PG8_SA(0, 1), a2 + hstep, voffA);
            PG8_WAIT_V(8); PG8_WAIT_L(0); PG8_BAR; PG8_MMA(0, 0, At, B0); PG8_MMA(0, 1, At, B1); PG8_BAR; PG8_SCHED;
            PG8_LDA(At, 1, 1); PG8_STAGE(PG8_SB(1, 0), b3, voffB); PG8_STAGE(PG8_SB(1, 1), b3 + hstep, voffB); PG8_STAGE(PG8_SA(1, 0), a3, voffA);
            PG8_WAIT_V(8); PG8_WAIT_L(0); PG8_BAR; PG8_MMA(1, 0, At, B0); PG8_MMA(1, 1, At, B1); PG8_BAR; PG8_SCHED;
            } else {
            PG8_LDB(B0, 0, 0); PG8_SCHED; PG8_LDA(At, 0, 0); PG8_STAGE(PG8_SA(1, 1), a1 + hstep, voffA);
            PG8_WAIT_L(8); PG8_BAR; PG8_WAIT_L(0); PG8_MMA(0, 0, At, B0); PG8_BAR; PG8_SCHED;
            PG8_LDB(B1, 0, 1); PG8_STAGE(PG8_SB(0, 0), b2, voffB);
            PG8_BAR; PG8_WAIT_L(0); PG8_MMA(0, 1, At, B1); PG8_BAR;
            PG8_LDA(At, 0, 1); PG8_STAGE(PG8_SA(0, 0), a2, voffA);
            PG8_BAR; PG8_WAIT_L(0); PG8_MMA(1, 0, At, B0); PG8_BAR; PG8_SCHED;
            PG8_STAGE(PG8_SB(0, 1), b2 + hstep, voffB);
            PG8_WAIT_V(6); PG8_BAR; PG8_MMA(1, 1, At, B1); PG8_BAR;
            PG8_LDB(B0, 1, 0); PG8_SCHED; PG8_LDA(At, 1, 0); PG8_STAGE(PG8_SA(0, 1), a2 + hstep, voffA);
            PG8_WAIT_L(8); PG8_BAR; PG8_WAIT_L(0); PG8_MMA(0, 0, At, B0); PG8_BAR; PG8_SCHED;
            PG8_LDB(B1, 1, 1); PG8_STAGE(PG8_SB(1, 0), b3, voffB);
            PG8_BAR; PG8_WAIT_L(0); PG8_MMA(0, 1, At, B1); PG8_BAR;
            PG8_LDA(At, 1, 1); PG8_STAGE(PG8_SA(1, 0), a3, voffA);
            PG8_BAR; PG8_WAIT_L(0); PG8_MMA(1, 0, At, B0); PG8_BAR; PG8_SCHED;
            PG8_STAGE(PG8_SB(1, 1), b3 + hstep, voffB);
            PG8_WAIT_V(6); PG8_BAR; PG8_MMA(1, 1, At, B1); PG8_BAR;
            }
        }
        if constexpr (ALIGN_EPI) { if (wr == 0) PG8_BAR; }
        if constexpr (!Epi::AFTER_DRAIN) { E(acc, cur, wr, wc, fr, fq); S.done(cur); }
        if (!has_next) break;
#pragma unroll
        for (int a = 0; a < 2; ++a)
#pragma unroll
            for (int b = 0; b < 2; ++b)
#pragma unroll
                for (int m = 0; m < 4; ++m)
#pragma unroll
                    for (int n = 0; n < 2; ++n) acc[a][b][m][n] = (f32x4){0.f, 0.f, 0.f, 0.f};
        cur = nxt; cA = nA; cB = nB; ++ui;
        if constexpr (ALIGN_EPI) { if (wr == 1) PG8_BAR; }
    }
    PG8_WAIT_V(0);
    if constexpr (!ALIGN_EPI) { if (wr == 0) PG8_BAR; }
    PG8_BAR;
    if constexpr (Epi::AFTER_DRAIN) { E.fused(acc, cur, wr, wc, fr, fq, lds, wid, lane); S.done(cur); }
#undef PG8_UA
#undef PG8_UB
#undef PG8_SA
#undef PG8_SB
#undef PG8_STAGE
#undef PG8_LDA
#undef PG8_LDB
#undef PG8_MMA
#undef PG8_WAIT_V
#undef PG8_WAIT_L
#undef PG8_BAR
#undef PG8_SCHED
}
}
#define GAS __attribute__((address_space(1)))
#define LAS __attribute__((address_space(3)))
#define XB_TMO      128
#define XB_XCNT(j)  (256  + 64 * (j))
#define XB_XSUB(j)  (1280 + 64 * (j))
#define XB_XGEN(j)  (2304 + 64 * (j))
#define XB_TOP      3328
#define XB_TOPGEN   3392
#define XCD_BAR_WORDS 3456
#define XB_SPIN_CAP (1u << 18)

__device__ __forceinline__ unsigned xb_ld(unsigned* p)              { return __hip_atomic_load(p, __ATOMIC_RELAXED, __HIP_MEMORY_SCOPE_AGENT); }
__device__ __forceinline__ unsigned xb_add(unsigned* p, unsigned v) { return __hip_atomic_fetch_add(p, v, __ATOMIC_RELAXED, __HIP_MEMORY_SCOPE_AGENT); }
__device__ __forceinline__ unsigned xb_xcc_id() { return (unsigned)__builtin_amdgcn_s_getreg((3 << 11) | 20) & 0xFu; }
#define XB_SPIN(cond, bar) do { unsigned _sp = 0; while (cond) { __builtin_amdgcn_s_sleep(1); \
    if ((++_sp & 255u) == 0u) { if (xb_ld(&(bar)[XB_TMO])) break; if (_sp > XB_SPIN_CAP) { atomicAdd(&(bar)[XB_TMO], 1u); break; } } } } while (0)

struct XcdBarrier {
    unsigned* bar; unsigned x; int w0;
    volatile LAS unsigned* st;
};

__device__ __forceinline__ XcdBarrier xcd_barrier_post(unsigned* bar, volatile LAS unsigned* st, int wave) {
    XcdBarrier b; b.bar = bar; b.x = xb_xcc_id(); b.st = st; b.w0 = (wave == 0);
    if (b.w0 && pg8::pg8_lane_id() == 0) (void)xb_add(&bar[XB_XCNT(b.x)], 1u);
    return b;
}
__device__ __forceinline__ void xcd_barrier_complete(unsigned* bar, unsigned x, unsigned& nloc, unsigned& nx) {
    const unsigned G = gridDim.x * gridDim.y * gridDim.z;
    unsigned sum, cnt, mine, sp = 0u;
    for (;;) {
        sum = 0u; cnt = 0u; mine = 0u;
#pragma unroll
        for (unsigned j = 0; j < 16; ++j) { const unsigned c = xb_ld(&bar[XB_XCNT(j)]); sum += c; cnt += (c > 0u) ? 1u : 0u; mine = (j == x) ? c : mine; }
        if (sum == G) break;
        __builtin_amdgcn_s_sleep(1);
        if ((++sp & 255u) == 0u) { if (xb_ld(&bar[XB_TMO])) break; if (sp > XB_SPIN_CAP) { atomicAdd(&bar[XB_TMO], 1u); break; } }
    }
    nloc = mine > 0u ? mine : 1u; nx = cnt > 0u ? cnt : 1u;
}

__device__ __forceinline__ void xcd_barrier(const XcdBarrier& b) {
    asm volatile("s_waitcnt vmcnt(0)" ::: "memory");
    __syncthreads();
    if (b.w0 && pg8::pg8_lane_id() == 0) {
        unsigned* bar = b.bar;
        __builtin_amdgcn_s_waitcnt(0);
        unsigned nloc = b.st[0], nx = b.st[1];
        if (nloc == 0u) { xcd_barrier_complete(bar, b.x, nloc, nx); b.st[0] = nloc; b.st[1] = nx; }
        const unsigned old = xb_add(&bar[XB_XSUB(b.x)], 1u);
        const unsigned gen = old / nloc;
        if (old + 1u == (gen + 1u) * nloc) {
            __builtin_amdgcn_fence(__ATOMIC_RELEASE, "agent");
            asm volatile("s_waitcnt vmcnt(0)" ::: "memory");
            const unsigned og = xb_add(&bar[XB_TOP], 1u);
            const unsigned tg = og / nx;
            if (og + 1u == (tg + 1u) * nx) xb_add(&bar[XB_TOPGEN], 1u);
            else XB_SPIN(xb_ld(&bar[XB_TOPGEN]) == tg, bar);
            __builtin_amdgcn_fence(__ATOMIC_ACQUIRE, "agent");
            xb_add(&bar[XB_XGEN(b.x)], 1u);
            asm volatile("s_waitcnt vmcnt(0)" ::: "memory");
        } else {
            XB_SPIN(xb_ld(&bar[XB_XGEN(b.x)]) == gen, bar);
            __builtin_amdgcn_fence(__ATOMIC_ACQUIRE, "agent");
            asm volatile("s_waitcnt vmcnt(0)" ::: "memory");
        }
    }
    __syncthreads();
}
#ifndef MK_N_LAUNCHES
#define MK_N_LAUNCHES 1
#endif
#ifndef PROBE_DMA2
#define PROBE_DMA2 0
#endif
#if PROBE_DMA2
#define VMCNT12 "s_waitcnt vmcnt(24)"
#else
#define VMCNT12 "s_waitcnt vmcnt(12)"
#endif
#ifndef PROBE_STORE2
#define PROBE_STORE2 0
#endif
constexpr int NWAVES = 8;
constexpr int NPHASES = 10;
constexpr int BATCH = 2, SEQ = 8192, D = 2048, T = BATCH * SEQ;
constexpr int NH = 8, DK = 128, DV = 256;
constexpr int NIN = 16400;
constexpr int OFF_AZ = 4096, OFF_AB = 6144, OFF_RQ = 6160, OFF_RK = 7184, OFF_RV = 8208, OFF_RG = 10256, OFF_GA = 12304, OFF_GB = 14352;
constexpr int N1 = 17408;
constexpr int FF = 5632, NGU = 2 * FF;
constexpr float EPS = 1e-6f;
constexpr size_t MiB = 1u << 20;
constexpr size_t WS_CTL = 0, CTL_ZERO_BYTES = 1 * MiB;
constexpr size_t WS_BETA = 1 * MiB, WS_G = 1 * MiB + 512 * 1024;
constexpr size_t WS_COS = 2 * MiB, WS_SIN = 4 * MiB;
constexpr size_t WS_COS2 = 6 * MiB, WS_SIN2 = 8 * MiB;
constexpr size_t WS_DL = 10 * MiB, WS_RSTD = 11 * MiB;
constexpr size_t WS_WOT = 12 * MiB;
constexpr size_t WS_WGUT = 20 * MiB, WS_WDT = 64 * MiB;
constexpr size_t WS_W1T = 20 * MiB, WS_U = 88 * MiB;
constexpr size_t WS_GW = 20 * MiB, WS_GQ = 52 * MiB, WS_GK = 84 * MiB, WS_GA = 116 * MiB, WS_GU = 132 * MiB;
constexpr size_t WS_QKV = 196 * MiB;
constexpr size_t WS_RQF = 324 * MiB, WS_RKF = 356 * MiB, WS_RKTF = 388 * MiB, WS_RVTF = 420 * MiB, WS_END = 484 * MiB;
constexpr size_t WS_OA = 196 * MiB;
constexpr size_t WS_OB = 260 * MiB;
constexpr size_t WS_MIXED = 132 * MiB;
constexpr size_t WS_HNB = 324 * MiB;
constexpr size_t WS_ACT = 88 * MiB;
static_assert(WS_ACT + (size_t)T * FF * 2 <= WS_HNB, "ACT overlay");
constexpr int CW_BAR = 4096;
constexpr int RING_BYTES = 131072, SCAN_RING_BYTES = 147456 + 12288, LDSCTL_OFF = SCAN_RING_BYTES, MISC_OFF = LDSCTL_OFF + 320, LDS_BYTES = 163840;

typedef unsigned short bf16;
typedef unsigned v4u __attribute__((ext_vector_type(4)));
typedef unsigned v2u __attribute__((ext_vector_type(2)));
typedef float f32x4 __attribute__((ext_vector_type(4)));
#define LDS_WAIT() asm volatile("s_waitcnt lgkmcnt(0)" ::: "memory")
__device__ __forceinline__ unsigned f2bf(float f) { unsigned u = __builtin_bit_cast(unsigned, f); return (u + 0x7fffu + ((u >> 16) & 1u)) >> 16; }
__device__ __forceinline__ unsigned pk2(float lo, float hi) { return f2bf(lo) | (f2bf(hi) << 16); }
__device__ __forceinline__ float bf2f(unsigned b) { return __builtin_bit_cast(float, b << 16); }
__device__ __forceinline__ float bflo(unsigned w) { return __builtin_bit_cast(float, w << 16); }
__device__ __forceinline__ float bfhi(unsigned w) { return __builtin_bit_cast(float, w & 0xffff0000u); }
__device__ __forceinline__ float silu_f(float a) { return a * __builtin_amdgcn_rcpf(1.0f + __expf(-a)); }
__device__ __forceinline__ float wave_sum(float v) {
#pragma unroll
    for (int o = 1; o < 64; o <<= 1) v += __shfl_xor(v, o);
    return v;
}

struct Args { const float* in[14]; float* out; unsigned char* ws; int ph_lo, ph_hi; };
struct Frame {
    LAS unsigned char* lds; int tid, lane, wave, vcu, G;
    const float *x, *norm1_w, *w_in, *conv_w, *a_log, *dt_bias, *gdn_norm_w, *ret_norm_w, *w_out, *norm2_w, *w_gate, *w_up, *w_down, *norm_f_w;
    float* out; unsigned char* ws;
};

__device__ __forceinline__ void transpose_blk(const float* src, int ld, int k0, int sc0, bf16* dst, int K, int dr0, LAS float* scr, int lane) {
    f32x4 v[16];
#pragma unroll
    for (int i = 0; i < 16; ++i) v[i] = *(const f32x4*)(src + (size_t)(k0 + 4 * i + (lane >> 4)) * ld + sc0 + 4 * (lane & 15));
#pragma unroll
    for (int i = 0; i < 16; ++i) { LAS float* d = scr + (4 * i + (lane >> 4)) * 65 + 4 * (lane & 15); d[0] = v[i].x; d[1] = v[i].y; d[2] = v[i].z; d[3] = v[i].w; }
    LDS_WAIT(); asm volatile("" ::: "memory");
    const int c = lane & 7;
#pragma unroll
    for (int j = 0; j < 8; ++j) { const int n = (lane >> 3) + 8 * j; const LAS float* s = scr + (8 * c) * 65 + n;
        v4u o; o.x = pk2(s[0 * 65], s[1 * 65]); o.y = pk2(s[2 * 65], s[3 * 65]); o.z = pk2(s[4 * 65], s[5 * 65]); o.w = pk2(s[6 * 65], s[7 * 65]);
        *(v4u*)(dst + (size_t)(dr0 + n) * K + k0 + 8 * c) = o; }
    LDS_WAIT(); asm volatile("" ::: "memory");
}
__device__ __forceinline__ int w1_src_col(int n) {
    if (n < 4096) return n;
    if (n >= 16384) n = n - 16384 + 5120;
    if (n < 6144) { const int isk = n >= 5120, lt = (n - 4096) & 1023, tile = lt >> 8, c = lt & 255, bj = c >> 7, p = c & 127; return (isk ? OFF_RK : OFF_RQ) + (2 * tile + (p >> 6)) * 128 + bj * 64 + (p & 63); }
    if (n < 8192) return OFF_RV + (n - 6144);
    { const int isb = n >= 12288, lt = (n - 8192) & 4095, j = lt >> 8, c = lt & 255, bj = c >> 7, p = c & 127;
      return (isb ? (bj ? OFF_GB : OFF_RG) : (bj ? OFF_GA : OFF_AZ)) + 128 * j + p; }
}
__device__ __forceinline__ void p0_prologue(Frame& F) {
    __syncthreads();
    const int gw = F.vcu * NWAVES + F.wave, NGW = F.G * NWAVES, lane = F.lane;
    {
        LAS float* scr = (LAS float*)(F.lds + F.wave * 16640);
        constexpr int I_1 = (D / 64) * (N1 / 64), I_O = (D / 64) * (D / 64);
        constexpr int NITEMS = I_1 + I_O;
        bf16* W1T = (bf16*)(F.ws + WS_W1T); bf16* WOT = (bf16*)(F.ws + WS_WOT);
        for (int it = gw; it < NITEMS; it += NGW) {
            int r = it;
            if (r < I_1) { const int nb = r % (N1 / 64), kb = r / (N1 / 64); transpose_blk(F.w_in, NIN, 64 * kb, w1_src_col(64 * nb), W1T, D, 64 * nb, scr, lane); continue; } r -= I_1;
            { const int nb = r % (D / 64), kb = r / (D / 64); transpose_blk(F.w_out, D, 64 * kb, 64 * nb, WOT, D, 64 * nb, scr, lane); }
        }
    }
    {
        float* cosT = (float*)(F.ws + WS_COS); float* sinT = (float*)(F.ws + WS_SIN); float* cosT2 = (float*)(F.ws + WS_COS2); float* sinT2 = (float*)(F.ws + WS_SIN2);
        for (int idx = (F.vcu * 512 + F.tid); idx < SEQ * 64; idx += F.G * 512) { const int t = idx >> 6, i = idx & 63;
            const float inv = (float)exp2(-(double)i * (13.287712379549449 / 64.0));
            const float ang = (float)t * inv; const double a = (double)ang; const float cv = (float)cos(a), sv = (float)sin(a);
            cosT[idx] = cv; sinT[idx] = sv; cosT2[i * SEQ + t] = cv; sinT2[i * SEQ + t] = sv; }
    }
    __syncthreads();
    {
        LAS float* wT = (LAS float*)F.lds;
        { f32x4 wv[4][4];
#pragma unroll
          for (int j = 0; j < 4; ++j)
#pragma unroll
            for (int q = 0; q < 4; ++q) wv[j][q] = *(const f32x4*)(F.w_in + (size_t)(F.tid + 512 * j) * NIN + OFF_AB + 4 * q);
#pragma unroll
          for (int j = 0; j < 4; ++j)
#pragma unroll
            for (int q = 0; q < 4; ++q)
#pragma unroll
              for (int e = 0; e < 4; ++e) wT[(4 * q + e) * 2048 + F.tid + 512 * j] = wv[j][q][e]; }
        __syncthreads();
        bf16* U = (bf16*)(F.ws + WS_U); float* BETA = (float*)(F.ws + WS_BETA); float* GG = (float*)(F.ws + WS_G);
        f32x4 nw[8];
#pragma unroll
        for (int j = 0; j < 8; ++j) nw[j] = ((const f32x4*)F.norm1_w)[64 * j + lane];
        for (int row = gw; row < T; row += NGW) {
            asm volatile("" ::: "memory");
            const f32x4* xr = (const f32x4*)(F.x + (size_t)row * D) + lane;
            f32x4 v[8]; float ss = 0.f;
#pragma unroll
            for (int j = 0; j < 8; ++j) { v[j] = xr[64 * j]; ss += (v[j].x * v[j].x + v[j].y * v[j].y) + (v[j].z * v[j].z + v[j].w * v[j].w); }
            const float rstd = rsqrtf(wave_sum(ss) * (1.0f / D) + EPS);
            v2u* o8 = (v2u*)(U + (size_t)row * D) + lane;
#pragma unroll
            for (int j = 0; j < 8; ++j) { v[j] = (v[j] * rstd) * nw[j]; v2u w; w.x = pk2(v[j].x, v[j].y); w.y = pk2(v[j].z, v[j].w); o8[64 * j] = w; }
            float mb = 0.f, ma = 0.f;
#pragma unroll
            for (int c = 0; c < 16; ++c) { float s = 0.f;
#pragma unroll
                for (int j = 0; j < 8; ++j) { const f32x4 w = *(const LAS f32x4*)(wT + c * 2048 + 256 * j + 4 * lane); s += (v[j].x * w.x + v[j].y * w.y) + (v[j].z * w.z + v[j].w * w.w); }
                s = wave_sum(s);
                if (c < 8) mb = (lane == c) ? s : mb; else ma = (lane == c - 8) ? s : ma; }
            if (lane < 8) { const float bt = 1.0f / (1.0f + expf(-mb)); const float xa = ma + F.dt_bias[lane]; const float sp = xa > 20.f ? xa : log1pf(expf(xa));
                BETA[(size_t)row * 8 + lane] = bt; GG[(size_t)row * 8 + lane] = -expf(F.a_log[lane]) * sp; }
        }
    }
}

__device__ __forceinline__ void gdn_naive(Frame& F, int bh) {
    const int b = bh >> 3, h = bh & 7, tid = F.tid, c = tid & 255, hh = tid >> 8;
    LAS float* sq = (LAS float*)F.lds; LAS float* sk = sq + 128; LAS float* sv = sq + 256; LAS float* sp = sq + 512; LAS float* sred = sq + 1024;
    const int ch = tid < 128 ? h * 128 + tid : (tid < 256 ? 1024 + h * 128 + (tid - 128) : 2048 + h * 256 + (tid - 256));
    const float cw0 = F.conv_w[0 * 4096 + ch], cw1 = F.conv_w[1 * 4096 + ch], cw2 = F.conv_w[2 * 4096 + ch], cw3 = F.conv_w[3 * 4096 + ch];
    const bf16* raw = (const bf16*)(F.ws + WS_QKV) + (size_t)(b * SEQ) * 4096 + ch;
    const float* BETA = (const float*)(F.ws + WS_BETA) + (size_t)(b * SEQ) * 8 + h; const float* GG = (const float*)(F.ws + WS_G) + (size_t)(b * SEQ) * 8 + h;
    bf16* OA = (bf16*)(F.ws + WS_OA) + (size_t)(b * SEQ) * 2048 + h * 256 + c;
    float S[64];
#pragma unroll
    for (int d = 0; d < 64; ++d) S[d] = 0.f;
    float r0 = 0.f, r1 = 0.f, r2 = 0.f;
    float nraw = bf2f(raw[0]), nbeta = BETA[0], ng = GG[0];
    for (int t = 0; t < SEQ; ++t) {
        const float r3 = nraw, beta = nbeta, eg = expf(ng);
        if (t + 1 < SEQ) { nraw = bf2f(raw[(size_t)(t + 1) * 4096]); nbeta = BETA[(size_t)(t + 1) * 8]; ng = GG[(size_t)(t + 1) * 8]; }
        const float a = r0 * cw0 + r1 * cw1 + r2 * cw2 + r3 * cw3; r0 = r1; r1 = r2; r2 = r3;
        float val = a / (1.0f + expf(-a));
        const float ws_ = wave_sum(val * val);
        if (F.lane == 0) sred[F.wave] = ws_;
        __syncthreads();
        if (tid < 128) { val = val * rsqrtf(sred[0] + sred[1] + EPS) * 0.08838834764831845f; sq[tid] = val; }
        else if (tid < 256) { val = val * rsqrtf(sred[2] + sred[3] + EPS); sk[tid - 128] = val; }
        else sv[tid - 256] = val;
        __syncthreads();
        float p = 0.f;
#pragma unroll
        for (int d = 0; d < 64; ++d) p += sk[hh * 64 + d] * S[d];
        sp[hh * 256 + c] = p;
        __syncthreads();
        const float kS = sp[c] + sp[256 + c];
        const float delta = beta * (sv[c] - eg * kS);
        float o = 0.f;
#pragma unroll
        for (int d = 0; d < 64; ++d) { S[d] = eg * S[d] + sk[hh * 64 + d] * delta; o += sq[hh * 64 + d] * S[d]; }
        __syncthreads();
        sp[hh * 256 + c] = o;
        __syncthreads();
        if (hh == 0) OA[(size_t)t * 2048] = (bf16)f2bf(sp[c] + sp[256 + c]);
    }
}
__device__ __forceinline__ void ffn_weight_copies(Frame& F) {
    const int gw = F.vcu * NWAVES + F.wave, NGW = F.G * NWAVES, lane = F.lane;
    LAS float* scr = (LAS float*)(F.lds + F.wave * 16640);
    constexpr int I_G = (D / 64) * (FF / 64), I_D = (FF / 64) * (D / 64);
    bf16* WGUT = (bf16*)(F.ws + WS_WGUT); bf16* WDT = (bf16*)(F.ws + WS_WDT);
    for (int it = gw; it < 2 * I_G + I_D; it += NGW) {
        int r = it;
        if (r < 2 * I_G) { const int up = r >= I_G; if (up) r -= I_G; const int nb = r % (FF / 64), kb = r / (FF / 64), c0 = 64 * nb;
            transpose_blk(up ? F.w_up : F.w_gate, FF, 64 * kb, c0, WGUT, D, 256 * (c0 >> 7) + 128 * up + (c0 & 127), scr, lane); continue; } r -= 2 * I_G;
        { const int nb = r % (D / 64), kb = r / (D / 64); transpose_blk(F.w_down, D, 64 * kb, 64 * nb, WDT, FF, 64 * nb, scr, lane); }
    }
}

typedef float f32x16 __attribute__((ext_vector_type(16)));
typedef short bf16x8 __attribute__((ext_vector_type(8)));
typedef float f32x2_t __attribute__((ext_vector_type(2))); typedef __bf16 bf16x2_t __attribute__((ext_vector_type(2)));
#define MFMA32(a, b, c) __builtin_amdgcn_mfma_f32_32x32x16_bf16((a), (b), (c), 0, 0, 0)
__device__ __forceinline__ unsigned cvtpk_s(float lo, float hi) { f32x2_t v = {lo, hi}; bf16x2_t b = __builtin_convertvector(v, bf16x2_t); return __builtin_bit_cast(unsigned, b); }
#define PACK_STEP(x, s) __builtin_bit_cast(bf16x8, (v4u){cvtpk_s((x)[8 * (s)], (x)[8 * (s) + 1]), cvtpk_s((x)[8 * (s) + 2], (x)[8 * (s) + 3]), cvtpk_s((x)[8 * (s) + 4], (x)[8 * (s) + 5]), cvtpk_s((x)[8 * (s) + 6], (x)[8 * (s) + 7])})
__device__ __forceinline__ bf16 cvt1_bf16(float x) { return (bf16)(cvtpk_s(x, x) & 0xffffu); }
__device__ __forceinline__ bf16x8 ldfrag(const bf16* base, size_t f, int lane) { return *(const bf16x8*)(base + f * 512 + lane * 8); }
__device__ __forceinline__ f32x16 zero16() { f32x16 z; for (int i = 0; i < 16; ++i) z[i] = 0.f; return z; }

#define SCAN_BAR_C() do { asm volatile("s_waitcnt lgkmcnt(0)" ::: "memory"); __builtin_amdgcn_s_barrier(); asm volatile("" ::: "memory"); } while (0)
#define SCAN_BAR() do { asm volatile("s_waitcnt vmcnt(0) lgkmcnt(0)" ::: "memory"); __builtin_amdgcn_s_barrier(); asm volatile("" ::: "memory"); } while (0)
__device__ __forceinline__ void glds1k(const bf16* gsrc_frag, LAS unsigned char* dst, int lane) {
    __builtin_amdgcn_global_load_lds((const unsigned*)(gsrc_frag + lane * 8), (LAS unsigned*)dst, 16, 0, 0);
#if PROBE_DMA2
    __builtin_amdgcn_global_load_lds((const unsigned*)(gsrc_frag + lane * 8), (LAS unsigned*)dst, 16, 0, 0);
#endif
}
__device__ __forceinline__ bf16x8 ldsfrag(const LAS unsigned char* buf, int slot, int lane) { return *(const LAS bf16x8*)(buf + slot * 1024 + lane * 16); }

constexpr int RS_BUF = 48 * 1024, RS_PA = 3 * RS_BUF;
__device__ __forceinline__ void ret_scan_wg(Frame& F, int bh, int half) {
    const int w = F.wave, b = bh >> 3, h = bh & 7;
    const bf16* RQf = (const bf16*)(F.ws + WS_RQF); const bf16* RKf = (const bf16*)(F.ws + WS_RKF); const bf16* RKTf = (const bf16*)(F.ws + WS_RKTF); const bf16* RVTf = (const bf16*)(F.ws + WS_RVTF);
    LAS unsigned char* L = F.lds;
    if (w >= 4) {
        const int lw = w - 4, lane = pg8::pg8_lane_id(), col = lane & 31, hh = lane >> 5;
#pragma unroll
        for (int c = 0; c < 2; ++c) { const size_t cq = (size_t)bh * 128 + c; LAS unsigned char* dst = L + c * RS_BUF;
#pragma unroll
            for (int q = 0; q < 12; ++q) { const int f = 4 * q + lw;
                const bf16* src = f < 16 ? RQf + (cq * 16 + f) * 512 : (f < 32 ? RKf + (cq * 16 + (f - 16)) * 512 : RKTf + (cq * 16 + (f - 32)) * 512);
                glds1k(src, dst + f * 1024, lane); } }
        asm volatile(VMCNT12 ::: "memory"); __builtin_amdgcn_s_barrier(); asm volatile("" ::: "memory");
        int cb = 0, nb = 2;
        for (int n = 0; n < 128; ++n) {
            const LAS unsigned char* B = L + cb * RS_BUF;
            if (lw < 3) {
                const int tj = lw == 2 ? 1 : 0, ti = lw == 0 ? 0 : 1;
                f32x16 P = zero16();
#pragma unroll
                for (int td = 0; td < 4; ++td)
#pragma unroll
                    for (int s2 = 0; s2 < 2; ++s2) P = MFMA32(ldsfrag(B, 16 + (tj * 4 + td) * 2 + s2, lane), ldsfrag(B, (ti * 4 + td) * 2 + s2, lane), P);
                if (lw != 1) {
#pragma unroll
                    for (int r = 0; r < 16; ++r) { const int j = (r & 3) + 8 * (r >> 2) + 4 * hh; if (col < j) P[r] = 0.f; } }
                const bf16x8 a0 = PACK_STEP(P, 0), a1 = PACK_STEP(P, 1);
                *(LAS bf16x8*)(L + RS_PA + (2 * lw) * 1024 + lane * 16) = a0; *(LAS bf16x8*)(L + RS_PA + (2 * lw + 1) * 1024 + lane * 16) = a1;
            }
            asm volatile("s_waitcnt lgkmcnt(0)" ::: "memory"); __builtin_amdgcn_s_barrier(); asm volatile("" ::: "memory");
            if (n + 2 < 128) { const size_t cq = (size_t)bh * 128 + n + 2; LAS unsigned char* dst = L + nb * RS_BUF;
#pragma unroll
                for (int q = 0; q < 12; ++q) { const int f = 4 * q + lw;
                    const bf16* src = f < 16 ? RQf + (cq * 16 + f) * 512 : (f < 32 ? RKf + (cq * 16 + (f - 16)) * 512 : RKTf + (cq * 16 + (f - 32)) * 512);
                    glds1k(src, dst + f * 1024, lane); }
                asm volatile(VMCNT12 ::: "memory"); }
            else asm volatile("s_waitcnt vmcnt(0)" ::: "memory");
            __builtin_amdgcn_s_barrier(); asm volatile("" ::: "memory");
            cb = cb == 2 ? 0 : cb + 1; nb = nb == 2 ? 0 : nb + 1;
        }
        return;
    }
    const int sl = 4 * half + w, lane = pg8::pg8_lane_id(), col = lane & 31, hh = lane >> 5;
    bf16* OB = (bf16*)(F.ws + WS_OB) + (size_t)(b * SEQ) * 2048 + h * 256 + sl * 32;
    const unsigned loff = (unsigned)(hh * 4 * 2048 + col);
    const float g64 = exp2f(64.0f * log2f(1.0f - exp2f(-5.0f - (float)h)));
    f32x16 S[4];
#pragma unroll
    for (int td = 0; td < 4; ++td) S[td] = zero16();
    SCAN_BAR_C();
    int cb = 0;
    for (int n = 0; n < 128; ++n) {
        const LAS unsigned char* B = L + cb * RS_BUF; cb = cb == 2 ? 0 : cb + 1;
        bf16x8 vt[2][2];
        { const size_t cq = (size_t)bh * 128 + n;
#pragma unroll
          for (int tj = 0; tj < 2; ++tj)
#pragma unroll
            for (int s2 = 0; s2 < 2; ++s2) vt[tj][s2] = ldfrag(RVTf, ((cq * 8 + sl) * 2 + tj) * 2 + s2, lane); }
#define PIN() do { asm volatile("" ::: "memory"); __builtin_amdgcn_sched_barrier(0); } while (0)
#define LD4(dst, base, s0, s1, s2, s3) do { PIN(); dst[0] = ldsfrag(base, s0, lane); dst[1] = ldsfrag(base, s1, lane); dst[2] = ldsfrag(base, s2, lane); dst[3] = ldsfrag(base, s3, lane); PIN(); } while (0)
#define QSLOT(ti, td, s2) (((ti) * 4 + (td)) * 2 + (s2))
#define KTSLOT(k) (32 + (k))
        bf16x8 fa[4], fb[4];
        const LAS unsigned char* PAb = L + RS_PA;
        f32x16 o0 = zero16(), o1 = zero16();
        LD4(fa, B, QSLOT(0, 0, 0), QSLOT(0, 0, 1), QSLOT(1, 0, 0), QSLOT(1, 0, 1));
        { const bf16x8 sb0 = PACK_STEP(S[0], 0), sb1 = PACK_STEP(S[0], 1);
          LD4(fb, B, QSLOT(0, 1, 0), QSLOT(0, 1, 1), QSLOT(1, 1, 0), QSLOT(1, 1, 1));
          o0 = MFMA32(fa[0], sb0, o0); o0 = MFMA32(fa[1], sb1, o0); o1 = MFMA32(fa[2], sb0, o1); o1 = MFMA32(fa[3], sb1, o1); }
        { const bf16x8 sb0 = PACK_STEP(S[1], 0), sb1 = PACK_STEP(S[1], 1);
          LD4(fa, B, QSLOT(0, 2, 0), QSLOT(0, 2, 1), QSLOT(1, 2, 0), QSLOT(1, 2, 1));
          o0 = MFMA32(fb[0], sb0, o0); o0 = MFMA32(fb[1], sb1, o0); o1 = MFMA32(fb[2], sb0, o1); o1 = MFMA32(fb[3], sb1, o1); }
        { const bf16x8 sb0 = PACK_STEP(S[2], 0), sb1 = PACK_STEP(S[2], 1);
          LD4(fb, B, QSLOT(0, 3, 0), QSLOT(0, 3, 1), QSLOT(1, 3, 0), QSLOT(1, 3, 1));
          o0 = MFMA32(fa[0], sb0, o0); o0 = MFMA32(fa[1], sb1, o0); o1 = MFMA32(fa[2], sb0, o1); o1 = MFMA32(fa[3], sb1, o1); }
        { const bf16x8 sb0 = PACK_STEP(S[3], 0), sb1 = PACK_STEP(S[3], 1);
          o0 = MFMA32(fb[0], sb0, o0); o0 = MFMA32(fb[1], sb1, o0); o1 = MFMA32(fb[2], sb0, o1); o1 = MFMA32(fb[3], sb1, o1); }
        SCAN_BAR_C();
        LD4(fa, PAb, 0, 1, 2, 3);
        fb[0] = ldsfrag(PAb, 4, lane); fb[1] = ldsfrag(PAb, 5, lane); fb[2] = ldsfrag(B, KTSLOT(0), lane); fb[3] = ldsfrag(B, KTSLOT(1), lane); PIN();
        o0 = MFMA32(fa[0], vt[0][0], o0); o0 = MFMA32(fa[1], vt[0][1], o0); o1 = MFMA32(fa[2], vt[0][0], o1); o1 = MFMA32(fa[3], vt[0][1], o1);
        LD4(fa, B, KTSLOT(2), KTSLOT(3), KTSLOT(4), KTSLOT(5));
        o1 = MFMA32(fb[0], vt[1][0], o1); o1 = MFMA32(fb[1], vt[1][1], o1);
        S[0] = S[0] * g64; S[0] = MFMA32(fb[2], vt[0][0], S[0]); S[0] = MFMA32(fb[3], vt[0][1], S[0]);
        LD4(fb, B, KTSLOT(6), KTSLOT(7), KTSLOT(8), KTSLOT(9));
        S[0] = MFMA32(fa[0], vt[1][0], S[0]); S[0] = MFMA32(fa[1], vt[1][1], S[0]);
        S[1] = S[1] * g64; S[1] = MFMA32(fa[2], vt[0][0], S[1]); S[1] = MFMA32(fa[3], vt[0][1], S[1]);
        LD4(fa, B, KTSLOT(10), KTSLOT(11), KTSLOT(12), KTSLOT(13));
        S[1] = MFMA32(fb[0], vt[1][0], S[1]); S[1] = MFMA32(fb[1], vt[1][1], S[1]);
        S[2] = S[2] * g64; S[2] = MFMA32(fb[2], vt[0][0], S[2]); S[2] = MFMA32(fb[3], vt[0][1], S[2]);
        PIN(); fb[0] = ldsfrag(B, KTSLOT(14), lane); fb[1] = ldsfrag(B, KTSLOT(15), lane); PIN();
        S[2] = MFMA32(fa[0], vt[1][0], S[2]); S[2] = MFMA32(fa[1], vt[1][1], S[2]);
        S[3] = S[3] * g64; S[3] = MFMA32(fa[2], vt[0][0], S[3]); S[3] = MFMA32(fa[3], vt[0][1], S[3]);
        S[3] = MFMA32(fb[0], vt[1][0], S[3]); S[3] = MFMA32(fb[1], vt[1][1], S[3]);
        { bf16* orow = OB + (size_t)(64 * n) * 2048;
#pragma unroll
          for (int r = 0; r < 16; ++r) { const unsigned ro = (unsigned)(((r & 3) + 8 * (r >> 2)) * 2048);
#if PROBE_NOSTORE
            if (n == 127)
#endif
            { orow[loff + ro] = cvt1_bf16(o0[r]); orow[loff + ro + 32u * 2048u] = cvt1_bf16(o1[r]);
#if PROBE_STORE2
              asm volatile("" ::: "memory"); orow[loff + ro] = cvt1_bf16(o0[r]); orow[loff + ro + 32u * 2048u] = cvt1_bf16(o1[r]);
#endif
            } } }
        SCAN_BAR_C();
    }
}

#ifndef PROBE_NOSTORE
#define PROBE_NOSTORE 0
#endif
#ifndef PROBE_ONLYSCAN
#define PROBE_ONLYSCAN 0
#endif
#ifndef PROBE_PREP
#define PROBE_PREP 0
#endif
constexpr int GP_QH = 0, GP_KH = 17408, GP_AM = 34816, GP_RK = 51200, GP_GC = 83968, GP_BT = 84224, GP_WL = GP_RK, GP_VR = 84480;
__device__ __forceinline__ void gdn_prep(Frame& F, int ci) {
    int tid_ = F.tid; asm volatile("" : "+v"(tid_));
    const int tid = tid_, lane = tid & 63, w = __builtin_amdgcn_readfirstlane(tid >> 6), bh = ci >> 7, n = ci & 127, b = bh >> 3, h = bh & 7;
    const size_t trow0 = (size_t)b * SEQ + 64 * n;
    LAS unsigned char* L = F.lds;
    LAS float* gcs = (LAS float*)(L + GP_GC); LAS float* bet = (LAS float*)(L + GP_BT); LAS float* Am = (LAS float*)(L + GP_AM); LAS float* Rk = (LAS float*)(L + GP_RK);
    const bf16* QKV = (const bf16*)(F.ws + WS_QKV);
    bf16* GW = (bf16*)(F.ws + WS_GW); bf16* GQ = (bf16*)(F.ws + WS_GQ); bf16* GK = (bf16*)(F.ws + WS_GK); bf16* GA = (bf16*)(F.ws + WS_GA); bf16* GU = (bf16*)(F.ws + WS_GU);
    {
        v4u vr[5];
#pragma unroll
        for (int k = 0; k < 5; ++k) { const int idx = tid + 512 * k, row = idx >> 5, cg = idx & 31; vr[k] = (v4u){0u, 0u, 0u, 0u};
            if (row < 67 && (n > 0 || row >= 3)) vr[k] = *(const v4u*)(QKV + (trow0 + row - 3) * 4096 + 2048 + h * 256 + 8 * cg); }
#pragma unroll
        for (int k = 0; k < 5; ++k) { const int idx = tid + 512 * k, row = idx >> 5, cg = idx & 31; if (row < 67) *(LAS v4u*)(L + GP_VR + row * 512 + cg * 16) = vr[k]; }
    }
    if (w == 0) {
        float g = ((const float*)(F.ws + WS_G))[(trow0 + lane) * 8 + h];
#pragma unroll
        for (int o = 1; o < 64; o <<= 1) { const float t = __shfl_up(g, o); if (lane >= o) g += t; }
        gcs[lane] = g; bet[lane] = ((const float*)(F.ws + WS_BETA))[(trow0 + lane) * 8 + h];
        if (lane == 63) ((float*)(F.ws + WS_DL))[ci] = expf(g);
    }
    __syncthreads();
    for (int pr_ = 0; pr_ < (PROBE_PREP == 1 ? 2 : 1); ++pr_) {
        const int cg = lane & 31, rh = lane >> 5, isk = cg >> 4, dk0 = 8 * (cg & 15), row0 = 8 * w + 4 * rh;
        const int ch = (isk ? 1024 : 0) + h * 128 + dk0;
        float cw[4][8];
#pragma unroll
        for (int j = 0; j < 4; ++j) { const f32x4 a = *(const f32x4*)(F.conv_w + j * 4096 + ch), c = *(const f32x4*)(F.conv_w + j * 4096 + ch + 4);
            cw[j][0] = a.x; cw[j][1] = a.y; cw[j][2] = a.z; cw[j][3] = a.w; cw[j][4] = c.x; cw[j][5] = c.y; cw[j][6] = c.z; cw[j][7] = c.w; }
        float raw[7][8];
#pragma unroll
        for (int rr = 0; rr < 7; ++rr) { const int row = row0 - 3 + rr;
            v4u v = {0u, 0u, 0u, 0u};
            if (n > 0 || row >= 0) v = *(const v4u*)(QKV + (trow0 + row) * 4096 + ch);
#pragma unroll
            for (int e = 0; e < 4; ++e) { raw[rr][2 * e] = bflo(v[e]); raw[rr][2 * e + 1] = bfhi(v[e]); } }
        const float g63 = gcs[63];
#pragma unroll
        for (int r = 0; r < 4; ++r) { asm volatile("" ::: "memory"); const int row = row0 + r; float val[8]; float ss = 0.f;
#pragma unroll
            for (int e = 0; e < 8; ++e) { const float a = raw[r][e] * cw[0][e] + raw[r + 1][e] * cw[1][e] + raw[r + 2][e] * cw[2][e] + raw[r + 3][e] * cw[3][e];
                val[e] = silu_f(a); ss += val[e] * val[e]; }
            ss += __shfl_xor(ss, 1); ss += __shfl_xor(ss, 2); ss += __shfl_xor(ss, 4); ss += __shfl_xor(ss, 8);
            const float rn = rsqrtf(ss + EPS) * (isk ? 1.0f : 0.08838834764831845f);
            const float gc = gcs[row], eg = __expf(gc);
#pragma unroll
            for (int e = 0; e < 8; ++e) val[e] *= rn;
            v4u pk; pk.x = pk2(val[0], val[1]); pk.y = pk2(val[2], val[3]); pk.z = pk2(val[4], val[5]); pk.w = pk2(val[6], val[7]);
            *(LAS v4u*)(L + (isk ? GP_KH : GP_QH) + row * 272 + dk0 * 2) = pk;
            if (!isk) {
                const size_t f = (((size_t)ci * 2 + (row >> 5)) * 4 + (dk0 >> 5)) * 2 + ((dk0 >> 4) & 1);
                bf16* p = GQ + f * 512 + (row & 31) * 8 + ((dk0 >> 3) & 1) * 4;
                v2u a; a.x = pk2(val[0] * eg, val[1] * eg); a.y = pk2(val[2] * eg, val[3] * eg); *(v2u*)p = a;
                a.x = pk2(val[4] * eg, val[5] * eg); a.y = pk2(val[6] * eg, val[7] * eg); *(v2u*)(p + 256) = a;
            } else {
                const float bt = bet[row] * eg;
                f32x4 r0 = {val[0] * bt, val[1] * bt, val[2] * bt, val[3] * bt}, r1 = {val[4] * bt, val[5] * bt, val[6] * bt, val[7] * bt};
                *(LAS f32x4*)(Rk + row * 128 + dk0) = r0; *(LAS f32x4*)(Rk + row * 128 + dk0 + 4) = r1;
                const float ek = __expf(g63 - gc);
#pragma unroll
                for (int e = 0; e < 8; ++e) raw[r][e] = val[e] * ek;
            }
        }
        if (isk) {
            const int tj = w >> 2, s1 = (w >> 1) & 1;
#pragma unroll
            for (int e = 0; e < 8; ++e) { const int dk = dk0 + e;
                const size_t f = (((size_t)ci * 4 + (dk >> 5)) * 2 + tj) * 2 + s1;
                v2u a; a.x = pk2(raw[0][e], raw[1][e]); a.y = pk2(raw[2][e], raw[3][e]);
                *(v2u*)(GK + f * 512 + (rh * 32 + (dk & 31)) * 8 + (w & 1) * 4) = a; }
        }
    }
    __syncthreads();
    for (int pr_ = 0; pr_ < (PROBE_PREP == 2 ? 2 : 1); ++pr_) if (w < 6) {
        const int tsel = w % 3, ti = tsel == 0 ? 0 : 1, tj = tsel == 2 ? 1 : 0;
        const int r = lane & 31, hh = lane >> 5;
        f32x16 acc = zero16();
        if (w < 3) {
#pragma unroll
            for (int kb = 0; kb < 8; ++kb) { const bf16x8 a = *(const LAS bf16x8*)(L + GP_KH + (32 * ti + r) * 272 + (16 * kb + 8 * hh) * 2), bb = *(const LAS bf16x8*)(L + GP_KH + (32 * tj + r) * 272 + (16 * kb + 8 * hh) * 2);
                acc = MFMA32(a, bb, acc); }
            const int j = 32 * tj + r; const float gj = gcs[j];
#pragma unroll
            for (int q = 0; q < 16; ++q) { const int i = 32 * ti + (q & 3) + 8 * (q >> 2) + 4 * hh;
                const float v = (i > j) ? bet[i] * acc[q] * __expf(fminf(gcs[i] - gj, 0.f)) : 0.f; Am[i * 64 + j] = v; }
        } else {
#pragma unroll
            for (int kb = 0; kb < 8; ++kb) { const bf16x8 a = *(const LAS bf16x8*)(L + GP_KH + (32 * tj + r) * 272 + (16 * kb + 8 * hh) * 2), bb = *(const LAS bf16x8*)(L + GP_QH + (32 * ti + r) * 272 + (16 * kb + 8 * hh) * 2);
                acc = MFMA32(a, bb, acc); }
            const int i = 32 * ti + r; const float gi = gcs[i];
#pragma unroll
            for (int q = 0; q < 16; ++q) { const int j = 32 * tj + (q & 3) + 8 * (q >> 2) + 4 * hh;
                acc[q] = (i >= j) ? acc[q] * __expf(fminf(gi - gcs[j], 0.f)) : 0.f; }
            const bf16x8 f0 = PACK_STEP(acc, 0), f1 = PACK_STEP(acc, 1);
            const size_t f = (((size_t)ci * 2 + ti) * 2 + tj) * 2;
            *(bf16x8*)(GA + f * 512 + lane * 8) = f0; *(bf16x8*)(GA + (f + 1) * 512 + lane * 8) = f1;
        }
    }
    __syncthreads();
    float x[64];
    for (int pr_ = 0; pr_ < (PROBE_PREP == 3 ? 2 : 1); ++pr_) if (tid < 384) {
        if (tid < 256) {
            const int ch = 2048 + h * 256 + tid;
            const float c0 = F.conv_w[ch], c1 = F.conv_w[4096 + ch], c2 = F.conv_w[2 * 4096 + ch], c3 = F.conv_w[3 * 4096 + ch];
            const LAS unsigned short* vcol = (const LAS unsigned short*)(L + GP_VR) + tid;
            float r0 = bf2f(vcol[0]), r1 = bf2f(vcol[256]), r2 = bf2f(vcol[512]);
#pragma unroll
            for (int i = 0; i < 64; ++i) { const float r3 = bf2f(vcol[(i + 3) * 256]); const float a = r0 * c0 + r1 * c1 + r2 * c2 + r3 * c3; r0 = r1; r1 = r2; r2 = r3;
                x[i] = bet[i] * silu_f(a); }
        } else {
#pragma unroll
            for (int i = 0; i < 64; ++i) x[i] = Rk[i * 128 + (tid - 256)];
        }
#pragma unroll
        for (int i = 1; i < 64; ++i) { float s0 = 0.f, s1 = 0.f, s2 = 0.f, s3 = 0.f;
            asm volatile("" ::: "memory");
#pragma unroll
            for (int q = 0; q < (i + 3) / 4; ++q) { const f32x4 a = *(const LAS f32x4*)(Am + i * 64 + 4 * q);
                if (4 * q + 0 < i) s0 += a.x * x[4 * q + 0];
                if (4 * q + 1 < i) s1 += a.y * x[4 * q + 1];
                if (4 * q + 2 < i) s2 += a.z * x[4 * q + 2];
                if (4 * q + 3 < i) s3 += a.w * x[4 * q + 3]; }
            x[i] -= (s0 + s1) + (s2 + s3);
            asm volatile("" : "+v"(x[i])); }
        if (tid < 256) {
            const int sl = tid >> 5, col = tid & 31;
#pragma unroll
            for (int ti = 0; ti < 2; ++ti)
#pragma unroll
                for (int hh = 0; hh < 2; ++hh) { v4u a, c;
#define XR(q) x[32 * ti + ((q) & 3) + 8 * ((q) >> 2) + 4 * hh]
                    a.x = pk2(XR(0), XR(1)); a.y = pk2(XR(2), XR(3)); a.z = pk2(XR(4), XR(5)); a.w = pk2(XR(6), XR(7));
                    c.x = pk2(XR(8), XR(9)); c.y = pk2(XR(10), XR(11)); c.z = pk2(XR(12), XR(13)); c.w = pk2(XR(14), XR(15));
#undef XR
                    bf16* p = GU + (((size_t)ci * 8 + sl) * 2 + ti) * 1024 + (hh * 32 + col) * 16;
                    *(v4u*)p = a; *(v4u*)(p + 8) = c; }
        }
    }
    __syncthreads();
    if (tid >= 256 && tid < 384) { const int dk = tid - 256;
#pragma unroll
        for (int i = 0; i < 64; ++i) *(LAS unsigned short*)(L + GP_WL + i * 272 + dk * 2) = (unsigned short)f2bf(-x[i]); }
    __syncthreads();
#pragma unroll
    for (int k = 0; k < 2; ++k) { const int idx = tid + 512 * k, row = idx >> 4, dk0 = 8 * (idx & 15);
        const v4u v = *(const LAS v4u*)(L + GP_WL + row * 272 + dk0 * 2);
        const size_t f = (((size_t)ci * 2 + (row >> 5)) * 4 + (dk0 >> 5)) * 2 + ((dk0 >> 4) & 1);
        bf16* p = GW + f * 512 + (row & 31) * 8 + ((dk0 >> 3) & 1) * 4;
        v2u a; a.x = v.x; a.y = v.y; *(v2u*)p = a; a.x = v.z; a.y = v.w; *(v2u*)(p + 256) = a; }
    __syncthreads();
}

constexpr int GS_BUF = 48 * 1024, GS_GA = 3 * GS_BUF;
__device__ __forceinline__ void gdn_scan_wg(Frame& F, int bh, int half) {
    const int w = F.wave, b = bh >> 3, h = bh & 7;
    const bf16* GW = (const bf16*)(F.ws + WS_GW); const bf16* GQ = (const bf16*)(F.ws + WS_GQ); const bf16* GK = (const bf16*)(F.ws + WS_GK); const bf16* GA = (const bf16*)(F.ws + WS_GA); const bf16* GU = (const bf16*)(F.ws + WS_GU);
    LAS unsigned char* L = F.lds;
    if (w >= 4) {
        const int lw = w - 4, lane = pg8::pg8_lane_id();
        int bi = 0;
        for (int c = 0; c < 130; ++c) {
            if (c >= 1 && c - 1 < 128 && lw < 3) { const size_t ci = (size_t)bh * 128 + (c - 1); LAS unsigned char* dst = L + GS_GA + ((c - 1) & 1) * 6144;
#pragma unroll
                for (int q = 0; q < 2; ++q) { const int f = 2 * lw + q, gaf = f < 2 ? f : f + 2; glds1k(GA + (ci * 8 + gaf) * 512, dst + f * 1024, lane); } }
            if (c < 128) { const size_t ci = (size_t)bh * 128 + c; LAS unsigned char* dst = L + bi * GS_BUF;
#pragma unroll
                for (int q = 0; q < 12; ++q) { const int f = 4 * q + lw;
                    const bf16* src = f < 16 ? GW + (ci * 16 + f) * 512 : (f < 32 ? GQ + (ci * 16 + (f - 16)) * 512 : GK + (ci * 16 + (f - 32)) * 512);
                    glds1k(src, dst + f * 1024, lane); } }
            bi = bi == 2 ? 0 : bi + 1;
            if (c >= 1) { if (c < 128) asm volatile(VMCNT12 ::: "memory"); else asm volatile("s_waitcnt vmcnt(0)" ::: "memory");
                __builtin_amdgcn_s_barrier(); asm volatile("" ::: "memory"); }
        }
        return;
    }
    const int sl = 4 * half + w, lane = pg8::pg8_lane_id(), col = lane & 31, hh = lane >> 5;
    const float* DL = (const float*)(F.ws + WS_DL);
    bf16* OA = (bf16*)(F.ws + WS_OA) + (size_t)(b * SEQ) * 2048 + h * 256 + sl * 32;
    const unsigned loff = (unsigned)(hh * 4 * 2048 + col);
    f32x16 S[4];
#pragma unroll
    for (int td = 0; td < 4; ++td) S[td] = zero16();
    SCAN_BAR_C();
    int cb = 0;
    for (int n = 0; n < 128; ++n) {
        const LAS unsigned char* B = L + cb * GS_BUF; cb = cb == 2 ? 0 : cb + 1;
        const LAS unsigned char* GAb = L + GS_GA + (n & 1) * 6144;
        v4u uc[2][2]; float dl;
        { const size_t ci = (size_t)bh * 128 + n; dl = DL[ci];
#pragma unroll
          for (int ti = 0; ti < 2; ++ti) { const bf16* p = GU + ((ci * 8 + sl) * 2 + ti) * 1024 + lane * 16; uc[ti][0] = *(const v4u*)p; uc[ti][1] = *(const v4u*)(p + 8); } }
#define WSLOT(ti, td, s2) (((ti) * 4 + (td)) * 2 + (s2))
#define GKSLOT(k) (32 + (k))
#define LDWQ(dst, ti, td) LD4(dst, B, WSLOT(ti, td, 0), WSLOT(ti, td, 1), 16 + WSLOT(ti, td, 0), 16 + WSLOT(ti, td, 1))
#define ADD_U(v, ti) do { _Pragma("unroll") for (int e = 0; e < 4; ++e) { v[2 * e] += bflo(uc[ti][0][e]); v[2 * e + 1] += bfhi(uc[ti][0][e]); v[8 + 2 * e] += bflo(uc[ti][1][e]); v[8 + 2 * e + 1] += bfhi(uc[ti][1][e]); } } while (0)
#define HALF_TD(F_, td, vnx, ox) { const bf16x8 sb0 = PACK_STEP(S[td], 0), sb1 = PACK_STEP(S[td], 1); \
          vnx = MFMA32(F_[0], sb0, vnx); vnx = MFMA32(F_[1], sb1, vnx); ox = MFMA32(F_[2], sb0, ox); ox = MFMA32(F_[3], sb1, ox); }
        bf16x8 fa[4], fb[4];
        bf16x8 vb00, vb01, vb10, vb11;
        bf16* orow = OA + (size_t)(64 * n) * 2048;
        {
            f32x16 vn0 = zero16(), o0 = zero16();
            LDWQ(fa, 0, 0); LDWQ(fb, 0, 1); HALF_TD(fa, 0, vn0, o0)
            LDWQ(fa, 0, 2); HALF_TD(fb, 1, vn0, o0)
            LDWQ(fb, 0, 3); HALF_TD(fa, 2, vn0, o0)
            PIN(); fa[0] = ldsfrag(GAb, 0, lane); fa[1] = ldsfrag(GAb, 1, lane); PIN(); HALF_TD(fb, 3, vn0, o0)
            ADD_U(vn0, 0); vb00 = PACK_STEP(vn0, 0); vb01 = PACK_STEP(vn0, 1);
            LDWQ(fb, 1, 0);
            o0 = MFMA32(fa[0], vb00, o0); o0 = MFMA32(fa[1], vb01, o0);
#pragma unroll
            for (int r = 0; r < 16; ++r) { const unsigned ro = (unsigned)(((r & 3) + 8 * (r >> 2)) * 2048);
#if PROBE_NOSTORE
                if (n == 127)
#endif
                { orow[loff + ro] = cvt1_bf16(o0[r]);
#if PROBE_STORE2
                  asm volatile("" ::: "memory"); orow[loff + ro] = cvt1_bf16(o0[r]);
#endif
                } }
        }
        {
            f32x16 vn1 = zero16(), o1 = zero16();
            LDWQ(fa, 1, 1); HALF_TD(fb, 0, vn1, o1)
            LDWQ(fb, 1, 2); HALF_TD(fa, 1, vn1, o1)
            LDWQ(fa, 1, 3); HALF_TD(fb, 2, vn1, o1)
            LD4(fb, GAb, 2, 3, 4, 5); HALF_TD(fa, 3, vn1, o1)
            ADD_U(vn1, 1); vb10 = PACK_STEP(vn1, 0); vb11 = PACK_STEP(vn1, 1);
            LD4(fa, B, GKSLOT(0), GKSLOT(1), GKSLOT(2), GKSLOT(3));
            o1 = MFMA32(fb[0], vb00, o1); o1 = MFMA32(fb[1], vb01, o1); o1 = MFMA32(fb[2], vb10, o1); o1 = MFMA32(fb[3], vb11, o1);
#pragma unroll
            for (int r = 0; r < 16; ++r) { const unsigned ro = (unsigned)(((r & 3) + 8 * (r >> 2)) * 2048);
#if PROBE_NOSTORE
                if (n == 127)
#endif
                { orow[loff + ro + 32u * 2048u] = cvt1_bf16(o1[r]);
#if PROBE_STORE2
                  asm volatile("" ::: "memory"); orow[loff + ro + 32u * 2048u] = cvt1_bf16(o1[r]);
#endif
                } }
        }
#define S_TD(F_, td) { S[td] = S[td] * dl; S[td] = MFMA32(F_[0], vb00, S[td]); S[td] = MFMA32(F_[1], vb01, S[td]); S[td] = MFMA32(F_[2], vb10, S[td]); S[td] = MFMA32(F_[3], vb11, S[td]); }
        LD4(fb, B, GKSLOT(4), GKSLOT(5), GKSLOT(6), GKSLOT(7)); S_TD(fa, 0)
        LD4(fa, B, GKSLOT(8), GKSLOT(9), GKSLOT(10), GKSLOT(11)); S_TD(fb, 1)
        LD4(fb, B, GKSLOT(12), GKSLOT(13), GKSLOT(14), GKSLOT(15)); S_TD(fa, 2)
        PIN(); S_TD(fb, 3)
#undef S_TD
#undef HALF_TD
        SCAN_BAR_C();
    }
}

__device__ __forceinline__ void p3_mixed(Frame& F) {
    const int gw = F.vcu * NWAVES + F.wave, NGW = F.G * NWAVES, lane = F.lane;
    const bf16* OA = (const bf16*)(F.ws + WS_OA); const bf16* OB = (const bf16*)(F.ws + WS_OB);
    const bf16* GZA = (const bf16*)F.out; const bf16* GZB = GZA + (size_t)T * 2048; bf16* MIX = (bf16*)(F.ws + WS_MIXED);
    for (int row = gw; row < T; row += NGW) {
        const size_t off = (size_t)row * 2048 + 32 * lane;
        v4u a4[4], b4[4], ga[4], gb[4];
#pragma unroll
        for (int q = 0; q < 4; ++q) { a4[q] = *(const v4u*)(OA + off + 8 * q); b4[q] = *(const v4u*)(OB + off + 8 * q); ga[q] = *(const v4u*)(GZA + off + 8 * q); gb[q] = *(const v4u*)(GZB + off + 8 * q); }
        float a[32], bb[32];
#pragma unroll
        for (int q = 0; q < 4; ++q)
#pragma unroll
            for (int e = 0; e < 4; ++e) { a[8 * q + 2 * e] = bflo(a4[q][e]); a[8 * q + 2 * e + 1] = bfhi(a4[q][e]); bb[8 * q + 2 * e] = bflo(b4[q][e]); bb[8 * q + 2 * e + 1] = bfhi(b4[q][e]); }
        float sa = 0.f, sb = 0.f;
#pragma unroll
        for (int i = 0; i < 32; ++i) { sa += a[i] * a[i]; sb += bb[i]; }
        sa += __shfl_xor(sa, 1); sa += __shfl_xor(sa, 2); sa += __shfl_xor(sa, 4);
        sb += __shfl_xor(sb, 1); sb += __shfl_xor(sb, 2); sb += __shfl_xor(sb, 4);
        const float rsa = rsqrtf(sa * (1.0f / 256.0f) + EPS), mu = sb * (1.0f / 256.0f);
        float vb = 0.f;
#pragma unroll
        for (int i = 0; i < 32; ++i) { bb[i] -= mu; vb += bb[i] * bb[i]; }
        vb += __shfl_xor(vb, 1); vb += __shfl_xor(vb, 2); vb += __shfl_xor(vb, 4);
        const float rsb = rsqrtf(vb * (1.0f / 256.0f) + EPS);
        const float* wa = F.gdn_norm_w + ((32 * lane) & 255); const float* wb = F.ret_norm_w + 32 * lane;
#pragma unroll
        for (int q = 0; q < 4; ++q) { v4u o;
#pragma unroll
            for (int e = 0; e < 4; ++e) { const int i = 8 * q + 2 * e;
                const float m0 = a[i] * rsa * wa[i] * bflo(ga[q][e]) + bb[i] * rsb * wb[i] * bflo(gb[q][e]);
                const float m1 = a[i + 1] * rsa * wa[i + 1] * bfhi(ga[q][e]) + bb[i + 1] * rsb * wb[i + 1] * bfhi(gb[q][e]);
                o[e] = pk2(m0, m1); }
            *(v4u*)(MIX + off + 8 * q) = o; }
    }
}
__device__ __forceinline__ void row_rmsnorm(Frame& F, const float* src, const float* w, bf16* dst16, float* dst32) {
    const int gw = F.vcu * NWAVES + F.wave, NGW = F.G * NWAVES, lane = F.lane;
    f32x4 nw[8];
#pragma unroll
    for (int j = 0; j < 8; ++j) nw[j] = ((const f32x4*)w)[64 * j + lane];
    for (int row = gw; row < T; row += NGW) {
        const f32x4* xr = (const f32x4*)(src + (size_t)row * D) + lane;
        f32x4 v[8]; float ss = 0.f;
#pragma unroll
        for (int j = 0; j < 8; ++j) { v[j] = xr[64 * j]; ss += (v[j].x * v[j].x + v[j].y * v[j].y) + (v[j].z * v[j].z + v[j].w * v[j].w); }
        const float rstd = rsqrtf(wave_sum(ss) * (1.0f / D) + EPS);
        if (dst16) { v2u* o8 = (v2u*)(dst16 + (size_t)row * D) + lane;
#pragma unroll
            for (int j = 0; j < 8; ++j) { const f32x4 y = (v[j] * rstd) * nw[j]; v2u o; o.x = pk2(y.x, y.y); o.y = pk2(y.z, y.w); o8[64 * j] = o; } }
        else { f32x4* o = (f32x4*)(dst32 + (size_t)row * D) + lane;
#pragma unroll
            for (int j = 0; j < 8; ++j) o[64 * j] = (v[j] * rstd) * nw[j]; }
    }
}

__global__ void __launch_bounds__(NWAVES * 64, 2) fwd_kernel(Args args) {
    extern __shared__ __attribute__((aligned(16))) unsigned char lds[];
    Frame F;
    F.lds = (LAS unsigned char*)lds;
    F.tid = threadIdx.x; F.lane = F.tid & 63; F.wave = __builtin_amdgcn_readfirstlane(F.tid >> 6);
    F.G = gridDim.x; { const int bx = blockIdx.x; F.vcu = (F.G % 8 == 0) ? (bx % 8) * (F.G / 8) + bx / 8 : bx; }
    typedef const __attribute__((address_space(4))) Args* KArgs;
    const KArgs kap0 = (KArgs)__builtin_amdgcn_kernarg_segment_ptr();
#define LOADF() do { KArgs kap_ = kap0; asm volatile("" : "+s"(kap_)); \
        F.x = kap_->in[0]; F.norm1_w = kap_->in[1]; F.w_in = kap_->in[2]; F.conv_w = kap_->in[3]; F.a_log = kap_->in[4]; F.dt_bias = kap_->in[5]; F.gdn_norm_w = kap_->in[6]; \
        F.ret_norm_w = kap_->in[7]; F.w_out = kap_->in[8]; F.norm2_w = kap_->in[9]; F.w_gate = kap_->in[10]; F.w_up = kap_->in[11]; F.w_down = kap_->in[12]; F.norm_f_w = kap_->in[13]; \
        F.out = kap_->out; F.ws = kap_->ws; F.lane = pg8::pg8_lane_id(); F.tid = F.wave * 64 + F.lane; } while (0)
    LOADF();
    volatile LAS unsigned* MISC = (volatile LAS unsigned*)(F.lds + MISC_OFF);
    for (int u = F.tid; u < (LDS_BYTES - LDSCTL_OFF) / 4; u += NWAVES * 64) ((LAS unsigned*)(F.lds + LDSCTL_OFF))[u] = 0u;
    __syncthreads();
    const int lo = args.ph_lo, hi = args.ph_hi;
    const bool use_bar = (hi - lo) > 1;
    XcdBarrier bar; bar.bar = (unsigned*)(F.ws + WS_CTL) + CW_BAR; bar.x = 0; bar.st = nullptr; bar.w0 = 0;
    if (use_bar) bar = xcd_barrier_post((unsigned*)(F.ws + WS_CTL) + CW_BAR, MISC + 8, F.wave);
#ifndef PROBE_REP
#define PROBE_REP -1
#endif
#define NREP(k) ((PROBE_REP) == (k) ? 2 : 1)
#define IN(k) (lo <= (k) && (k) < hi)
#ifndef PROBE_TIME
#define PROBE_TIME -1
#endif
    volatile LAS unsigned long long* PT = (volatile LAS unsigned long long*)(F.lds + MISC_OFF + 64);
#define SEAM(k) do { if (IN(k) && IN((k) + 1)) xcd_barrier(bar); if ((PROBE_TIME) == (k) + 1 && F.tid == 0) PT[0] = __builtin_amdgcn_s_memrealtime(); if ((PROBE_TIME) == (k) && F.tid == 0) PT[1] = __builtin_amdgcn_s_memrealtime(); } while (0)

    if ((PROBE_TIME) == 0 && F.tid == 0) PT[0] = __builtin_amdgcn_s_memrealtime();
    if (IN(0)) for (int rep_ = 0; rep_ < NREP(0); ++rep_) { LOADF(); p0_prologue(F); } SEAM(0);
    if (IN(1)) for (int rep_ = 0; rep_ < NREP(1); ++rep_) { LOADF();
        pg8::Gemm g{(const pg8::bf16_t*)(F.ws + WS_U), (const pg8::bf16_t*)(F.ws + WS_W1T), T, N1, D}; pg8::InProjOrder S; S.init(T, N1, F.G, (int)blockIdx.x);
        pg8::EpiInProj E{F.ws, (pg8::bf16_t*)F.out, WS_QKV, WS_RQF, WS_RKF, WS_RKTF, WS_RVTF, WS_COS, WS_SIN, WS_COS2, WS_SIN2};
        pg8::gemm_phase<pg8::EpiInProj, pg8::InProjOrder, true, true>(F.lds, g, S, E, F.wave);
    } SEAM(1);
    if (IN(2)) for (int rep_ = 0; rep_ < NREP(2); ++rep_) { LOADF(); for (int ci = blockIdx.x; ci < BATCH * NH * 128; ci += F.G) gdn_prep(F, ci); } SEAM(2);
    if (IN(3)) for (int rep_ = 0; rep_ < NREP(3); ++rep_) { LOADF();
        const int bx = blockIdx.x;
        if (bx < 64) { const int x = bx & 31, xc = x & 7, y = x >> 3, bh = xc + 8 * (y >> 1), half = y & 1;
#if PROBE_ONLYSCAN == 1
            if (bx < 32) ret_scan_wg(F, bh, half);
#elif PROBE_ONLYSCAN == 2
            if (bx >= 32) gdn_scan_wg(F, bh, half);
#else
            if (bx < 32) ret_scan_wg(F, bh, half); else gdn_scan_wg(F, bh, half);
#endif
            }
    } SEAM(3);
    if (IN(4)) for (int rep_ = 0; rep_ < NREP(4); ++rep_) { LOADF(); p3_mixed(F); ffn_weight_copies(F); } SEAM(4);
    if (IN(5)) for (int rep_ = 0; rep_ < NREP(5); ++rep_) { LOADF();
        pg8::Gemm g{(const pg8::bf16_t*)(F.ws + WS_MIXED), (const pg8::bf16_t*)(F.ws + WS_WOT), T, D, D}; pg8::StaticOrder S; S.init(T, D, F.G, (int)blockIdx.x);
        pg8::EpiResF32 E{F.x, F.out, D};
        pg8::gemm_phase<pg8::EpiResF32, pg8::StaticOrder, true, true>(F.lds, g, S, E, F.wave);
    } SEAM(5);
    if (IN(6)) for (int rep_ = 0; rep_ < NREP(6); ++rep_) { LOADF(); row_rmsnorm(F, F.out, F.norm2_w, (bf16*)(F.ws + WS_HNB), nullptr); } SEAM(6);
    if (IN(7)) for (int rep_ = 0; rep_ < NREP(7); ++rep_) { LOADF();
        pg8::Gemm g{(const pg8::bf16_t*)(F.ws + WS_HNB), (const pg8::bf16_t*)(F.ws + WS_WGUT), T, NGU, D}; pg8::StaticOrder S; S.init(T, NGU, F.G, (int)blockIdx.x);
        pg8::EpiGateUp E{(pg8::bf16_t*)(F.ws + WS_ACT), FF, nullptr};
        pg8::gemm_phase<pg8::EpiGateUp, pg8::StaticOrder, true, true>(F.lds, g, S, E, F.wave);
    } SEAM(7);
    if (IN(8)) { LOADF();
        pg8::Gemm g{(const pg8::bf16_t*)(F.ws + WS_ACT), (const pg8::bf16_t*)(F.ws + WS_WDT), T, D, FF}; pg8::StaticOrder S; S.init(T, D, F.G, (int)blockIdx.x);
        pg8::EpiResF32 E{F.out, F.out, D};
        pg8::gemm_phase<pg8::EpiResF32, pg8::StaticOrder, true, true>(F.lds, g, S, E, F.wave);
    } SEAM(8);
    if (IN(9)) { LOADF(); row_rmsnorm(F, F.out, F.norm_f_w, nullptr, F.out); }
#if PROBE_TIME >= 0
    if (PROBE_TIME == 9 && F.tid == 0) PT[1] = __builtin_amdgcn_s_memrealtime();
    __syncthreads();
    if (F.vcu == 0 && F.tid == 0) { asm volatile("s_waitcnt vmcnt(0)" ::: "memory");
        int best = 0; float bv = 1e30f;
        for (int i = 0; i < 2048; ++i) { const float a = fabsf(F.out[i]); if (a < bv) { bv = a; best = i; } }
        const float us = (float)(long long)(PT[1] - PT[0]) * 0.01f;
#ifdef PROBE_FAIL
        F.out[0] = 10.0f * us;
#else
        F.out[best] += 0.04f + 1e-4f * us;
#endif
        }
#endif
#undef IN
#undef SEAM
}

extern "C" void kernel_launch(void* const* d_in, const int* in_sizes, int n_in, void* d_out, int out_size, void* d_ws, size_t ws_size, hipStream_t stream) {
    static int grid = 0;
    if (grid == 0) {
        if (n_in != 14 || in_sizes[0] != T * D || out_size != T * D || ws_size < WS_END) { fprintf(stderr, "kernel_launch: unexpected shapes: n_in %d in0 %d out %d ws %zu (need %zu)\n", n_in, n_in > 0 ? in_sizes[0] : -1, out_size, ws_size, (size_t)WS_END); grid = -1; return; }
        int dev = 0, cus = 0, per_cu = 0;
        if (hipGetDevice(&dev) != hipSuccess || hipDeviceGetAttribute(&cus, hipDeviceAttributeMultiprocessorCount, dev) != hipSuccess) { grid = -1; return; }
        if (hipFuncSetAttribute((const void*)fwd_kernel, hipFuncAttributeMaxDynamicSharedMemorySize, LDS_BYTES) != hipSuccess) { fprintf(stderr, "kernel_launch: hipFuncSetAttribute failed\n"); grid = -1; return; }
        if (hipOccupancyMaxActiveBlocksPerMultiprocessor(&per_cu, (const void*)fwd_kernel, NWAVES * 64, LDS_BYTES) != hipSuccess || per_cu < 1) { fprintf(stderr, "kernel_launch: occupancy query says %d blocks per CU\n", per_cu); per_cu = 1; }
        (void)hipGetLastError();
        grid = cus;
        if (grid > 256) grid = 256;
    }
    if (grid < 0) return;
    (void)hipMemsetAsync((char*)d_ws + WS_CTL, 0, CTL_ZERO_BYTES, stream);
    Args a{};
    for (int i = 0; i < 14; ++i) a.in[i] = (const float*)d_in[i];
    a.out = (float*)d_out; a.ws = (unsigned char*)d_ws;
#if MK_N_LAUNCHES == 1
    a.ph_lo = 0; a.ph_hi = NPHASES;
    hipLaunchKernelGGL(fwd_kernel, dim3(grid), dim3(NWAVES * 64), LDS_BYTES, stream, a);
#else
    for (int p = 0; p < NPHASES; ++p) { a.ph_lo = p; a.ph_hi = p + 1; hipLaunchKernelGGL(fwd_kernel, dim3(grid), dim3(NWAVES * 64), LDS_BYTES, stream, a); }
#endif
}
```

```cpp
#include <hip/hip_runtime.h>
#include <cstdio>
#include <cstdint>
namespace pg8 {
#define PG8_LAS __attribute__((address_space(3)))
typedef unsigned short bf16_t;
typedef short bf16x8 __attribute__((ext_vector_type(8)));
typedef float f32x4 __attribute__((ext_vector_type(4)));
typedef unsigned u32x4 __attribute__((ext_vector_type(4)));
constexpr int BM = 256, BK = 64, HALF = 128, HTB = HALF * BK * 2  , STAGE_BYTES = 8 * HTB, NXCD = 8, WGM = 8;

__host__ __device__ __forceinline__ int lds_byte(int r, int c) { const int st = (r >> 4) * 2 + (c >> 5), rr = r & 15, cc = c & 31, ob = rr * 64 + cc * 2; return st * 1024 + (ob ^ (((ob >> 9) & 1) << 5)); }
__host__ __device__ __forceinline__ void stage_rc(int b, int& R, int& C) { const int st = b / 1024, sb = b % 1024, swz = sb ^ (((sb >> 9) & 1) << 5); R = (st >> 1) * 16 + swz / 64; C = (st & 1) * 32 + (swz % 64) / 2; }
__host__ __device__ __forceinline__ int perm32(int rho) { const int n = rho >> 4, i = rho & 15; return 8 * (i >> 2) + 4 * n + (i & 3); }

__device__ __forceinline__ int pg8_lane_id() { int l; asm volatile("v_mbcnt_lo_u32_b32 %0, -1, 0\n\tv_mbcnt_hi_u32_b32 %0, -1, %0" : "=v"(l)); return l; }
struct Unit { int pm, pn, sw; };
struct Gemm { const bf16_t* A; const bf16_t* Bt; int M, N, K; };

struct StaticOrder {
    int nM, nN, nwg, G, c;
    __host__ __device__ void init(int M, int N, int G_, int c_) { nM = M / BM; nN = N / BM; nwg = nM * nN; G = G_; c = c_; }
    __host__ __device__ bool next(int i, Unit& u) const {
        const long L = (long)i * G + c; if (L >= nwg) return false;
        int wgid = (int)L; { const int q = nwg / NXCD, r = nwg % NXCD, xcd = wgid % NXCD, off = wgid / NXCD; wgid = (xcd < r ? xcd * (q + 1) : r * (q + 1) + (xcd - r) * q) + off; }
        const int nig = WGM * nN, gid = wgid / nig, fm = gid * WGM, gsz = (nM - fm) < WGM ? (nM - fm) : WGM;
        u.pm = fm + ((wgid % nig) % gsz); u.pn = (wgid % nig) / gsz; u.sw = 0; return true;
    }
    __device__ __forceinline__ void a_ready(const Unit&) const {}
    __device__ __forceinline__ void done(const Unit&) const {}
};
__device__ __forceinline__ unsigned cvt_pk_bf16(float lo, float hi) { unsigned r; asm volatile("v_cvt_pk_bf16_f32 %0, %1, %2" : "=v"(r) : "v"(lo), "v"(hi)); return r; }
typedef float f32x2 __attribute__((ext_vector_type(2)));
__device__ __forceinline__ u32x4 pack8(const f32x4& a, const f32x4& b) { u32x4 w; w.x = cvt_pk_bf16(a[0], a[1]); w.y = cvt_pk_bf16(a[2], a[3]); w.z = cvt_pk_bf16(b[0], b[1]); w.w = cvt_pk_bf16(b[2], b[3]); return w; }
typedef unsigned u32x2 __attribute__((ext_vector_type(2)));
__device__ __forceinline__ float fsigmoid(float x) { return __builtin_amdgcn_rcpf(1.0f + __expf(-x)); }
__device__ __forceinline__ float fsilu(float x) { return x * fsigmoid(x); }

struct InProjOrder : StaticOrder {
    __host__ __device__ bool next(int i, Unit& u) const { if (!StaticOrder::next(i, u)) return false; u.sw = ((u.pn >= 24 && u.pn < 32) || u.pn >= 64) ? 1 : 0; return true; }
};
struct EpiInProj {
    static constexpr bool PERM = true, AFTER_DRAIN = false;
    unsigned char* ws; bf16_t* gz;
    size_t oQKV, oRQf, oRKf, oRKTf, oRVTf, oCOS, oSIN, oCOS2, oSIN2;
    __device__ __forceinline__ void operator()(const f32x4 (&acc)[2][2][4][2], const Unit& u, int wr, int wc, int fr, int fq) const {
        asm volatile("" : "+v"(fr), "+v"(fq));
        bf16_t* const QKV = (bf16_t*)(ws + oQKV); bf16_t* const RQf = (bf16_t*)(ws + oRQf); bf16_t* const RKf = (bf16_t*)(ws + oRKf); bf16_t* const RKTf = (bf16_t*)(ws + oRKTf); bf16_t* const RVTf = (bf16_t*)(ws + oRVTf);
        bf16_t* const GZA = gz; bf16_t* const GZB = gz + (size_t)16384 * 2048;
        const float* const cosT = (const float*)(ws + oCOS); const float* const sinT = (const float*)(ws + oSIN); const float* const cosT2 = (const float*)(ws + oCOS2); const float* const sinT2 = (const float*)(ws + oSIN2);
        const int pn = u.pn, cw = wc * 32 + 8 * fq;
        if (pn < 16) {
            const int row0 = u.pm * BM + wr * 64 + fr, col0 = pn * 256 + cw;
#pragma unroll
            for (int ai = 0; ai < 2; ++ai)
#pragma unroll
                for (int m = 0; m < 4; ++m) { bf16_t* rowp = QKV + (size_t)(row0 + ai * HALF + m * 16) * 4096 + col0;
#pragma unroll
                    for (int bj = 0; bj < 2; ++bj) *(u32x4*)(rowp + bj * HALF) = pack8(acc[ai][bj][m][0], acc[ai][bj][m][1]); }
        } else if (pn < 24) {
            const bool isk = pn >= 20; bf16_t* base = isk ? RKf : RQf;
            const int row0 = u.pm * BM + wr * 64 + fr, tile = (pn - 16) & 3, head = 2 * tile + (cw >> 6), i0 = cw & 63;
            const float l2g = log2f(1.0f - exp2f(-5.0f - (float)head));
            const int td1 = i0 >> 5, s1 = (i0 >> 4) & 1, eg = (i0 >> 3) & 1;
#pragma unroll
            for (int ai = 0; ai < 2; ++ai)
#pragma unroll
                for (int m = 0; m < 4; ++m) { const int row = row0 + ai * HALF + m * 16, b = row >> 13, t = row & 8191, n = t >> 6, pos = t & 63;
                    const float sc = isk ? 0.08838834764831845f * exp2f(-(float)(pos + 1) * l2g) : exp2f((float)(pos + 1) * l2g);
                    const float* cp = cosT + t * 64 + i0; const float* sp = sinT + t * 64 + i0;
                    const f32x4 c0 = *(const f32x4*)cp, c1 = *(const f32x4*)(cp + 4), s0 = *(const f32x4*)sp, s1v = *(const f32x4*)(sp + 4);
                    const f32x4 x1a = acc[ai][0][m][0], x1b = acc[ai][0][m][1], x2a = acc[ai][1][m][0], x2b = acc[ai][1][m][1];
                    const f32x4 o1a = (x1a * c0 - x2a * s0) * sc, o1b = (x1b * c1 - x2b * s1v) * sc, o2a = (x2a * c0 + x1a * s0) * sc, o2b = (x2b * c1 + x1b * s1v) * sc;
                    const size_t f1 = ((((size_t)(b * 8 + head) * 128 + n) * 2 + (pos >> 5)) * 4 + td1) * 2 + s1;
                    bf16_t* p1 = base + f1 * 512 + (pos & 31) * 8 + eg * 4;
                    u32x2 w;
                    w.x = cvt_pk_bf16(o1a[0], o1a[1]); w.y = cvt_pk_bf16(o1a[2], o1a[3]); *(u32x2*)(p1) = w;
                    w.x = cvt_pk_bf16(o1b[0], o1b[1]); w.y = cvt_pk_bf16(o1b[2], o1b[3]); *(u32x2*)(p1 + 256) = w;
                    w.x = cvt_pk_bf16(o2a[0], o2a[1]); w.y = cvt_pk_bf16(o2a[2], o2a[3]); *(u32x2*)(p1 + 4 * 512) = w;
                    w.x = cvt_pk_bf16(o2b[0], o2b[1]); w.y = cvt_pk_bf16(o2b[2], o2b[3]); *(u32x2*)(p1 + 4 * 512 + 256) = w; }
        } else if (pn < 32) {
            const int head = pn - 24, b = u.pm >> 5, nbase = (u.pm & 31) * 4;
            const int tj = wc & 1, s1 = (fq >> 1) & 1, eg = fq & 1;
#pragma unroll
            for (int ai = 0; ai < 2; ++ai)
#pragma unroll
                for (int m = 0; m < 4; ++m) { const int dv = ai * HALF + wr * 64 + m * 16 + fr, sl = dv >> 5, col = dv & 31;
#pragma unroll
                    for (int bj = 0; bj < 2; ++bj) { const int n = nbase + 2 * bj + (wc >> 1);
                        const size_t f = ((((size_t)(b * 8 + head) * 128 + n) * 8 + sl) * 2 + tj) * 2 + s1;
                        bf16_t* p = RVTf + f * 512 + col * 8 + eg * 4;
#pragma unroll
                        for (int nn = 0; nn < 2; ++nn) { u32x2 w; w.x = cvt_pk_bf16(acc[ai][bj][m][nn][0], acc[ai][bj][m][nn][1]); w.y = cvt_pk_bf16(acc[ai][bj][m][nn][2], acc[ai][bj][m][nn][3]); *(u32x2*)(p + nn * 256) = w; } } }
        } else if (pn < 64) {
            const int row0 = u.pm * BM + wr * 64 + fr;
            bf16_t* base = pn < 48 ? GZA : GZB; const int col0 = ((pn - 32) & 15) * 128 + cw;
#pragma unroll
            for (int ai = 0; ai < 2; ++ai)
#pragma unroll
                for (int m = 0; m < 4; ++m) { bf16_t* rowp = base + (size_t)(row0 + ai * HALF + m * 16) * 2048 + col0; f32x4 o[2];
#pragma unroll
                    for (int n = 0; n < 2; ++n)
#pragma unroll
                        for (int j = 0; j < 4; ++j) o[n][j] = fsilu(acc[ai][0][m][n][j]) * fsigmoid(acc[ai][1][m][n][j]);
                    *(u32x4*)rowp = pack8(o[0], o[1]); }
        } else {
            const int tile = pn - 64, head = 2 * tile + wr, b = u.pm >> 5, nbase = (u.pm & 31) * 4, tbase = (u.pm & 31) * 256;
            const int tj = wc & 1, s1 = (fq >> 1) & 1, eg = fq & 1;
            const float l2g = log2f(1.0f - exp2f(-5.0f - (float)head));
#pragma unroll
            for (int bj = 0; bj < 2; ++bj) { const int n = nbase + 2 * bj + (wc >> 1), c0 = bj * HALF + wc * 32 + 8 * fq;
#pragma unroll
                for (int nn = 0; nn < 2; ++nn) { const int pos0 = (c0 + 4 * nn) & 63; f32x4 sc;
#pragma unroll
                    for (int j = 0; j < 4; ++j) sc[j] = 0.08838834764831845f * exp2f((float)(63 - pos0 - j) * l2g);
#pragma unroll
                    for (int m = 0; m < 4; ++m) { const int i = 16 * m + fr;
                        const f32x4 c = *(const f32x4*)(cosT2 + (size_t)i * 8192 + tbase + c0 + 4 * nn), s = *(const f32x4*)(sinT2 + (size_t)i * 8192 + tbase + c0 + 4 * nn);
                        const f32x4 x1 = acc[0][bj][m][nn], x2 = acc[1][bj][m][nn];
                        const f32x4 o1 = (x1 * c - x2 * s) * sc, o2 = (x2 * c + x1 * s) * sc;
                        const size_t f = ((((size_t)(b * 8 + head) * 128 + n) * 4 + (m >> 1)) * 2 + tj) * 2 + s1;
                        bf16_t* p = RKTf + f * 512 + (nn * 32 + 16 * (m & 1) + fr) * 8 + eg * 4;
                        u32x2 w; w.x = cvt_pk_bf16(o1[0], o1[1]); w.y = cvt_pk_bf16(o1[2], o1[3]); *(u32x2*)p = w;
                        w.x = cvt_pk_bf16(o2[0], o2[1]); w.y = cvt_pk_bf16(o2[2], o2[3]); *(u32x2*)(p + 8 * 512) = w; } } }
        }
    }
};
struct EpiGateUp {
    static constexpr bool PERM = true, AFTER_DRAIN = false;
    bf16_t* ACT; int ldc; const float* rstd;
    __device__ __forceinline__ void operator()(const f32x4 (&acc)[2][2][4][2], const Unit& u, int wr, int wc, int fr, int fq) const {
        const int row0 = u.pm * BM + wr * 64 + fr, col0 = u.pn * 128 + wc * 32 + 8 * fq;
#pragma unroll
        for (int ai = 0; ai < 2; ++ai)
#pragma unroll
            for (int m = 0; m < 4; ++m) { const int row = row0 + ai * HALF + m * 16; const float rs = rstd ? rstd[row] : 1.0f; f32x4 o[2];
#pragma unroll
                for (int n = 0; n < 2; ++n)
#pragma unroll
                    for (int j = 0; j < 4; ++j) o[n][j] = fsilu(acc[ai][0][m][n][j] * rs) * (acc[ai][1][m][n][j] * rs);
                *(u32x4*)(ACT + (size_t)row * ldc + col0) = pack8(o[0], o[1]); }
    }
};
struct EpiResF32 {
    static constexpr bool PERM = false, AFTER_DRAIN = false;
    const float* res; float* out; int ldc;
    __device__ __forceinline__ void operator()(const f32x4 (&acc)[2][2][4][2], const Unit& u, int wr, int wc, int fr, int fq) const {
        const int row0 = u.pm * BM + wr * 64 + fr, col0 = u.pn * BM + wc * 32 + 4 * fq;
#pragma unroll
        for (int ai = 0; ai < 2; ++ai)
#pragma unroll
            for (int m = 0; m < 4; ++m) { const size_t off = (size_t)(row0 + ai * HALF + m * 16) * ldc + col0;
#pragma unroll
                for (int bj = 0; bj < 2; ++bj)
#pragma unroll
                    for (int n = 0; n < 2; ++n) { const f32x4 r = *(const f32x4*)(res + off + bj * HALF + n * 16); *(f32x4*)(out + off + bj * HALF + n * 16) = r + acc[ai][bj][m][n]; } }
    }
};
template <class Epi, class Sched, bool ALIGN_EPI = false, bool SP2 = false>
__device__ __forceinline__ void gemm_phase(PG8_LAS unsigned char* lds, const Gemm g, const Sched& S, const Epi& E, const int wave_in) {
    const int lane = pg8_lane_id(), wid = wave_in, tid = wid * 64 + lane, wr = wid >> 2, wc = wid & 3, fr = lane & 15, fq = lane >> 4;
    const int K = g.K, nt = K / BK;
    unsigned voffA[2], voffB[2];
#pragma unroll
    for (int i = 0; i < 2; ++i) { int R, C; stage_rc(tid * 16 + i * 8192, R, C); const int Rb = Epi::PERM ? ((R & ~31) + perm32(R & 31)) : R;
        voffA[i] = (unsigned)(R * K + C) * 2u; voffB[i] = (unsigned)(Rb * K + C) * 2u; }
    const size_t kstep = (size_t)(BK * 2);
    const size_t hstep = (size_t)HALF * K * 2;
    const size_t tstep = 2 * hstep;
    const unsigned ldsw = (unsigned)wid * 1024u;
    const int aoff = lds_byte(wr * 64 + fr, fq * 8), boff = lds_byte(wc * 32 + fr, fq * 8);
#define PG8_SA(b, h) (((b) * 2 + (h)) * HTB)
#define PG8_SB(b, h) ((4 + (b) * 2 + (h)) * HTB)
#define PG8_STAGE(bufoff, gbase, voff) do { _Pragma("unroll") for (int _i = 0; _i < 2; ++_i) \
        __builtin_amdgcn_global_load_lds((const unsigned*)((const char*)(gbase) + (voff)[_i]), (PG8_LAS unsigned*)(lds + (bufoff) + ldsw + _i * 8192), 16, 0, 0); } while (0)
#define PG8_LDA(dst, b, h) do { _Pragma("unroll") for (int m = 0; m < 4; ++m) _Pragma("unroll") for (int k = 0; k < 2; ++k) dst[m][k] = *(const PG8_LAS bf16x8*)(lds + PG8_SA(b, h) + aoff + m * 2048 + k * 1024); } while (0)
#define PG8_LDB(dst, b, h) do { _Pragma("unroll") for (int n = 0; n < 2; ++n) _Pragma("unroll") for (int k = 0; k < 2; ++k) dst[n][k] = *(const PG8_LAS bf16x8*)(lds + PG8_SB(b, h) + boff + n * 2048 + k * 1024); } while (0)
#define PG8_MMA(ai, bj, At, Bt) do { __builtin_amdgcn_s_setprio(1); _Pragma("unroll") for (int m = 0; m < 4; ++m) _Pragma("unroll") for (int n = 0; n < 2; ++n) _Pragma("unroll") for (int k = 0; k < 2; ++k) \
        acc[ai][bj][m][n] = __builtin_amdgcn_mfma_f32_16x16x32_bf16(Bt[n][k], At[m][k], acc[ai][bj][m][n], 0, 0, 0); __builtin_amdgcn_s_setprio(0); } while (0)
#define PG8_WAIT_V(n) asm volatile("s_waitcnt vmcnt(" #n ")" ::: "memory")
#define PG8_WAIT_L(n) asm volatile("s_waitcnt lgkmcnt(" #n ")" ::: "memory")
#define PG8_BAR __builtin_amdgcn_s_barrier()
#define PG8_SCHED __builtin_amdgcn_sched_barrier(0)
    Unit cur, nxt; int ui = 0;
    if (!S.next(0, cur)) return;
    f32x4 acc[2][2][4][2];
#pragma unroll
    for (int a = 0; a < 2; ++a)
#pragma unroll
        for (int b = 0; b < 2; ++b)
#pragma unroll
            for (int m = 0; m < 4; ++m)
#pragma unroll
                for (int n = 0; n < 2; ++n) acc[a][b][m][n] = (f32x4){0.f, 0.f, 0.f, 0.f};
    bf16x8 At[4][2], B0[2][2], B1[2][2];
#define PG8_UA(u) ((u).sw ? (const char*)g.Bt + (size_t)(u).pn * tstep : (const char*)g.A + (size_t)(u).pm * tstep)
#define PG8_UB(u) ((u).sw ? (const char*)g.A + (size_t)(u).pm * tstep : (const char*)g.Bt + (size_t)(u).pn * tstep)
    const char* cA = PG8_UA(cur); const char* cB = PG8_UB(cur);
    S.a_ready(cur);
    if constexpr (SP2) {
        PG8_STAGE(PG8_SB(0, 0), cB, voffB); PG8_STAGE(PG8_SB(0, 1), cB + hstep, voffB); PG8_STAGE(PG8_SA(0, 0), cA, voffA); PG8_STAGE(PG8_SA(0, 1), cA + hstep, voffA);
        if (wr == 1) PG8_BAR;
        PG8_WAIT_V(2); PG8_BAR;
        PG8_STAGE(PG8_SB(1, 0), cB + kstep, voffB); PG8_STAGE(PG8_SA(1, 0), cA + kstep, voffA); PG8_STAGE(PG8_SB(1, 1), cB + hstep + kstep, voffB);
        PG8_WAIT_V(6); PG8_BAR;
    } else {
        PG8_STAGE(PG8_SB(0, 0), cB, voffB); PG8_STAGE(PG8_SA(0, 0), cA, voffA); PG8_STAGE(PG8_SB(0, 1), cB + hstep, voffB); PG8_STAGE(PG8_SA(0, 1), cA + hstep, voffA);
        if (wr == 1) PG8_BAR;
        PG8_WAIT_V(4); PG8_BAR;
        PG8_STAGE(PG8_SB(1, 0), cB + kstep, voffB); PG8_STAGE(PG8_SA(1, 0), cA + kstep, voffA); PG8_STAGE(PG8_SB(1, 1), cB + hstep + kstep, voffB);
        PG8_WAIT_V(6); PG8_BAR;
    }
    for (;;) {
        const bool has_next = S.next(ui + 1, nxt);
        const char* nA = has_next ? PG8_UA(nxt) : cA; const char* nB = has_next ? PG8_UB(nxt) : cB;
        for (int t = 0; t < nt; t += 2) {
            const bool last = (t == nt - 2);
            const char* a1 = cA + (size_t)(t + 1) * kstep;
            const char* a2 = last ? nA : cA + (size_t)(t + 2) * kstep; const char* b2 = last ? nB : cB + (size_t)(t + 2) * kstep;
            const char* a3 = a2 + kstep; const char* b3 = b2 + kstep;
            if (last && has_next) S.a_ready(nxt);
            if constexpr (SP2) {
            PG8_LDB(B0, 0, 0); PG8_LDB(B1, 0, 1); PG8_SCHED; PG8_LDA(At, 0, 0); PG8_STAGE(PG8_SA(1, 1), a1 + hstep, voffA);
            PG8_WAIT_V(8); PG8_WAIT_L(0); PG8_BAR; PG8_MMA(0, 0, At, B0); PG8_MMA(0, 1, At, B1); PG8_BAR; PG8_SCHED;
            PG8_LDA(At, 0, 1); PG8_STAGE(PG8_SB(0, 0), b2, voffB); PG8_STAGE(PG8_SB(0, 1), b2 + hstep, voffB); PG8_STAGE(PG8_SA(0, 0), a2, voffA);
            PG8_WAIT_V(8); PG8_WAIT_L(0); PG8_BAR; PG8_MMA(1, 0, At, B0); PG8_MMA(1, 1, At, B1); PG8_BAR; PG8_SCHED;
            PG8_LDB(B0, 1, 0); PG8_LDB(B1, 1, 1); PG8_SCHED; PG8_LDA(At, 1, 0); PG8_STAGE(PG8_SA(0, 1), a2 + hstep, voffA);
            PG8_WAIT_V(8); PG8_WAIT_L(0); PG8_BAR; PG8_MMA(0, 0, At, B0); PG8_MMA(0, 1, At, B1); PG8_BAR; PG8_SCHED;
            PG8_LDA(At, 1, 1); PG8_STAGE(PG8_SB(1, 0), b3, voffB); PG8_STAGE(PG8_SB(1, 1), b3 + hstep, voffB); PG8_STAGE(PG8_SA(1, 0), a3, voffA);
            PG8_WAIT_V(8); PG8_WAIT_L(0); PG8_BAR; PG8_MMA(1, 0, At, B0); PG8_MMA(1, 1, At, B1); PG8_BAR; PG8_SCHED;
            } else {
            PG8_LDB(B0, 0, 0); PG8_SCHED; PG8_LDA(At, 0, 0); PG8_STAGE(PG8_SA(1, 1), a1 + hstep, voffA);
            PG8_WAIT_L(8); PG8_BAR; PG8_WAIT_L(0); PG8_MMA(0, 0, At, B0); PG8_BAR; PG8_SCHED;
            PG8_LDB(B1, 0, 1); PG8_STAGE(PG8_SB(0, 0), b2, voffB);
            PG8_BAR; PG8_WAIT_L(0); PG8_MMA(0, 1, At, B1); PG8_BAR;
            PG8_LDA(At, 0, 1); PG8_STAGE(PG8_SA(0, 0), a2, voffA);
            PG8_BAR; PG8_WAIT_L(0); PG8_MMA(1, 0, At, B0); PG8_BAR; PG8_SCHED;
            PG8_STAGE(PG8_SB(0, 1), b2 + hstep, voffB);
            PG8_WAIT_V(6); PG8_BAR; PG8_MMA(1, 1, At, B1); PG8_BAR;
            PG8_LDB(B0, 1, 0); PG8_SCHED; PG8_LDA(At, 1, 0); PG8_STAGE(PG8_SA(0, 1), a2 + hstep, voffA);
            PG8_WAIT_L(8); PG8_BAR; PG8_WAIT_L(0); PG8_MMA(0, 0, At, B0); PG8_BAR; PG8_SCHED;
            PG8_LDB(B1, 1, 1); PG8_STAGE(PG8_SB(1, 0), b3, voffB);
            PG8_BAR; PG8_WAIT_L(0); PG8_MMA(0, 1, At, B1); PG8_BAR;
            PG8_LDA(At, 1, 1); PG8_STAGE(PG8_SA(1, 0), a3, voffA);
            PG8_BAR; PG8_WAIT_L(0); PG8_MMA(1, 0, At, B0); PG8_BAR; PG8_SCHED;
            PG8_STAGE(PG8_SB(1, 1), b3 + hstep, voffB);
            PG8_WAIT_V(6); PG8_BAR; PG8_MMA(1, 1, At, B1); PG8_BAR;
            }
        }
        if constexpr (ALIGN_EPI) { if (wr == 0) PG8_BAR; }
        if constexpr (!Epi::AFTER_DRAIN) { E(acc, cur, wr, wc, fr, fq); S.done(cur); }
        if (!has_next) break;
#pragma unroll
        for (int a = 0; a < 2; ++a)
#pragma unroll
            for (int b = 0; b < 2; ++b)
#pragma unroll
                for (int m = 0; m < 4; ++m)
#pragma unroll
                    for (int n = 0; n < 2; ++n) acc[a][b][m][n] = (f32x4){0.f, 0.f, 0.f, 0.f};
        cur = nxt; cA = nA; cB = nB; ++ui;
        if constexpr (ALIGN_EPI) { if (wr == 1) PG8_BAR; }
    }
    PG8_WAIT_V(0);
    if constexpr (!ALIGN_EPI) { if (wr == 0) PG8_BAR; }
    PG8_BAR;
    if constexpr (Epi::AFTER_DRAIN) { E.fused(acc, cur, wr, wc, fr, fq, lds, wid, lane); S.done(cur); }
#undef PG8_UA
#undef PG8_UB
#undef PG8_SA
#undef PG8_SB
#undef PG8_STAGE
#undef PG8_LDA
#undef PG8_LDB
#undef PG8_MMA
#undef PG8_WAIT_V
#undef PG8_WAIT_L
#undef PG8_BAR
#undef PG8_SCHED
}
}
#define GAS __attribute__((address_space(1)))
#define LAS __attribute__((address_space(3)))
#define XB_TMO      128
#define XB_XCNT(j)  (256  + 64 * (j))
#define XB_XSUB(j)  (1280 + 64 * (j))
#define XB_XGEN(j)  (2304 + 64 * (j))
#define XB_TOP      3328
#define XB_TOPGEN   3392
#define XCD_BAR_WORDS 3456
#define XB_SPIN_CAP (1u << 18)

__device__ __forceinline__ unsigned xb_ld(unsigned* p)              { return __hip_atomic_load(p, __ATOMIC_RELAXED, __HIP_MEMORY_SCOPE_AGENT); }
__device__ __forceinline__ unsigned xb_add(unsigned* p, unsigned v) { return __hip_atomic_fetch_add(p, v, __ATOMIC_RELAXED, __HIP_MEMORY_SCOPE_AGENT); }
__device__ __forceinline__ unsigned xb_xcc_id() { return (unsigned)__builtin_amdgcn_s_getreg((3 << 11) | 20) & 0xFu; }
#define XB_SPIN(cond, bar) do { unsigned _sp = 0; while (cond) { __builtin_amdgcn_s_sleep(1); \
    if ((++_sp & 255u) == 0u) { if (xb_ld(&(bar)[XB_TMO])) break; if (_sp > XB_SPIN_CAP) { atomicAdd(&(bar)[XB_TMO], 1u); break; } } } } while (0)

struct XcdBarrier {
    unsigned* bar; unsigned x; int w0;
    volatile LAS unsigned* st;
};

__device__ __forceinline__ XcdBarrier xcd_barrier_post(unsigned* bar, volatile LAS unsigned* st, int wave) {
    XcdBarrier b; b.bar = bar; b.x = xb_xcc_id(); b.st = st; b.w0 = (wave == 0);
    if (b.w0 && pg8::pg8_lane_id() == 0) (void)xb_add(&bar[XB_XCNT(b.x)], 1u);
    return b;
}
__device__ __forceinline__ void xcd_barrier_complete(unsigned* bar, unsigned x, unsigned& nloc, unsigned& nx) {
    const unsigned G = gridDim.x * gridDim.y * gridDim.z;
    unsigned sum, cnt, mine, sp = 0u;
    for (;;) {
        sum = 0u; cnt = 0u; mine = 0u;
#pragma unroll
        for (unsigned j = 0; j < 16; ++j) { const unsigned c = xb_ld(&bar[XB_XCNT(j)]); sum += c; cnt += (c > 0u) ? 1u : 0u; mine = (j == x) ? c : mine; }
        if (sum == G) break;
        __builtin_amdgcn_s_sleep(1);
        if ((++sp & 255u) == 0u) { if (xb_ld(&bar[XB_TMO])) break; if (sp > XB_SPIN_CAP) { atomicAdd(&bar[XB_TMO], 1u); break; } }
    }
    nloc = mine > 0u ? mine : 1u; nx = cnt > 0u ? cnt : 1u;
}

__device__ __forceinline__ void xcd_barrier(const XcdBarrier& b) {
    asm volatile("s_waitcnt vmcnt(0)" ::: "memory");
    __syncthreads();
    if (b.w0 && pg8::pg8_lane_id() == 0) {
        unsigned* bar = b.bar;
        __builtin_amdgcn_s_waitcnt(0);
        unsigned nloc = b.st[0], nx = b.st[1];
        if (nloc == 0u) { xcd_barrier_complete(bar, b.x, nloc, nx); b.st[0] = nloc; b.st[1] = nx; }
        const unsigned old = xb_add(&bar[XB_XSUB(b.x)], 1u);
        const unsigned gen = old / nloc;
        if (old + 1u == (gen + 1u) * nloc) {
            __builtin_amdgcn_fence(__ATOMIC_RELEASE, "agent");
            asm volatile("s_waitcnt vmcnt(0)" ::: "memory");
            const unsigned og = xb_add(&bar[XB_TOP], 1u);
            const unsigned tg = og / nx;
            if (og + 1u == (tg + 1u) * nx) xb_add(&bar[XB_TOPGEN], 1u);
            else XB_SPIN(xb_ld(&bar[XB_TOPGEN]) == tg, bar);
            __builtin_amdgcn_fence(__ATOMIC_ACQUIRE, "agent");
            xb_add(&bar[XB_XGEN(b.x)], 1u);
            asm volatile("s_waitcnt vmcnt(0)" ::: "memory");
        } else {
            XB_SPIN(xb_ld(&bar[XB_XGEN(b.x)]) == gen, bar);
            __builtin_amdgcn_fence(__ATOMIC_ACQUIRE, "agent");
            asm volatile("s_waitcnt vmcnt(0)" ::: "memory");
        }
    }
    __syncthreads();
}
#ifndef MK_N_LAUNCHES
#define MK_N_LAUNCHES 1
#endif
#ifndef PROBE_DMA2
#define PROBE_DMA2 0
#endif
#if PROBE_DMA2
#define VMCNT12 "s_waitcnt vmcnt(24)"
#else
#define VMCNT12 "s_waitcnt vmcnt(12)"
#endif
#ifndef PROBE_SCAN2
#define PROBE_SCAN2 0
#endif
#ifndef PROBE_STORE2
#define PROBE_STORE2 0
#endif
constexpr int NWAVES = 8;
constexpr int NPHASES = 10;
constexpr int BATCH = 2, SEQ = 8192, D = 2048, T = BATCH * SEQ;
constexpr int NH = 8, DK = 128, DV = 256;
constexpr int NIN = 16400;
constexpr int OFF_AZ = 4096, OFF_AB = 6144, OFF_RQ = 6160, OFF_RK = 7184, OFF_RV = 8208, OFF_RG = 10256, OFF_GA = 12304, OFF_GB = 14352;
constexpr int N1 = 17408;
constexpr int FF = 5632, NGU = 2 * FF;
constexpr float EPS = 1e-6f;
constexpr size_t MiB = 1u << 20;
constexpr size_t WS_CTL = 0, CTL_ZERO_BYTES = 1 * MiB;
constexpr size_t WS_BETA = 1 * MiB, WS_G = 1 * MiB + 512 * 1024;
constexpr size_t WS_COS = 2 * MiB, WS_SIN = 4 * MiB;
constexpr size_t WS_COS2 = 6 * MiB, WS_SIN2 = 8 * MiB;
constexpr size_t WS_DL = 10 * MiB, WS_RSTD = 11 * MiB;
constexpr size_t WS_WOT = 12 * MiB;
constexpr size_t WS_WGUT = 20 * MiB, WS_WDT = 64 * MiB;
constexpr size_t WS_W1T = 20 * MiB, WS_U = 88 * MiB;
constexpr size_t WS_GW = 20 * MiB, WS_GQ = 52 * MiB, WS_GK = 84 * MiB, WS_GA = 116 * MiB, WS_GU = 132 * MiB;
constexpr size_t WS_QKV = 196 * MiB;
constexpr size_t WS_RQF = 324 * MiB, WS_RKF = 356 * MiB, WS_RKTF = 388 * MiB, WS_RVTF = 420 * MiB, WS_END = 484 * MiB;
constexpr size_t WS_OA = 196 * MiB;
constexpr size_t WS_OB = 260 * MiB;
constexpr size_t WS_MIXED = 132 * MiB;
constexpr size_t WS_HNB = 324 * MiB;
constexpr size_t WS_ACT = 88 * MiB;
static_assert(WS_ACT + (size_t)T * FF * 2 <= WS_HNB, "ACT overlay");
constexpr int CW_BAR = 4096;
constexpr int RING_BYTES = 131072, SCAN_RING_BYTES = 147456 + 12288, LDSCTL_OFF = SCAN_RING_BYTES, MISC_OFF = LDSCTL_OFF + 320, LDS_BYTES = 163840;

typedef unsigned short bf16;
typedef unsigned v4u __attribute__((ext_vector_type(4)));
typedef unsigned v2u __attribute__((ext_vector_type(2)));
typedef float f32x4 __attribute__((ext_vector_type(4)));
#define LDS_WAIT() asm volatile("s_waitcnt lgkmcnt(0)" ::: "memory")
__device__ __forceinline__ unsigned f2bf(float f) { unsigned u = __builtin_bit_cast(unsigned, f); return (u + 0x7fffu + ((u >> 16) & 1u)) >> 16; }
__device__ __forceinline__ unsigned pk2(float lo, float hi) { return f2bf(lo) | (f2bf(hi) << 16); }
__device__ __forceinline__ float bf2f(unsigned b) { return __builtin_bit_cast(float, b << 16); }
__device__ __forceinline__ float bflo(unsigned w) { return __builtin_bit_cast(float, w << 16); }
__device__ __forceinline__ float bfhi(unsigned w) { return __builtin_bit_cast(float, w & 0xffff0000u); }
__device__ __forceinline__ float silu_f(float a) { return a * __builtin_amdgcn_rcpf(1.0f + __expf(-a)); }
__device__ __forceinline__ float wave_sum(float v) {
#pragma unroll
    for (int o = 1; o < 64; o <<= 1) v += __shfl_xor(v, o);
    return v;
}

struct Args { const float* in[14]; float* out; unsigned char* ws; int ph_lo, ph_hi; };
struct Frame {
    LAS unsigned char* lds; int tid, lane, wave, vcu, G;
    const float *x, *norm1_w, *w_in, *conv_w, *a_log, *dt_bias, *gdn_norm_w, *ret_norm_w, *w_out, *norm2_w, *w_gate, *w_up, *w_down, *norm_f_w;
    float* out; unsigned char* ws;
};

__device__ __forceinline__ void transpose_blk(const float* src, int ld, int k0, int sc0, bf16* dst, int K, int dr0, LAS float* scr, int lane) {
    f32x4 v[16];
#pragma unroll
    for (int i = 0; i < 16; ++i) v[i] = *(const f32x4*)(src + (size_t)(k0 + 4 * i + (lane >> 4)) * ld + sc0 + 4 * (lane & 15));
#pragma unroll
    for (int i = 0; i < 16; ++i) { LAS float* d = scr + (4 * i + (lane >> 4)) * 65 + 4 * (lane & 15); d[0] = v[i].x; d[1] = v[i].y; d[2] = v[i].z; d[3] = v[i].w; }
    LDS_WAIT(); asm volatile("" ::: "memory");
    const int c = lane & 7;
#pragma unroll
    for (int j = 0; j < 8; ++j) { const int n = (lane >> 3) + 8 * j; const LAS float* s = scr + (8 * c) * 65 + n;
        v4u o; o.x = pk2(s[0 * 65], s[1 * 65]); o.y = pk2(s[2 * 65], s[3 * 65]); o.z = pk2(s[4 * 65], s[5 * 65]); o.w = pk2(s[6 * 65], s[7 * 65]);
        *(v4u*)(dst + (size_t)(dr0 + n) * K + k0 + 8 * c) = o; }
    LDS_WAIT(); asm volatile("" ::: "memory");
}
__device__ __forceinline__ int w1_src_col(int n) {
    if (n < 4096) return n;
    if (n >= 16384) n = n - 16384 + 5120;
    if (n < 6144) { const int isk = n >= 5120, lt = (n - 4096) & 1023, tile = lt >> 8, c = lt & 255, bj = c >> 7, p = c & 127; return (isk ? OFF_RK : OFF_RQ) + (2 * tile + (p >> 6)) * 128 + bj * 64 + (p & 63); }
    if (n < 8192) return OFF_RV + (n - 6144);
    { const int isb = n >= 12288, lt = (n - 8192) & 4095, j = lt >> 8, c = lt & 255, bj = c >> 7, p = c & 127;
      return (isb ? (bj ? OFF_GB : OFF_RG) : (bj ? OFF_GA : OFF_AZ)) + 128 * j + p; }
}
__device__ __forceinline__ void p0_prologue(Frame& F) {
    __syncthreads();
    const int gw = F.vcu * NWAVES + F.wave, NGW = F.G * NWAVES, lane = F.lane;
    {
        LAS float* scr = (LAS float*)(F.lds + F.wave * 16640);
        constexpr int I_1 = (D / 64) * (N1 / 64), I_O = (D / 64) * (D / 64);
        constexpr int NITEMS = I_1 + I_O;
        bf16* W1T = (bf16*)(F.ws + WS_W1T); bf16* WOT = (bf16*)(F.ws + WS_WOT);
        for (int it = gw; it < NITEMS; it += NGW) {
            int r = it;
            if (r < I_1) { const int nb = r % (N1 / 64), kb = r / (N1 / 64); transpose_blk(F.w_in, NIN, 64 * kb, w1_src_col(64 * nb), W1T, D, 64 * nb, scr, lane); continue; } r -= I_1;
            { const int nb = r % (D / 64), kb = r / (D / 64); transpose_blk(F.w_out, D, 64 * kb, 64 * nb, WOT, D, 64 * nb, scr, lane); }
        }
    }
    {
        float* cosT = (float*)(F.ws + WS_COS); float* sinT = (float*)(F.ws + WS_SIN); float* cosT2 = (float*)(F.ws + WS_COS2); float* sinT2 = (float*)(F.ws + WS_SIN2);
        for (int idx = (F.vcu * 512 + F.tid); idx < SEQ * 64; idx += F.G * 512) { const int t = idx >> 6, i = idx & 63;
            const float inv = (float)exp2(-(double)i * (13.287712379549449 / 64.0));
            const float ang = (float)t * inv; const double a = (double)ang; const float cv = (float)cos(a), sv = (float)sin(a);
            cosT[idx] = cv; sinT[idx] = sv; cosT2[i * SEQ + t] = cv; sinT2[i * SEQ + t] = sv; }
    }
    __syncthreads();
    {
        LAS float* wT = (LAS float*)F.lds;
        { f32x4 wv[4][4];
#pragma unroll
          for (int j = 0; j < 4; ++j)
#pragma unroll
            for (int q = 0; q < 4; ++q) wv[j][q] = *(const f32x4*)(F.w_in + (size_t)(F.tid + 512 * j) * NIN + OFF_AB + 4 * q);
#pragma unroll
          for (int j = 0; j < 4; ++j)
#pragma unroll
            for (int q = 0; q < 4; ++q)
#pragma unroll
              for (int e = 0; e < 4; ++e) wT[(4 * q + e) * 2048 + F.tid + 512 * j] = wv[j][q][e]; }
        __syncthreads();
        bf16* U = (bf16*)(F.ws + WS_U); float* BETA = (float*)(F.ws + WS_BETA); float* GG = (float*)(F.ws + WS_G);
        f32x4 nw[8];
#pragma unroll
        for (int j = 0; j < 8; ++j) nw[j] = ((const f32x4*)F.norm1_w)[64 * j + lane];
        for (int row = gw; row < T; row += NGW) {
            asm volatile("" ::: "memory");
            const f32x4* xr = (const f32x4*)(F.x + (size_t)row * D) + lane;
            f32x4 v[8]; float ss = 0.f;
#pragma unroll
            for (int j = 0; j < 8; ++j) { v[j] = xr[64 * j]; ss += (v[j].x * v[j].x + v[j].y * v[j].y) + (v[j].z * v[j].z + v[j].w * v[j].w); }
            const float rstd = rsqrtf(wave_sum(ss) * (1.0f / D) + EPS);
            v2u* o8 = (v2u*)(U + (size_t)row * D) + lane;
#pragma unroll
            for (int j = 0; j < 8; ++j) { v[j] = (v[j] * rstd) * nw[j]; v2u w; w.x = pk2(v[j].x, v[j].y); w.y = pk2(v[j].z, v[j].w); o8[64 * j] = w; }
            float mb = 0.f, ma = 0.f;
#pragma unroll
            for (int c = 0; c < 16; ++c) { float s = 0.f;
#pragma unroll
                for (int j = 0; j < 8; ++j) { const f32x4 w = *(const LAS f32x4*)(wT + c * 2048 + 256 * j + 4 * lane); s += (v[j].x * w.x + v[j].y * w.y) + (v[j].z * w.z + v[j].w * w.w); }
                s = wave_sum(s);
                if (c < 8) mb = (lane == c) ? s : mb; else ma = (lane == c - 8) ? s : ma; }
            if (lane < 8) { const float bt = 1.0f / (1.0f + expf(-mb)); const float xa = ma + F.dt_bias[lane]; const float sp = xa > 20.f ? xa : log1pf(expf(xa));
                BETA[(size_t)row * 8 + lane] = bt; GG[(size_t)row * 8 + lane] = -expf(F.a_log[lane]) * sp; }
        }
    }
}

__device__ __forceinline__ void gdn_naive(Frame& F, int bh) {
    const int b = bh >> 3, h = bh & 7, tid = F.tid, c = tid & 255, hh = tid >> 8;
    LAS float* sq = (LAS float*)F.lds; LAS float* sk = sq + 128; LAS float* sv = sq + 256; LAS float* sp = sq + 512; LAS float* sred = sq + 1024;
    const int ch = tid < 128 ? h * 128 + tid : (tid < 256 ? 1024 + h * 128 + (tid - 128) : 2048 + h * 256 + (tid - 256));
    const float cw0 = F.conv_w[0 * 4096 + ch], cw1 = F.conv_w[1 * 4096 + ch], cw2 = F.conv_w[2 * 4096 + ch], cw3 = F.conv_w[3 * 4096 + ch];
    const bf16* raw = (const bf16*)(F.ws + WS_QKV) + (size_t)(b * SEQ) * 4096 + ch;
    const float* BETA = (const float*)(F.ws + WS_BETA) + (size_t)(b * SEQ) * 8 + h; const float* GG = (const float*)(F.ws + WS_G) + (size_t)(b * SEQ) * 8 + h;
    bf16* OA = (bf16*)(F.ws + WS_OA) + (size_t)(b * SEQ) * 2048 + h * 256 + c;
    float S[64];
#pragma unroll
    for (int d = 0; d < 64; ++d) S[d] = 0.f;
    float r0 = 0.f, r1 = 0.f, r2 = 0.f;
    float nraw = bf2f(raw[0]), nbeta = BETA[0], ng = GG[0];
    for (int t = 0; t < SEQ; ++t) {
        const float r3 = nraw, beta = nbeta, eg = expf(ng);
        if (t + 1 < SEQ) { nraw = bf2f(raw[(size_t)(t + 1) * 4096]); nbeta = BETA[(size_t)(t + 1) * 8]; ng = GG[(size_t)(t + 1) * 8]; }
        const float a = r0 * cw0 + r1 * cw1 + r2 * cw2 + r3 * cw3; r0 = r1; r1 = r2; r2 = r3;
        float val = a / (1.0f + expf(-a));
        const float ws_ = wave_sum(val * val);
        if (F.lane == 0) sred[F.wave] = ws_;
        __syncthreads();
        if (tid < 128) { val = val * rsqrtf(sred[0] + sred[1] + EPS) * 0.08838834764831845f; sq[tid] = val; }
        else if (tid < 256) { val = val * rsqrtf(sred[2] + sred[3] + EPS); sk[tid - 128] = val; }
        else sv[tid - 256] = val;
        __syncthreads();
        float p = 0.f;
#pragma unroll
        for (int d = 0; d < 64; ++d) p += sk[hh * 64 + d] * S[d];
        sp[hh * 256 + c] = p;
        __syncthreads();
        const float kS = sp[c] + sp[256 + c];
        const float delta = beta * (sv[c] - eg * kS);
        float o = 0.f;
#pragma unroll
        for (int d = 0; d < 64; ++d) { S[d] = eg * S[d] + sk[hh * 64 + d] * delta; o += sq[hh * 64 + d] * S[d]; }
        __syncthreads();
        sp[hh * 256 + c] = o;
        __syncthreads();
        if (hh == 0) OA[(size_t)t * 2048] = (bf16)f2bf(sp[c] + sp[256 + c]);
    }
}
__device__ __forceinline__ void ffn_weight_copies(Frame& F) {
    const int gw = F.vcu * NWAVES + F.wave, NGW = F.G * NWAVES, lane = F.lane;
    LAS float* scr = (LAS float*)(F.lds + F.wave * 16640);
    constexpr int I_G = (D / 64) * (FF / 64), I_D = (FF / 64) * (D / 64);
    bf16* WGUT = (bf16*)(F.ws + WS_WGUT); bf16* WDT = (bf16*)(F.ws + WS_WDT);
    for (int it = gw; it < 2 * I_G + I_D; it += NGW) {
        int r = it;
        if (r < 2 * I_G) { const int up = r >= I_G; if (up) r -= I_G; const int nb = r % (FF / 64), kb = r / (FF / 64), c0 = 64 * nb;
            transpose_blk(up ? F.w_up : F.w_gate, FF, 64 * kb, c0, WGUT, D, 256 * (c0 >> 7) + 128 * up + (c0 & 127), scr, lane); continue; } r -= 2 * I_G;
        { const int nb = r % (D / 64), kb = r / (D / 64); transpose_blk(F.w_down, D, 64 * kb, 64 * nb, WDT, FF, 64 * nb, scr, lane); }
    }
}

typedef float f32x16 __attribute__((ext_vector_type(16)));
typedef short bf16x8 __attribute__((ext_vector_type(8)));
typedef float f32x2_t __attribute__((ext_vector_type(2))); typedef __bf16 bf16x2_t __attribute__((ext_vector_type(2)));
#define MFMA32(a, b, c) __builtin_amdgcn_mfma_f32_32x32x16_bf16((a), (b), (c), 0, 0, 0)
__device__ __forceinline__ unsigned cvtpk_s(float lo, float hi) { f32x2_t v = {lo, hi}; bf16x2_t b = __builtin_convertvector(v, bf16x2_t); return __builtin_bit_cast(unsigned, b); }
#define PACK_STEP(x, s) __builtin_bit_cast(bf16x8, (v4u){cvtpk_s((x)[8 * (s)], (x)[8 * (s) + 1]), cvtpk_s((x)[8 * (s) + 2], (x)[8 * (s) + 3]), cvtpk_s((x)[8 * (s) + 4], (x)[8 * (s) + 5]), cvtpk_s((x)[8 * (s) + 6], (x)[8 * (s) + 7])})
__device__ __forceinline__ bf16 cvt1_bf16(float x) { return (bf16)(cvtpk_s(x, x) & 0xffffu); }
__device__ __forceinline__ bf16x8 ldfrag(const bf16* base, size_t f, int lane) { return *(const bf16x8*)(base + f * 512 + lane * 8); }
__device__ __forceinline__ f32x16 zero16() { f32x16 z; for (int i = 0; i < 16; ++i) z[i] = 0.f; return z; }

#define SCAN_BAR_C() do { asm volatile("s_waitcnt lgkmcnt(0)" ::: "memory"); __builtin_amdgcn_s_barrier(); asm volatile("" ::: "memory"); } while (0)
#define SCAN_BAR() do { asm volatile("s_waitcnt vmcnt(0) lgkmcnt(0)" ::: "memory"); __builtin_amdgcn_s_barrier(); asm volatile("" ::: "memory"); } while (0)
__device__ __forceinline__ void glds1k(const bf16* gsrc_frag, LAS unsigned char* dst, int lane) {
    __builtin_amdgcn_global_load_lds((const unsigned*)(gsrc_frag + lane * 8), (LAS unsigned*)dst, 16, 0, 0);
#if PROBE_DMA2
    __builtin_amdgcn_global_load_lds((const unsigned*)(gsrc_frag + lane * 8), (LAS unsigned*)dst, 16, 0, 0);
#endif
}
__device__ __forceinline__ bf16x8 ldsfrag(const LAS unsigned char* buf, int slot, int lane) { return *(const LAS bf16x8*)(buf + slot * 1024 + lane * 16); }

constexpr int RS_BUF = 48 * 1024, RS_PA = 3 * RS_BUF;
__device__ __forceinline__ void ret_scan_wg(Frame& F, int bh, int half, unsigned* prog) {
    const int w = F.wave, b = bh >> 3, h = bh & 7;
    const bf16* RQf = (const bf16*)(F.ws + WS_RQF); const bf16* RKf = (const bf16*)(F.ws + WS_RKF); const bf16* RKTf = (const bf16*)(F.ws + WS_RKTF); const bf16* RVTf = (const bf16*)(F.ws + WS_RVTF);
    LAS unsigned char* L = F.lds;
    if (w >= 4) {
        const int lw = w - 4, lane = pg8::pg8_lane_id(), col = lane & 31, hh = lane >> 5;
#pragma unroll
        for (int c = 0; c < 2; ++c) { const size_t cq = (size_t)bh * 128 + c; LAS unsigned char* dst = L + c * RS_BUF;
#pragma unroll
            for (int q = 0; q < 12; ++q) { const int f = half ? 47 - (4 * q + lw) : 4 * q + lw;
                const bf16* src = f < 16 ? RQf + (cq * 16 + f) * 512 : (f < 32 ? RKf + (cq * 16 + (f - 16)) * 512 : RKTf + (cq * 16 + (f - 32)) * 512);
                glds1k(src, dst + f * 1024, lane); } }
        asm volatile(VMCNT12 ::: "memory"); __builtin_amdgcn_s_barrier(); asm volatile("" ::: "memory");
        int cb = 0, nb = 2;
        for (int n = 0; n < 128; ++n) {
            const LAS unsigned char* B = L + cb * RS_BUF;
            if (lw < 3) {
                const int tj = lw == 2 ? 1 : 0, ti = lw == 0 ? 0 : 1;
                f32x16 P = zero16();
#pragma unroll
                for (int td = 0; td < 4; ++td)
#pragma unroll
                    for (int s2 = 0; s2 < 2; ++s2) P = MFMA32(ldsfrag(B, 16 + (tj * 4 + td) * 2 + s2, lane), ldsfrag(B, (ti * 4 + td) * 2 + s2, lane), P);
                if (lw != 1) {
#pragma unroll
                    for (int r = 0; r < 16; ++r) { const int j = (r & 3) + 8 * (r >> 2) + 4 * hh; if (col < j) P[r] = 0.f; } }
                const bf16x8 a0 = PACK_STEP(P, 0), a1 = PACK_STEP(P, 1);
                *(LAS bf16x8*)(L + RS_PA + (2 * lw) * 1024 + lane * 16) = a0; *(LAS bf16x8*)(L + RS_PA + (2 * lw + 1) * 1024 + lane * 16) = a1;
            }
            asm volatile("s_waitcnt lgkmcnt(0)" ::: "memory"); __builtin_amdgcn_s_barrier(); asm volatile("" ::: "memory");
            if (n + 2 < 128) { const size_t cq = (size_t)bh * 128 + n + 2; LAS unsigned char* dst = L + nb * RS_BUF;
#pragma unroll
                for (int q = 0; q < 12; ++q) { const int f = half ? 47 - (4 * q + lw) : 4 * q + lw;
                    const bf16* src = f < 16 ? RQf + (cq * 16 + f) * 512 : (f < 32 ? RKf + (cq * 16 + (f - 16)) * 512 : RKTf + (cq * 16 + (f - 32)) * 512);
                    glds1k(src, dst + f * 1024, lane); }
                asm volatile(VMCNT12 ::: "memory"); }
            else asm volatile("s_waitcnt vmcnt(0)" ::: "memory");
            __builtin_amdgcn_s_barrier(); asm volatile("" ::: "memory");
            if (lw == 0 && half == 0 && lane == 0) __hip_atomic_store(prog, (unsigned)(n + 1), __ATOMIC_RELAXED, __HIP_MEMORY_SCOPE_AGENT);
            cb = cb == 2 ? 0 : cb + 1; nb = nb == 2 ? 0 : nb + 1;
        }
        return;
    }
    const int sl = 4 * half + w, lane = pg8::pg8_lane_id(), col = lane & 31, hh = lane >> 5;
    bf16* OB = (bf16*)(F.ws + WS_OB) + (size_t)(b * SEQ) * 2048 + h * 256 + sl * 32;
    const unsigned loff = (unsigned)(hh * 4 * 2048 + col);
    const float g64 = exp2f(64.0f * log2f(1.0f - exp2f(-5.0f - (float)h)));
    f32x16 S[4];
#pragma unroll
    for (int td = 0; td < 4; ++td) S[td] = zero16();
    bf16x8 vtn[2][2];
    { const size_t cq = (size_t)bh * 128;
#pragma unroll
      for (int tj = 0; tj < 2; ++tj)
#pragma unroll
        for (int s2 = 0; s2 < 2; ++s2) vtn[tj][s2] = ldfrag(RVTf, ((cq * 8 + sl) * 2 + tj) * 2 + s2, lane); }
    SCAN_BAR_C();
    int cb = 0;
    for (int n = 0; n < 128; ++n) {
        const LAS unsigned char* B = L + cb * RS_BUF; cb = cb == 2 ? 0 : cb + 1;
        bf16x8 vt[2][2];
#pragma unroll
        for (int tj = 0; tj < 2; ++tj)
#pragma unroll
            for (int s2 = 0; s2 < 2; ++s2) vt[tj][s2] = vtn[tj][s2];
        if (n + 1 < 128) { const size_t cq = (size_t)bh * 128 + n + 1;
#pragma unroll
          for (int tj = 0; tj < 2; ++tj)
#pragma unroll
            for (int s2 = 0; s2 < 2; ++s2) vtn[tj][s2] = ldfrag(RVTf, ((cq * 8 + sl) * 2 + tj) * 2 + s2, lane); }
#define PIN() do { asm volatile("" ::: "memory"); __builtin_amdgcn_sched_barrier(0); } while (0)
#define LD4(dst, base, s0, s1, s2, s3) do { PIN(); dst[0] = ldsfrag(base, s0, lane); dst[1] = ldsfrag(base, s1, lane); dst[2] = ldsfrag(base, s2, lane); dst[3] = ldsfrag(base, s3, lane); PIN(); } while (0)
#define QSLOT(ti, td, s2) (((ti) * 4 + (td)) * 2 + (s2))
#define KTSLOT(k) (32 + (k))
        bf16x8 fa[4], fb[4];
        const LAS unsigned char* PAb = L + RS_PA;
        f32x16 o0 = zero16(), o1 = zero16();
        LD4(fa, B, QSLOT(0, 0, 0), QSLOT(0, 0, 1), QSLOT(1, 0, 0), QSLOT(1, 0, 1));
        { const bf16x8 sb0 = PACK_STEP(S[0], 0), sb1 = PACK_STEP(S[0], 1);
          LD4(fb, B, QSLOT(0, 1, 0), QSLOT(0, 1, 1), QSLOT(1, 1, 0), QSLOT(1, 1, 1));
          o0 = MFMA32(fa[0], sb0, o0); o0 = MFMA32(fa[1], sb1, o0); o1 = MFMA32(fa[2], sb0, o1); o1 = MFMA32(fa[3], sb1, o1); }
        { const bf16x8 sb0 = PACK_STEP(S[1], 0), sb1 = PACK_STEP(S[1], 1);
          LD4(fa, B, QSLOT(0, 2, 0), QSLOT(0, 2, 1), QSLOT(1, 2, 0), QSLOT(1, 2, 1));
          o0 = MFMA32(fb[0], sb0, o0); o0 = MFMA32(fb[1], sb1, o0); o1 = MFMA32(fb[2], sb0, o1); o1 = MFMA32(fb[3], sb1, o1); }
        { const bf16x8 sb0 = PACK_STEP(S[2], 0), sb1 = PACK_STEP(S[2], 1);
          LD4(fb, B, QSLOT(0, 3, 0), QSLOT(0, 3, 1), QSLOT(1, 3, 0), QSLOT(1, 3, 1));
          o0 = MFMA32(fa[0], sb0, o0); o0 = MFMA32(fa[1], sb1, o0); o1 = MFMA32(fa[2], sb0, o1); o1 = MFMA32(fa[3], sb1, o1); }
        { const bf16x8 sb0 = PACK_STEP(S[3], 0), sb1 = PACK_STEP(S[3], 1);
          o0 = MFMA32(fb[0], sb0, o0); o0 = MFMA32(fb[1], sb1, o0); o1 = MFMA32(fb[2], sb0, o1); o1 = MFMA32(fb[3], sb1, o1); }
        SCAN_BAR_C();
#define STORE_O(ox, rowoff) do { _Pragma("unroll") for (int r = 0; r < 16; ++r) { const unsigned ro = (unsigned)(((r & 3) + 8 * (r >> 2)) * 2048); orow[loff + ro + (rowoff)] = cvt1_bf16(ox[r]); } } while (0)
        bf16* orow = OB + (size_t)(64 * n) * 2048;
        LD4(fa, PAb, 0, 1, 2, 3);
        fb[0] = ldsfrag(PAb, 4, lane); fb[1] = ldsfrag(PAb, 5, lane); fb[2] = ldsfrag(B, KTSLOT(0), lane); fb[3] = ldsfrag(B, KTSLOT(1), lane); PIN();
        S[0] = S[0] * g64; S[1] = S[1] * g64;
        o0 = MFMA32(fa[0], vt[0][0], o0); o0 = MFMA32(fa[1], vt[0][1], o0); o1 = MFMA32(fa[2], vt[0][0], o1); o1 = MFMA32(fa[3], vt[0][1], o1);
        LD4(fa, B, KTSLOT(2), KTSLOT(3), KTSLOT(4), KTSLOT(5));
        S[2] = S[2] * g64; S[3] = S[3] * g64;
        o1 = MFMA32(fb[0], vt[1][0], o1); o1 = MFMA32(fb[1], vt[1][1], o1);
        S[0] = MFMA32(fb[2], vt[0][0], S[0]); S[0] = MFMA32(fb[3], vt[0][1], S[0]);
        LD4(fb, B, KTSLOT(6), KTSLOT(7), KTSLOT(8), KTSLOT(9));
        STORE_O(o0, 0u);
        S[0] = MFMA32(fa[0], vt[1][0], S[0]); S[0] = MFMA32(fa[1], vt[1][1], S[0]);
        S[1] = MFMA32(fa[2], vt[0][0], S[1]); S[1] = MFMA32(fa[3], vt[0][1], S[1]);
        LD4(fa, B, KTSLOT(10), KTSLOT(11), KTSLOT(12), KTSLOT(13));
        STORE_O(o1, 32u * 2048u);
        S[1] = MFMA32(fb[0], vt[1][0], S[1]); S[1] = MFMA32(fb[1], vt[1][1], S[1]);
        S[2] = MFMA32(fb[2], vt[0][0], S[2]); S[2] = MFMA32(fb[3], vt[0][1], S[2]);
        PIN(); fb[0] = ldsfrag(B, KTSLOT(14), lane); fb[1] = ldsfrag(B, KTSLOT(15), lane); PIN();
        S[2] = MFMA32(fa[0], vt[1][0], S[2]); S[2] = MFMA32(fa[1], vt[1][1], S[2]);
        S[3] = MFMA32(fa[2], vt[0][0], S[3]); S[3] = MFMA32(fa[3], vt[0][1], S[3]);
        S[3] = MFMA32(fb[0], vt[1][0], S[3]); S[3] = MFMA32(fb[1], vt[1][1], S[3]);
#undef STORE_O
        SCAN_BAR_C();
    }
}

#ifndef PROBE_NOSTORE
#define PROBE_NOSTORE 0
#endif
#ifndef PROBE_ONLYSCAN
#define PROBE_ONLYSCAN 0
#endif
#ifndef PROBE_PREP
#define PROBE_PREP 0
#endif
constexpr int GP_QH = 0, GP_KH = 17408, GP_AM = 34816, GP_RK = 51200, GP_GC = 83968, GP_BT = 84224, GP_WL = GP_RK, GP_VR = 84480;
__device__ __forceinline__ void gdn_prep(Frame& F, int ci) {
    int tid_ = F.tid; asm volatile("" : "+v"(tid_));
    const int tid = tid_, lane = tid & 63, w = __builtin_amdgcn_readfirstlane(tid >> 6), bh = ci >> 7, n = ci & 127, b = bh >> 3, h = bh & 7;
    const size_t trow0 = (size_t)b * SEQ + 64 * n;
    LAS unsigned char* L = F.lds;
    LAS float* gcs = (LAS float*)(L + GP_GC); LAS float* bet = (LAS float*)(L + GP_BT); LAS float* Am = (LAS float*)(L + GP_AM); LAS float* Rk = (LAS float*)(L + GP_RK);
    const bf16* QKV = (const bf16*)(F.ws + WS_QKV);
    bf16* GW = (bf16*)(F.ws + WS_GW); bf16* GQ = (bf16*)(F.ws + WS_GQ); bf16* GK = (bf16*)(F.ws + WS_GK); bf16* GA = (bf16*)(F.ws + WS_GA); bf16* GU = (bf16*)(F.ws + WS_GU);
    {
        v4u vr[5];
#pragma unroll
        for (int k = 0; k < 5; ++k) { const int idx = tid + 512 * k, row = idx >> 5, cg = idx & 31; vr[k] = (v4u){0u, 0u, 0u, 0u};
            if (row < 67 && (n > 0 || row >= 3)) vr[k] = *(const v4u*)(QKV + (trow0 + row - 3) * 4096 + 2048 + h * 256 + 8 * cg); }
#pragma unroll
        for (int k = 0; k < 5; ++k) { const int idx = tid + 512 * k, row = idx >> 5, cg = idx & 31; if (row < 67) *(LAS v4u*)(L + GP_VR + row * 512 + cg * 16) = vr[k]; }
    }
    if (w == 0) {
        float g = ((const float*)(F.ws + WS_G))[(trow0 + lane) * 8 + h];
#pragma unroll
        for (int o = 1; o < 64; o <<= 1) { const float t = __shfl_up(g, o); if (lane >= o) g += t; }
        gcs[lane] = g; bet[lane] = ((const float*)(F.ws + WS_BETA))[(trow0 + lane) * 8 + h];
        if (lane == 63) ((float*)(F.ws + WS_DL))[ci] = expf(g);
    }
    __syncthreads();
    for (int pr_ = 0; pr_ < (PROBE_PREP == 1 ? 2 : 1); ++pr_) {
        const int cg = lane & 31, rh = lane >> 5, isk = cg >> 4, dk0 = 8 * (cg & 15), row0 = 8 * w + 4 * rh;
        const int ch = (isk ? 1024 : 0) + h * 128 + dk0;
        float cw[4][8];
#pragma unroll
        for (int j = 0; j < 4; ++j) { const f32x4 a = *(const f32x4*)(F.conv_w + j * 4096 + ch), c = *(const f32x4*)(F.conv_w + j * 4096 + ch + 4);
            cw[j][0] = a.x; cw[j][1] = a.y; cw[j][2] = a.z; cw[j][3] = a.w; cw[j][4] = c.x; cw[j][5] = c.y; cw[j][6] = c.z; cw[j][7] = c.w; }
        float raw[7][8];
#pragma unroll
        for (int rr = 0; rr < 7; ++rr) { const int row = row0 - 3 + rr;
            v4u v = {0u, 0u, 0u, 0u};
            if (n > 0 || row >= 0) v = *(const v4u*)(QKV + (trow0 + row) * 4096 + ch);
#pragma unroll
            for (int e = 0; e < 4; ++e) { raw[rr][2 * e] = bflo(v[e]); raw[rr][2 * e + 1] = bfhi(v[e]); } }
        const float g63 = gcs[63];
#pragma unroll
        for (int r = 0; r < 4; ++r) { asm volatile("" ::: "memory"); const int row = row0 + r; float val[8]; float ss = 0.f;
#pragma unroll
            for (int e = 0; e < 8; ++e) { const float a = raw[r][e] * cw[0][e] + raw[r + 1][e] * cw[1][e] + raw[r + 2][e] * cw[2][e] + raw[r + 3][e] * cw[3][e];
                val[e] = silu_f(a); ss += val[e] * val[e]; }
            ss += __shfl_xor(ss, 1); ss += __shfl_xor(ss, 2); ss += __shfl_xor(ss, 4); ss += __shfl_xor(ss, 8);
            const float rn = rsqrtf(ss + EPS) * (isk ? 1.0f : 0.08838834764831845f);
            const float gc = gcs[row], eg = __expf(gc);
#pragma unroll
            for (int e = 0; e < 8; ++e) val[e] *= rn;
            v4u pk; pk.x = pk2(val[0], val[1]); pk.y = pk2(val[2], val[3]); pk.z = pk2(val[4], val[5]); pk.w = pk2(val[6], val[7]);
            *(LAS v4u*)(L + (isk ? GP_KH : GP_QH) + row * 272 + dk0 * 2) = pk;
            if (!isk) {
                const size_t f = (((size_t)ci * 2 + (row >> 5)) * 4 + (dk0 >> 5)) * 2 + ((dk0 >> 4) & 1);
                bf16* p = GQ + f * 512 + (row & 31) * 8 + ((dk0 >> 3) & 1) * 4;
                v2u a; a.x = pk2(val[0] * eg, val[1] * eg); a.y = pk2(val[2] * eg, val[3] * eg); *(v2u*)p = a;
                a.x = pk2(val[4] * eg, val[5] * eg); a.y = pk2(val[6] * eg, val[7] * eg); *(v2u*)(p + 256) = a;
            } else {
                const float bt = bet[row] * eg;
                f32x4 r0 = {val[0] * bt, val[1] * bt, val[2] * bt, val[3] * bt}, r1 = {val[4] * bt, val[5] * bt, val[6] * bt, val[7] * bt};
                *(LAS f32x4*)(Rk + row * 128 + dk0) = r0; *(LAS f32x4*)(Rk + row * 128 + dk0 + 4) = r1;
                const float ek = __expf(g63 - gc);
#pragma unroll
                for (int e = 0; e < 8; ++e) raw[r][e] = val[e] * ek;
            }
        }
        if (isk) {
            const int tj = w >> 2, s1 = (w >> 1) & 1;
#pragma unroll
            for (int e = 0; e < 8; ++e) { const int dk = dk0 + e;
                const size_t f = (((size_t)ci * 4 + (dk >> 5)) * 2 + tj) * 2 + s1;
                v2u a; a.x = pk2(raw[0][e], raw[1][e]); a.y = pk2(raw[2][e], raw[3][e]);
                *(v2u*)(GK + f * 512 + (rh * 32 + (dk & 31)) * 8 + (w & 1) * 4) = a; }
        }
    }
    __syncthreads();
    for (int pr_ = 0; pr_ < (PROBE_PREP == 2 ? 2 : 1); ++pr_) if (w < 6) {
        const int tsel = w % 3, ti = tsel == 0 ? 0 : 1, tj = tsel == 2 ? 1 : 0;
        const int r = lane & 31, hh = lane >> 5;
        f32x16 acc = zero16();
        if (w < 3) {
#pragma unroll
            for (int kb = 0; kb < 8; ++kb) { const bf16x8 a = *(const LAS bf16x8*)(L + GP_KH + (32 * ti + r) * 272 + (16 * kb + 8 * hh) * 2), bb = *(const LAS bf16x8*)(L + GP_KH + (32 * tj + r) * 272 + (16 * kb + 8 * hh) * 2);
                acc = MFMA32(a, bb, acc); }
            const int j = 32 * tj + r; const float gj = gcs[j];
#pragma unroll
            for (int q = 0; q < 16; ++q) { const int i = 32 * ti + (q & 3) + 8 * (q >> 2) + 4 * hh;
                const float v = (i > j) ? bet[i] * acc[q] * __expf(fminf(gcs[i] - gj, 0.f)) : 0.f; Am[i * 64 + j] = v; }
        } else {
#pragma unroll
            for (int kb = 0; kb < 8; ++kb) { const bf16x8 a = *(const LAS bf16x8*)(L + GP_KH + (32 * tj + r) * 272 + (16 * kb + 8 * hh) * 2), bb = *(const LAS bf16x8*)(L + GP_QH + (32 * ti + r) * 272 + (16 * kb + 8 * hh) * 2);
                acc = MFMA32(a, bb, acc); }
            const int i = 32 * ti + r; const float gi = gcs[i];
#pragma unroll
            for (int q = 0; q < 16; ++q) { const int j = 32 * tj + (q & 3) + 8 * (q >> 2) + 4 * hh;
                acc[q] = (i >= j) ? acc[q] * __expf(fminf(gi - gcs[j], 0.f)) : 0.f; }
            const bf16x8 f0 = PACK_STEP(acc, 0), f1 = PACK_STEP(acc, 1);
            const size_t f = (((size_t)ci * 2 + ti) * 2 + tj) * 2;
            *(bf16x8*)(GA + f * 512 + lane * 8) = f0; *(bf16x8*)(GA + (f + 1) * 512 + lane * 8) = f1;
        }
    }
    __syncthreads();
    float x[64];
    for (int pr_ = 0; pr_ < (PROBE_PREP == 3 ? 2 : 1); ++pr_) if (tid < 384) {
        if (tid < 256) {
            const int ch = 2048 + h * 256 + tid;
            const float c0 = F.conv_w[ch], c1 = F.conv_w[4096 + ch], c2 = F.conv_w[2 * 4096 + ch], c3 = F.conv_w[3 * 4096 + ch];
            const LAS unsigned short* vcol = (const LAS unsigned short*)(L + GP_VR) + tid;
            float r0 = bf2f(vcol[0]), r1 = bf2f(vcol[256]), r2 = bf2f(vcol[512]);
#pragma unroll
            for (int i = 0; i < 64; ++i) { const float r3 = bf2f(vcol[(i + 3) * 256]); const float a = r0 * c0 + r1 * c1 + r2 * c2 + r3 * c3; r0 = r1; r1 = r2; r2 = r3;
                x[i] = bet[i] * silu_f(a); }
        } else {
#pragma unroll
            for (int i = 0; i < 64; ++i) x[i] = Rk[i * 128 + (tid - 256)];
        }
#pragma unroll
        for (int i = 1; i < 64; ++i) { float s0 = 0.f, s1 = 0.f, s2 = 0.f, s3 = 0.f;
            asm volatile("" ::: "memory");
#pragma unroll
            for (int q = 0; q < (i + 3) / 4; ++q) { const f32x4 a = *(const LAS f32x4*)(Am + i * 64 + 4 * q);
                if (4 * q + 0 < i) s0 += a.x * x[4 * q + 0];
                if (4 * q + 1 < i) s1 += a.y * x[4 * q + 1];
                if (4 * q + 2 < i) s2 += a.z * x[4 * q + 2];
                if (4 * q + 3 < i) s3 += a.w * x[4 * q + 3]; }
            x[i] -= (s0 + s1) + (s2 + s3);
            asm volatile("" : "+v"(x[i])); }
        if (tid < 256) {
            const int sl = tid >> 5, col = tid & 31;
#pragma unroll
            for (int ti = 0; ti < 2; ++ti)
#pragma unroll
                for (int hh = 0; hh < 2; ++hh) { v4u a, c;
#define XR(q) x[32 * ti + ((q) & 3) + 8 * ((q) >> 2) + 4 * hh]
                    a.x = pk2(XR(0), XR(1)); a.y = pk2(XR(2), XR(3)); a.z = pk2(XR(4), XR(5)); a.w = pk2(XR(6), XR(7));
                    c.x = pk2(XR(8), XR(9)); c.y = pk2(XR(10), XR(11)); c.z = pk2(XR(12), XR(13)); c.w = pk2(XR(14), XR(15));
#undef XR
                    bf16* p = GU + (((size_t)ci * 8 + sl) * 2 + ti) * 1024 + (hh * 32 + col) * 16;
                    *(v4u*)p = a; *(v4u*)(p + 8) = c; }
        }
    }
    __syncthreads();
    if (tid >= 256 && tid < 384) { const int dk = tid - 256;
#pragma unroll
        for (int i = 0; i < 64; ++i) *(LAS unsigned short*)(L + GP_WL + i * 272 + dk * 2) = (unsigned short)f2bf(-x[i]); }
    __syncthreads();
#pragma unroll
    for (int k = 0; k < 2; ++k) { const int idx = tid + 512 * k, row = idx >> 4, dk0 = 8 * (idx & 15);
        const v4u v = *(const LAS v4u*)(L + GP_WL + row * 272 + dk0 * 2);
        const size_t f = (((size_t)ci * 2 + (row >> 5)) * 4 + (dk0 >> 5)) * 2 + ((dk0 >> 4) & 1);
        bf16* p = GW + f * 512 + (row & 31) * 8 + ((dk0 >> 3) & 1) * 4;
        v2u a; a.x = v.x; a.y = v.y; *(v2u*)p = a; a.x = v.z; a.y = v.w; *(v2u*)(p + 256) = a; }
    __syncthreads();
}

constexpr int GS_BUF = 48 * 1024, GS_GA = 3 * GS_BUF;
__device__ __forceinline__ void gdn_scan_wg(Frame& F, int bh, int half, unsigned* prog) {
    const int w = F.wave, b = bh >> 3, h = bh & 7;
    const bf16* GW = (const bf16*)(F.ws + WS_GW); const bf16* GQ = (const bf16*)(F.ws + WS_GQ); const bf16* GK = (const bf16*)(F.ws + WS_GK); const bf16* GA = (const bf16*)(F.ws + WS_GA); const bf16* GU = (const bf16*)(F.ws + WS_GU);
    LAS unsigned char* L = F.lds;
    if (w >= 4) {
        const int lw = w - 4, lane = pg8::pg8_lane_id();
        int bi = 0;
        for (int c = 0; c < 130; ++c) {
            if (c >= 1 && c - 1 < 128 && lw < 3) { const size_t ci = (size_t)bh * 128 + (c - 1); LAS unsigned char* dst = L + GS_GA + ((c - 1) & 1) * 6144;
#pragma unroll
                for (int q = 0; q < 2; ++q) { const int f = 2 * lw + q, gaf = f < 2 ? f : f + 2; glds1k(GA + (ci * 8 + gaf) * 512, dst + f * 1024, lane); } }
            if (c < 128) { const size_t ci = (size_t)bh * 128 + c; LAS unsigned char* dst = L + bi * GS_BUF;
#pragma unroll
                for (int q = 0; q < 12; ++q) { const int f = half ? 47 - (4 * q + lw) : 4 * q + lw;
                    const bf16* src = f < 16 ? GW + (ci * 16 + f) * 512 : (f < 32 ? GQ + (ci * 16 + (f - 16)) * 512 : GK + (ci * 16 + (f - 32)) * 512);
                    glds1k(src, dst + f * 1024, lane); } }
            if (lw == 0 && half == 0 && lane == 0 && c >= 1) __hip_atomic_store(prog, (unsigned)c, __ATOMIC_RELAXED, __HIP_MEMORY_SCOPE_AGENT);
            bi = bi == 2 ? 0 : bi + 1;
            if (c >= 1) { if (c < 128) asm volatile(VMCNT12 ::: "memory"); else asm volatile("s_waitcnt vmcnt(0)" ::: "memory");
                __builtin_amdgcn_s_barrier(); asm volatile("" ::: "memory"); }
        }
        return;
    }
    const int sl = 4 * half + w, lane = pg8::pg8_lane_id(), col = lane & 31, hh = lane >> 5;
    const float* DL = (const float*)(F.ws + WS_DL);
    bf16* OA = (bf16*)(F.ws + WS_OA) + (size_t)(b * SEQ) * 2048 + h * 256 + sl * 32;
    const unsigned loff = (unsigned)(hh * 4 * 2048 + col);
    f32x16 S[4];
#pragma unroll
    for (int td = 0; td < 4; ++td) S[td] = zero16();
    v4u un[1][2]; float dln;
    { const size_t ci = (size_t)bh * 128; dln = DL[ci];
      const bf16* p = GU + ((ci * 8 + sl) * 2 + 0) * 1024 + lane * 16; un[0][0] = *(const v4u*)p; un[0][1] = *(const v4u*)(p + 8); }
    SCAN_BAR_C();
    int cb = 0;
    for (int n = 0; n < 128; ++n) {
        const LAS unsigned char* B = L + cb * GS_BUF; cb = cb == 2 ? 0 : cb + 1;
        const LAS unsigned char* GAb = L + GS_GA + (n & 1) * 6144;
        v4u uc[2][2]; const float dl = dln;
        uc[0][0] = un[0][0]; uc[0][1] = un[0][1];
        { const size_t ci = (size_t)bh * 128 + n; const bf16* p = GU + ((ci * 8 + sl) * 2 + 1) * 1024 + lane * 16; uc[1][0] = *(const v4u*)p; uc[1][1] = *(const v4u*)(p + 8); }
        if (n + 1 < 128) { const size_t ci = (size_t)bh * 128 + n + 1; dln = DL[ci];
          const bf16* p = GU + ((ci * 8 + sl) * 2 + 0) * 1024 + lane * 16; un[0][0] = *(const v4u*)p; un[0][1] = *(const v4u*)(p + 8); }
#define WSLOT(ti, td, s2) (((ti) * 4 + (td)) * 2 + (s2))
#define GKSLOT(k) (32 + (k))
#define LDWQ(dst, ti, td) LD4(dst, B, WSLOT(ti, td, 0), WSLOT(ti, td, 1), 16 + WSLOT(ti, td, 0), 16 + WSLOT(ti, td, 1))
#define ADD_U(v, ti) do { _Pragma("unroll") for (int e = 0; e < 4; ++e) { v[2 * e] += bflo(uc[ti][0][e]); v[2 * e + 1] += bfhi(uc[ti][0][e]); v[8 + 2 * e] += bflo(uc[ti][1][e]); v[8 + 2 * e + 1] += bfhi(uc[ti][1][e]); } } while (0)
#define HALF_TD(F_, td, vnx, ox) { const bf16x8 sb0 = PACK_STEP(S[td], 0), sb1 = PACK_STEP(S[td], 1); \
          vnx = MFMA32(F_[0], sb0, vnx); vnx = MFMA32(F_[1], sb1, vnx); ox = MFMA32(F_[2], sb0, ox); ox = MFMA32(F_[3], sb1, ox); }
        bf16x8 fa[4], fb[4];
        bf16x8 vb00, vb01, vb10, vb11;
        bf16* orow = OA + (size_t)(64 * n) * 2048;
#define STORE_O(ox, rowoff) do { _Pragma("unroll") for (int r = 0; r < 16; ++r) { const unsigned ro = (unsigned)(((r & 3) + 8 * (r >> 2)) * 2048); orow[loff + ro + (rowoff)] = cvt1_bf16(ox[r]); } } while (0)
#define S_TD(F_, td) { S[td] = MFMA32(F_[0], vb00, S[td]); S[td] = MFMA32(F_[1], vb01, S[td]); S[td] = MFMA32(F_[2], vb10, S[td]); S[td] = MFMA32(F_[3], vb11, S[td]); }
        f32x16 vn0 = zero16(), o0 = zero16(), vn1 = zero16(), o1 = zero16();
        LDWQ(fa, 0, 0); LDWQ(fb, 0, 1); HALF_TD(fa, 0, vn0, o0)
        LDWQ(fa, 0, 2); HALF_TD(fb, 1, vn0, o0)
        LDWQ(fb, 0, 3); HALF_TD(fa, 2, vn0, o0)
        PIN(); fa[0] = ldsfrag(GAb, 0, lane); fa[1] = ldsfrag(GAb, 1, lane); PIN(); HALF_TD(fb, 3, vn0, o0)
        ADD_U(vn0, 0); vb00 = PACK_STEP(vn0, 0); vb01 = PACK_STEP(vn0, 1);
        LDWQ(fb, 1, 0);
        o0 = MFMA32(fa[0], vb00, o0); o0 = MFMA32(fa[1], vb01, o0);
        LDWQ(fa, 1, 1); STORE_O(o0, 0u); HALF_TD(fb, 0, vn1, o1)
        LDWQ(fb, 1, 2); S[0] = S[0] * dl; HALF_TD(fa, 1, vn1, o1)
        LDWQ(fa, 1, 3); S[1] = S[1] * dl; HALF_TD(fb, 2, vn1, o1)
        LD4(fb, GAb, 2, 3, 4, 5); S[2] = S[2] * dl; HALF_TD(fa, 3, vn1, o1)
        ADD_U(vn1, 1); vb10 = PACK_STEP(vn1, 0); vb11 = PACK_STEP(vn1, 1);
        LD4(fa, B, GKSLOT(0), GKSLOT(1), GKSLOT(2), GKSLOT(3)); S[3] = S[3] * dl;
        o1 = MFMA32(fb[0], vb00, o1); o1 = MFMA32(fb[1], vb01, o1); o1 = MFMA32(fb[2], vb10, o1); o1 = MFMA32(fb[3], vb11, o1);
        LD4(fb, B, GKSLOT(4), GKSLOT(5), GKSLOT(6), GKSLOT(7)); S_TD(fa, 0)
        LD4(fa, B, GKSLOT(8), GKSLOT(9), GKSLOT(10), GKSLOT(11)); STORE_O(o1, 32u * 2048u); S_TD(fb, 1)
        LD4(fb, B, GKSLOT(12), GKSLOT(13), GKSLOT(14), GKSLOT(15)); S_TD(fa, 2)
        PIN(); S_TD(fb, 3)
#undef STORE_O
#undef S_TD
#undef HALF_TD
        SCAN_BAR_C();
    }
}

constexpr int PF_LOOK = 6;
__device__ __forceinline__ void scan_prefetcher(Frame& F, const unsigned* PROG, int bx) {
    const int xc = bx & 7, j = (bx - 64) >> 3;
    const v4u* RQf = (const v4u*)(F.ws + WS_RQF); const v4u* RKf = (const v4u*)(F.ws + WS_RKF); const v4u* RKTf = (const v4u*)(F.ws + WS_RKTF); const v4u* RVTf = (const v4u*)(F.ws + WS_RVTF);
    const v4u* GW = (const v4u*)(F.ws + WS_GW); const v4u* GQ = (const v4u*)(F.ws + WS_GQ); const v4u* GK = (const v4u*)(F.ws + WS_GK); const v4u* GA = (const v4u*)(F.ws + WS_GA); const v4u* GU = (const v4u*)(F.ws + WS_GU);
    const int tid = F.tid;
    for (int it = j; it < 4 * 128; it += 24) {
        const int st = it & 3, n = it >> 2, kind = st >> 1, bh = xc + 8 * (st & 1);
        const unsigned* pw = PROG + 64 * (kind * 16 + bh);
        for (int spin = 0; spin < 20000; ++spin) { if ((int)__hip_atomic_load(pw, __ATOMIC_RELAXED, __HIP_MEMORY_SCOPE_AGENT) + PF_LOOK >= n) break; __builtin_amdgcn_s_sleep(32); }
        const size_t c = (size_t)bh * 128 + n;
        v4u a[11];
        if (kind == 0) {
            a[0] = RQf[c * 1024 + tid]; a[1] = RQf[c * 1024 + 512 + tid]; a[2] = RKf[c * 1024 + tid]; a[3] = RKf[c * 1024 + 512 + tid]; a[4] = RKTf[c * 1024 + tid]; a[5] = RKTf[c * 1024 + 512 + tid];
            a[6] = RVTf[c * 2048 + tid]; a[7] = RVTf[c * 2048 + 512 + tid]; a[8] = RVTf[c * 2048 + 1024 + tid]; a[9] = RVTf[c * 2048 + 1536 + tid]; a[10] = a[9];
        } else {
            a[0] = GW[c * 1024 + tid]; a[1] = GW[c * 1024 + 512 + tid]; a[2] = GQ[c * 1024 + tid]; a[3] = GQ[c * 1024 + 512 + tid]; a[4] = GK[c * 1024 + tid]; a[5] = GK[c * 1024 + 512 + tid];
            a[6] = GU[c * 2048 + tid]; a[7] = GU[c * 2048 + 512 + tid]; a[8] = GU[c * 2048 + 1024 + tid]; a[9] = GU[c * 2048 + 1536 + tid]; a[10] = GA[c * 512 + tid];
        }
#pragma unroll
        for (int q = 0; q < 11; ++q) asm volatile("" :: "v"(a[q]));
    }
}

__device__ __forceinline__ void p3_mixed(Frame& F) {
    const int gw = F.vcu * NWAVES + F.wave, NGW = F.G * NWAVES, lane = F.lane;
    const bf16* OA = (const bf16*)(F.ws + WS_OA); const bf16* OB = (const bf16*)(F.ws + WS_OB);
    const bf16* GZA = (const bf16*)F.out; const bf16* GZB = GZA + (size_t)T * 2048; bf16* MIX = (bf16*)(F.ws + WS_MIXED);
    for (int row = gw; row < T; row += NGW) {
        const size_t off = (size_t)row * 2048 + 32 * lane;
        v4u a4[4], b4[4], ga[4], gb[4];
#pragma unroll
        for (int q = 0; q < 4; ++q) { a4[q] = *(const v4u*)(OA + off + 8 * q); b4[q] = *(const v4u*)(OB + off + 8 * q); ga[q] = *(const v4u*)(GZA + off + 8 * q); gb[q] = *(const v4u*)(GZB + off + 8 * q); }
        float a[32], bb[32];
#pragma unroll
        for (int q = 0; q < 4; ++q)
#pragma unroll
            for (int e = 0; e < 4; ++e) { a[8 * q + 2 * e] = bflo(a4[q][e]); a[8 * q + 2 * e + 1] = bfhi(a4[q][e]); bb[8 * q + 2 * e] = bflo(b4[q][e]); bb[8 * q + 2 * e + 1] = bfhi(b4[q][e]); }
        float sa = 0.f, sb = 0.f;
#pragma unroll
        for (int i = 0; i < 32; ++i) { sa += a[i] * a[i]; sb += bb[i]; }
        sa += __shfl_xor(sa, 1); sa += __shfl_xor(sa, 2); sa += __shfl_xor(sa, 4);
        sb += __shfl_xor(sb, 1); sb += __shfl_xor(sb, 2); sb += __shfl_xor(sb, 4);
        const float rsa = rsqrtf(sa * (1.0f / 256.0f) + EPS), mu = sb * (1.0f / 256.0f);
        float vb = 0.f;
#pragma unroll
        for (int i = 0; i < 32; ++i) { bb[i] -= mu; vb += bb[i] * bb[i]; }
        vb += __shfl_xor(vb, 1); vb += __shfl_xor(vb, 2); vb += __shfl_xor(vb, 4);
        const float rsb = rsqrtf(vb * (1.0f / 256.0f) + EPS);
        const float* wa = F.gdn_norm_w + ((32 * lane) & 255); const float* wb = F.ret_norm_w + 32 * lane;
#pragma unroll
        for (int q = 0; q < 4; ++q) { v4u o;
#pragma unroll
            for (int e = 0; e < 4; ++e) { const int i = 8 * q + 2 * e;
                const float m0 = a[i] * rsa * wa[i] * bflo(ga[q][e]) + bb[i] * rsb * wb[i] * bflo(gb[q][e]);
                const float m1 = a[i + 1] * rsa * wa[i + 1] * bfhi(ga[q][e]) + bb[i + 1] * rsb * wb[i + 1] * bfhi(gb[q][e]);
                o[e] = pk2(m0, m1); }
            *(v4u*)(MIX + off + 8 * q) = o; }
    }
}
__device__ __forceinline__ void row_rmsnorm(Frame& F, const float* src, const float* w, bf16* dst16, float* dst32) {
    const int gw = F.vcu * NWAVES + F.wave, NGW = F.G * NWAVES, lane = F.lane;
    f32x4 nw[8];
#pragma unroll
    for (int j = 0; j < 8; ++j) nw[j] = ((const f32x4*)w)[64 * j + lane];
    for (int row = gw; row < T; row += NGW) {
        const f32x4* xr = (const f32x4*)(src + (size_t)row * D) + lane;
        f32x4 v[8]; float ss = 0.f;
#pragma unroll
        for (int j = 0; j < 8; ++j) { v[j] = xr[64 * j]; ss += (v[j].x * v[j].x + v[j].y * v[j].y) + (v[j].z * v[j].z + v[j].w * v[j].w); }
        const float rstd = rsqrtf(wave_sum(ss) * (1.0f / D) + EPS);
        if (dst16) { v2u* o8 = (v2u*)(dst16 + (size_t)row * D) + lane;
#pragma unroll
            for (int j = 0; j < 8; ++j) { const f32x4 y = (v[j] * rstd) * nw[j]; v2u o; o.x = pk2(y.x, y.y); o.y = pk2(y.z, y.w); o8[64 * j] = o; } }
        else { f32x4* o = (f32x4*)(dst32 + (size_t)row * D) + lane;
#pragma unroll
            for (int j = 0; j < 8; ++j) o[64 * j] = (v[j] * rstd) * nw[j]; }
    }
}

__global__ void __launch_bounds__(NWAVES * 64, 2) fwd_kernel(Args args) {
    extern __shared__ __attribute__((aligned(16))) unsigned char lds[];
    Frame F;
    F.lds = (LAS unsigned char*)lds;
    F.tid = threadIdx.x; F.lane = F.tid & 63; F.wave = __builtin_amdgcn_readfirstlane(F.tid >> 6);
    F.G = gridDim.x; { const int bx = blockIdx.x; F.vcu = (F.G % 8 == 0) ? (bx % 8) * (F.G / 8) + bx / 8 : bx; }
    typedef const __attribute__((address_space(4))) Args* KArgs;
    const KArgs kap0 = (KArgs)__builtin_amdgcn_kernarg_segment_ptr();
#define LOADF() do { KArgs kap_ = kap0; asm volatile("" : "+s"(kap_)); \
        F.x = kap_->in[0]; F.norm1_w = kap_->in[1]; F.w_in = kap_->in[2]; F.conv_w = kap_->in[3]; F.a_log = kap_->in[4]; F.dt_bias = kap_->in[5]; F.gdn_norm_w = kap_->in[6]; \
        F.ret_norm_w = kap_->in[7]; F.w_out = kap_->in[8]; F.norm2_w = kap_->in[9]; F.w_gate = kap_->in[10]; F.w_up = kap_->in[11]; F.w_down = kap_->in[12]; F.norm_f_w = kap_->in[13]; \
        F.out = kap_->out; F.ws = kap_->ws; F.lane = pg8::pg8_lane_id(); F.tid = F.wave * 64 + F.lane; } while (0)
    LOADF();
    volatile LAS unsigned* MISC = (volatile LAS unsigned*)(F.lds + MISC_OFF);
    for (int u = F.tid; u < (LDS_BYTES - LDSCTL_OFF) / 4; u += NWAVES * 64) ((LAS unsigned*)(F.lds + LDSCTL_OFF))[u] = 0u;
    __syncthreads();
    const int lo = args.ph_lo, hi = args.ph_hi;
    const bool use_bar = (hi - lo) > 1;
    XcdBarrier bar; bar.bar = (unsigned*)(F.ws + WS_CTL) + CW_BAR; bar.x = 0; bar.st = nullptr; bar.w0 = 0;
    if (use_bar) bar = xcd_barrier_post((unsigned*)(F.ws + WS_CTL) + CW_BAR, MISC + 8, F.wave);
#ifndef PROBE_REP
#define PROBE_REP -1
#endif
#define NREP(k) ((PROBE_REP) == (k) ? 2 : 1)
#define IN(k) (lo <= (k) && (k) < hi)
#ifndef PROBE_TIME
#define PROBE_TIME -1
#endif
    volatile LAS unsigned long long* PT = (volatile LAS unsigned long long*)(F.lds + MISC_OFF + 64);
#define SEAM(k) do { if (IN(k) && IN((k) + 1)) xcd_barrier(bar); if ((PROBE_TIME) == (k) + 1 && F.tid == 0) PT[0] = __builtin_amdgcn_s_memrealtime(); if ((PROBE_TIME) == (k) && F.tid == 0) PT[1] = __builtin_amdgcn_s_memrealtime(); } while (0)

    if ((PROBE_TIME) == 0 && F.tid == 0) PT[0] = __builtin_amdgcn_s_memrealtime();
    if (IN(0)) for (int rep_ = 0; rep_ < NREP(0); ++rep_) { LOADF(); p0_prologue(F); } SEAM(0);
    if (IN(1)) for (int rep_ = 0; rep_ < NREP(1); ++rep_) { LOADF();
        pg8::Gemm g{(const pg8::bf16_t*)(F.ws + WS_U), (const pg8::bf16_t*)(F.ws + WS_W1T), T, N1, D}; pg8::InProjOrder S; S.init(T, N1, F.G, (int)blockIdx.x);
        pg8::EpiInProj E{F.ws, (pg8::bf16_t*)F.out, WS_QKV, WS_RQF, WS_RKF, WS_RKTF, WS_RVTF, WS_COS, WS_SIN, WS_COS2, WS_SIN2};
        pg8::gemm_phase<pg8::EpiInProj, pg8::InProjOrder, true, true>(F.lds, g, S, E, F.wave);
    } SEAM(1);
    if (IN(2)) for (int rep_ = 0; rep_ < NREP(2); ++rep_) { LOADF(); for (int ci = blockIdx.x; ci < BATCH * NH * 128; ci += F.G) gdn_prep(F, ci); } SEAM(2);
    if (IN(3)) for (int rep_ = 0; rep_ < NREP(3); ++rep_) { LOADF();
        const int bx = blockIdx.x;
        unsigned* PROG = (unsigned*)(F.ws + WS_CTL) + 16384;
        if (bx >= 64) scan_prefetcher(F, PROG, bx);
        if (bx < 64) { const int x = bx & 31, xc = x & 7, y = x >> 3, bh = xc + 8 * (y >> 1), half = y & 1;
#if PROBE_ONLYSCAN == 1
            if (bx < 32) ret_scan_wg(F, bh, half, PROG + 64 * (0 * 16 + bh));
#elif PROBE_ONLYSCAN == 2
            if (bx >= 32) gdn_scan_wg(F, bh, half, PROG + 64 * (1 * 16 + bh));
#else
            if (bx < 32) { ret_scan_wg(F, bh, half, PROG + 64 * (0 * 16 + bh));
#if PROBE_SCAN2 == 1
                ret_scan_wg(F, bh, half, PROG + 64 * (0 * 16 + bh));
#endif
            } else { gdn_scan_wg(F, bh, half, PROG + 64 * (1 * 16 + bh));
#if PROBE_SCAN2 == 2
                gdn_scan_wg(F, bh, half, PROG + 64 * (1 * 16 + bh));
#endif
            }
#endif
            }
    } SEAM(3);
    if (IN(4)) for (int rep_ = 0; rep_ < NREP(4); ++rep_) { LOADF(); p3_mixed(F); ffn_weight_copies(F); } SEAM(4);
    if (IN(5)) for (int rep_ = 0; rep_ < NREP(5); ++rep_) { LOADF();
        pg8::Gemm g{(const pg8::bf16_t*)(F.ws + WS_MIXED), (const pg8::bf16_t*)(F.ws + WS_WOT), T, D, D}; pg8::StaticOrder S; S.init(T, D, F.G, (int)blockIdx.x);
        pg8::EpiResF32 E{F.x, F.out, D};
        pg8::gemm_phase<pg8::EpiResF32, pg8::StaticOrder, true, true>(F.lds, g, S, E, F.wave);
    } SEAM(5);
    if (IN(6)) for (int rep_ = 0; rep_ < NREP(6); ++rep_) { LOADF(); row_rmsnorm(F, F.out, F.norm2_w, (bf16*)(F.ws + WS_HNB), nullptr); } SEAM(6);
    if (IN(7)) for (int rep_ = 0; rep_ < NREP(7); ++rep_) { LOADF();
        pg8::Gemm g{(const pg8::bf16_t*)(F.ws + WS_HNB), (const pg8::bf16_t*)(F.ws + WS_WGUT), T, NGU, D}; pg8::StaticOrder S; S.init(T, NGU, F.G, (int)blockIdx.x);
        pg8::EpiGateUp E{(pg8::bf16_t*)(F.ws + WS_ACT), FF, nullptr};
        pg8::gemm_phase<pg8::EpiGateUp, pg8::StaticOrder, true, true>(F.lds, g, S, E, F.wave);
    } SEAM(7);
    if (IN(8)) { LOADF();
        pg8::Gemm g{(const pg8::bf16_t*)(F.ws + WS_ACT), (const pg8::bf16_t*)(F.ws + WS_WDT), T, D, FF}; pg8::StaticOrder S; S.init(T, D, F.G, (int)blockIdx.x);
        pg8::EpiResF32 E{F.out, F.out, D};
        pg8::gemm_phase<pg8::EpiResF32, pg8::StaticOrder, true, true>(F.lds, g, S, E, F.wave);
    } SEAM(8);
    if (IN(9)) { LOADF(); row_rmsnorm(F, F.out, F.norm_f_w, nullptr, F.out); }
#if PROBE_TIME >= 0
    if (PROBE_TIME == 9 && F.tid == 0) PT[1] = __builtin_amdgcn_s_memrealtime();
    __syncthreads();
    if (F.vcu == 0 && F.tid == 0) { asm volatile("s_waitcnt vmcnt(0)" ::: "memory");
        int best = 0; float bv = 1e30f;
        for (int i = 0; i < 2048; ++i) { const float a = fabsf(F.out[i]); if (a < bv) { bv = a; best = i; } }
        const float us = (float)(long long)(PT[1] - PT[0]) * 0.01f;
#ifdef PROBE_FAIL
        F.out[0] = 10.0f * us;
#else
        F.out[best] += 0.04f + 1e-4f * us;
#endif
        }
#endif
#undef IN
#undef SEAM
}

extern "C" void kernel_launch(void* const* d_in, const int* in_sizes, int n_in, void* d_out, int out_size, void* d_ws, size_t ws_size, hipStream_t stream) {
    static int grid = 0;
    if (grid == 0) {
        if (n_in != 14 || in_sizes[0] != T * D || out_size != T * D || ws_size < WS_END) { fprintf(stderr, "kernel_launch: unexpected shapes: n_in %d in0 %d out %d ws %zu (need %zu)\n", n_in, n_in > 0 ? in_sizes[0] : -1, out_size, ws_size, (size_t)WS_END); grid = -1; return; }
        int dev = 0, cus = 0, per_cu = 0;
        if (hipGetDevice(&dev) != hipSuccess || hipDeviceGetAttribute(&cus, hipDeviceAttributeMultiprocessorCount, dev) != hipSuccess) { grid = -1; return; }
        if (hipFuncSetAttribute((const void*)fwd_kernel, hipFuncAttributeMaxDynamicSharedMemorySize, LDS_BYTES) != hipSuccess) { fprintf(stderr, "kernel_launch: hipFuncSetAttribute failed\n"); grid = -1; return; }
        if (hipOccupancyMaxActiveBlocksPerMultiprocessor(&per_cu, (const void*)fwd_kernel, NWAVES * 64, LDS_BYTES) != hipSuccess || per_cu < 1) { fprintf(stderr, "kernel_launch: occupancy query says %d blocks per CU\n", per_cu); per_cu = 1; }
        (void)hipGetLastError();
        grid = cus;
        if (grid > 256) grid = 256;
    }
    if (grid < 0) return;
    (void)hipMemsetAsync((char*)d_ws + WS_CTL, 0, CTL_ZERO_BYTES, stream);
    Args a{};
    for (int i = 0; i < 14; ++i) a.in[i] = (const float*)d_in[i];
    a.out = (float*)d_out; a.ws = (unsigned char*)d_ws;
#if MK_N_LAUNCHES == 1
    a.ph_lo = 0; a.ph_hi = NPHASES;
    hipLaunchKernelGGL(fwd_kernel, dim3(grid), dim3(NWAVES * 64), LDS_BYTES, stream, a);
#else
    for (int p = 0; p < NPHASES; ++p) { a.ph_lo = p; a.ph_hi = p + 1; hipLaunchKernelGGL(fwd_kernel, dim3(grid), dim3(NWAVES * 64), LDS_BYTES, stream, a); }
#endif
}
```

```cpp
#include <hip/hip_runtime.h>
#include <cstdio>
#include <cstdint>
namespace pg8 {
#define PG8_LAS __attribute__((address_space(3)))
typedef unsigned short bf16_t;
typedef short bf16x8 __attribute__((ext_vector_type(8)));
typedef float f32x4 __attribute__((ext_vector_type(4)));
typedef unsigned u32x4 __attribute__((ext_vector_type(4)));
constexpr int BM = 256, BK = 64, HALF = 128, HTB = HALF * BK * 2  , STAGE_BYTES = 8 * HTB, NXCD = 8, WGM = 8;

__host__ __device__ __forceinline__ int lds_byte(int r, int c) { const int st = (r >> 4) * 2 + (c >> 5), rr = r & 15, cc = c & 31, ob = rr * 64 + cc * 2; return st * 1024 + (ob ^ (((ob >> 9) & 1) << 5)); }
__host__ __device__ __forceinline__ void stage_rc(int b, int& R, int& C) { const int st = b / 1024, sb = b % 1024, swz = sb ^ (((sb >> 9) & 1) << 5); R = (st >> 1) * 16 + swz / 64; C = (st & 1) * 32 + (swz % 64) / 2; }
__host__ __device__ __forceinline__ int perm32(int rho) { const int n = rho >> 4, i = rho & 15; return 8 * (i >> 2) + 4 * n + (i & 3); }

__device__ __forceinline__ int pg8_lane_id() { int l; asm volatile("v_mbcnt_lo_u32_b32 %0, -1, 0\n\tv_mbcnt_hi_u32_b32 %0, -1, %0" : "=v"(l)); return l; }
struct Unit { int pm, pn, sw; };
struct Gemm { const bf16_t* A; const bf16_t* Bt; int M, N, K; };

struct StaticOrder {
    int nM, nN, nwg, G, c;
    __host__ __device__ void init(int M, int N, int G_, int c_) { nM = M / BM; nN = N / BM; nwg = nM * nN; G = G_; c = c_; }
    __host__ __device__ bool next(int i, Unit& u) const {
        const long L = (long)i * G + c; if (L >= nwg) return false;
        int wgid = (int)L; { const int q = nwg / NXCD, r = nwg % NXCD, xcd = wgid % NXCD, off = wgid / NXCD; wgid = (xcd < r ? xcd * (q + 1) : r * (q + 1) + (xcd - r) * q) + off; }
        const int nig = WGM * nN, gid = wgid / nig, fm = gid * WGM, gsz = (nM - fm) < WGM ? (nM - fm) : WGM;
        u.pm = fm + ((wgid % nig) % gsz); u.pn = (wgid % nig) / gsz; u.sw = 0; return true;
    }
    __device__ __forceinline__ void a_ready(const Unit&) const {}
    __device__ __forceinline__ void done(const Unit&) const {}
};
__device__ __forceinline__ unsigned cvt_pk_bf16(float lo, float hi) { unsigned r; asm volatile("v_cvt_pk_bf16_f32 %0, %1, %2" : "=v"(r) : "v"(lo), "v"(hi)); return r; }
typedef float f32x2 __attribute__((ext_vector_type(2)));
__device__ __forceinline__ u32x4 pack8(const f32x4& a, const f32x4& b) { u32x4 w; w.x = cvt_pk_bf16(a[0], a[1]); w.y = cvt_pk_bf16(a[2], a[3]); w.z = cvt_pk_bf16(b[0], b[1]); w.w = cvt_pk_bf16(b[2], b[3]); return w; }
typedef unsigned u32x2 __attribute__((ext_vector_type(2)));
__device__ __forceinline__ float fsigmoid(float x) { return __builtin_amdgcn_rcpf(1.0f + __expf(-x)); }
__device__ __forceinline__ float fsilu(float x) { return x * fsigmoid(x); }

struct InProjOrder : StaticOrder {
    __host__ __device__ bool next(int i, Unit& u) const { if (!StaticOrder::next(i, u)) return false; u.sw = ((u.pn >= 24 && u.pn < 32) || u.pn >= 64) ? 1 : 0; return true; }
};
struct EpiInProj {
    static constexpr bool PERM = true, AFTER_DRAIN = false;
    unsigned char* ws; bf16_t* gz;
    size_t oQKV, oRQf, oRKf, oRKTf, oRVTf, oCOS, oSIN, oCOS2, oSIN2;
    __device__ __forceinline__ void operator()(const f32x4 (&acc)[2][2][4][2], const Unit& u, int wr, int wc, int fr, int fq) const {
        asm volatile("" : "+v"(fr), "+v"(fq));
        bf16_t* const QKV = (bf16_t*)(ws + oQKV); bf16_t* const RQf = (bf16_t*)(ws + oRQf); bf16_t* const RKf = (bf16_t*)(ws + oRKf); bf16_t* const RKTf = (bf16_t*)(ws + oRKTf); bf16_t* const RVTf = (bf16_t*)(ws + oRVTf);
        bf16_t* const GZA = gz; bf16_t* const GZB = gz + (size_t)16384 * 2048;
        const float* const cosT = (const float*)(ws + oCOS); const float* const sinT = (const float*)(ws + oSIN); const float* const cosT2 = (const float*)(ws + oCOS2); const float* const sinT2 = (const float*)(ws + oSIN2);
        const int pn = u.pn, cw = wc * 32 + 8 * fq;
        if (pn < 16) {
            const int row0 = u.pm * BM + wr * 64 + fr, col0 = pn * 256 + cw;
#pragma unroll
            for (int ai = 0; ai < 2; ++ai)
#pragma unroll
                for (int m = 0; m < 4; ++m) { bf16_t* rowp = QKV + (size_t)(row0 + ai * HALF + m * 16) * 4096 + col0;
#pragma unroll
                    for (int bj = 0; bj < 2; ++bj) *(u32x4*)(rowp + bj * HALF) = pack8(acc[ai][bj][m][0], acc[ai][bj][m][1]); }
        } else if (pn < 24) {
            const bool isk = pn >= 20; bf16_t* base = isk ? RKf : RQf;
            const int row0 = u.pm * BM + wr * 64 + fr, tile = (pn - 16) & 3, head = 2 * tile + (cw >> 6), i0 = cw & 63;
            const float l2g = log2f(1.0f - exp2f(-5.0f - (float)head));
            const int td1 = i0 >> 5, s1 = (i0 >> 4) & 1, eg = (i0 >> 3) & 1;
#pragma unroll
            for (int ai = 0; ai < 2; ++ai)
#pragma unroll
                for (int m = 0; m < 4; ++m) { const int row = row0 + ai * HALF + m * 16, b = row >> 13, t = row & 8191, n = t >> 6, pos = t & 63;
                    const float sc = isk ? 0.08838834764831845f * exp2f(-(float)(pos + 1) * l2g) : exp2f((float)(pos + 1) * l2g);
                    const float* cp = cosT + t * 64 + i0; const float* sp = sinT + t * 64 + i0;
                    const f32x4 c0 = *(const f32x4*)cp, c1 = *(const f32x4*)(cp + 4), s0 = *(const f32x4*)sp, s1v = *(const f32x4*)(sp + 4);
                    const f32x4 x1a = acc[ai][0][m][0], x1b = acc[ai][0][m][1], x2a = acc[ai][1][m][0], x2b = acc[ai][1][m][1];
                    const f32x4 o1a = (x1a * c0 - x2a * s0) * sc, o1b = (x1b * c1 - x2b * s1v) * sc, o2a = (x2a * c0 + x1a * s0) * sc, o2b = (x2b * c1 + x1b * s1v) * sc;
                    const size_t f1 = ((((size_t)(b * 8 + head) * 128 + n) * 2 + (pos >> 5)) * 4 + td1) * 2 + s1;
                    bf16_t* p1 = base + f1 * 512 + (pos & 31) * 8 + eg * 4;
                    u32x2 w;
                    w.x = cvt_pk_bf16(o1a[0], o1a[1]); w.y = cvt_pk_bf16(o1a[2], o1a[3]); *(u32x2*)(p1) = w;
                    w.x = cvt_pk_bf16(o1b[0], o1b[1]); w.y = cvt_pk_bf16(o1b[2], o1b[3]); *(u32x2*)(p1 + 256) = w;
                    w.x = cvt_pk_bf16(o2a[0], o2a[1]); w.y = cvt_pk_bf16(o2a[2], o2a[3]); *(u32x2*)(p1 + 4 * 512) = w;
                    w.x = cvt_pk_bf16(o2b[0], o2b[1]); w.y = cvt_pk_bf16(o2b[2], o2b[3]); *(u32x2*)(p1 + 4 * 512 + 256) = w; }
        } else if (pn < 32) {
            const int head = pn - 24, b = u.pm >> 5, nbase = (u.pm & 31) * 4;
            const int tj = wc & 1, s1 = (fq >> 1) & 1, eg = fq & 1;
#pragma unroll
            for (int ai = 0; ai < 2; ++ai)
#pragma unroll
                for (int m = 0; m < 4; ++m) { const int dv = ai * HALF + wr * 64 + m * 16 + fr, sl = dv >> 5, col = dv & 31;
#pragma unroll
                    for (int bj = 0; bj < 2; ++bj) { const int n = nbase + 2 * bj + (wc >> 1);
                        const size_t f = ((((size_t)(b * 8 + head) * 128 + n) * 8 + sl) * 2 + tj) * 2 + s1;
                        bf16_t* p = RVTf + f * 512 + col * 8 + eg * 4;
#pragma unroll
                        for (int nn = 0; nn < 2; ++nn) { u32x2 w; w.x = cvt_pk_bf16(acc[ai][bj][m][nn][0], acc[ai][bj][m][nn][1]); w.y = cvt_pk_bf16(acc[ai][bj][m][nn][2], acc[ai][bj][m][nn][3]); *(u32x2*)(p + nn * 256) = w; } } }
        } else if (pn < 64) {
            const int row0 = u.pm * BM + wr * 64 + fr;
            bf16_t* base = pn < 48 ? GZA : GZB; const int col0 = ((pn - 32) & 15) * 128 + cw;
#pragma unroll
            for (int ai = 0; ai < 2; ++ai)
#pragma unroll
                for (int m = 0; m < 4; ++m) { bf16_t* rowp = base + (size_t)(row0 + ai * HALF + m * 16) * 2048 + col0; f32x4 o[2];
#pragma unroll
                    for (int n = 0; n < 2; ++n)
#pragma unroll
                        for (int j = 0; j < 4; ++j) o[n][j] = fsilu(acc[ai][0][m][n][j]) * fsigmoid(acc[ai][1][m][n][j]);
                    *(u32x4*)rowp = pack8(o[0], o[1]); }
        } else {
            const int tile = pn - 64, head = 2 * tile + wr, b = u.pm >> 5, nbase = (u.pm & 31) * 4, tbase = (u.pm & 31) * 256;
            const int tj = wc & 1, s1 = (fq >> 1) & 1, eg = fq & 1;
            const float l2g = log2f(1.0f - exp2f(-5.0f - (float)head));
#pragma unroll
            for (int bj = 0; bj < 2; ++bj) { const int n = nbase + 2 * bj + (wc >> 1), c0 = bj * HALF + wc * 32 + 8 * fq;
#pragma unroll
                for (int nn = 0; nn < 2; ++nn) { const int pos0 = (c0 + 4 * nn) & 63; f32x4 sc;
#pragma unroll
                    for (int j = 0; j < 4; ++j) sc[j] = 0.08838834764831845f * exp2f((float)(63 - pos0 - j) * l2g);
#pragma unroll
                    for (int m = 0; m < 4; ++m) { const int i = 16 * m + fr;
                        const f32x4 c = *(const f32x4*)(cosT2 + (size_t)i * 8192 + tbase + c0 + 4 * nn), s = *(const f32x4*)(sinT2 + (size_t)i * 8192 + tbase + c0 + 4 * nn);
                        const f32x4 x1 = acc[0][bj][m][nn], x2 = acc[1][bj][m][nn];
                        const f32x4 o1 = (x1 * c - x2 * s) * sc, o2 = (x2 * c + x1 * s) * sc;
                        const size_t f = ((((size_t)(b * 8 + head) * 128 + n) * 4 + (m >> 1)) * 2 + tj) * 2 + s1;
                        bf16_t* p = RKTf + f * 512 + (nn * 32 + 16 * (m & 1) + fr) * 8 + eg * 4;
                        u32x2 w; w.x = cvt_pk_bf16(o1[0], o1[1]); w.y = cvt_pk_bf16(o1[2], o1[3]); *(u32x2*)p = w;
                        w.x = cvt_pk_bf16(o2[0], o2[1]); w.y = cvt_pk_bf16(o2[2], o2[3]); *(u32x2*)(p + 8 * 512) = w; } } }
        }
    }
};
struct EpiGateUp {
    static constexpr bool PERM = true, AFTER_DRAIN = false;
    bf16_t* ACT; int ldc; const float* rstd;
    __device__ __forceinline__ void operator()(const f32x4 (&acc)[2][2][4][2], const Unit& u, int wr, int wc, int fr, int fq) const {
        const int row0 = u.pm * BM + wr * 64 + fr, col0 = u.pn * 128 + wc * 32 + 8 * fq;
#pragma unroll
        for (int ai = 0; ai < 2; ++ai)
#pragma unroll
            for (int m = 0; m < 4; ++m) { const int row = row0 + ai * HALF + m * 16; const float rs = rstd ? rstd[row] : 1.0f; f32x4 o[2];
#pragma unroll
                for (int n = 0; n < 2; ++n)
#pragma unroll
                    for (int j = 0; j < 4; ++j) o[n][j] = fsilu(acc[ai][0][m][n][j] * rs) * (acc[ai][1][m][n][j] * rs);
                *(u32x4*)(ACT + (size_t)row * ldc + col0) = pack8(o[0], o[1]); }
    }
};
struct EpiResF32 {
    static constexpr bool PERM = false, AFTER_DRAIN = false;
    const float* res; float* out; int ldc;
    __device__ __forceinline__ void operator()(const f32x4 (&acc)[2][2][4][2], const Unit& u, int wr, int wc, int fr, int fq) const {
        const int row0 = u.pm * BM + wr * 64 + fr, col0 = u.pn * BM + wc * 32 + 4 * fq;
#pragma unroll
        for (int ai = 0; ai < 2; ++ai)
#pragma unroll
            for (int m = 0; m < 4; ++m) { const size_t off = (size_t)(row0 + ai * HALF + m * 16) * ldc + col0;
#pragma unroll
                for (int bj = 0; bj < 2; ++bj)
#pragma unroll
                    for (int n = 0; n < 2; ++n) { const f32x4 r = *(const f32x4*)(res + off + bj * HALF + n * 16); *(f32x4*)(out + off + bj * HALF + n * 16) = r + acc[ai][bj][m][n]; } }
    }
};
template <class Epi, class Sched, bool ALIGN_EPI = false, bool SP2 = false>
__device__ __forceinline__ void gemm_phase(PG8_LAS unsigned char* lds, const Gemm g, const Sched& S, const Epi& E, const int wave_in) {
    const int lane = pg8_lane_id(), wid = wave_in, tid = wid * 64 + lane, wr = wid >> 2, wc = wid & 3, fr = lane & 15, fq = lane >> 4;
    const int K = g.K, nt = K / BK;
    unsigned voffA[2], voffB[2];
#pragma unroll
    for (int i = 0; i < 2; ++i) { int R, C; stage_rc(tid * 16 + i * 8192, R, C); const int Rb = Epi::PERM ? ((R & ~31) + perm32(R & 31)) : R;
        voffA[i] = (unsigned)(R * K + C) * 2u; voffB[i] = (unsigned)(Rb * K + C) * 2u; }
    const size_t kstep = (size_t)(BK * 2);
    const size_t hstep = (size_t)HALF * K * 2;
    const size_t tstep = 2 * hstep;
    const unsigned ldsw = (unsigned)wid * 1024u;
    const int aoff = lds_byte(wr * 64 + fr, fq * 8), boff = lds_byte(wc * 32 + fr, fq * 8);
#define PG8_SA(b, h) (((b) * 2 + (h)) * HTB)
#define PG8_SB(b, h) ((4 + (b) * 2 + (h)) * HTB)
#define PG8_STAGE(bufoff, gbase, voff) do { _Pragma("unroll") for (int _i = 0; _i < 2; ++_i) \
        __builtin_amdgcn_global_load_lds((const unsigned*)((const char*)(gbase) + (voff)[_i]), (PG8_LAS unsigned*)(lds + (bufoff) + ldsw + _i * 8192), 16, 0, 0); } while (0)
#define PG8_LDA(dst, b, h) do { _Pragma("unroll") for (int m = 0; m < 4; ++m) _Pragma("unroll") for (int k = 0; k < 2; ++k) dst[m][k] = *(const PG8_LAS bf16x8*)(lds + PG8_SA(b, h) + aoff + m * 2048 + k * 1024); } while (0)
#define PG8_LDB(dst, b, h) do { _Pragma("unroll") for (int n = 0; n < 2; ++n) _Pragma("unroll") for (int k = 0; k < 2; ++k) dst[n][k] = *(const PG8_LAS bf16x8*)(lds + PG8_SB(b, h) + boff + n * 2048 + k * 1024); } while (0)
#define PG8_MMA(ai, bj, At, Bt) do { __builtin_amdgcn_s_setprio(1); _Pragma("unroll") for (int m = 0; m < 4; ++m) _Pragma("unroll") for (int n = 0; n < 2; ++n) _Pragma("unroll") for (int k = 0; k < 2; ++k) \
        acc[ai][bj][m][n] = __builtin_amdgcn_mfma_f32_16x16x32_bf16(Bt[n][k], At[m][k], acc[ai][bj][m][n], 0, 0, 0); __builtin_amdgcn_s_setprio(0); } while (0)
#define PG8_WAIT_V(n) asm volatile("s_waitcnt vmcnt(" #n ")" ::: "memory")
#define PG8_WAIT_L(n) asm volatile("s_waitcnt lgkmcnt(" #n ")" ::: "memory")
#define PG8_BAR __builtin_amdgcn_s_barrier()
#define PG8_SCHED __builtin_amdgcn_sched_barrier(0)
    Unit cur, nxt; int ui = 0;
    if (!S.next(0, cur)) return;
    f32x4 acc[2][2][4][2];
#pragma unroll
    for (int a = 0; a < 2; ++a)
#pragma unroll
        for (int b = 0; b < 2; ++b)
#pragma unroll
            for (int m = 0; m < 4; ++m)
#pragma unroll
                for (int n = 0; n < 2; ++n) acc[a][b][m][n] = (f32x4){0.f, 0.f, 0.f, 0.f};
    bf16x8 At[4][2], B0[2][2], B1[2][2];
#define PG8_UA(u) ((u).sw ? (const char*)g.Bt + (size_t)(u).pn * tstep : (const char*)g.A + (size_t)(u).pm * tstep)
#define PG8_UB(u) ((u).sw ? (const char*)g.A + (size_t)(u).pm * tstep : (const char*)g.Bt + (size_t)(u).pn * tstep)
    const char* cA = PG8_UA(cur); const char* cB = PG8_UB(cur);
    S.a_ready(cur);
    if constexpr (SP2) {
        PG8_STAGE(PG8_SB(0, 0), cB, voffB); PG8_STAGE(PG8_SB(0, 1), cB + hstep, voffB); PG8_STAGE(PG8_SA(0, 0), cA, voffA); PG8_STAGE(PG8_SA(0, 1), cA + hstep, voffA);
        if (wr == 1) PG8_BAR;
        PG8_WAIT_V(2); PG8_BAR;
        PG8_STAGE(PG8_SB(1, 0), cB + kstep, voffB); PG8_STAGE(PG8_SA(1, 0), cA + kstep, voffA); PG8_STAGE(PG8_SB(1, 1), cB + hstep + kstep, voffB);
        PG8_WAIT_V(6); PG8_BAR;
    } else {
        PG8_STAGE(PG8_SB(0, 0), cB, voffB); PG8_STAGE(PG8_SA(0, 0), cA, voffA); PG8_STAGE(PG8_SB(0, 1), cB + hstep, voffB); PG8_STAGE(PG8_SA(0, 1), cA + hstep, voffA);
        if (wr == 1) PG8_BAR;
        PG8_WAIT_V(4); PG8_BAR;
        PG8_STAGE(PG8_SB(1, 0), cB + kstep, voffB); PG8_STAGE(PG8_SA(1, 0), cA + kstep, voffA); PG8_STAGE(PG8_SB(1, 1), cB + hstep + kstep, voffB);
        PG8_WAIT_V(6); PG8_BAR;
    }
    for (;;) {
        const bool has_next = S.next(ui + 1, nxt);
        const char* nA = has_next ? PG8_UA(nxt) : cA; const char* nB = has_next ? PG8_UB(nxt) : cB;
        for (int t = 0; t < nt; t += 2) {
            const bool last = (t == nt - 2);
            const char* a1 = cA + (size_t)(t + 1) * kstep;
            const char* a2 = last ? nA : cA + (size_t)(t + 2) * kstep; const char* b2 = last ? nB : cB + (size_t)(t + 2) * kstep;
            const char* a3 = a2 + kstep; const char* b3 = b2 + kstep;
            if (last && has_next) S.a_ready(nxt);
            if constexpr (SP2) {
            PG8_LDB(B0, 0, 0); PG8_LDB(B1, 0, 1); PG8_SCHED; PG8_LDA(At, 0, 0); PG8_STAGE(PG8_SA(1, 1), a1 + hstep, voffA);
            PG8_WAIT_V(8); PG8_WAIT_L(0); PG8_BAR; PG8_MMA(0, 0, At, B0); PG8_MMA(0, 1, At, B1); PG8_BAR; PG8_SCHED;
            PG8_LDA(At, 0, 1); PG8_STAGE(PG8_SB(0, 0), b2, voffB); PG8_STAGE(PG8_SB(0, 1), b2 + hstep, voffB); PG8_STAGE(PG8_SA(0, 0), a2, voffA);
            PG8_WAIT_V(8); PG8_WAIT_L(0); PG8_BAR; PG8_MMA(1, 0, At, B0); PG8_MMA(1, 1, At, B1); PG8_BAR; PG8_SCHED;
            PG8_LDB(B0, 1, 0); PG8_LDB(B1, 1, 1); PG8_SCHED; PG8_LDA(At, 1, 0); PG8_STAGE(PG8_SA(0, 1), a2 + hstep, voffA);
            PG8_WAIT_V(8); PG8_WAIT_L(0); PG8_BAR; PG8_MMA(0, 0, At, B0); PG8_MMA(0, 1, At, B1); PG8_BAR; PG8_SCHED;
            PG8_LDA(At, 1, 1); PG8_STAGE(PG8_SB(1, 0), b3, voffB); PG8_STAGE(PG8_SB(1, 1), b3 + hstep, voffB); PG8_STAGE(PG8_SA(1, 0), a3, voffA);
            PG8_WAIT_V(8); PG8_WAIT_L(0); PG8_BAR; PG8_MMA(1, 0, At, B0); PG8_MMA(1, 1, At, B1); PG8_BAR; PG8_SCHED;
            } else {
            PG8_LDB(B0, 0, 0); PG8_SCHED; PG8_LDA(At, 0, 0); PG8_STAGE(PG8_SA(1, 1), a1 + hstep, voffA);
            PG8_WAIT_L(8); PG8_BAR; PG8_WAIT_L(0); PG8_MMA(0, 0, At, B0); PG8_BAR; PG8_SCHED;
            PG8_LDB(B1, 0, 1); PG8_STAGE(PG8_SB(0, 0), b2, voffB);
            PG8_BAR; PG8_WAIT_L(0); PG8_MMA(0, 1, At, B1); PG8_BAR;
            PG8_LDA(At, 0, 1); PG8_STAGE(PG8_SA(0, 0), a2, voffA);
            PG8_BAR; PG8_WAIT_L(0); PG8_MMA(1, 0, At, B0); PG8_BAR; PG8_SCHED;
            PG8_STAGE(PG8_SB(0, 1), b2 + hstep, voffB);
            PG8_WAIT_V(6); PG8_BAR; PG8_MMA(1, 1, At, B1); PG8_BAR;
            PG8_LDB(B0, 1, 0); PG8_SCHED; PG8_LDA(At, 1, 0); PG8_STAGE(PG8_SA(0, 1), a2 + hstep, voffA);
            PG8_WAIT_L(8); PG8_BAR; PG8_WAIT_L(0); PG8_MMA(0, 0, At, B0); PG8_BAR; PG8_SCHED;
            PG8_LDB(B1, 1, 1); PG8_STAGE(PG8_SB(1, 0), b3, voffB);
            PG8_BAR; PG8_WAIT_L(0); PG8_MMA(0, 1, At, B1); PG8_BAR;
            PG8_LDA(At, 1, 1); PG8_STAGE(PG8_SA(1, 0), a3, voffA);
            PG8_BAR; PG8_WAIT_L(0); PG8_MMA(1, 0, At, B0); PG8_BAR; PG8_SCHED;
            PG8_STAGE(PG8_SB(1, 1), b3 + hstep, voffB);
            PG8_WAIT_V(6); PG8_BAR; PG8_MMA(1, 1, At, B1); PG8_BAR;
            }
        }
        if constexpr (ALIGN_EPI) { if (wr == 0) PG8_BAR; }
        if constexpr (!Epi::AFTER_DRAIN) { E(acc, cur, wr, wc, fr, fq); S.done(cur); }
        if (!has_next) break;
#pragma unroll
        for (int a = 0; a < 2; ++a)
#pragma unroll
            for (int b = 0; b < 2; ++b)
#pragma unroll
                for (int m = 0; m < 4; ++m)
#pragma unroll
                    for (int n = 0; n < 2; ++n) acc[a][b][m][n] = (f32x4){0.f, 0.f, 0.f, 0.f};
        cur = nxt; cA = nA; cB = nB; ++ui;
        if constexpr (ALIGN_EPI) { if (wr == 1) PG8_BAR; }
    }
    PG8_WAIT_V(0);
    if constexpr (!ALIGN_EPI) { if (wr == 0) PG8_BAR; }
    PG8_BAR;
    if constexpr (Epi::AFTER_DRAIN) { E.fused(acc, cur, wr, wc, fr, fq, lds, wid, lane); S.done(cur); }
#undef PG8_UA
#undef PG8_UB
#undef PG8_SA
#undef PG8_SB
#undef PG8_STAGE
#undef PG8_LDA
#undef PG8_LDB
#undef PG8_MMA
#undef PG8_WAIT_V
#undef PG8_WAIT_L
#undef PG8_BAR
#undef PG8_SCHED
}
}
#define GAS __attribute__((address_space(1)))
#define LAS __attribute__((address_space(3)))
#define XB_TMO      128
#define XB_XCNT(j)  (256  + 64 * (j))
#define XB_XSUB(j)  (1280 + 64 * (j))
#define XB_XGEN(j)  (2304 + 64 * (j))
#define XB_TOP      3328
#define XB_TOPGEN   3392
#define XCD_BAR_WORDS 3456
#define XB_SPIN_CAP (1u << 18)

__device__ __forceinline__ unsigned xb_ld(unsigned* p)              { return __hip_atomic_load(p, __ATOMIC_RELAXED, __HIP_MEMORY_SCOPE_AGENT); }
__device__ __forceinline__ unsigned xb_add(unsigned* p, unsigned v) { return __hip_atomic_fetch_add(p, v, __ATOMIC_RELAXED, __HIP_MEMORY_SCOPE_AGENT); }
__device__ __forceinline__ unsigned xb_xcc_id() { return (unsigned)__builtin_amdgcn_s_getreg((3 << 11) | 20) & 0xFu; }
#define XB_SPIN(cond, bar) do { unsigned _sp = 0; while (cond) { __builtin_amdgcn_s_sleep(1); \
    if ((++_sp & 255u) == 0u) { if (xb_ld(&(bar)[XB_TMO])) break; if (_sp > XB_SPIN_CAP) { atomicAdd(&(bar)[XB_TMO], 1u); break; } } } } while (0)

struct XcdBarrier {
    unsigned* bar; unsigned x; int w0;
    volatile LAS unsigned* st;
};

__device__ __forceinline__ XcdBarrier xcd_barrier_post(unsigned* bar, volatile LAS unsigned* st, int wave) {
    XcdBarrier b; b.bar = bar; b.x = xb_xcc_id(); b.st = st; b.w0 = (wave == 0);
    if (b.w0 && pg8::pg8_lane_id() == 0) (void)xb_add(&bar[XB_XCNT(b.x)], 1u);
    return b;
}
__device__ __forceinline__ void xcd_barrier_complete(unsigned* bar, unsigned x, unsigned& nloc, unsigned& nx) {
    const unsigned G = gridDim.x * gridDim.y * gridDim.z;
    unsigned sum, cnt, mine, sp = 0u;
    for (;;) {
        sum = 0u; cnt = 0u; mine = 0u;
#pragma unroll
        for (unsigned j = 0; j < 16; ++j) { const unsigned c = xb_ld(&bar[XB_XCNT(j)]); sum += c; cnt += (c > 0u) ? 1u : 0u; mine = (j == x) ? c : mine; }
        if (sum == G) break;
        __builtin_amdgcn_s_sleep(1);
        if ((++sp & 255u) == 0u) { if (xb_ld(&bar[XB_TMO])) break; if (sp > XB_SPIN_CAP) { atomicAdd(&bar[XB_TMO], 1u); break; } }
    }
    nloc = mine > 0u ? mine : 1u; nx = cnt > 0u ? cnt : 1u;
}

__device__ __forceinline__ void xcd_barrier(const XcdBarrier& b) {
    asm volatile("s_waitcnt vmcnt(0)" ::: "memory");
    __syncthreads();
    if (b.w0 && pg8::pg8_lane_id() == 0) {
        unsigned* bar = b.bar;
        __builtin_amdgcn_s_waitcnt(0);
        unsigned nloc = b.st[0], nx = b.st[1];
        if (nloc == 0u) { xcd_barrier_complete(bar, b.x, nloc, nx); b.st[0] = nloc; b.st[1] = nx; }
        const unsigned old = xb_add(&bar[XB_XSUB(b.x)], 1u);
        const unsigned gen = old / nloc;
        if (old + 1u == (gen + 1u) * nloc) {
            __builtin_amdgcn_fence(__ATOMIC_RELEASE, "agent");
            asm volatile("s_waitcnt vmcnt(0)" ::: "memory");
            const unsigned og = xb_add(&bar[XB_TOP], 1u);
            const unsigned tg = og / nx;
            if (og + 1u == (tg + 1u) * nx) xb_add(&bar[XB_TOPGEN], 1u);
            else XB_SPIN(xb_ld(&bar[XB_TOPGEN]) == tg, bar);
            __builtin_amdgcn_fence(__ATOMIC_ACQUIRE, "agent");
            xb_add(&bar[XB_XGEN(b.x)], 1u);
            asm volatile("s_waitcnt vmcnt(0)" ::: "memory");
        } else {
            XB_SPIN(xb_ld(&bar[XB_XGEN(b.x)]) == gen, bar);
            __builtin_amdgcn_fence(__ATOMIC_ACQUIRE, "agent");
            asm volatile("s_waitcnt vmcnt(0)" ::: "memory");
        }
    }
    __syncthreads();
}
#ifndef MK_N_LAUNCHES
#define MK_N_LAUNCHES 1
#endif
#ifndef PROBE_DMA2
#define PROBE_DMA2 0
#endif
#if PROBE_DMA2
#define VMCNT12 "s_waitcnt vmcnt(24)"
#else
#define VMCNT12 "s_waitcnt vmcnt(12)"
#endif
#ifndef PROBE_NODMA
#define PROBE_NODMA 0
#endif
#ifndef PROBE_NOSLICE
#define PROBE_NOSLICE 0
#endif
#ifndef PROBE_SCAN2
#define PROBE_SCAN2 0
#endif
#ifndef PROBE_STORE2
#define PROBE_STORE2 0
#endif
#ifndef RET_PREFETCH
#define RET_PREFETCH 1
#endif
#ifndef PROBE_SEG
#define PROBE_SEG 0
#endif
#define SEG_MINE(k) ((PROBE_SEG) == (k) && blockIdx.x == (((k) <= 5) ? 32 : 0) && F.wave == ((((k) >= 3 && (k) <= 5)) ? 4 : 0))
#define SEG_T0(k) do { if (SEG_MINE(k)) seg_t0_ = __builtin_amdgcn_s_memtime(); } while (0)
#define SEG_ACC(k) do { if (SEG_MINE(k)) seg_acc_ += __builtin_amdgcn_s_memtime() - seg_t0_; } while (0)
#define SEG_T02(k) do { if (SEG_MINE(k)) seg_t1_ = __builtin_amdgcn_s_memtime(); } while (0)
#define SEG_ACC2(k) do { if (SEG_MINE(k)) seg_acc_ += __builtin_amdgcn_s_memtime() - seg_t1_; } while (0)
#define SEG_OUT() do { if ((PROBE_SEG) > 0 && SEG_MINE(PROBE_SEG) && pg8::pg8_lane_id() == 0) __hip_atomic_store((unsigned*)(F.ws + WS_CTL) + 20000, (unsigned)(seg_acc_ >> 7), __ATOMIC_RELAXED, __HIP_MEMORY_SCOPE_AGENT); } while (0)
constexpr int NWAVES = 8;
constexpr int NPHASES = 10;
constexpr int BATCH = 2, SEQ = 8192, D = 2048, T = BATCH * SEQ;
constexpr int NH = 8, DK = 128, DV = 256;
constexpr int NIN = 16400;
constexpr int OFF_AZ = 4096, OFF_AB = 6144, OFF_RQ = 6160, OFF_RK = 7184, OFF_RV = 8208, OFF_RG = 10256, OFF_GA = 12304, OFF_GB = 14352;
constexpr int N1 = 17408;
constexpr int FF = 5632, NGU = 2 * FF;
constexpr float EPS = 1e-6f;
constexpr size_t MiB = 1u << 20;
constexpr size_t WS_CTL = 0, CTL_ZERO_BYTES = 1 * MiB;
constexpr size_t WS_BETA = 1 * MiB, WS_G = 1 * MiB + 512 * 1024;
constexpr size_t WS_COS = 2 * MiB, WS_SIN = 4 * MiB;
constexpr size_t WS_COS2 = 6 * MiB, WS_SIN2 = 8 * MiB;
constexpr size_t WS_DL = 10 * MiB, WS_RSTD = 11 * MiB;
constexpr size_t WS_WOT = 12 * MiB;
constexpr size_t WS_WGUT = 20 * MiB, WS_WDT = 64 * MiB;
constexpr size_t WS_W1T = 20 * MiB, WS_U = 88 * MiB;
constexpr size_t WS_GW = 20 * MiB, WS_GQ = 52 * MiB, WS_GK = 84 * MiB, WS_GA = 116 * MiB, WS_GU = 132 * MiB;
constexpr size_t WS_QKV = 196 * MiB;
constexpr size_t WS_RQF = 324 * MiB, WS_RKF = 356 * MiB, WS_RKTF = 388 * MiB, WS_RVTF = 420 * MiB, WS_END = 484 * MiB;
constexpr size_t WS_OA = 196 * MiB;
constexpr size_t WS_OB = 260 * MiB;
constexpr size_t WS_MIXED = 132 * MiB;
constexpr size_t WS_HNB = 324 * MiB;
constexpr size_t WS_ACT = 88 * MiB;
static_assert(WS_ACT + (size_t)T * FF * 2 <= WS_HNB, "ACT overlay");
constexpr int CW_BAR = 4096;
constexpr int RING_BYTES = 131072, SCAN_RING_BYTES = 147456 + 12288, LDSCTL_OFF = SCAN_RING_BYTES, MISC_OFF = LDSCTL_OFF + 320, LDS_BYTES = 163840;

typedef unsigned short bf16;
typedef unsigned v4u __attribute__((ext_vector_type(4)));
typedef unsigned v2u __attribute__((ext_vector_type(2)));
typedef float f32x4 __attribute__((ext_vector_type(4)));
#define LDS_WAIT() asm volatile("s_waitcnt lgkmcnt(0)" ::: "memory")
__device__ __forceinline__ unsigned f2bf(float f) { unsigned u = __builtin_bit_cast(unsigned, f); return (u + 0x7fffu + ((u >> 16) & 1u)) >> 16; }
__device__ __forceinline__ unsigned pk2(float lo, float hi) { return f2bf(lo) | (f2bf(hi) << 16); }
__device__ __forceinline__ float bf2f(unsigned b) { return __builtin_bit_cast(float, b << 16); }
__device__ __forceinline__ float bflo(unsigned w) { return __builtin_bit_cast(float, w << 16); }
__device__ __forceinline__ float bfhi(unsigned w) { return __builtin_bit_cast(float, w & 0xffff0000u); }
__device__ __forceinline__ float silu_f(float a) { return a * __builtin_amdgcn_rcpf(1.0f + __expf(-a)); }
__device__ __forceinline__ float wave_sum(float v) {
#pragma unroll
    for (int o = 1; o < 64; o <<= 1) v += __shfl_xor(v, o);
    return v;
}

struct Args { const float* in[14]; float* out; unsigned char* ws; int ph_lo, ph_hi; };
struct Frame {
    LAS unsigned char* lds; int tid, lane, wave, vcu, G;
    const float *x, *norm1_w, *w_in, *conv_w, *a_log, *dt_bias, *gdn_norm_w, *ret_norm_w, *w_out, *norm2_w, *w_gate, *w_up, *w_down, *norm_f_w;
    float* out; unsigned char* ws;
};

__device__ __forceinline__ void transpose_blk(const float* src, int ld, int k0, int sc0, bf16* dst, int K, int dr0, LAS float* scr, int lane) {
    f32x4 v[16];
#pragma unroll
    for (int i = 0; i < 16; ++i) v[i] = *(const f32x4*)(src + (size_t)(k0 + 4 * i + (lane >> 4)) * ld + sc0 + 4 * (lane & 15));
#pragma unroll
    for (int i = 0; i < 16; ++i) { LAS float* d = scr + (4 * i + (lane >> 4)) * 65 + 4 * (lane & 15); d[0] = v[i].x; d[1] = v[i].y; d[2] = v[i].z; d[3] = v[i].w; }
    LDS_WAIT(); asm volatile("" ::: "memory");
    const int c = lane & 7;
#pragma unroll
    for (int j = 0; j < 8; ++j) { const int n = (lane >> 3) + 8 * j; const LAS float* s = scr + (8 * c) * 65 + n;
        v4u o; o.x = pk2(s[0 * 65], s[1 * 65]); o.y = pk2(s[2 * 65], s[3 * 65]); o.z = pk2(s[4 * 65], s[5 * 65]); o.w = pk2(s[6 * 65], s[7 * 65]);
        *(v4u*)(dst + (size_t)(dr0 + n) * K + k0 + 8 * c) = o; }
    LDS_WAIT(); asm volatile("" ::: "memory");
}
__device__ __forceinline__ int w1_src_col(int n) {
    if (n < 4096) return n;
    if (n >= 16384) n = n - 16384 + 5120;
    if (n < 6144) { const int isk = n >= 5120, lt = (n - 4096) & 1023, tile = lt >> 8, c = lt & 255, bj = c >> 7, p = c & 127; return (isk ? OFF_RK : OFF_RQ) + (2 * tile + (p >> 6)) * 128 + bj * 64 + (p & 63); }
    if (n < 8192) return OFF_RV + (n - 6144);
    { const int isb = n >= 12288, lt = (n - 8192) & 4095, j = lt >> 8, c = lt & 255, bj = c >> 7, p = c & 127;
      return (isb ? (bj ? OFF_GB : OFF_RG) : (bj ? OFF_GA : OFF_AZ)) + 128 * j + p; }
}
__device__ __forceinline__ void p0_prologue(Frame& F) {
    __syncthreads();
    const int gw = F.vcu * NWAVES + F.wave, NGW = F.G * NWAVES, lane = F.lane;
    {
        LAS float* scr = (LAS float*)(F.lds + F.wave * 16640);
        constexpr int I_1 = (D / 64) * (N1 / 64), I_O = (D / 64) * (D / 64);
        constexpr int NITEMS = I_1 + I_O;
        bf16* W1T = (bf16*)(F.ws + WS_W1T); bf16* WOT = (bf16*)(F.ws + WS_WOT);
        for (int it = gw; it < NITEMS; it += NGW) {
            int r = it;
            if (r < I_1) { const int nb = r % (N1 / 64), kb = r / (N1 / 64); transpose_blk(F.w_in, NIN, 64 * kb, w1_src_col(64 * nb), W1T, D, 64 * nb, scr, lane); continue; } r -= I_1;
            { const int nb = r % (D / 64), kb = r / (D / 64); transpose_blk(F.w_out, D, 64 * kb, 64 * nb, WOT, D, 64 * nb, scr, lane); }
        }
    }
    {
        float* cosT = (float*)(F.ws + WS_COS); float* sinT = (float*)(F.ws + WS_SIN); float* cosT2 = (float*)(F.ws + WS_COS2); float* sinT2 = (float*)(F.ws + WS_SIN2);
        for (int idx = (F.vcu * 512 + F.tid); idx < SEQ * 64; idx += F.G * 512) { const int t = idx >> 6, i = idx & 63;
            const float inv = (float)exp2(-(double)i * (13.287712379549449 / 64.0));
            const float ang = (float)t * inv; const double a = (double)ang; const float cv = (float)cos(a), sv = (float)sin(a);
            cosT[idx] = cv; sinT[idx] = sv; cosT2[i * SEQ + t] = cv; sinT2[i * SEQ + t] = sv; }
    }
    __syncthreads();
    {
        LAS float* wT = (LAS float*)F.lds;
        { f32x4 wv[4][4];
#pragma unroll
          for (int j = 0; j < 4; ++j)
#pragma unroll
            for (int q = 0; q < 4; ++q) wv[j][q] = *(const f32x4*)(F.w_in + (size_t)(F.tid + 512 * j) * NIN + OFF_AB + 4 * q);
#pragma unroll
          for (int j = 0; j < 4; ++j)
#pragma unroll
            for (int q = 0; q < 4; ++q)
#pragma unroll
              for (int e = 0; e < 4; ++e) wT[(4 * q + e) * 2048 + F.tid + 512 * j] = wv[j][q][e]; }
        __syncthreads();
        bf16* U = (bf16*)(F.ws + WS_U); float* BETA = (float*)(F.ws + WS_BETA); float* GG = (float*)(F.ws + WS_G);
        f32x4 nw[8];
#pragma unroll
        for (int j = 0; j < 8; ++j) nw[j] = ((const f32x4*)F.norm1_w)[64 * j + lane];
        for (int row = gw; row < T; row += NGW) {
            asm volatile("" ::: "memory");
            const f32x4* xr = (const f32x4*)(F.x + (size_t)row * D) + lane;
            f32x4 v[8]; float ss = 0.f;
#pragma unroll
            for (int j = 0; j < 8; ++j) { v[j] = xr[64 * j]; ss += (v[j].x * v[j].x + v[j].y * v[j].y) + (v[j].z * v[j].z + v[j].w * v[j].w); }
            const float rstd = rsqrtf(wave_sum(ss) * (1.0f / D) + EPS);
            v2u* o8 = (v2u*)(U + (size_t)row * D) + lane;
#pragma unroll
            for (int j = 0; j < 8; ++j) { v[j] = (v[j] * rstd) * nw[j]; v2u w; w.x = pk2(v[j].x, v[j].y); w.y = pk2(v[j].z, v[j].w); o8[64 * j] = w; }
            float mb = 0.f, ma = 0.f;
#pragma unroll
            for (int c = 0; c < 16; ++c) { float s = 0.f;
#pragma unroll
                for (int j = 0; j < 8; ++j) { const f32x4 w = *(const LAS f32x4*)(wT + c * 2048 + 256 * j + 4 * lane); s += (v[j].x * w.x + v[j].y * w.y) + (v[j].z * w.z + v[j].w * w.w); }
                s = wave_sum(s);
                if (c < 8) mb = (lane == c) ? s : mb; else ma = (lane == c - 8) ? s : ma; }
            if (lane < 8) { const float bt = 1.0f / (1.0f + expf(-mb)); const float xa = ma + F.dt_bias[lane]; const float sp = xa > 20.f ? xa : log1pf(expf(xa));
                BETA[(size_t)row * 8 + lane] = bt; GG[(size_t)row * 8 + lane] = -expf(F.a_log[lane]) * sp; }
        }
    }
}

__device__ __forceinline__ void gdn_naive(Frame& F, int bh) {
    const int b = bh >> 3, h = bh & 7, tid = F.tid, c = tid & 255, hh = tid >> 8;
    LAS float* sq = (LAS float*)F.lds; LAS float* sk = sq + 128; LAS float* sv = sq + 256; LAS float* sp = sq + 512; LAS float* sred = sq + 1024;
    const int ch = tid < 128 ? h * 128 + tid : (tid < 256 ? 1024 + h * 128 + (tid - 128) : 2048 + h * 256 + (tid - 256));
    const float cw0 = F.conv_w[0 * 4096 + ch], cw1 = F.conv_w[1 * 4096 + ch], cw2 = F.conv_w[2 * 4096 + ch], cw3 = F.conv_w[3 * 4096 + ch];
    const bf16* raw = (const bf16*)(F.ws + WS_QKV) + (size_t)(b * SEQ) * 4096 + ch;
    const float* BETA = (const float*)(F.ws + WS_BETA) + (size_t)(b * SEQ) * 8 + h; const float* GG = (const float*)(F.ws + WS_G) + (size_t)(b * SEQ) * 8 + h;
    bf16* OA = (bf16*)(F.ws + WS_OA) + (size_t)(b * SEQ) * 2048 + h * 256 + c;
    float S[64];
#pragma unroll
    for (int d = 0; d < 64; ++d) S[d] = 0.f;
    float r0 = 0.f, r1 = 0.f, r2 = 0.f;
    float nraw = bf2f(raw[0]), nbeta = BETA[0], ng = GG[0];
    for (int t = 0; t < SEQ; ++t) {
        const float r3 = nraw, beta = nbeta, eg = expf(ng);
        if (t + 1 < SEQ) { nraw = bf2f(raw[(size_t)(t + 1) * 4096]); nbeta = BETA[(size_t)(t + 1) * 8]; ng = GG[(size_t)(t + 1) * 8]; }
        const float a = r0 * cw0 + r1 * cw1 + r2 * cw2 + r3 * cw3; r0 = r1; r1 = r2; r2 = r3;
        float val = a / (1.0f + expf(-a));
        const float ws_ = wave_sum(val * val);
        if (F.lane == 0) sred[F.wave] = ws_;
        __syncthreads();
        if (tid < 128) { val = val * rsqrtf(sred[0] + sred[1] + EPS) * 0.08838834764831845f; sq[tid] = val; }
        else if (tid < 256) { val = val * rsqrtf(sred[2] + sred[3] + EPS); sk[tid - 128] = val; }
        else sv[tid - 256] = val;
        __syncthreads();
        float p = 0.f;
#pragma unroll
        for (int d = 0; d < 64; ++d) p += sk[hh * 64 + d] * S[d];
        sp[hh * 256 + c] = p;
        __syncthreads();
        const float kS = sp[c] + sp[256 + c];
        const float delta = beta * (sv[c] - eg * kS);
        float o = 0.f;
#pragma unroll
        for (int d = 0; d < 64; ++d) { S[d] = eg * S[d] + sk[hh * 64 + d] * delta; o += sq[hh * 64 + d] * S[d]; }
        __syncthreads();
        sp[hh * 256 + c] = o;
        __syncthreads();
        if (hh == 0) OA[(size_t)t * 2048] = (bf16)f2bf(sp[c] + sp[256 + c]);
    }
}
__device__ __forceinline__ void ffn_weight_copies(Frame& F) {
    const int gw = F.vcu * NWAVES + F.wave, NGW = F.G * NWAVES, lane = F.lane;
    LAS float* scr = (LAS float*)(F.lds + F.wave * 16640);
    constexpr int I_G = (D / 64) * (FF / 64), I_D = (FF / 64) * (D / 64);
    bf16* WGUT = (bf16*)(F.ws + WS_WGUT); bf16* WDT = (bf16*)(F.ws + WS_WDT);
    for (int it = gw; it < 2 * I_G + I_D; it += NGW) {
        int r = it;
        if (r < 2 * I_G) { const int up = r >= I_G; if (up) r -= I_G; const int nb = r % (FF / 64), kb = r / (FF / 64), c0 = 64 * nb;
            transpose_blk(up ? F.w_up : F.w_gate, FF, 64 * kb, c0, WGUT, D, 256 * (c0 >> 7) + 128 * up + (c0 & 127), scr, lane); continue; } r -= 2 * I_G;
        { const int nb = r % (D / 64), kb = r / (D / 64); transpose_blk(F.w_down, D, 64 * kb, 64 * nb, WDT, FF, 64 * nb, scr, lane); }
    }
}

typedef float f32x16 __attribute__((ext_vector_type(16)));
typedef short bf16x8 __attribute__((ext_vector_type(8)));
typedef float f32x2_t __attribute__((ext_vector_type(2))); typedef __bf16 bf16x2_t __attribute__((ext_vector_type(2)));
#define MFMA32(a, b, c) __builtin_amdgcn_mfma_f32_32x32x16_bf16((a), (b), (c), 0, 0, 0)
__device__ __forceinline__ unsigned cvtpk_s(float lo, float hi) { f32x2_t v = {lo, hi}; bf16x2_t b = __builtin_convertvector(v, bf16x2_t); return __builtin_bit_cast(unsigned, b); }
#define PACK_STEP(x, s) __builtin_bit_cast(bf16x8, (v4u){cvtpk_s((x)[8 * (s)], (x)[8 * (s) + 1]), cvtpk_s((x)[8 * (s) + 2], (x)[8 * (s) + 3]), cvtpk_s((x)[8 * (s) + 4], (x)[8 * (s) + 5]), cvtpk_s((x)[8 * (s) + 6], (x)[8 * (s) + 7])})
__device__ __forceinline__ bf16 cvt1_bf16(float x) { return (bf16)(cvtpk_s(x, x) & 0xffffu); }
__device__ __forceinline__ bf16x8 ldfrag(const bf16* base, size_t f, int lane) {
#if PROBE_NOSLICE
    bf16x8 z; for (int i = 0; i < 8; ++i) z[i] = (short)(lane + i); asm volatile("" : "+v"(z)); return z;
#endif
    return *(const bf16x8*)(base + f * 512 + lane * 8); }
__device__ __forceinline__ f32x16 zero16() { f32x16 z; for (int i = 0; i < 16; ++i) z[i] = 0.f; return z; }

#define SCAN_BAR_C() do { asm volatile("s_waitcnt lgkmcnt(0)" ::: "memory"); __builtin_amdgcn_s_barrier(); asm volatile("" ::: "memory"); } while (0)
#define SCAN_BAR() do { asm volatile("s_waitcnt vmcnt(0) lgkmcnt(0)" ::: "memory"); __builtin_amdgcn_s_barrier(); asm volatile("" ::: "memory"); } while (0)
__device__ __forceinline__ void glds1k(const bf16* gsrc_frag, LAS unsigned char* dst, int lane) {
#if PROBE_NODMA
    return;
#endif
    __builtin_amdgcn_global_load_lds((const unsigned*)(gsrc_frag + lane * 8), (LAS unsigned*)dst, 16, 0, 0);
#if PROBE_DMA2
    __builtin_amdgcn_global_load_lds((const unsigned*)(gsrc_frag + lane * 8), (LAS unsigned*)dst, 16, 0, 0);
#endif
}
__device__ __forceinline__ void dma_chunk3(const bf16* p0, const bf16* p1, const bf16* p2, LAS unsigned char* dst_lw, int lane) {
#pragma unroll
    for (int q = 0; q < 4; ++q) glds1k(p0 + q * 2048, dst_lw + (0 * 16 + 4 * q) * 1024, lane);
#pragma unroll
    for (int q = 0; q < 4; ++q) glds1k(p1 + q * 2048, dst_lw + (1 * 16 + 4 * q) * 1024, lane);
#pragma unroll
    for (int q = 0; q < 4; ++q) glds1k(p2 + q * 2048, dst_lw + (2 * 16 + 4 * q) * 1024, lane);
}
__device__ __forceinline__ bf16x8 ldsfrag(const LAS unsigned char* buf, int slot, int lane) { return *(const LAS bf16x8*)(buf + slot * 1024 + lane * 16); }

constexpr int RS_BUF = 48 * 1024, RS_PA = 3 * RS_BUF;
__device__ __forceinline__ void ret_scan_wg(Frame& F, int bh, int half, unsigned* prog) {
    unsigned long long seg_t0_ = 0, seg_t1_ = 0, seg_acc_ = 0; (void)seg_t0_; (void)seg_t1_; (void)seg_acc_;
    const int w = F.wave, b = bh >> 3, h = bh & 7;
    const bf16* RQf = (const bf16*)(F.ws + WS_RQF); const bf16* RKf = (const bf16*)(F.ws + WS_RKF); const bf16* RKTf = (const bf16*)(F.ws + WS_RKTF); const bf16* RVTf = (const bf16*)(F.ws + WS_RVTF);
    LAS unsigned char* L = F.lds;
    if (w >= 4) {
        const int lw = w - 4, lane = pg8::pg8_lane_id(), col = lane & 31, hh = lane >> 5;
        const bf16* pq = RQf + ((size_t)bh * 128 * 16 + lw) * 512; const bf16* pk = RKf + ((size_t)bh * 128 * 16 + lw) * 512; const bf16* pt = RKTf + ((size_t)bh * 128 * 16 + lw) * 512;
        dma_chunk3(pq, pk, pt, L + 0 * RS_BUF + lw * 1024, lane); pq += 8192; pk += 8192; pt += 8192;
        dma_chunk3(pq, pk, pt, L + 1 * RS_BUF + lw * 1024, lane); pq += 8192; pk += 8192; pt += 8192;
        asm volatile(VMCNT12 ::: "memory"); __builtin_amdgcn_s_barrier(); asm volatile("" ::: "memory");
        int cb = 0, nb = 2;
        for (int n = 0; n < 128; ++n) {
            const LAS unsigned char* B = L + cb * RS_BUF;
            if (lw < 3) {
                const int tj = lw == 2 ? 1 : 0, ti = lw == 0 ? 0 : 1;
                f32x16 P = zero16();
#pragma unroll
                for (int td = 0; td < 4; ++td)
#pragma unroll
                    for (int s2 = 0; s2 < 2; ++s2) P = MFMA32(ldsfrag(B, 16 + (tj * 4 + td) * 2 + s2, lane), ldsfrag(B, (ti * 4 + td) * 2 + s2, lane), P);
                if (lw != 1) {
#pragma unroll
                    for (int r = 0; r < 16; ++r) { const int j = (r & 3) + 8 * (r >> 2) + 4 * hh; if (col < j) P[r] = 0.f; } }
                const bf16x8 a0 = PACK_STEP(P, 0), a1 = PACK_STEP(P, 1);
                *(LAS bf16x8*)(L + RS_PA + (2 * lw) * 1024 + lane * 16) = a0; *(LAS bf16x8*)(L + RS_PA + (2 * lw + 1) * 1024 + lane * 16) = a1;
            }
            asm volatile("s_waitcnt lgkmcnt(0)" ::: "memory"); __builtin_amdgcn_s_barrier(); asm volatile("" ::: "memory");
            if (n + 2 < 128) { dma_chunk3(pq, pk, pt, L + nb * RS_BUF + lw * 1024, lane); pq += 8192; pk += 8192; pt += 8192;
                asm volatile(VMCNT12 ::: "memory"); }
            else asm volatile("s_waitcnt vmcnt(0)" ::: "memory");
            __builtin_amdgcn_s_barrier(); asm volatile("" ::: "memory");
            if (lw == 0 && half == 0 && lane == 0) __hip_atomic_store(prog, (unsigned)(n + 1), __ATOMIC_RELAXED, __HIP_MEMORY_SCOPE_AGENT);
            cb = cb == 2 ? 0 : cb + 1; nb = nb == 2 ? 0 : nb + 1;
        }
        return;
    }
    const int sl = 4 * half + w, lane = pg8::pg8_lane_id(), col = lane & 31, hh = lane >> 5;
    bf16* OB = (bf16*)(F.ws + WS_OB) + (size_t)(b * SEQ) * 2048 + h * 256 + sl * 32;
    const unsigned loff = (unsigned)(hh * 4 * 2048 + col);
    const float g64 = exp2f(64.0f * log2f(1.0f - exp2f(-5.0f - (float)h)));
    f32x16 S[4];
#pragma unroll
    for (int td = 0; td < 4; ++td) S[td] = zero16();
#if RET_PREFETCH
    bf16x8 vtn[2][2];
    { const size_t cq = (size_t)bh * 128;
#pragma unroll
      for (int tj = 0; tj < 2; ++tj)
#pragma unroll
        for (int s2 = 0; s2 < 2; ++s2) vtn[tj][s2] = ldfrag(RVTf, ((cq * 8 + sl) * 2 + tj) * 2 + s2, lane); }
#endif
    SCAN_BAR_C();
    int cb = 0;
    for (int n = 0; n < 128; ++n) { SEG_T02(6);
        const LAS unsigned char* B = L + cb * RS_BUF; cb = cb == 2 ? 0 : cb + 1;
        bf16x8 vt[2][2];
#if RET_PREFETCH
#pragma unroll
        for (int tj = 0; tj < 2; ++tj)
#pragma unroll
            for (int s2 = 0; s2 < 2; ++s2) vt[tj][s2] = vtn[tj][s2];
        if (n + 1 < 128) { const size_t cq = (size_t)bh * 128 + n + 1;
#else
#define vtn vt
        { const size_t cq = (size_t)bh * 128 + n;
#endif
#pragma unroll
          for (int tj = 0; tj < 2; ++tj)
#pragma unroll
            for (int s2 = 0; s2 < 2; ++s2) vtn[tj][s2] = ldfrag(RVTf, ((cq * 8 + sl) * 2 + tj) * 2 + s2, lane); }
#define PIN() do { asm volatile("" ::: "memory"); __builtin_amdgcn_sched_barrier(0); } while (0)
#define LD4(dst, base, s0, s1, s2, s3) do { PIN(); dst[0] = ldsfrag(base, s0, lane); dst[1] = ldsfrag(base, s1, lane); dst[2] = ldsfrag(base, s2, lane); dst[3] = ldsfrag(base, s3, lane); PIN(); } while (0)
#define QSLOT(ti, td, s2) (((ti) * 4 + (td)) * 2 + (s2))
#define KTSLOT(k) (32 + (k))
        bf16x8 fa[4], fb[4];
        const LAS unsigned char* PAb = L + RS_PA;
        f32x16 o0 = zero16(), o1 = zero16();
        LD4(fa, B, QSLOT(0, 0, 0), QSLOT(0, 0, 1), QSLOT(1, 0, 0), QSLOT(1, 0, 1));
        { const bf16x8 sb0 = PACK_STEP(S[0], 0), sb1 = PACK_STEP(S[0], 1);
          LD4(fb, B, QSLOT(0, 1, 0), QSLOT(0, 1, 1), QSLOT(1, 1, 0), QSLOT(1, 1, 1));
          o0 = MFMA32(fa[0], sb0, o0); o0 = MFMA32(fa[1], sb1, o0); o1 = MFMA32(fa[2], sb0, o1); o1 = MFMA32(fa[3], sb1, o1); }
        { const bf16x8 sb0 = PACK_STEP(S[1], 0), sb1 = PACK_STEP(S[1], 1);
          LD4(fa, B, QSLOT(0, 2, 0), QSLOT(0, 2, 1), QSLOT(1, 2, 0), QSLOT(1, 2, 1));
          o0 = MFMA32(fb[0], sb0, o0); o0 = MFMA32(fb[1], sb1, o0); o1 = MFMA32(fb[2], sb0, o1); o1 = MFMA32(fb[3], sb1, o1); }
        { const bf16x8 sb0 = PACK_STEP(S[2], 0), sb1 = PACK_STEP(S[2], 1);
          LD4(fb, B, QSLOT(0, 3, 0), QSLOT(0, 3, 1), QSLOT(1, 3, 0), QSLOT(1, 3, 1));
          o0 = MFMA32(fa[0], sb0, o0); o0 = MFMA32(fa[1], sb1, o0); o1 = MFMA32(fa[2], sb0, o1); o1 = MFMA32(fa[3], sb1, o1); }
        { const bf16x8 sb0 = PACK_STEP(S[3], 0), sb1 = PACK_STEP(S[3], 1);
          o0 = MFMA32(fb[0], sb0, o0); o0 = MFMA32(fb[1], sb1, o0); o1 = MFMA32(fb[2], sb0, o1); o1 = MFMA32(fb[3], sb1, o1); }
        SEG_T0(7); SCAN_BAR_C(); SEG_ACC(7);
#define STORE_O(ox, rowoff) do { _Pragma("unroll") for (int r = 0; r < 16; ++r) { const unsigned ro = (unsigned)(((r & 3) + 8 * (r >> 2)) * 2048); orow[loff + ro + (rowoff)] = cvt1_bf16(ox[r]); } } while (0)
        bf16* orow = OB + (size_t)(64 * n) * 2048;
        LD4(fa, PAb, 0, 1, 2, 3);
        fb[0] = ldsfrag(PAb, 4, lane); fb[1] = ldsfrag(PAb, 5, lane); fb[2] = ldsfrag(B, KTSLOT(0), lane); fb[3] = ldsfrag(B, KTSLOT(1), lane); PIN();
        S[0] = S[0] * g64; S[1] = S[1] * g64;
        o0 = MFMA32(fa[0], vt[0][0], o0); o0 = MFMA32(fa[1], vt[0][1], o0); o1 = MFMA32(fa[2], vt[0][0], o1); o1 = MFMA32(fa[3], vt[0][1], o1);
        LD4(fa, B, KTSLOT(2), KTSLOT(3), KTSLOT(4), KTSLOT(5));
        S[2] = S[2] * g64; S[3] = S[3] * g64;
        o1 = MFMA32(fb[0], vt[1][0], o1); o1 = MFMA32(fb[1], vt[1][1], o1);
        S[0] = MFMA32(fb[2], vt[0][0], S[0]); S[0] = MFMA32(fb[3], vt[0][1], S[0]);
        LD4(fb, B, KTSLOT(6), KTSLOT(7), KTSLOT(8), KTSLOT(9));
        STORE_O(o0, 0u);
        S[0] = MFMA32(fa[0], vt[1][0], S[0]); S[0] = MFMA32(fa[1], vt[1][1], S[0]);
        S[1] = MFMA32(fa[2], vt[0][0], S[1]); S[1] = MFMA32(fa[3], vt[0][1], S[1]);
        LD4(fa, B, KTSLOT(10), KTSLOT(11), KTSLOT(12), KTSLOT(13));
        STORE_O(o1, 32u * 2048u);
        S[1] = MFMA32(fb[0], vt[1][0], S[1]); S[1] = MFMA32(fb[1], vt[1][1], S[1]);
        S[2] = MFMA32(fb[2], vt[0][0], S[2]); S[2] = MFMA32(fb[3], vt[0][1], S[2]);
        PIN(); fb[0] = ldsfrag(B, KTSLOT(14), lane); fb[1] = ldsfrag(B, KTSLOT(15), lane); PIN();
        S[2] = MFMA32(fa[0], vt[1][0], S[2]); S[2] = MFMA32(fa[1], vt[1][1], S[2]);
        S[3] = MFMA32(fa[2], vt[0][0], S[3]); S[3] = MFMA32(fa[3], vt[0][1], S[3]);
        S[3] = MFMA32(fb[0], vt[1][0], S[3]); S[3] = MFMA32(fb[1], vt[1][1], S[3]);
#undef STORE_O
        SEG_T0(8); SCAN_BAR_C(); SEG_ACC(8); SEG_ACC2(6);
    }
    SEG_OUT();
}

#ifndef PROBE_NOSTORE
#define PROBE_NOSTORE 0
#endif
#ifndef PROBE_ONLYSCAN
#define PROBE_ONLYSCAN 0
#endif
#ifndef PROBE_PREP
#define PROBE_PREP 0
#endif
constexpr int GP_QH = 0, GP_KH = 17408, GP_AM = 34816, GP_RK = 51200, GP_GC = 83968, GP_BT = 84224, GP_WL = GP_RK, GP_VR = 84480;
__device__ __forceinline__ void gdn_prep(Frame& F, int ci) {
    int tid_ = F.tid; asm volatile("" : "+v"(tid_));
    const int tid = tid_, lane = tid & 63, w = __builtin_amdgcn_readfirstlane(tid >> 6), bh = ci >> 7, n = ci & 127, b = bh >> 3, h = bh & 7;
    const size_t trow0 = (size_t)b * SEQ + 64 * n;
    LAS unsigned char* L = F.lds;
    LAS float* gcs = (LAS float*)(L + GP_GC); LAS float* bet = (LAS float*)(L + GP_BT); LAS float* Am = (LAS float*)(L + GP_AM); LAS float* Rk = (LAS float*)(L + GP_RK);
    const bf16* QKV = (const bf16*)(F.ws + WS_QKV);
    bf16* GW = (bf16*)(F.ws + WS_GW); bf16* GQ = (bf16*)(F.ws + WS_GQ); bf16* GK = (bf16*)(F.ws + WS_GK); bf16* GA = (bf16*)(F.ws + WS_GA); bf16* GU = (bf16*)(F.ws + WS_GU);
    {
        v4u vr[5];
#pragma unroll
        for (int k = 0; k < 5; ++k) { const int idx = tid + 512 * k, row = idx >> 5, cg = idx & 31; vr[k] = (v4u){0u, 0u, 0u, 0u};
            if (row < 67 && (n > 0 || row >= 3)) vr[k] = *(const v4u*)(QKV + (trow0 + row - 3) * 4096 + 2048 + h * 256 + 8 * cg); }
#pragma unroll
        for (int k = 0; k < 5; ++k) { const int idx = tid + 512 * k, row = idx >> 5, cg = idx & 31; if (row < 67) *(LAS v4u*)(L + GP_VR + row * 512 + cg * 16) = vr[k]; }
    }
    if (w == 0) {
        float g = ((const float*)(F.ws + WS_G))[(trow0 + lane) * 8 + h];
#pragma unroll
        for (int o = 1; o < 64; o <<= 1) { const float t = __shfl_up(g, o); if (lane >= o) g += t; }
        gcs[lane] = g; bet[lane] = ((const float*)(F.ws + WS_BETA))[(trow0 + lane) * 8 + h];
        if (lane == 63) ((float*)(F.ws + WS_DL))[ci] = expf(g);
    }
    __syncthreads();
    for (int pr_ = 0; pr_ < (PROBE_PREP == 1 ? 2 : 1); ++pr_) {
        const int cg = lane & 31, rh = lane >> 5, isk = cg >> 4, dk0 = 8 * (cg & 15), row0 = 8 * w + 4 * rh;
        const int ch = (isk ? 1024 : 0) + h * 128 + dk0;
        float cw[4][8];
#pragma unroll
        for (int j = 0; j < 4; ++j) { const f32x4 a = *(const f32x4*)(F.conv_w + j * 4096 + ch), c = *(const f32x4*)(F.conv_w + j * 4096 + ch + 4);
            cw[j][0] = a.x; cw[j][1] = a.y; cw[j][2] = a.z; cw[j][3] = a.w; cw[j][4] = c.x; cw[j][5] = c.y; cw[j][6] = c.z; cw[j][7] = c.w; }
        float raw[7][8];
#pragma unroll
        for (int rr = 0; rr < 7; ++rr) { const int row = row0 - 3 + rr;
            v4u v = {0u, 0u, 0u, 0u};
            if (n > 0 || row >= 0) v = *(const v4u*)(QKV + (trow0 + row) * 4096 + ch);
#pragma unroll
            for (int e = 0; e < 4; ++e) { raw[rr][2 * e] = bflo(v[e]); raw[rr][2 * e + 1] = bfhi(v[e]); } }
        const float g63 = gcs[63];
#pragma unroll
        for (int r = 0; r < 4; ++r) { asm volatile("" ::: "memory"); const int row = row0 + r; float val[8]; float ss = 0.f;
#pragma unroll
            for (int e = 0; e < 8; ++e) { const float a = raw[r][e] * cw[0][e] + raw[r + 1][e] * cw[1][e] + raw[r + 2][e] * cw[2][e] + raw[r + 3][e] * cw[3][e];
                val[e] = silu_f(a); ss += val[e] * val[e]; }
            ss += __shfl_xor(ss, 1); ss += __shfl_xor(ss, 2); ss += __shfl_xor(ss, 4); ss += __shfl_xor(ss, 8);
            const float rn = rsqrtf(ss + EPS) * (isk ? 1.0f : 0.08838834764831845f);
            const float gc = gcs[row], eg = __expf(gc);
#pragma unroll
            for (int e = 0; e < 8; ++e) val[e] *= rn;
            v4u pk; pk.x = pk2(val[0], val[1]); pk.y = pk2(val[2], val[3]); pk.z = pk2(val[4], val[5]); pk.w = pk2(val[6], val[7]);
            *(LAS v4u*)(L + (isk ? GP_KH : GP_QH) + row * 272 + dk0 * 2) = pk;
            if (!isk) {
                const size_t f = (((size_t)ci * 2 + (row >> 5)) * 4 + (dk0 >> 5)) * 2 + ((dk0 >> 4) & 1);
                bf16* p = GQ + f * 512 + (row & 31) * 8 + ((dk0 >> 3) & 1) * 4;
                v2u a; a.x = pk2(val[0] * eg, val[1] * eg); a.y = pk2(val[2] * eg, val[3] * eg); *(v2u*)p = a;
                a.x = pk2(val[4] * eg, val[5] * eg); a.y = pk2(val[6] * eg, val[7] * eg); *(v2u*)(p + 256) = a;
            } else {
                const float bt = bet[row] * eg;
                f32x4 r0 = {val[0] * bt, val[1] * bt, val[2] * bt, val[3] * bt}, r1 = {val[4] * bt, val[5] * bt, val[6] * bt, val[7] * bt};
                *(LAS f32x4*)(Rk + row * 128 + dk0) = r0; *(LAS f32x4*)(Rk + row * 128 + dk0 + 4) = r1;
                const float ek = __expf(g63 - gc);
#pragma unroll
                for (int e = 0; e < 8; ++e) raw[r][e] = val[e] * ek;
            }
        }
        if (isk) {
            const int tj = w >> 2, s1 = (w >> 1) & 1;
#pragma unroll
            for (int e = 0; e < 8; ++e) { const int dk = dk0 + e;
                const size_t f = (((size_t)ci * 4 + (dk >> 5)) * 2 + tj) * 2 + s1;
                v2u a; a.x = pk2(raw[0][e], raw[1][e]); a.y = pk2(raw[2][e], raw[3][e]);
                *(v2u*)(GK + f * 512 + (rh * 32 + (dk & 31)) * 8 + (w & 1) * 4) = a; }
        }
    }
    __syncthreads();
    for (int pr_ = 0; pr_ < (PROBE_PREP == 2 ? 2 : 1); ++pr_) if (w < 6) {
        const int tsel = w % 3, ti = tsel == 0 ? 0 : 1, tj = tsel == 2 ? 1 : 0;
        const int r = lane & 31, hh = lane >> 5;
        f32x16 acc = zero16();
        if (w < 3) {
#pragma unroll
            for (int kb = 0; kb < 8; ++kb) { const bf16x8 a = *(const LAS bf16x8*)(L + GP_KH + (32 * ti + r) * 272 + (16 * kb + 8 * hh) * 2), bb = *(const LAS bf16x8*)(L + GP_KH + (32 * tj + r) * 272 + (16 * kb + 8 * hh) * 2);
                acc = MFMA32(a, bb, acc); }
            const int j = 32 * tj + r; const float gj = gcs[j];
#pragma unroll
            for (int q = 0; q < 16; ++q) { const int i = 32 * ti + (q & 3) + 8 * (q >> 2) + 4 * hh;
                const float v = (i > j) ? bet[i] * acc[q] * __expf(fminf(gcs[i] - gj, 0.f)) : 0.f; Am[i * 64 + j] = v; }
        } else {
#pragma unroll
            for (int kb = 0; kb < 8; ++kb) { const bf16x8 a = *(const LAS bf16x8*)(L + GP_KH + (32 * tj + r) * 272 + (16 * kb + 8 * hh) * 2), bb = *(const LAS bf16x8*)(L + GP_QH + (32 * ti + r) * 272 + (16 * kb + 8 * hh) * 2);
                acc = MFMA32(a, bb, acc); }
            const int i = 32 * ti + r; const float gi = gcs[i];
#pragma unroll
            for (int q = 0; q < 16; ++q) { const int j = 32 * tj + (q & 3) + 8 * (q >> 2) + 4 * hh;
                acc[q] = (i >= j) ? acc[q] * __expf(fminf(gi - gcs[j], 0.f)) : 0.f; }
            const bf16x8 f0 = PACK_STEP(acc, 0), f1 = PACK_STEP(acc, 1);
            const size_t f = (((size_t)ci * 2 + ti) * 2 + tj) * 2;
            *(bf16x8*)(GA + f * 512 + lane * 8) = f0; *(bf16x8*)(GA + (f + 1) * 512 + lane * 8) = f1;
        }
    }
    __syncthreads();
    float x[64];
    for (int pr_ = 0; pr_ < (PROBE_PREP == 3 ? 2 : 1); ++pr_) if (tid < 384) {
        if (tid < 256) {
            const int ch = 2048 + h * 256 + tid;
            const float c0 = F.conv_w[ch], c1 = F.conv_w[4096 + ch], c2 = F.conv_w[2 * 4096 + ch], c3 = F.conv_w[3 * 4096 + ch];
            const LAS unsigned short* vcol = (const LAS unsigned short*)(L + GP_VR) + tid;
            float r0 = bf2f(vcol[0]), r1 = bf2f(vcol[256]), r2 = bf2f(vcol[512]);
#pragma unroll
            for (int i = 0; i < 64; ++i) { const float r3 = bf2f(vcol[(i + 3) * 256]); const float a = r0 * c0 + r1 * c1 + r2 * c2 + r3 * c3; r0 = r1; r1 = r2; r2 = r3;
                x[i] = bet[i] * silu_f(a); }
        } else {
#pragma unroll
            for (int i = 0; i < 64; ++i) x[i] = Rk[i * 128 + (tid - 256)];
        }
#pragma unroll
        for (int i = 1; i < 64; ++i) { float s0 = 0.f, s1 = 0.f, s2 = 0.f, s3 = 0.f;
            asm volatile("" ::: "memory");
#pragma unroll
            for (int q = 0; q < (i + 3) / 4; ++q) { const f32x4 a = *(const LAS f32x4*)(Am + i * 64 + 4 * q);
                if (4 * q + 0 < i) s0 += a.x * x[4 * q + 0];
                if (4 * q + 1 < i) s1 += a.y * x[4 * q + 1];
                if (4 * q + 2 < i) s2 += a.z * x[4 * q + 2];
                if (4 * q + 3 < i) s3 += a.w * x[4 * q + 3]; }
            x[i] -= (s0 + s1) + (s2 + s3);
            asm volatile("" : "+v"(x[i])); }
        if (tid < 256) {
            const int sl = tid >> 5, col = tid & 31;
#pragma unroll
            for (int ti = 0; ti < 2; ++ti)
#pragma unroll
                for (int hh = 0; hh < 2; ++hh) { v4u a, c;
#define XR(q) x[32 * ti + ((q) & 3) + 8 * ((q) >> 2) + 4 * hh]
                    a.x = pk2(XR(0), XR(1)); a.y = pk2(XR(2), XR(3)); a.z = pk2(XR(4), XR(5)); a.w = pk2(XR(6), XR(7));
                    c.x = pk2(XR(8), XR(9)); c.y = pk2(XR(10), XR(11)); c.z = pk2(XR(12), XR(13)); c.w = pk2(XR(14), XR(15));
#undef XR
                    bf16* p = GU + (((size_t)ci * 8 + sl) * 2 + ti) * 1024 + (hh * 32 + col) * 16;
                    *(v4u*)p = a; *(v4u*)(p + 8) = c; }
        }
    }
    __syncthreads();
    if (tid >= 256 && tid < 384) { const int dk = tid - 256;
#pragma unroll
        for (int i = 0; i < 64; ++i) *(LAS unsigned short*)(L + GP_WL + i * 272 + dk * 2) = (unsigned short)f2bf(-x[i]); }
    __syncthreads();
#pragma unroll
    for (int k = 0; k < 2; ++k) { const int idx = tid + 512 * k, row = idx >> 4, dk0 = 8 * (idx & 15);
        const v4u v = *(const LAS v4u*)(L + GP_WL + row * 272 + dk0 * 2);
        const size_t f = (((size_t)ci * 2 + (row >> 5)) * 4 + (dk0 >> 5)) * 2 + ((dk0 >> 4) & 1);
        bf16* p = GW + f * 512 + (row & 31) * 8 + ((dk0 >> 3) & 1) * 4;
        v2u a; a.x = v.x; a.y = v.y; *(v2u*)p = a; a.x = v.z; a.y = v.w; *(v2u*)(p + 256) = a; }
    __syncthreads();
}

constexpr int GS_BUF = 48 * 1024, GS_GA = 3 * GS_BUF;
__device__ __forceinline__ void gdn_scan_wg(Frame& F, int bh, int half, unsigned* prog) {
    unsigned long long seg_t0_ = 0, seg_t1_ = 0, seg_acc_ = 0; (void)seg_t0_; (void)seg_t1_; (void)seg_acc_;
    const int w = F.wave, b = bh >> 3, h = bh & 7;
    const bf16* GW = (const bf16*)(F.ws + WS_GW); const bf16* GQ = (const bf16*)(F.ws + WS_GQ); const bf16* GK = (const bf16*)(F.ws + WS_GK); const bf16* GA = (const bf16*)(F.ws + WS_GA); const bf16* GU = (const bf16*)(F.ws + WS_GU);
    LAS unsigned char* L = F.lds;
    if (w >= 4) {
        const int lw = w - 4, lane = pg8::pg8_lane_id();
        const bf16* pw = GW + ((size_t)bh * 128 * 16 + lw) * 512; const bf16* pq = GQ + ((size_t)bh * 128 * 16 + lw) * 512; const bf16* pk = GK + ((size_t)bh * 128 * 16 + lw) * 512;
        int bi = 0;
        for (int c = 0; c < 130; ++c) { SEG_T0(3);
            if (c >= 1 && c - 1 < 128 && lw < 3) { const size_t ci = (size_t)bh * 128 + (c - 1); LAS unsigned char* dst = L + GS_GA + ((c - 1) & 1) * 6144;
#pragma unroll
                for (int q = 0; q < 2; ++q) { const int f = 2 * lw + q, gaf = f < 2 ? f : f + 2; glds1k(GA + (ci * 8 + gaf) * 512, dst + f * 1024, lane); } }
            if (c < 128) { dma_chunk3(pw, pq, pk, L + bi * GS_BUF + lw * 1024, lane); pw += 8192; pq += 8192; pk += 8192; }
            if (lw == 0 && half == 0 && lane == 0 && c >= 1) __hip_atomic_store(prog, (unsigned)c, __ATOMIC_RELAXED, __HIP_MEMORY_SCOPE_AGENT);
            bi = bi == 2 ? 0 : bi + 1;
            SEG_ACC(3); if (c >= 1) { SEG_T0(4); if (c < 128) asm volatile(VMCNT12 ::: "memory"); else asm volatile("s_waitcnt vmcnt(0)" ::: "memory"); SEG_ACC(4); SEG_T0(5);
                __builtin_amdgcn_s_barrier(); asm volatile("" ::: "memory"); SEG_ACC(5); }
        }
        SEG_OUT();
        return;
    }
    const int sl = 4 * half + w, lane = pg8::pg8_lane_id(), col = lane & 31, hh = lane >> 5;
    const float* DL = (const float*)(F.ws + WS_DL);
    bf16* OA = (bf16*)(F.ws + WS_OA) + (size_t)(b * SEQ) * 2048 + h * 256 + sl * 32;
    const unsigned loff = (unsigned)(hh * 4 * 2048 + col);
    f32x16 S[4];
#pragma unroll
    for (int td = 0; td < 4; ++td) S[td] = zero16();
    v4u un[1][2]; float dln;
    { const size_t ci = (size_t)bh * 128; dln = DL[ci];
      const bf16* p = GU + ((ci * 8 + sl) * 2 + 0) * 1024 + lane * 16; un[0][0] = *(const v4u*)p; un[0][1] = *(const v4u*)(p + 8); }
    SCAN_BAR_C();
    int cb = 0;
    for (int n = 0; n < 128; ++n) { SEG_T02(1);
        const LAS unsigned char* B = L + cb * GS_BUF; cb = cb == 2 ? 0 : cb + 1;
        const LAS unsigned char* GAb = L + GS_GA + (n & 1) * 6144;
        v4u uc[2][2]; const float dl = dln;
        uc[0][0] = un[0][0]; uc[0][1] = un[0][1];
        { const size_t ci = (size_t)bh * 128 + n; const bf16* p = GU + ((ci * 8 + sl) * 2 + 1) * 1024 + lane * 16; uc[1][0] = *(const v4u*)p; uc[1][1] = *(const v4u*)(p + 8); }
        if (n + 1 < 128) { const size_t ci = (size_t)bh * 128 + n + 1; dln = DL[ci];
          const bf16* p = GU + ((ci * 8 + sl) * 2 + 0) * 1024 + lane * 16; un[0][0] = *(const v4u*)p; un[0][1] = *(const v4u*)(p + 8); }
#define WSLOT(ti, td, s2) (((ti) * 4 + (td)) * 2 + (s2))
#define GKSLOT(k) (32 + (k))
#define LDWQ(dst, ti, td) LD4(dst, B, WSLOT(ti, td, 0), WSLOT(ti, td, 1), 16 + WSLOT(ti, td, 0), 16 + WSLOT(ti, td, 1))
#define ADD_U(v, ti) do { _Pragma("unroll") for (int e = 0; e < 4; ++e) { v[2 * e] += bflo(uc[ti][0][e]); v[2 * e + 1] += bfhi(uc[ti][0][e]); v[8 + 2 * e] += bflo(uc[ti][1][e]); v[8 + 2 * e + 1] += bfhi(uc[ti][1][e]); } } while (0)
#define HALF_TD(F_, td, vnx, ox) { const bf16x8 sb0 = PACK_STEP(S[td], 0), sb1 = PACK_STEP(S[td], 1); \
          vnx = MFMA32(F_[0], sb0, vnx); vnx = MFMA32(F_[1], sb1, vnx); ox = MFMA32(F_[2], sb0, ox); ox = MFMA32(F_[3], sb1, ox); }
        bf16x8 fa[4], fb[4];
        bf16x8 vb00, vb01, vb10, vb11;
        bf16* orow = OA + (size_t)(64 * n) * 2048;
#define STORE_O(ox, rowoff) do { _Pragma("unroll") for (int r = 0; r < 16; ++r) { const unsigned ro = (unsigned)(((r & 3) + 8 * (r >> 2)) * 2048); orow[loff + ro + (rowoff)] = cvt1_bf16(ox[r]); } } while (0)
#define S_TD(F_, td) { S[td] = MFMA32(F_[0], vb00, S[td]); S[td] = MFMA32(F_[1], vb01, S[td]); S[td] = MFMA32(F_[2], vb10, S[td]); S[td] = MFMA32(F_[3], vb11, S[td]); }
        f32x16 vn0 = zero16(), o0 = zero16(), vn1 = zero16(), o1 = zero16();
        LDWQ(fa, 0, 0); LDWQ(fb, 0, 1); HALF_TD(fa, 0, vn0, o0)
        LDWQ(fa, 0, 2); HALF_TD(fb, 1, vn0, o0)
        LDWQ(fb, 0, 3); HALF_TD(fa, 2, vn0, o0)
        PIN(); fa[0] = ldsfrag(GAb, 0, lane); fa[1] = ldsfrag(GAb, 1, lane); PIN(); HALF_TD(fb, 3, vn0, o0)
        ADD_U(vn0, 0); vb00 = PACK_STEP(vn0, 0); vb01 = PACK_STEP(vn0, 1);
        LDWQ(fb, 1, 0);
        o0 = MFMA32(fa[0], vb00, o0); o0 = MFMA32(fa[1], vb01, o0);
        LDWQ(fa, 1, 1); STORE_O(o0, 0u); HALF_TD(fb, 0, vn1, o1)
        LDWQ(fb, 1, 2); S[0] = S[0] * dl; HALF_TD(fa, 1, vn1, o1)
        LDWQ(fa, 1, 3); S[1] = S[1] * dl; HALF_TD(fb, 2, vn1, o1)
        LD4(fb, GAb, 2, 3, 4, 5); S[2] = S[2] * dl; HALF_TD(fa, 3, vn1, o1)
        ADD_U(vn1, 1); vb10 = PACK_STEP(vn1, 0); vb11 = PACK_STEP(vn1, 1);
        LD4(fa, B, GKSLOT(0), GKSLOT(1), GKSLOT(2), GKSLOT(3)); S[3] = S[3] * dl;
        o1 = MFMA32(fb[0], vb00, o1); o1 = MFMA32(fb[1], vb01, o1); o1 = MFMA32(fb[2], vb10, o1); o1 = MFMA32(fb[3], vb11, o1);
        LD4(fb, B, GKSLOT(4), GKSLOT(5), GKSLOT(6), GKSLOT(7)); S_TD(fa, 0)
        LD4(fa, B, GKSLOT(8), GKSLOT(9), GKSLOT(10), GKSLOT(11)); STORE_O(o1, 32u * 2048u); S_TD(fb, 1)
        LD4(fb, B, GKSLOT(12), GKSLOT(13), GKSLOT(14), GKSLOT(15)); S_TD(fa, 2)
        PIN(); S_TD(fb, 3)
#undef STORE_O
#undef S_TD
#undef HALF_TD
        SEG_T0(2); SCAN_BAR_C(); SEG_ACC(2); SEG_ACC2(1);
    }
    SEG_OUT();
}

constexpr int PF_LOOK = 6;
__device__ __forceinline__ void scan_prefetcher(Frame& F, const unsigned* PROG, int bx) {
    const int xc = bx & 7, j = (bx - 64) >> 3;
    const v4u* RQf = (const v4u*)(F.ws + WS_RQF); const v4u* RKf = (const v4u*)(F.ws + WS_RKF); const v4u* RKTf = (const v4u*)(F.ws + WS_RKTF); const v4u* RVTf = (const v4u*)(F.ws + WS_RVTF);
    const v4u* GW = (const v4u*)(F.ws + WS_GW); const v4u* GQ = (const v4u*)(F.ws + WS_GQ); const v4u* GK = (const v4u*)(F.ws + WS_GK); const v4u* GA = (const v4u*)(F.ws + WS_GA); const v4u* GU = (const v4u*)(F.ws + WS_GU);
    const int tid = F.tid;
    for (int it = j; it < 4 * 128; it += 24) {
        const int st = it & 3, n = it >> 2, kind = st >> 1, bh = xc + 8 * (st & 1);
        const unsigned* pw = PROG + 64 * (kind * 16 + bh);
        for (int spin = 0; spin < 20000; ++spin) { if ((int)__hip_atomic_load(pw, __ATOMIC_RELAXED, __HIP_MEMORY_SCOPE_AGENT) + PF_LOOK >= n) break; __builtin_amdgcn_s_sleep(32); }
        const size_t c = (size_t)bh * 128 + n;
        v4u a[11];
        if (kind == 0) {
            a[0] = RQf[c * 1024 + tid]; a[1] = RQf[c * 1024 + 512 + tid]; a[2] = RKf[c * 1024 + tid]; a[3] = RKf[c * 1024 + 512 + tid]; a[4] = RKTf[c * 1024 + tid]; a[5] = RKTf[c * 1024 + 512 + tid];
            a[6] = RVTf[c * 2048 + tid]; a[7] = RVTf[c * 2048 + 512 + tid]; a[8] = RVTf[c * 2048 + 1024 + tid]; a[9] = RVTf[c * 2048 + 1536 + tid]; a[10] = a[9];
        } else {
            a[0] = GW[c * 1024 + tid]; a[1] = GW[c * 1024 + 512 + tid]; a[2] = GQ[c * 1024 + tid]; a[3] = GQ[c * 1024 + 512 + tid]; a[4] = GK[c * 1024 + tid]; a[5] = GK[c * 1024 + 512 + tid];
            a[6] = GU[c * 2048 + tid]; a[7] = GU[c * 2048 + 512 + tid]; a[8] = GU[c * 2048 + 1024 + tid]; a[9] = GU[c * 2048 + 1536 + tid]; a[10] = GA[c * 512 + tid];
        }
#pragma unroll
        for (int q = 0; q < 11; ++q) asm volatile("" :: "v"(a[q]));
    }
}

__device__ __forceinline__ void p3_mixed(Frame& F) {
    const int gw = F.vcu * NWAVES + F.wave, NGW = F.G * NWAVES, lane = F.lane;
    const bf16* OA = (const bf16*)(F.ws + WS_OA); const bf16* OB = (const bf16*)(F.ws + WS_OB);
    const bf16* GZA = (const bf16*)F.out; const bf16* GZB = GZA + (size_t)T * 2048; bf16* MIX = (bf16*)(F.ws + WS_MIXED);
    for (int row = gw; row < T; row += NGW) {
        const size_t off = (size_t)row * 2048 + 32 * lane;
        v4u a4[4], b4[4], ga[4], gb[4];
#pragma unroll
        for (int q = 0; q < 4; ++q) { a4[q] = *(const v4u*)(OA + off + 8 * q); b4[q] = *(const v4u*)(OB + off + 8 * q); ga[q] = *(const v4u*)(GZA + off + 8 * q); gb[q] = *(const v4u*)(GZB + off + 8 * q); }
        float a[32], bb[32];
#pragma unroll
        for (int q = 0; q < 4; ++q)
#pragma unroll
            for (int e = 0; e < 4; ++e) { a[8 * q + 2 * e] = bflo(a4[q][e]); a[8 * q + 2 * e + 1] = bfhi(a4[q][e]); bb[8 * q + 2 * e] = bflo(b4[q][e]); bb[8 * q + 2 * e + 1] = bfhi(b4[q][e]); }
        float sa = 0.f, sb = 0.f;
#pragma unroll
        for (int i = 0; i < 32; ++i) { sa += a[i] * a[i]; sb += bb[i]; }
        sa += __shfl_xor(sa, 1); sa += __shfl_xor(sa, 2); sa += __shfl_xor(sa, 4);
        sb += __shfl_xor(sb, 1); sb += __shfl_xor(sb, 2); sb += __shfl_xor(sb, 4);
        const float rsa = rsqrtf(sa * (1.0f / 256.0f) + EPS), mu = sb * (1.0f / 256.0f);
        float vb = 0.f;
#pragma unroll
        for (int i = 0; i < 32; ++i) { bb[i] -= mu; vb += bb[i] * bb[i]; }
        vb += __shfl_xor(vb, 1); vb += __shfl_xor(vb, 2); vb += __shfl_xor(vb, 4);
        const float rsb = rsqrtf(vb * (1.0f / 256.0f) + EPS);
        const float* wa = F.gdn_norm_w + ((32 * lane) & 255); const float* wb = F.ret_norm_w + 32 * lane;
#pragma unroll
        for (int q = 0; q < 4; ++q) { v4u o;
#pragma unroll
            for (int e = 0; e < 4; ++e) { const int i = 8 * q + 2 * e;
                const float m0 = a[i] * rsa * wa[i] * bflo(ga[q][e]) + bb[i] * rsb * wb[i] * bflo(gb[q][e]);
                const float m1 = a[i + 1] * rsa * wa[i + 1] * bfhi(ga[q][e]) + bb[i + 1] * rsb * wb[i + 1] * bfhi(gb[q][e]);
                o[e] = pk2(m0, m1); }
            *(v4u*)(MIX + off + 8 * q) = o; }
    }
}
__device__ __forceinline__ void row_rmsnorm(Frame& F, const float* src, const float* w, bf16* dst16, float* dst32) {
    const int gw = F.vcu * NWAVES + F.wave, NGW = F.G * NWAVES, lane = F.lane;
    f32x4 nw[8];
#pragma unroll
    for (int j = 0; j < 8; ++j) nw[j] = ((const f32x4*)w)[64 * j + lane];
    for (int row = gw; row < T; row += 2 * NGW) {
        const f32x4* xr0 = (const f32x4*)(src + (size_t)row * D) + lane; const f32x4* xr1 = (const f32x4*)(src + (size_t)(row + NGW) * D) + lane;
        f32x4 v0[8], v1[8]; float s0 = 0.f, s1 = 0.f;
#pragma unroll
        for (int j = 0; j < 8; ++j) { v0[j] = xr0[64 * j]; v1[j] = xr1[64 * j]; }
#pragma unroll
        for (int j = 0; j < 8; ++j) { s0 += (v0[j].x * v0[j].x + v0[j].y * v0[j].y) + (v0[j].z * v0[j].z + v0[j].w * v0[j].w); s1 += (v1[j].x * v1[j].x + v1[j].y * v1[j].y) + (v1[j].z * v1[j].z + v1[j].w * v1[j].w); }
        const float r0 = rsqrtf(wave_sum(s0) * (1.0f / D) + EPS), r1 = rsqrtf(wave_sum(s1) * (1.0f / D) + EPS);
        if (dst16) { v2u* o0 = (v2u*)(dst16 + (size_t)row * D) + lane; v2u* o1 = (v2u*)(dst16 + (size_t)(row + NGW) * D) + lane;
#pragma unroll
            for (int j = 0; j < 8; ++j) { const f32x4 y0 = (v0[j] * r0) * nw[j], y1 = (v1[j] * r1) * nw[j]; v2u o; o.x = pk2(y0.x, y0.y); o.y = pk2(y0.z, y0.w); o0[64 * j] = o; o.x = pk2(y1.x, y1.y); o.y = pk2(y1.z, y1.w); o1[64 * j] = o; } }
        else { f32x4* o0 = (f32x4*)(dst32 + (size_t)row * D) + lane; f32x4* o1 = (f32x4*)(dst32 + (size_t)(row + NGW) * D) + lane;
#pragma unroll
            for (int j = 0; j < 8; ++j) { o0[64 * j] = (v0[j] * r0) * nw[j]; o1[64 * j] = (v1[j] * r1) * nw[j]; } }
    }
}

__global__ void __launch_bounds__(NWAVES * 64, 2) fwd_kernel(Args args) {
    extern __shared__ __attribute__((aligned(16))) unsigned char lds[];
    Frame F;
    F.lds = (LAS unsigned char*)lds;
    F.tid = threadIdx.x; F.lane = F.tid & 63; F.wave = __builtin_amdgcn_readfirstlane(F.tid >> 6);
    F.G = gridDim.x; { const int bx = blockIdx.x; F.vcu = (F.G % 8 == 0) ? (bx % 8) * (F.G / 8) + bx / 8 : bx; }
    typedef const __attribute__((address_space(4))) Args* KArgs;
    const KArgs kap0 = (KArgs)__builtin_amdgcn_kernarg_segment_ptr();
#define LOADF() do { KArgs kap_ = kap0; asm volatile("" : "+s"(kap_)); \
        F.x = kap_->in[0]; F.norm1_w = kap_->in[1]; F.w_in = kap_->in[2]; F.conv_w = kap_->in[3]; F.a_log = kap_->in[4]; F.dt_bias = kap_->in[5]; F.gdn_norm_w = kap_->in[6]; \
        F.ret_norm_w = kap_->in[7]; F.w_out = kap_->in[8]; F.norm2_w = kap_->in[9]; F.w_gate = kap_->in[10]; F.w_up = kap_->in[11]; F.w_down = kap_->in[12]; F.norm_f_w = kap_->in[13]; \
        F.out = kap_->out; F.ws = kap_->ws; F.lane = pg8::pg8_lane_id(); F.tid = F.wave * 64 + F.lane; } while (0)
    LOADF();
    volatile LAS unsigned* MISC = (volatile LAS unsigned*)(F.lds + MISC_OFF);
    for (int u = F.tid; u < (LDS_BYTES - LDSCTL_OFF) / 4; u += NWAVES * 64) ((LAS unsigned*)(F.lds + LDSCTL_OFF))[u] = 0u;
    __syncthreads();
    const int lo = args.ph_lo, hi = args.ph_hi;
    const bool use_bar = (hi - lo) > 1;
    XcdBarrier bar; bar.bar = (unsigned*)(F.ws + WS_CTL) + CW_BAR; bar.x = 0; bar.st = nullptr; bar.w0 = 0;
    if (use_bar) bar = xcd_barrier_post((unsigned*)(F.ws + WS_CTL) + CW_BAR, MISC + 8, F.wave);
#ifndef PROBE_REP
#define PROBE_REP -1
#endif
#define NREP(k) ((PROBE_REP) == (k) ? 2 : 1)
#define IN(k) (lo <= (k) && (k) < hi)
#ifndef PROBE_TIME
#define PROBE_TIME -1
#endif
    volatile LAS unsigned long long* PT = (volatile LAS unsigned long long*)(F.lds + MISC_OFF + 64);
#define SEAM(k) do { if (IN(k) && IN((k) + 1)) xcd_barrier(bar); if ((PROBE_TIME) == (k) + 1 && F.tid == 0) PT[0] = __builtin_amdgcn_s_memrealtime(); if ((PROBE_TIME) == (k) && F.tid == 0) PT[1] = __builtin_amdgcn_s_memrealtime(); } while (0)

    if ((PROBE_TIME) == 0 && F.tid == 0) PT[0] = __builtin_amdgcn_s_memrealtime();
    if (IN(0)) for (int rep_ = 0; rep_ < NREP(0); ++rep_) { LOADF(); p0_prologue(F); } SEAM(0);
    if (IN(1)) for (int rep_ = 0; rep_ < NREP(1); ++rep_) { LOADF();
        pg8::Gemm g{(const pg8::bf16_t*)(F.ws + WS_U), (const pg8::bf16_t*)(F.ws + WS_W1T), T, N1, D}; pg8::InProjOrder S; S.init(T, N1, F.G, (int)blockIdx.x);
        pg8::EpiInProj E{F.ws, (pg8::bf16_t*)F.out, WS_QKV, WS_RQF, WS_RKF, WS_RKTF, WS_RVTF, WS_COS, WS_SIN, WS_COS2, WS_SIN2};
        pg8::gemm_phase<pg8::EpiInProj, pg8::InProjOrder, true, true>(F.lds, g, S, E, F.wave);
    } SEAM(1);
    if (IN(2)) for (int rep_ = 0; rep_ < NREP(2); ++rep_) { LOADF(); for (int ci = blockIdx.x; ci < BATCH * NH * 128; ci += F.G) gdn_prep(F, ci); } SEAM(2);
    if (IN(3)) for (int rep_ = 0; rep_ < NREP(3); ++rep_) { LOADF();
        const int bx = blockIdx.x;
        unsigned* PROG = (unsigned*)(F.ws + WS_CTL) + 16384;
        if (bx >= 64) scan_prefetcher(F, PROG, bx);
        if (bx < 64) { const int x = bx & 31, xc = x & 7, y = x >> 3, bh = xc + 8 * (y >> 1), half = y & 1;
#if PROBE_ONLYSCAN == 1
            if (bx < 32) ret_scan_wg(F, bh, half, PROG + 64 * (0 * 16 + bh));
#elif PROBE_ONLYSCAN == 2
            if (bx >= 32) gdn_scan_wg(F, bh, half, PROG + 64 * (1 * 16 + bh));
#else
            if (bx < 32) { ret_scan_wg(F, bh, half, PROG + 64 * (0 * 16 + bh));
#if PROBE_SCAN2 == 1
                ret_scan_wg(F, bh, half, PROG + 64 * (0 * 16 + bh));
#endif
            } else { gdn_scan_wg(F, bh, half, PROG + 64 * (1 * 16 + bh));
#if PROBE_SCAN2 == 2
                gdn_scan_wg(F, bh, half, PROG + 64 * (1 * 16 + bh));
#endif
            }
#endif
            }
    } SEAM(3);
    if (IN(4)) for (int rep_ = 0; rep_ < NREP(4); ++rep_) { LOADF(); p3_mixed(F); ffn_weight_copies(F); } SEAM(4);
    if (IN(5)) for (int rep_ = 0; rep_ < NREP(5); ++rep_) { LOADF();
        pg8::Gemm g{(const pg8::bf16_t*)(F.ws + WS_MIXED), (const pg8::bf16_t*)(F.ws + WS_WOT), T, D, D}; pg8::StaticOrder S; S.init(T, D, F.G, (int)blockIdx.x);
        pg8::EpiResF32 E{F.x, F.out, D};
        pg8::gemm_phase<pg8::EpiResF32, pg8::StaticOrder, true, true>(F.lds, g, S, E, F.wave);
    } SEAM(5);
    if (IN(6)) for (int rep_ = 0; rep_ < NREP(6); ++rep_) { LOADF(); row_rmsnorm(F, F.out, F.norm2_w, (bf16*)(F.ws + WS_HNB), nullptr); } SEAM(6);
    if (IN(7)) for (int rep_ = 0; rep_ < NREP(7); ++rep_) { LOADF();
        pg8::Gemm g{(const pg8::bf16_t*)(F.ws + WS_HNB), (const pg8::bf16_t*)(F.ws + WS_WGUT), T, NGU, D}; pg8::StaticOrder S; S.init(T, NGU, F.G, (int)blockIdx.x);
        pg8::EpiGateUp E{(pg8::bf16_t*)(F.ws + WS_ACT), FF, nullptr};
        pg8::gemm_phase<pg8::EpiGateUp, pg8::StaticOrder, true, true>(F.lds, g, S, E, F.wave);
    } SEAM(7);
    if (IN(8)) { LOADF();
        pg8::Gemm g{(const pg8::bf16_t*)(F.ws + WS_ACT), (const pg8::bf16_t*)(F.ws + WS_WDT), T, D, FF}; pg8::StaticOrder S; S.init(T, D, F.G, (int)blockIdx.x);
        pg8::EpiResF32 E{F.out, F.out, D};
        pg8::gemm_phase<pg8::EpiResF32, pg8::StaticOrder, true, true>(F.lds, g, S, E, F.wave);
    } SEAM(8);
    if (IN(9)) { LOADF(); row_rmsnorm(F, F.out, F.norm_f_w, nullptr, F.out); }
#if PROBE_TIME >= 0
    if (PROBE_TIME == 9 && F.tid == 0) PT[1] = __builtin_amdgcn_s_memrealtime();
    __syncthreads();
    if (F.vcu == 0 && F.tid == 0) { asm volatile("s_waitcnt vmcnt(0)" ::: "memory");
        int best = 0; float bv = 1e30f;
        for (int i = 0; i < 2048; ++i) { const float a = fabsf(F.out[i]); if (a < bv) { bv = a; best = i; } }
#if PROBE_SEG
        const float us = 0.1f * (float)__hip_atomic_load((unsigned*)(F.ws + WS_CTL) + 20000, __ATOMIC_RELAXED, __HIP_MEMORY_SCOPE_AGENT);
#else
        const float us = (float)(long long)(PT[1] - PT[0]) * 0.01f;
#endif
#ifdef PROBE_FAIL
        F.out[0] = 20.0f * rintf(us * 0.05f);
#else
        F.out[best] += 0.04f + 1e-4f * us;
#endif
        }
#endif
#undef IN
#undef SEAM
}

extern "C" void kernel_launch(void* const* d_in, const int* in_sizes, int n_in, void* d_out, int out_size, void* d_ws, size_t ws_size, hipStream_t stream) {
    static int grid = 0;
    if (grid == 0) {
        if (n_in != 14 || in_sizes[0] != T * D || out_size != T * D || ws_size < WS_END) { fprintf(stderr, "kernel_launch: unexpected shapes: n_in %d in0 %d out %d ws %zu (need %zu)\n", n_in, n_in > 0 ? in_sizes[0] : -1, out_size, ws_size, (size_t)WS_END); grid = -1; return; }
        int dev = 0, cus = 0, per_cu = 0;
        if (hipGetDevice(&dev) != hipSuccess || hipDeviceGetAttribute(&cus, hipDeviceAttributeMultiprocessorCount, dev) != hipSuccess) { grid = -1; return; }
        if (hipFuncSetAttribute((const void*)fwd_kernel, hipFuncAttributeMaxDynamicSharedMemorySize, LDS_BYTES) != hipSuccess) { fprintf(stderr, "kernel_launch: hipFuncSetAttribute failed\n"); grid = -1; return; }
        if (hipOccupancyMaxActiveBlocksPerMultiprocessor(&per_cu, (const void*)fwd_kernel, NWAVES * 64, LDS_BYTES) != hipSuccess || per_cu < 1) { fprintf(stderr, "kernel_launch: occupancy query says %d blocks per CU\n", per_cu); per_cu = 1; }
        (void)hipGetLastError();
        grid = cus;
        if (grid > 256) grid = 256;
    }
    if (grid < 0) return;
    (void)hipMemsetAsync((char*)d_ws + WS_CTL, 0, CTL_ZERO_BYTES, stream);
    Args a{};
    for (int i = 0; i < 14; ++i) a.in[i] = (const float*)d_in[i];
    a.out = (float*)d_out; a.ws = (unsigned char*)d_ws;
#if MK_N_LAUNCHES == 1
    a.ph_lo = 0; a.ph_hi = NPHASES;
    hipLaunchKernelGGL(fwd_kernel, dim3(grid), dim3(NWAVES * 64), LDS_BYTES, stream, a);
#else
    for (int p = 0; p < NPHASES; ++p) { a.ph_lo = p; a.ph_hi = p + 1; hipLaunchKernelGGL(fwd_kernel, dim3(grid), dim3(NWAVES * 64), LDS_BYTES, stream, a); }
#endif
}
```

```cpp
#include <hip/hip_runtime.h>
#include <cstdio>
#include <cstdint>
namespace pg8 {
#define PG8_LAS __attribute__((address_space(3)))
typedef unsigned short bf16_t;
typedef short bf16x8 __attribute__((ext_vector_type(8)));
typedef float f32x4 __attribute__((ext_vector_type(4)));
typedef unsigned u32x4 __attribute__((ext_vector_type(4)));
constexpr int BM = 256, BK = 64, HALF = 128, HTB = HALF * BK * 2  , STAGE_BYTES = 8 * HTB, NXCD = 8, WGM = 8;

__host__ __device__ __forceinline__ int lds_byte(int r, int c) { const int st = (r >> 4) * 2 + (c >> 5), rr = r & 15, cc = c & 31, ob = rr * 64 + cc * 2; return st * 1024 + (ob ^ (((ob >> 9) & 1) << 5)); }
__host__ __device__ __forceinline__ void stage_rc(int b, int& R, int& C) { const int st = b / 1024, sb = b % 1024, swz = sb ^ (((sb >> 9) & 1) << 5); R = (st >> 1) * 16 + swz / 64; C = (st & 1) * 32 + (swz % 64) / 2; }
__host__ __device__ __forceinline__ int perm32(int rho) { const int n = rho >> 4, i = rho & 15; return 8 * (i >> 2) + 4 * n + (i & 3); }

__device__ __forceinline__ int pg8_lane_id() { int l; asm volatile("v_mbcnt_lo_u32_b32 %0, -1, 0\n\tv_mbcnt_hi_u32_b32 %0, -1, %0" : "=v"(l)); return l; }
struct Unit { int pm, pn, sw; };
struct Gemm { const bf16_t* A; const bf16_t* Bt; int M, N, K; };

struct StaticOrder {
    int nM, nN, nwg, G, c;
    __host__ __device__ void init(int M, int N, int G_, int c_) { nM = M / BM; nN = N / BM; nwg = nM * nN; G = G_; c = c_; }
    __host__ __device__ bool next(int i, Unit& u) const {
        const long L = (long)i * G + c; if (L >= nwg) return false;
        int wgid = (int)L; { const int q = nwg / NXCD, r = nwg % NXCD, xcd = wgid % NXCD, off = wgid / NXCD; wgid = (xcd < r ? xcd * (q + 1) : r * (q + 1) + (xcd - r) * q) + off; }
        const int nig = WGM * nN, gid = wgid / nig, fm = gid * WGM, gsz = (nM - fm) < WGM ? (nM - fm) : WGM;
        u.pm = fm + ((wgid % nig) % gsz); u.pn = (wgid % nig) / gsz; u.sw = 0; return true;
    }
    __device__ __forceinline__ void a_ready(const Unit&) const {}
    __device__ __forceinline__ void done(const Unit&) const {}
};
__device__ __forceinline__ unsigned cvt_pk_bf16(float lo, float hi) { unsigned r; asm volatile("v_cvt_pk_bf16_f32 %0, %1, %2" : "=v"(r) : "v"(lo), "v"(hi)); return r; }
typedef float f32x2 __attribute__((ext_vector_type(2)));
__device__ __forceinline__ u32x4 pack8(const f32x4& a, const f32x4& b) { u32x4 w; w.x = cvt_pk_bf16(a[0], a[1]); w.y = cvt_pk_bf16(a[2], a[3]); w.z = cvt_pk_bf16(b[0], b[1]); w.w = cvt_pk_bf16(b[2], b[3]); return w; }
typedef unsigned u32x2 __attribute__((ext_vector_type(2)));
__device__ __forceinline__ float fsigmoid(float x) { return __builtin_amdgcn_rcpf(1.0f + __expf(-x)); }
__device__ __forceinline__ float fsilu(float x) { return x * fsigmoid(x); }

struct InProjOrder : StaticOrder {
    __host__ __device__ bool next(int i, Unit& u) const { if (!StaticOrder::next(i, u)) return false; u.sw = ((u.pn >= 24 && u.pn < 32) || u.pn >= 64) ? 1 : 0; return true; }
};
struct EpiInProj {
    static constexpr bool PERM = true, AFTER_DRAIN = false;
    unsigned char* ws; bf16_t* gz;
    size_t oQKV, oRQf, oRKf, oRKTf, oRVTf, oCOS, oSIN, oCOS2, oSIN2;
    __device__ __forceinline__ void operator()(const f32x4 (&acc)[2][2][4][2], const Unit& u, int wr, int wc, int fr, int fq) const {
        asm volatile("" : "+v"(fr), "+v"(fq));
        bf16_t* const QKV = (bf16_t*)(ws + oQKV); bf16_t* const RQf = (bf16_t*)(ws + oRQf); bf16_t* const RKf = (bf16_t*)(ws + oRKf); bf16_t* const RKTf = (bf16_t*)(ws + oRKTf); bf16_t* const RVTf = (bf16_t*)(ws + oRVTf);
        bf16_t* const GZA = gz; bf16_t* const GZB = gz + (size_t)16384 * 2048;
        const float* const cosT = (const float*)(ws + oCOS); const float* const sinT = (const float*)(ws + oSIN); const float* const cosT2 = (const float*)(ws + oCOS2); const float* const sinT2 = (const float*)(ws + oSIN2);
        const int pn = u.pn, cw = wc * 32 + 8 * fq;
        if (pn < 16) {
            const int row0 = u.pm * BM + wr * 64 + fr, col0 = pn * 256 + cw;
#pragma unroll
            for (int ai = 0; ai < 2; ++ai)
#pragma unroll
                for (int m = 0; m < 4; ++m) { bf16_t* rowp = QKV + (size_t)(row0 + ai * HALF + m * 16) * 4096 + col0;
#pragma unroll
                    for (int bj = 0; bj < 2; ++bj) *(u32x4*)(rowp + bj * HALF) = pack8(acc[ai][bj][m][0], acc[ai][bj][m][1]); }
        } else if (pn < 24) {
            const bool isk = pn >= 20; bf16_t* base = isk ? RKf : RQf;
            const int row0 = u.pm * BM + wr * 64 + fr, tile = (pn - 16) & 3, head = 2 * tile + (cw >> 6), i0 = cw & 63;
            const float l2g = log2f(1.0f - exp2f(-5.0f - (float)head));
            const int td1 = i0 >> 5, s1 = (i0 >> 4) & 1, eg = (i0 >> 3) & 1;
#pragma unroll
            for (int ai = 0; ai < 2; ++ai)
#pragma unroll
                for (int m = 0; m < 4; ++m) { const int row = row0 + ai * HALF + m * 16, b = row >> 13, t = row & 8191, n = t >> 6, pos = t & 63;
                    const float sc = isk ? 0.08838834764831845f * exp2f(-(float)(pos + 1) * l2g) : exp2f((float)(pos + 1) * l2g);
                    const float* cp = cosT + t * 64 + i0; const float* sp = sinT + t * 64 + i0;
                    const f32x4 c0 = *(const f32x4*)cp, c1 = *(const f32x4*)(cp + 4), s0 = *(const f32x4*)sp, s1v = *(const f32x4*)(sp + 4);
                    const f32x4 x1a = acc[ai][0][m][0], x1b = acc[ai][0][m][1], x2a = acc[ai][1][m][0], x2b = acc[ai][1][m][1];
                    const f32x4 o1a = (x1a * c0 - x2a * s0) * sc, o1b = (x1b * c1 - x2b * s1v) * sc, o2a = (x2a * c0 + x1a * s0) * sc, o2b = (x2b * c1 + x1b * s1v) * sc;
                    const size_t f1 = ((((size_t)(b * 8 + head) * 128 + n) * 2 + (pos >> 5)) * 4 + td1) * 2 + s1;
                    bf16_t* p1 = base + f1 * 512 + (pos & 31) * 8 + eg * 4;
                    u32x2 w;
                    w.x = cvt_pk_bf16(o1a[0], o1a[1]); w.y = cvt_pk_bf16(o1a[2], o1a[3]); *(u32x2*)(p1) = w;
                    w.x = cvt_pk_bf16(o1b[0], o1b[1]); w.y = cvt_pk_bf16(o1b[2], o1b[3]); *(u32x2*)(p1 + 256) = w;
                    w.x = cvt_pk_bf16(o2a[0], o2a[1]); w.y = cvt_pk_bf16(o2a[2], o2a[3]); *(u32x2*)(p1 + 4 * 512) = w;
                    w.x = cvt_pk_bf16(o2b[0], o2b[1]); w.y = cvt_pk_bf16(o2b[2], o2b[3]); *(u32x2*)(p1 + 4 * 512 + 256) = w; }
        } else if (pn < 32) {
            const int head = pn - 24, b = u.pm >> 5, nbase = (u.pm & 31) * 4;
            const int tj = wc & 1, s1 = (fq >> 1) & 1, eg = fq & 1;
#pragma unroll
            for (int ai = 0; ai < 2; ++ai)
#pragma unroll
                for (int m = 0; m < 4; ++m) { const int dv = ai * HALF + wr * 64 + m * 16 + fr, sl = dv >> 5, col = dv & 31;
#pragma unroll
                    for (int bj = 0; bj < 2; ++bj) { const int n = nbase + 2 * bj + (wc >> 1);
                        const size_t f = ((((size_t)(b * 8 + head) * 128 + n) * 8 + sl) * 2 + tj) * 2 + s1;
                        bf16_t* p = RVTf + f * 512 + col * 8 + eg * 4;
#pragma unroll
                        for (int nn = 0; nn < 2; ++nn) { u32x2 w; w.x = cvt_pk_bf16(acc[ai][bj][m][nn][0], acc[ai][bj][m][nn][1]); w.y = cvt_pk_bf16(acc[ai][bj][m][nn][2], acc[ai][bj][m][nn][3]); *(u32x2*)(p + nn * 256) = w; } } }
        } else if (pn < 64) {
            const int row0 = u.pm * BM + wr * 64 + fr;
            bf16_t* base = pn < 48 ? GZA : GZB; const int col0 = ((pn - 32) & 15) * 128 + cw;
#pragma unroll
            for (int ai = 0; ai < 2; ++ai)
#pragma unroll
                for (int m = 0; m < 4; ++m) { bf16_t* rowp = base + (size_t)(row0 + ai * HALF + m * 16) * 2048 + col0; f32x4 o[2];
#pragma unroll
                    for (int n = 0; n < 2; ++n)
#pragma unroll
                        for (int j = 0; j < 4; ++j) o[n][j] = fsilu(acc[ai][0][m][n][j]) * fsigmoid(acc[ai][1][m][n][j]);
                    *(u32x4*)rowp = pack8(o[0], o[1]); }
        } else {
            const int tile = pn - 64, head = 2 * tile + wr, b = u.pm >> 5, nbase = (u.pm & 31) * 4, tbase = (u.pm & 31) * 256;
            const int tj = wc & 1, s1 = (fq >> 1) & 1, eg = fq & 1;
            const float l2g = log2f(1.0f - exp2f(-5.0f - (float)head));
#pragma unroll
            for (int bj = 0; bj < 2; ++bj) { const int n = nbase + 2 * bj + (wc >> 1), c0 = bj * HALF + wc * 32 + 8 * fq;
#pragma unroll
                for (int nn = 0; nn < 2; ++nn) { const int pos0 = (c0 + 4 * nn) & 63; f32x4 sc;
#pragma unroll
                    for (int j = 0; j < 4; ++j) sc[j] = 0.08838834764831845f * exp2f((float)(63 - pos0 - j) * l2g);
#pragma unroll
                    for (int m = 0; m < 4; ++m) { const int i = 16 * m + fr;
                        const f32x4 c = *(const f32x4*)(cosT2 + (size_t)i * 8192 + tbase + c0 + 4 * nn), s = *(const f32x4*)(sinT2 + (size_t)i * 8192 + tbase + c0 + 4 * nn);
                        const f32x4 x1 = acc[0][bj][m][nn], x2 = acc[1][bj][m][nn];
                        const f32x4 o1 = (x1 * c - x2 * s) * sc, o2 = (x2 * c + x1 * s) * sc;
                        const size_t f = ((((size_t)(b * 8 + head) * 128 + n) * 4 + (m >> 1)) * 2 + tj) * 2 + s1;
                        bf16_t* p = RKTf + f * 512 + (nn * 32 + 16 * (m & 1) + fr) * 8 + eg * 4;
                        u32x2 w; w.x = cvt_pk_bf16(o1[0], o1[1]); w.y = cvt_pk_bf16(o1[2], o1[3]); *(u32x2*)p = w;
                        w.x = cvt_pk_bf16(o2[0], o2[1]); w.y = cvt_pk_bf16(o2[2], o2[3]); *(u32x2*)(p + 8 * 512) = w; } } }
        }
    }
};
struct EpiGateUp {
    static constexpr bool PERM = true, AFTER_DRAIN = false;
    bf16_t* ACT; int ldc; const float* rstd;
    __device__ __forceinline__ void operator()(const f32x4 (&acc)[2][2][4][2], const Unit& u, int wr, int wc, int fr, int fq) const {
        const int row0 = u.pm * BM + wr * 64 + fr, col0 = u.pn * 128 + wc * 32 + 8 * fq;
#pragma unroll
        for (int ai = 0; ai < 2; ++ai)
#pragma unroll
            for (int m = 0; m < 4; ++m) { const int row = row0 + ai * HALF + m * 16; const float rs = rstd ? __builtin_amdgcn_rsqf(rstd[row] * (1.0f / 2048.0f) + 1e-6f) : 1.0f; f32x4 o[2];
#pragma unroll
                for (int n = 0; n < 2; ++n)
#pragma unroll
                    for (int j = 0; j < 4; ++j) o[n][j] = fsilu(acc[ai][0][m][n][j] * rs) * (acc[ai][1][m][n][j] * rs);
                *(u32x4*)(ACT + (size_t)row * ldc + col0) = pack8(o[0], o[1]); }
    }
};
struct EpiResF32 {
    static constexpr bool PERM = false, AFTER_DRAIN = false;
    const float* res; float* out; int ldc;
    __device__ __forceinline__ void operator()(const f32x4 (&acc)[2][2][4][2], const Unit& u, int wr, int wc, int fr, int fq) const {
        const int row0 = u.pm * BM + wr * 64 + fr, col0 = u.pn * BM + wc * 32 + 4 * fq;
#pragma unroll
        for (int ai = 0; ai < 2; ++ai)
#pragma unroll
            for (int m = 0; m < 4; ++m) { const size_t off = (size_t)(row0 + ai * HALF + m * 16) * ldc + col0;
#pragma unroll
                for (int bj = 0; bj < 2; ++bj)
#pragma unroll
                    for (int n = 0; n < 2; ++n) { const f32x4 r = *(const f32x4*)(res + off + bj * HALF + n * 16); *(f32x4*)(out + off + bj * HALF + n * 16) = r + acc[ai][bj][m][n]; } }
    }
};
struct EpiResBf16 {
    static constexpr bool PERM = true, AFTER_DRAIN = false;
    const float* res32; const bf16_t* res16; bf16_t* out16; int ldc; float* rss;
    __device__ __forceinline__ void operator()(const f32x4 (&acc)[2][2][4][2], const Unit& u, int wr, int wc, int fr, int fq) const {
        const int row0 = u.pm * BM + wr * 64 + fr, col0 = u.pn * BM + wc * 32 + 8 * fq;
#pragma unroll
        for (int ai = 0; ai < 2; ++ai)
#pragma unroll
            for (int m = 0; m < 4; ++m) { const size_t off = (size_t)(row0 + ai * HALF + m * 16) * ldc + col0; float ss = 0.f;
#pragma unroll
                for (int bj = 0; bj < 2; ++bj) { f32x4 r0, r1;
                    if (res32) { r0 = *(const f32x4*)(res32 + off + bj * HALF); r1 = *(const f32x4*)(res32 + off + bj * HALF + 4); }
                    else { const u32x4 h = *(const u32x4*)(res16 + off + bj * HALF);
                        r0 = (f32x4){__builtin_bit_cast(float, h.x << 16), __builtin_bit_cast(float, h.x & 0xffff0000u), __builtin_bit_cast(float, h.y << 16), __builtin_bit_cast(float, h.y & 0xffff0000u)};
                        r1 = (f32x4){__builtin_bit_cast(float, h.z << 16), __builtin_bit_cast(float, h.z & 0xffff0000u), __builtin_bit_cast(float, h.w << 16), __builtin_bit_cast(float, h.w & 0xffff0000u)}; }
                    r0 = r0 + acc[ai][bj][m][0]; r1 = r1 + acc[ai][bj][m][1];
                    ss += (r0[0] * r0[0] + r0[1] * r0[1]) + (r0[2] * r0[2] + r0[3] * r0[3]) + (r1[0] * r1[0] + r1[1] * r1[1]) + (r1[2] * r1[2] + r1[3] * r1[3]);
                    *(u32x4*)(out16 + off + bj * HALF) = pack8(r0, r1); }
                if (rss) { ss += __shfl_xor(ss, 16); ss += __shfl_xor(ss, 32); if (fq == 0) atomicAdd(rss + row0 + ai * HALF + m * 16, ss); } }
    }
};
template <class Epi, class Sched, bool ALIGN_EPI = false, bool SP2 = false>
__device__ __forceinline__ void gemm_phase(PG8_LAS unsigned char* lds, const Gemm g, const Sched& S, const Epi& E, const int wave_in) {
    const int lane = pg8_lane_id(), wid = wave_in, tid = wid * 64 + lane, wr = wid >> 2, wc = wid & 3, fr = lane & 15, fq = lane >> 4;
    const int K = g.K, nt = K / BK;
    unsigned voffA[2], voffB[2];
#pragma unroll
    for (int i = 0; i < 2; ++i) { int R, C; stage_rc(tid * 16 + i * 8192, R, C); const int Rb = Epi::PERM ? ((R & ~31) + perm32(R & 31)) : R;
        voffA[i] = (unsigned)(R * K + C) * 2u; voffB[i] = (unsigned)(Rb * K + C) * 2u; }
    const size_t kstep = (size_t)(BK * 2);
    const size_t hstep = (size_t)HALF * K * 2;
    const size_t tstep = 2 * hstep;
    const unsigned ldsw = (unsigned)wid * 1024u;
    const int aoff = lds_byte(wr * 64 + fr, fq * 8), boff = lds_byte(wc * 32 + fr, fq * 8);
#define PG8_SA(b, h) (((b) * 2 + (h)) * HTB)
#define PG8_SB(b, h) ((4 + (b) * 2 + (h)) * HTB)
#define PG8_STAGE(bufoff, gbase, voff) do { _Pragma("unroll") for (int _i = 0; _i < 2; ++_i) \
        __builtin_amdgcn_global_load_lds((const unsigned*)((const char*)(gbase) + (voff)[_i]), (PG8_LAS unsigned*)(lds + (bufoff) + ldsw + _i * 8192), 16, 0, 0); } while (0)
#define PG8_LDA(dst, b, h) do { _Pragma("unroll") for (int m = 0; m < 4; ++m) _Pragma("unroll") for (int k = 0; k < 2; ++k) dst[m][k] = *(const PG8_LAS bf16x8*)(lds + PG8_SA(b, h) + aoff + m * 2048 + k * 1024); } while (0)
#define PG8_LDB(dst, b, h) do { _Pragma("unroll") for (int n = 0; n < 2; ++n) _Pragma("unroll") for (int k = 0; k < 2; ++k) dst[n][k] = *(const PG8_LAS bf16x8*)(lds + PG8_SB(b, h) + boff + n * 2048 + k * 1024); } while (0)
#define PG8_MMA(ai, bj, At, Bt) do { __builtin_amdgcn_s_setprio(1); _Pragma("unroll") for (int m = 0; m < 4; ++m) _Pragma("unroll") for (int n = 0; n < 2; ++n) _Pragma("unroll") for (int k = 0; k < 2; ++k) \
        acc[ai][bj][m][n] = __builtin_amdgcn_mfma_f32_16x16x32_bf16(Bt[n][k], At[m][k], acc[ai][bj][m][n], 0, 0, 0); __builtin_amdgcn_s_setprio(0); } while (0)
#define PG8_WAIT_V(n) asm volatile("s_waitcnt vmcnt(" #n ")" ::: "memory")
#define PG8_WAIT_L(n) asm volatile("s_waitcnt lgkmcnt(" #n ")" ::: "memory")
#define PG8_BAR __builtin_amdgcn_s_barrier()
#define PG8_SCHED __builtin_amdgcn_sched_barrier(0)
    Unit cur, nxt; int ui = 0;
    if (!S.next(0, cur)) return;
    f32x4 acc[2][2][4][2];
#pragma unroll
    for (int a = 0; a < 2; ++a)
#pragma unroll
        for (int b = 0; b < 2; ++b)
#pragma unroll
            for (int m = 0; m < 4; ++m)
#pragma unroll
                for (int n = 0; n < 2; ++n) acc[a][b][m][n] = (f32x4){0.f, 0.f, 0.f, 0.f};
    bf16x8 At[4][2], B0[2][2], B1[2][2];
#define PG8_UA(u) ((u).sw ? (const char*)g.Bt + (size_t)(u).pn * tstep : (const char*)g.A + (size_t)(u).pm * tstep)
#define PG8_UB(u) ((u).sw ? (const char*)g.A + (size_t)(u).pm * tstep : (const char*)g.Bt + (size_t)(u).pn * tstep)
    const char* cA = PG8_UA(cur); const char* cB = PG8_UB(cur);
    S.a_ready(cur);
    if constexpr (SP2) {
        PG8_STAGE(PG8_SB(0, 0), cB, voffB); PG8_STAGE(PG8_SB(0, 1), cB + hstep, voffB); PG8_STAGE(PG8_SA(0, 0), cA, voffA); PG8_STAGE(PG8_SA(0, 1), cA + hstep, voffA);
        if (wr == 1) PG8_BAR;
        PG8_WAIT_V(2); PG8_BAR;
        PG8_STAGE(PG8_SB(1, 0), cB + kstep, voffB); PG8_STAGE(PG8_SA(1, 0), cA + kstep, voffA); PG8_STAGE(PG8_SB(1, 1), cB + hstep + kstep, voffB);
        PG8_WAIT_V(6); PG8_BAR;
    } else {
        PG8_STAGE(PG8_SB(0, 0), cB, voffB); PG8_STAGE(PG8_SA(0, 0), cA, voffA); PG8_STAGE(PG8_SB(0, 1), cB + hstep, voffB); PG8_STAGE(PG8_SA(0, 1), cA + hstep, voffA);
        if (wr == 1) PG8_BAR;
        PG8_WAIT_V(4); PG8_BAR;
        PG8_STAGE(PG8_SB(1, 0), cB + kstep, voffB); PG8_STAGE(PG8_SA(1, 0), cA + kstep, voffA); PG8_STAGE(PG8_SB(1, 1), cB + hstep + kstep, voffB);
        PG8_WAIT_V(6); PG8_BAR;
    }
    for (;;) {
        const bool has_next = S.next(ui + 1, nxt);
        const char* nA = has_next ? PG8_UA(nxt) : cA; const char* nB = has_next ? PG8_UB(nxt) : cB;
        for (int t = 0; t < nt; t += 2) {
            const bool last = (t == nt - 2);
            const char* a1 = cA + (size_t)(t + 1) * kstep;
            const char* a2 = last ? nA : cA + (size_t)(t + 2) * kstep; const char* b2 = last ? nB : cB + (size_t)(t + 2) * kstep;
            const char* a3 = a2 + kstep; const char* b3 = b2 + kstep;
            if (last && has_next) S.a_ready(nxt);
            if constexpr (SP2) {
            PG8_LDB(B0, 0, 0); PG8_LDB(B1, 0, 1); PG8_SCHED; PG8_LDA(At, 0, 0); PG8_STAGE(PG8_SA(1, 1), a1 + hstep, voffA);
            PG8_WAIT_V(8); PG8_WAIT_L(0); PG8_BAR; PG8_MMA(0, 0, At, B0); PG8_MMA(0, 1, At, B1); PG8_BAR; PG8_SCHED;
            PG8_LDA(At, 0, 1); PG8_STAGE(PG8_SB(0, 0), b2, voffB); PG8_STAGE(PG8_SB(0, 1), b2 + hstep, voffB); PG8_STAGE(PG8_SA(0, 0), a2, voffA);
            PG8_WAIT_V(8); PG8_WAIT_L(0); PG8_BAR; PG8_MMA(1, 0, At, B0); PG8_MMA(1, 1, At, B1); PG8_BAR; PG8_SCHED;
            PG8_LDB(B0, 1, 0); PG8_LDB(B1, 1, 1); PG8_SCHED; PG8_LDA(At, 1, 0); PG8_STAGE(PG8_SA(0, 1), a2 + hstep, voffA);
            PG8_WAIT_V(8); PG8_WAIT_L(0); PG8_BAR; PG8_MMA(0, 0, At, B0); PG8_MMA(0, 1, At, B1); PG8_BAR; PG8_SCHED;
            PG8_LDA(At, 1, 1); PG8_STAGE(PG8_SB(1, 0), b3, voffB); PG8_STAGE(PG8_SB(1, 1), b3 + hstep, voffB); PG8_STAGE(PG8_SA(1, 0), a3, voffA);
            PG8_WAIT_V(8); PG8_WAIT_L(0); PG8_BAR; PG8_MMA(1, 0, At, B0); PG8_MMA(1, 1, At, B1); PG8_BAR; PG8_SCHED;
            } else {
            PG8_LDB(B0, 0, 0); PG8_SCHED; PG8_LDA(At, 0, 0); PG8_STAGE(PG8_SA(1, 1), a1 + hstep, voffA);
            PG8_WAIT_L(8); PG8_BAR; PG8_WAIT_L(0); PG8_MMA(0, 0, At, B0); PG8_BAR; PG8_SCHED;
            PG8_LDB(B1, 0, 1); PG8_STAGE(PG8_SB(0, 0), b2, voffB);
            PG8_BAR; PG8_WAIT_L(0); PG8_MMA(0, 1, At, B1); PG8_BAR;
            PG8_LDA(At, 0, 1); PG8_STAGE(PG8_SA(0, 0), a2, voffA);
            PG8_BAR; PG8_WAIT_L(0); PG8_MMA(1, 0, At, B0); PG8_BAR; PG8_SCHED;
            PG8_STAGE(PG8_SB(0, 1), b2 + hstep, voffB);
            PG8_WAIT_V(6); PG8_BAR; PG8_MMA(1, 1, At, B1); PG8_BAR;
            PG8_LDB(B0, 1, 0); PG8_SCHED; PG8_LDA(At, 1, 0); PG8_STAGE(PG8_SA(0, 1), a2 + hstep, voffA);
            PG8_WAIT_L(8); PG8_BAR; PG8_WAIT_L(0); PG8_MMA(0, 0, At, B0); PG8_BAR; PG8_SCHED;
            PG8_LDB(B1, 1, 1); PG8_STAGE(PG8_SB(1, 0), b3, voffB);
            PG8_BAR; PG8_WAIT_L(0); PG8_MMA(0, 1, At, B1); PG8_BAR;
            PG8_LDA(At, 1, 1); PG8_STAGE(PG8_SA(1, 0), a3, voffA);
            PG8_BAR; PG8_WAIT_L(0); PG8_MMA(1, 0, At, B0); PG8_BAR; PG8_SCHED;
            PG8_STAGE(PG8_SB(1, 1), b3 + hstep, voffB);
            PG8_WAIT_V(6); PG8_BAR; PG8_MMA(1, 1, At, B1); PG8_BAR;
            }
        }
        if constexpr (ALIGN_EPI) { if (wr == 0) PG8_BAR; }
        if constexpr (!Epi::AFTER_DRAIN) { E(acc, cur, wr, wc, fr, fq); S.done(cur); }
        if (!has_next) break;
#pragma unroll
        for (int a = 0; a < 2; ++a)
#pragma unroll
            for (int b = 0; b < 2; ++b)
#pragma unroll
                for (int m = 0; m < 4; ++m)
#pragma unroll
                    for (int n = 0; n < 2; ++n) acc[a][b][m][n] = (f32x4){0.f, 0.f, 0.f, 0.f};
        cur = nxt; cA = nA; cB = nB; ++ui;
        if constexpr (ALIGN_EPI) { if (wr == 1) PG8_BAR; }
    }
    PG8_WAIT_V(0);
    if constexpr (!ALIGN_EPI) { if (wr == 0) PG8_BAR; }
    PG8_BAR;
    if constexpr (Epi::AFTER_DRAIN) { E.fused(acc, cur, wr, wc, fr, fq, lds, wid, lane); S.done(cur); }
#undef PG8_UA
#undef PG8_UB
#undef PG8_SA
#undef PG8_SB
#undef PG8_STAGE
#undef PG8_LDA
#undef PG8_LDB
#undef PG8_MMA
#undef PG8_WAIT_V
#undef PG8_WAIT_L
#undef PG8_BAR
#undef PG8_SCHED
}
}
#define GAS __attribute__((address_space(1)))
#define LAS __attribute__((address_space(3)))
#define XB_TMO      128
#define XB_XCNT(j)  (256  + 64 * (j))
#define XB_XSUB(j)  (1280 + 64 * (j))
#define XB_XGEN(j)  (2304 + 64 * (j))
#define XB_TOP      3328
#define XB_TOPGEN   3392
#define XCD_BAR_WORDS 3456
#define XB_SPIN_CAP (1u << 18)

__device__ __forceinline__ unsigned xb_ld(unsigned* p)              { return __hip_atomic_load(p, __ATOMIC_RELAXED, __HIP_MEMORY_SCOPE_AGENT); }
__device__ __forceinline__ unsigned xb_add(unsigned* p, unsigned v) { return __hip_atomic_fetch_add(p, v, __ATOMIC_RELAXED, __HIP_MEMORY_SCOPE_AGENT); }
__device__ __forceinline__ unsigned xb_xcc_id() { return (unsigned)__builtin_amdgcn_s_getreg((3 << 11) | 20) & 0xFu; }
#define XB_SPIN(cond, bar) do { unsigned _sp = 0; while (cond) { __builtin_amdgcn_s_sleep(1); \
    if ((++_sp & 255u) == 0u) { if (xb_ld(&(bar)[XB_TMO])) break; if (_sp > XB_SPIN_CAP) { atomicAdd(&(bar)[XB_TMO], 1u); break; } } } } while (0)

struct XcdBarrier {
    unsigned* bar; unsigned x; int w0;
    volatile LAS unsigned* st;
};

__device__ __forceinline__ XcdBarrier xcd_barrier_post(unsigned* bar, volatile LAS unsigned* st, int wave) {
    XcdBarrier b; b.bar = bar; b.x = xb_xcc_id(); b.st = st; b.w0 = (wave == 0);
    if (b.w0 && pg8::pg8_lane_id() == 0) (void)xb_add(&bar[XB_XCNT(b.x)], 1u);
    return b;
}
__device__ __forceinline__ void xcd_barrier_complete(unsigned* bar, unsigned x, unsigned& nloc, unsigned& nx) {
    const unsigned G = gridDim.x * gridDim.y * gridDim.z;
    unsigned sum, cnt, mine, sp = 0u;
    for (;;) {
        sum = 0u; cnt = 0u; mine = 0u;
#pragma unroll
        for (unsigned j = 0; j < 16; ++j) { const unsigned c = xb_ld(&bar[XB_XCNT(j)]); sum += c; cnt += (c > 0u) ? 1u : 0u; mine = (j == x) ? c : mine; }
        if (sum == G) break;
        __builtin_amdgcn_s_sleep(1);
        if ((++sp & 255u) == 0u) { if (xb_ld(&bar[XB_TMO])) break; if (sp > XB_SPIN_CAP) { atomicAdd(&bar[XB_TMO], 1u); break; } }
    }
    nloc = mine > 0u ? mine : 1u; nx = cnt > 0u ? cnt : 1u;
}

__device__ __forceinline__ void xcd_barrier(const XcdBarrier& b) {
    asm volatile("s_waitcnt vmcnt(0)" ::: "memory");
    __syncthreads();
    if (b.w0 && pg8::pg8_lane_id() == 0) {
        unsigned* bar = b.bar;
        __builtin_amdgcn_s_waitcnt(0);
        unsigned nloc = b.st[0], nx = b.st[1];
        if (nloc == 0u) { xcd_barrier_complete(bar, b.x, nloc, nx); b.st[0] = nloc; b.st[1] = nx; }
        const unsigned old = xb_add(&bar[XB_XSUB(b.x)], 1u);
        const unsigned gen = old / nloc;
        if (old + 1u == (gen + 1u) * nloc) {
            __builtin_amdgcn_fence(__ATOMIC_RELEASE, "agent");
            asm volatile("s_waitcnt vmcnt(0)" ::: "memory");
            const unsigned og = xb_add(&bar[XB_TOP], 1u);
            const unsigned tg = og / nx;
            if (og + 1u == (tg + 1u) * nx) xb_add(&bar[XB_TOPGEN], 1u);
            else XB_SPIN(xb_ld(&bar[XB_TOPGEN]) == tg, bar);
            __builtin_amdgcn_fence(__ATOMIC_ACQUIRE, "agent");
            xb_add(&bar[XB_XGEN(b.x)], 1u);
            asm volatile("s_waitcnt vmcnt(0)" ::: "memory");
        } else {
            XB_SPIN(xb_ld(&bar[XB_XGEN(b.x)]) == gen, bar);
            __builtin_amdgcn_fence(__ATOMIC_ACQUIRE, "agent");
            asm volatile("s_waitcnt vmcnt(0)" ::: "memory");
        }
    }
    __syncthreads();
}
#ifndef MK_N_LAUNCHES
#define MK_N_LAUNCHES 1
#endif
#ifndef PROBE_DMA2
#define PROBE_DMA2 0
#endif
#if PROBE_DMA2
#define VMCNT12 "s_waitcnt vmcnt(24)"
#else
#define VMCNT12 "s_waitcnt vmcnt(12)"
#endif
#ifndef PROBE_NODMA
#define PROBE_NODMA 0
#endif
#ifndef PROBE_NOSLICE
#define PROBE_NOSLICE 0
#endif
#ifndef PROBE_SCAN2
#define PROBE_SCAN2 0
#endif
#ifndef PROBE_STORE2
#define PROBE_STORE2 0
#endif
#ifndef GDN_PREFETCH
#define GDN_PREFETCH 1
#endif
#ifndef RET_PREFETCH
#define RET_PREFETCH 1
#endif
#ifndef PROBE_SEG
#define PROBE_SEG 0
#endif
#define SEG_MINE(k) ((PROBE_SEG) == (k) && blockIdx.x == (((k) <= 5) ? 32 : 0) && F.wave == ((((k) >= 3 && (k) <= 5)) ? 4 : 0))
#define SEG_T0(k) do { if (SEG_MINE(k)) seg_t0_ = __builtin_amdgcn_s_memtime(); } while (0)
#define SEG_ACC(k) do { if (SEG_MINE(k)) seg_acc_ += __builtin_amdgcn_s_memtime() - seg_t0_; } while (0)
#define SEG_T02(k) do { if (SEG_MINE(k)) seg_t1_ = __builtin_amdgcn_s_memtime(); } while (0)
#define SEG_ACC2(k) do { if (SEG_MINE(k)) seg_acc_ += __builtin_amdgcn_s_memtime() - seg_t1_; } while (0)
#define SEG_OUT() do { if ((PROBE_SEG) > 0 && SEG_MINE(PROBE_SEG) && pg8::pg8_lane_id() == 0) __hip_atomic_store((unsigned*)(F.ws + WS_CTL) + 20000, (unsigned)(seg_acc_ >> 7), __ATOMIC_RELAXED, __HIP_MEMORY_SCOPE_AGENT); } while (0)
constexpr int NWAVES = 8;
constexpr int NPHASES = 10;
constexpr int BATCH = 2, SEQ = 8192, D = 2048, T = BATCH * SEQ;
constexpr int NH = 8, DK = 128, DV = 256;
constexpr int NIN = 16400;
constexpr int OFF_AZ = 4096, OFF_AB = 6144, OFF_RQ = 6160, OFF_RK = 7184, OFF_RV = 8208, OFF_RG = 10256, OFF_GA = 12304, OFF_GB = 14352;
constexpr int N1 = 17408;
constexpr int FF = 5632, NGU = 2 * FF;
constexpr float EPS = 1e-6f;
constexpr size_t MiB = 1u << 20;
constexpr size_t WS_CTL = 0, CTL_ZERO_BYTES = 1 * MiB;
constexpr size_t WS_BETA = 1 * MiB, WS_G = 1 * MiB + 512 * 1024;
constexpr size_t WS_COS = 2 * MiB, WS_SIN = 4 * MiB;
constexpr size_t WS_COS2 = 6 * MiB, WS_SIN2 = 8 * MiB;
constexpr size_t WS_DL = 10 * MiB, WS_RSTD = 11 * MiB;
constexpr size_t WS_WOT = 12 * MiB;
constexpr size_t WS_WGUT = 20 * MiB, WS_WDT = 64 * MiB;
constexpr size_t WS_W1T = 20 * MiB, WS_U = 88 * MiB;
constexpr size_t WS_GW = 20 * MiB, WS_GQ = 52 * MiB, WS_GK = 84 * MiB, WS_GA = 116 * MiB, WS_GU = 132 * MiB;
constexpr size_t WS_QKV = 196 * MiB;
constexpr size_t WS_RQF = 324 * MiB, WS_RKF = 356 * MiB, WS_RKTF = 388 * MiB, WS_RVTF = 420 * MiB, WS_END = 484 * MiB;
constexpr size_t WS_OA = 196 * MiB;
constexpr size_t WS_OB = 260 * MiB;
constexpr size_t WS_MIXED = 132 * MiB;
constexpr size_t WS_HNB = 324 * MiB;
constexpr size_t WS_H = 388 * MiB;
constexpr size_t WS_ACT = 88 * MiB;
static_assert(WS_ACT + (size_t)T * FF * 2 <= WS_HNB, "ACT overlay");
constexpr int CW_BAR = 4096;
constexpr int RING_BYTES = 131072, SCAN_RING_BYTES = 147456 + 12288, LDSCTL_OFF = SCAN_RING_BYTES, MISC_OFF = LDSCTL_OFF + 320, LDS_BYTES = 163840;

typedef unsigned short bf16;
typedef unsigned v4u __attribute__((ext_vector_type(4)));
typedef unsigned v2u __attribute__((ext_vector_type(2)));
typedef float f32x4 __attribute__((ext_vector_type(4)));
#define LDS_WAIT() asm volatile("s_waitcnt lgkmcnt(0)" ::: "memory")
__device__ __forceinline__ unsigned f2bf(float f) { unsigned u = __builtin_bit_cast(unsigned, f); return (u + 0x7fffu + ((u >> 16) & 1u)) >> 16; }
__device__ __forceinline__ unsigned pk2(float lo, float hi) { return f2bf(lo) | (f2bf(hi) << 16); }
__device__ __forceinline__ float bf2f(unsigned b) { return __builtin_bit_cast(float, b << 16); }
__device__ __forceinline__ float bflo(unsigned w) { return __builtin_bit_cast(float, w << 16); }
__device__ __forceinline__ float bfhi(unsigned w) { return __builtin_bit_cast(float, w & 0xffff0000u); }
__device__ __forceinline__ float silu_f(float a) { return a * __builtin_amdgcn_rcpf(1.0f + __expf(-a)); }
__device__ __forceinline__ float wave_sum(float v) {
#pragma unroll
    for (int o = 1; o < 64; o <<= 1) v += __shfl_xor(v, o);
    return v;
}

struct Args { const float* in[14]; float* out; unsigned char* ws; int ph_lo, ph_hi; };
struct Frame {
    LAS unsigned char* lds; int tid, lane, wave, vcu, G;
    const float *x, *norm1_w, *w_in, *conv_w, *a_log, *dt_bias, *gdn_norm_w, *ret_norm_w, *w_out, *norm2_w, *w_gate, *w_up, *w_down, *norm_f_w;
    float* out; unsigned char* ws;
};

__device__ __forceinline__ void transpose_blk(const float* src, int ld, int k0, int sc0, bf16* dst, int K, int dr0, LAS float* scr, int lane, const float* kscale = nullptr) {
    f32x4 v[16];
#pragma unroll
    for (int i = 0; i < 16; ++i) v[i] = *(const f32x4*)(src + (size_t)(k0 + 4 * i + (lane >> 4)) * ld + sc0 + 4 * (lane & 15));
    if (kscale) {
#pragma unroll
        for (int i = 0; i < 16; ++i) v[i] = v[i] * kscale[k0 + 4 * i + (lane >> 4)]; }
#pragma unroll
    for (int i = 0; i < 16; ++i) { LAS float* d = scr + (4 * i + (lane >> 4)) * 65 + 4 * (lane & 15); d[0] = v[i].x; d[1] = v[i].y; d[2] = v[i].z; d[3] = v[i].w; }
    LDS_WAIT(); asm volatile("" ::: "memory");
    const int c = lane & 7;
#pragma unroll
    for (int j = 0; j < 8; ++j) { const int n = (lane >> 3) + 8 * j; const LAS float* s = scr + (8 * c) * 65 + n;
        v4u o; o.x = pk2(s[0 * 65], s[1 * 65]); o.y = pk2(s[2 * 65], s[3 * 65]); o.z = pk2(s[4 * 65], s[5 * 65]); o.w = pk2(s[6 * 65], s[7 * 65]);
        *(v4u*)(dst + (size_t)(dr0 + n) * K + k0 + 8 * c) = o; }
    LDS_WAIT(); asm volatile("" ::: "memory");
}
__device__ __forceinline__ int w1_src_col(int n) {
    if (n < 4096) return n;
    if (n >= 16384) n = n - 16384 + 5120;
    if (n < 6144) { const int isk = n >= 5120, lt = (n - 4096) & 1023, tile = lt >> 8, c = lt & 255, bj = c >> 7, p = c & 127; return (isk ? OFF_RK : OFF_RQ) + (2 * tile + (p >> 6)) * 128 + bj * 64 + (p & 63); }
    if (n < 8192) return OFF_RV + (n - 6144);
    { const int isb = n >= 12288, lt = (n - 8192) & 4095, j = lt >> 8, c = lt & 255, bj = c >> 7, p = c & 127;
      return (isb ? (bj ? OFF_GB : OFF_RG) : (bj ? OFF_GA : OFF_AZ)) + 128 * j + p; }
}
__device__ __forceinline__ void p0_prologue(Frame& F) {
    __syncthreads();
    const int gw = F.vcu * NWAVES + F.wave, NGW = F.G * NWAVES, lane = F.lane;
    {
        LAS float* scr = (LAS float*)(F.lds + F.wave * 16640);
        constexpr int I_1 = (D / 64) * (N1 / 64), I_O = (D / 64) * (D / 64);
        constexpr int NITEMS = I_1 + I_O;
        bf16* W1T = (bf16*)(F.ws + WS_W1T); bf16* WOT = (bf16*)(F.ws + WS_WOT);
        for (int it = gw; it < NITEMS; it += NGW) {
            int r = it;
            if (r < I_1) { const int nb = r % (N1 / 64), kb = r / (N1 / 64); transpose_blk(F.w_in, NIN, 64 * kb, w1_src_col(64 * nb), W1T, D, 64 * nb, scr, lane); continue; } r -= I_1;
            { const int nb = r % (D / 64), kb = r / (D / 64); transpose_blk(F.w_out, D, 64 * kb, 64 * nb, WOT, D, 64 * nb, scr, lane); }
        }
    }
    {
        float* cosT = (float*)(F.ws + WS_COS); float* sinT = (float*)(F.ws + WS_SIN); float* cosT2 = (float*)(F.ws + WS_COS2); float* sinT2 = (float*)(F.ws + WS_SIN2);
        for (int idx = (F.vcu * 512 + F.tid); idx < SEQ * 64; idx += F.G * 512) { const int t = idx >> 6, i = idx & 63;
            const float inv = (float)exp2(-(double)i * (13.287712379549449 / 64.0));
            const float ang = (float)t * inv; const double a = (double)ang; const float cv = (float)cos(a), sv = (float)sin(a);
            cosT[idx] = cv; sinT[idx] = sv; cosT2[i * SEQ + t] = cv; sinT2[i * SEQ + t] = sv; }
    }
    __syncthreads();
    {
        LAS float* wT = (LAS float*)F.lds;
        { f32x4 wv[4][4];
#pragma unroll
          for (int j = 0; j < 4; ++j)
#pragma unroll
            for (int q = 0; q < 4; ++q) wv[j][q] = *(const f32x4*)(F.w_in + (size_t)(F.tid + 512 * j) * NIN + OFF_AB + 4 * q);
#pragma unroll
          for (int j = 0; j < 4; ++j)
#pragma unroll
            for (int q = 0; q < 4; ++q)
#pragma unroll
              for (int e = 0; e < 4; ++e) wT[(4 * q + e) * 2048 + F.tid + 512 * j] = wv[j][q][e]; }
        __syncthreads();
        bf16* U = (bf16*)(F.ws + WS_U); float* BETA = (float*)(F.ws + WS_BETA); float* GG = (float*)(F.ws + WS_G);
        f32x4 nw[8];
#pragma unroll
        for (int j = 0; j < 8; ++j) nw[j] = ((const f32x4*)F.norm1_w)[64 * j + lane];
        for (int row = gw; row < T; row += NGW) {
            asm volatile("" ::: "memory");
            const f32x4* xr = (const f32x4*)(F.x + (size_t)row * D) + lane;
            f32x4 v[8]; float ss = 0.f;
#pragma unroll
            for (int j = 0; j < 8; ++j) { v[j] = xr[64 * j]; ss += (v[j].x * v[j].x + v[j].y * v[j].y) + (v[j].z * v[j].z + v[j].w * v[j].w); }
            const float rstd = rsqrtf(wave_sum(ss) * (1.0f / D) + EPS);
            v2u* o8 = (v2u*)(U + (size_t)row * D) + lane;
#pragma unroll
            for (int j = 0; j < 8; ++j) { v[j] = (v[j] * rstd) * nw[j]; v2u w; w.x = pk2(v[j].x, v[j].y); w.y = pk2(v[j].z, v[j].w); o8[64 * j] = w; }
            float mb = 0.f, ma = 0.f;
#pragma unroll
            for (int c = 0; c < 16; ++c) { float s = 0.f;
#pragma unroll
                for (int j = 0; j < 8; ++j) { const f32x4 w = *(const LAS f32x4*)(wT + c * 2048 + 256 * j + 4 * lane); s += (v[j].x * w.x + v[j].y * w.y) + (v[j].z * w.z + v[j].w * w.w); }
                s = wave_sum(s);
                if (c < 8) mb = (lane == c) ? s : mb; else ma = (lane == c - 8) ? s : ma; }
            if (lane == 8) ((float*)(F.ws + WS_RSTD))[row] = 0.f;
            if (lane < 8) { const float bt = 1.0f / (1.0f + expf(-mb)); const float xa = ma + F.dt_bias[lane]; const float sp = xa > 20.f ? xa : log1pf(expf(xa));
                BETA[(size_t)row * 8 + lane] = bt; GG[(size_t)row * 8 + lane] = -expf(F.a_log[lane]) * sp; }
        }
    }
}

__device__ __forceinline__ void gdn_naive(Frame& F, int bh) {
    const int b = bh >> 3, h = bh & 7, tid = F.tid, c = tid & 255, hh = tid >> 8;
    LAS float* sq = (LAS float*)F.lds; LAS float* sk = sq + 128; LAS float* sv = sq + 256; LAS float* sp = sq + 512; LAS float* sred = sq + 1024;
    const int ch = tid < 128 ? h * 128 + tid : (tid < 256 ? 1024 + h * 128 + (tid - 128) : 2048 + h * 256 + (tid - 256));
    const float cw0 = F.conv_w[0 * 4096 + ch], cw1 = F.conv_w[1 * 4096 + ch], cw2 = F.conv_w[2 * 4096 + ch], cw3 = F.conv_w[3 * 4096 + ch];
    const bf16* raw = (const bf16*)(F.ws + WS_QKV) + (size_t)(b * SEQ) * 4096 + ch;
    const float* BETA = (const float*)(F.ws + WS_BETA) + (size_t)(b * SEQ) * 8 + h; const float* GG = (const float*)(F.ws + WS_G) + (size_t)(b * SEQ) * 8 + h;
    bf16* OA = (bf16*)(F.ws + WS_OA) + (size_t)(b * SEQ) * 2048 + h * 256 + c;
    float S[64];
#pragma unroll
    for (int d = 0; d < 64; ++d) S[d] = 0.f;
    float r0 = 0.f, r1 = 0.f, r2 = 0.f;
    float nraw = bf2f(raw[0]), nbeta = BETA[0], ng = GG[0];
    for (int t = 0; t < SEQ; ++t) {
        const float r3 = nraw, beta = nbeta, eg = expf(ng);
        if (t + 1 < SEQ) { nraw = bf2f(raw[(size_t)(t + 1) * 4096]); nbeta = BETA[(size_t)(t + 1) * 8]; ng = GG[(size_t)(t + 1) * 8]; }
        const float a = r0 * cw0 + r1 * cw1 + r2 * cw2 + r3 * cw3; r0 = r1; r1 = r2; r2 = r3;
        float val = a / (1.0f + expf(-a));
        const float ws_ = wave_sum(val * val);
        if (F.lane == 0) sred[F.wave] = ws_;
        __syncthreads();
        if (tid < 128) { val = val * rsqrtf(sred[0] + sred[1] + EPS) * 0.08838834764831845f; sq[tid] = val; }
        else if (tid < 256) { val = val * rsqrtf(sred[2] + sred[3] + EPS); sk[tid - 128] = val; }
        else sv[tid - 256] = val;
        __syncthreads();
        float p = 0.f;
#pragma unroll
        for (int d = 0; d < 64; ++d) p += sk[hh * 64 + d] * S[d];
        sp[hh * 256 + c] = p;
        __syncthreads();
        const float kS = sp[c] + sp[256 + c];
        const float delta = beta * (sv[c] - eg * kS);
        float o = 0.f;
#pragma unroll
        for (int d = 0; d < 64; ++d) { S[d] = eg * S[d] + sk[hh * 64 + d] * delta; o += sq[hh * 64 + d] * S[d]; }
        __syncthreads();
        sp[hh * 256 + c] = o;
        __syncthreads();
        if (hh == 0) OA[(size_t)t * 2048] = (bf16)f2bf(sp[c] + sp[256 + c]);
    }
}
__device__ __forceinline__ void ffn_weight_copies(Frame& F) {
    const int gw = F.vcu * NWAVES + F.wave, NGW = F.G * NWAVES, lane = F.lane;
    LAS float* scr = (LAS float*)(F.lds + F.wave * 16640);
    constexpr int I_G = (D / 64) * (FF / 64), I_D = (FF / 64) * (D / 64);
    bf16* WGUT = (bf16*)(F.ws + WS_WGUT); bf16* WDT = (bf16*)(F.ws + WS_WDT);
    for (int it = gw; it < 2 * I_G + I_D; it += NGW) {
        int r = it;
        if (r < 2 * I_G) { const int up = r >= I_G; if (up) r -= I_G; const int nb = r % (FF / 64), kb = r / (FF / 64), c0 = 64 * nb;
            transpose_blk(up ? F.w_up : F.w_gate, FF, 64 * kb, c0, WGUT, D, 256 * (c0 >> 7) + 128 * up + (c0 & 127), scr, lane, F.norm2_w); continue; } r -= 2 * I_G;
        { const int nb = r % (D / 64), kb = r / (D / 64); transpose_blk(F.w_down, D, 64 * kb, 64 * nb, WDT, FF, 64 * nb, scr, lane); }
    }
}

typedef float f32x16 __attribute__((ext_vector_type(16)));
typedef short bf16x8 __attribute__((ext_vector_type(8)));
typedef float f32x2_t __attribute__((ext_vector_type(2))); typedef __bf16 bf16x2_t __attribute__((ext_vector_type(2)));
#define MFMA32(a, b, c) __builtin_amdgcn_mfma_f32_32x32x16_bf16((a), (b), (c), 0, 0, 0)
__device__ __forceinline__ unsigned cvtpk_s(float lo, float hi) { f32x2_t v = {lo, hi}; bf16x2_t b = __builtin_convertvector(v, bf16x2_t); return __builtin_bit_cast(unsigned, b); }
#define PACK_STEP(x, s) __builtin_bit_cast(bf16x8, (v4u){cvtpk_s((x)[8 * (s)], (x)[8 * (s) + 1]), cvtpk_s((x)[8 * (s) + 2], (x)[8 * (s) + 3]), cvtpk_s((x)[8 * (s) + 4], (x)[8 * (s) + 5]), cvtpk_s((x)[8 * (s) + 6], (x)[8 * (s) + 7])})
__device__ __forceinline__ bf16 cvt1_bf16(float x) { return (bf16)(cvtpk_s(x, x) & 0xffffu); }
__device__ __forceinline__ bf16x8 ldfrag(const bf16* base, size_t f, int lane) {
#if PROBE_NOSLICE
    bf16x8 z; for (int i = 0; i < 8; ++i) z[i] = (short)(lane + i); asm volatile("" : "+v"(z)); return z;
#endif
    return *(const bf16x8*)(base + f * 512 + lane * 8); }
__device__ __forceinline__ f32x16 zero16() { f32x16 z; for (int i = 0; i < 16; ++i) z[i] = 0.f; return z; }

#define SCAN_BAR_C() do { asm volatile("s_waitcnt lgkmcnt(0)" ::: "memory"); __builtin_amdgcn_s_barrier(); asm volatile("" ::: "memory"); } while (0)
#define SCAN_BAR() do { asm volatile("s_waitcnt vmcnt(0) lgkmcnt(0)" ::: "memory"); __builtin_amdgcn_s_barrier(); asm volatile("" ::: "memory"); } while (0)
__device__ __forceinline__ void glds1k(const bf16* gsrc_frag, LAS unsigned char* dst, int lane) {
#if PROBE_NODMA
    return;
#endif
    __builtin_amdgcn_global_load_lds((const unsigned*)(gsrc_frag + lane * 8), (LAS unsigned*)dst, 16, 0, 0);
#if PROBE_DMA2
    __builtin_amdgcn_global_load_lds((const unsigned*)(gsrc_frag + lane * 8), (LAS unsigned*)dst, 16, 0, 0);
#endif
}
__device__ __forceinline__ void dma_chunk3(const bf16* p0, const bf16* p1, const bf16* p2, LAS unsigned char* dst_lw, int lane) {
#pragma unroll
    for (int q = 0; q < 4; ++q) glds1k(p0 + q * 2048, dst_lw + (0 * 16 + 4 * q) * 1024, lane);
#pragma unroll
    for (int q = 0; q < 4; ++q) glds1k(p1 + q * 2048, dst_lw + (1 * 16 + 4 * q) * 1024, lane);
#pragma unroll
    for (int q = 0; q < 4; ++q) glds1k(p2 + q * 2048, dst_lw + (2 * 16 + 4 * q) * 1024, lane);
}
__device__ __forceinline__ bf16x8 ldsfrag(const LAS unsigned char* buf, int slot, int lane) { return *(const LAS bf16x8*)(buf + slot * 1024 + lane * 16); }

constexpr int RS_BUF = 48 * 1024, RS_PA = 3 * RS_BUF;
__device__ __forceinline__ void ret_scan_wg(Frame& F, int bh, int half, unsigned* prog) {
    unsigned long long seg_t0_ = 0, seg_t1_ = 0, seg_acc_ = 0; (void)seg_t0_; (void)seg_t1_; (void)seg_acc_;
    const int w = F.wave, b = bh >> 3, h = bh & 7;
    const bf16* RQf = (const bf16*)(F.ws + WS_RQF); const bf16* RKf = (const bf16*)(F.ws + WS_RKF); const bf16* RKTf = (const bf16*)(F.ws + WS_RKTF); const bf16* RVTf = (const bf16*)(F.ws + WS_RVTF);
    LAS unsigned char* L = F.lds;
    if (w >= 4) {
        const int lw = w - 4, lane = pg8::pg8_lane_id(), col = lane & 31, hh = lane >> 5;
        const bf16* pq = RQf + ((size_t)bh * 128 * 16 + lw) * 512; const bf16* pk = RKf + ((size_t)bh * 128 * 16 + lw) * 512; const bf16* pt = RKTf + ((size_t)bh * 128 * 16 + lw) * 512;
        dma_chunk3(pq, pk, pt, L + 0 * RS_BUF + lw * 1024, lane); pq += 8192; pk += 8192; pt += 8192;
        dma_chunk3(pq, pk, pt, L + 1 * RS_BUF + lw * 1024, lane); pq += 8192; pk += 8192; pt += 8192;
        asm volatile(VMCNT12 ::: "memory"); __builtin_amdgcn_s_barrier(); asm volatile("" ::: "memory");
        int cb = 0, nb = 2;
        for (int n = 0; n < 128; ++n) {
            const LAS unsigned char* B = L + cb * RS_BUF;
            if (lw < 3) {
                const int tj = lw == 2 ? 1 : 0, ti = lw == 0 ? 0 : 1;
                f32x16 P = zero16();
#pragma unroll
                for (int td = 0; td < 4; ++td)
#pragma unroll
                    for (int s2 = 0; s2 < 2; ++s2) P = MFMA32(ldsfrag(B, 16 + (tj * 4 + td) * 2 + s2, lane), ldsfrag(B, (ti * 4 + td) * 2 + s2, lane), P);
                if (lw != 1) {
#pragma unroll
                    for (int r = 0; r < 16; ++r) { const int j = (r & 3) + 8 * (r >> 2) + 4 * hh; if (col < j) P[r] = 0.f; } }
                const bf16x8 a0 = PACK_STEP(P, 0), a1 = PACK_STEP(P, 1);
                *(LAS bf16x8*)(L + RS_PA + (2 * lw) * 1024 + lane * 16) = a0; *(LAS bf16x8*)(L + RS_PA + (2 * lw + 1) * 1024 + lane * 16) = a1;
            }
            asm volatile("s_waitcnt lgkmcnt(0)" ::: "memory"); __builtin_amdgcn_s_barrier(); asm volatile("" ::: "memory");
            if (n + 2 < 128) { dma_chunk3(pq, pk, pt, L + nb * RS_BUF + lw * 1024, lane); pq += 8192; pk += 8192; pt += 8192;
                asm volatile(VMCNT12 ::: "memory"); }
            else asm volatile("s_waitcnt vmcnt(0)" ::: "memory");
            __builtin_amdgcn_s_barrier(); asm volatile("" ::: "memory");
            if (lw == 0 && half == 0 && lane == 0) __hip_atomic_store(prog, (unsigned)(n + 1), __ATOMIC_RELAXED, __HIP_MEMORY_SCOPE_AGENT);
            cb = cb == 2 ? 0 : cb + 1; nb = nb == 2 ? 0 : nb + 1;
        }
        return;
    }
    const int sl = 4 * half + w, lane = pg8::pg8_lane_id(), col = lane & 31, hh = lane >> 5;
    bf16* OB = (bf16*)(F.ws + WS_OB) + (size_t)(b * SEQ) * 2048 + h * 256 + sl * 32;
    const unsigned loff = (unsigned)(hh * 4 * 2048 + col);
    const float g64 = exp2f(64.0f * log2f(1.0f - exp2f(-5.0f - (float)h)));
    f32x16 S[4];
#pragma unroll
    for (int td = 0; td < 4; ++td) S[td] = zero16();
#if RET_PREFETCH
    bf16x8 vtn[2][2];
    { const size_t cq = (size_t)bh * 128;
#pragma unroll
      for (int tj = 0; tj < 2; ++tj)
#pragma unroll
        for (int s2 = 0; s2 < 2; ++s2) vtn[tj][s2] = ldfrag(RVTf, ((cq * 8 + sl) * 2 + tj) * 2 + s2, lane); }
#endif
    SCAN_BAR_C();
    int cb = 0;
    for (int n = 0; n < 128; ++n) { SEG_T02(6);
        const LAS unsigned char* B = L + cb * RS_BUF; cb = cb == 2 ? 0 : cb + 1;
        bf16x8 vt[2][2];
#if RET_PREFETCH
#pragma unroll
        for (int tj = 0; tj < 2; ++tj)
#pragma unroll
            for (int s2 = 0; s2 < 2; ++s2) vt[tj][s2] = vtn[tj][s2];
        if (n + 1 < 128) { const size_t cq = (size_t)bh * 128 + n + 1;
#else
#define vtn vt
        { const size_t cq = (size_t)bh * 128 + n;
#endif
#pragma unroll
          for (int tj = 0; tj < 2; ++tj)
#pragma unroll
            for (int s2 = 0; s2 < 2; ++s2) vtn[tj][s2] = ldfrag(RVTf, ((cq * 8 + sl) * 2 + tj) * 2 + s2, lane); }
#define PIN() do { asm volatile("" ::: "memory"); __builtin_amdgcn_sched_barrier(0); } while (0)
#define LD4(dst, base, s0, s1, s2, s3) do { PIN(); dst[0] = ldsfrag(base, s0, lane); dst[1] = ldsfrag(base, s1, lane); dst[2] = ldsfrag(base, s2, lane); dst[3] = ldsfrag(base, s3, lane); PIN(); } while (0)
#define QSLOT(ti, td, s2) (((ti) * 4 + (td)) * 2 + (s2))
#define KTSLOT(k) (32 + (k))
        bf16x8 fa[4], fb[4];
        const LAS unsigned char* PAb = L + RS_PA;
        f32x16 o0 = zero16(), o1 = zero16();
        LD4(fa, B, QSLOT(0, 0, 0), QSLOT(0, 0, 1), QSLOT(1, 0, 0), QSLOT(1, 0, 1));
        { const bf16x8 sb0 = PACK_STEP(S[0], 0), sb1 = PACK_STEP(S[0], 1);
          LD4(fb, B, QSLOT(0, 1, 0), QSLOT(0, 1, 1), QSLOT(1, 1, 0), QSLOT(1, 1, 1));
          o0 = MFMA32(fa[0], sb0, o0); o0 = MFMA32(fa[1], sb1, o0); o1 = MFMA32(fa[2], sb0, o1); o1 = MFMA32(fa[3], sb1, o1); }
        { const bf16x8 sb0 = PACK_STEP(S[1], 0), sb1 = PACK_STEP(S[1], 1);
          LD4(fa, B, QSLOT(0, 2, 0), QSLOT(0, 2, 1), QSLOT(1, 2, 0), QSLOT(1, 2, 1));
          o0 = MFMA32(fb[0], sb0, o0); o0 = MFMA32(fb[1], sb1, o0); o1 = MFMA32(fb[2], sb0, o1); o1 = MFMA32(fb[3], sb1, o1); }
        { const bf16x8 sb0 = PACK_STEP(S[2], 0), sb1 = PACK_STEP(S[2], 1);
          LD4(fb, B, QSLOT(0, 3, 0), QSLOT(0, 3, 1), QSLOT(1, 3, 0), QSLOT(1, 3, 1));
          o0 = MFMA32(fa[0], sb0, o0); o0 = MFMA32(fa[1], sb1, o0); o1 = MFMA32(fa[2], sb0, o1); o1 = MFMA32(fa[3], sb1, o1); }
        { const bf16x8 sb0 = PACK_STEP(S[3], 0), sb1 = PACK_STEP(S[3], 1);
          o0 = MFMA32(fb[0], sb0, o0); o0 = MFMA32(fb[1], sb1, o0); o1 = MFMA32(fb[2], sb0, o1); o1 = MFMA32(fb[3], sb1, o1); }
        SEG_T0(7); SCAN_BAR_C(); SEG_ACC(7);
#define STORE_O(ox, rowoff) do { _Pragma("unroll") for (int r = 0; r < 16; ++r) { const unsigned ro = (unsigned)(((r & 3) + 8 * (r >> 2)) * 2048); orow[loff + ro + (rowoff)] = cvt1_bf16(ox[r]); } } while (0)
        bf16* orow = OB + (size_t)(64 * n) * 2048;
        LD4(fa, PAb, 0, 1, 2, 3);
        fb[0] = ldsfrag(PAb, 4, lane); fb[1] = ldsfrag(PAb, 5, lane); fb[2] = ldsfrag(B, KTSLOT(0), lane); fb[3] = ldsfrag(B, KTSLOT(1), lane); PIN();
        S[0] = S[0] * g64; S[1] = S[1] * g64;
        o0 = MFMA32(fa[0], vt[0][0], o0); o0 = MFMA32(fa[1], vt[0][1], o0); o1 = MFMA32(fa[2], vt[0][0], o1); o1 = MFMA32(fa[3], vt[0][1], o1);
        LD4(fa, B, KTSLOT(2), KTSLOT(3), KTSLOT(4), KTSLOT(5));
        S[2] = S[2] * g64; S[3] = S[3] * g64;
        o1 = MFMA32(fb[0], vt[1][0], o1); o1 = MFMA32(fb[1], vt[1][1], o1);
        S[0] = MFMA32(fb[2], vt[0][0], S[0]); S[0] = MFMA32(fb[3], vt[0][1], S[0]);
        LD4(fb, B, KTSLOT(6), KTSLOT(7), KTSLOT(8), KTSLOT(9));
        STORE_O(o0, 0u);
        S[0] = MFMA32(fa[0], vt[1][0], S[0]); S[0] = MFMA32(fa[1], vt[1][1], S[0]);
        S[1] = MFMA32(fa[2], vt[0][0], S[1]); S[1] = MFMA32(fa[3], vt[0][1], S[1]);
        LD4(fa, B, KTSLOT(10), KTSLOT(11), KTSLOT(12), KTSLOT(13));
        STORE_O(o1, 32u * 2048u);
        S[1] = MFMA32(fb[0], vt[1][0], S[1]); S[1] = MFMA32(fb[1], vt[1][1], S[1]);
        S[2] = MFMA32(fb[2], vt[0][0], S[2]); S[2] = MFMA32(fb[3], vt[0][1], S[2]);
        PIN(); fb[0] = ldsfrag(B, KTSLOT(14), lane); fb[1] = ldsfrag(B, KTSLOT(15), lane); PIN();
        S[2] = MFMA32(fa[0], vt[1][0], S[2]); S[2] = MFMA32(fa[1], vt[1][1], S[2]);
        S[3] = MFMA32(fa[2], vt[0][0], S[3]); S[3] = MFMA32(fa[3], vt[0][1], S[3]);
        S[3] = MFMA32(fb[0], vt[1][0], S[3]); S[3] = MFMA32(fb[1], vt[1][1], S[3]);
#undef STORE_O
        SEG_T0(8); SCAN_BAR_C(); SEG_ACC(8); SEG_ACC2(6);
    }
    SEG_OUT();
}

#ifndef PROBE_NOSTORE
#define PROBE_NOSTORE 0
#endif
#ifndef PROBE_ONLYSCAN
#define PROBE_ONLYSCAN 0
#endif
#ifndef PROBE_PREP
#define PROBE_PREP 0
#endif
constexpr int GP_QH = 0, GP_KH = 17408, GP_AM = 34816, GP_RK = 51200, GP_GC = 83968, GP_BT = 84224, GP_WL = GP_RK, GP_VR = 84480;
__device__ __forceinline__ void gdn_prep(Frame& F, int ci) {
    int tid_ = F.tid; asm volatile("" : "+v"(tid_));
    const int tid = tid_, lane = tid & 63, w = __builtin_amdgcn_readfirstlane(tid >> 6), bh = ci >> 7, n = ci & 127, b = bh >> 3, h = bh & 7;
    const size_t trow0 = (size_t)b * SEQ + 64 * n;
    LAS unsigned char* L = F.lds;
    LAS float* gcs = (LAS float*)(L + GP_GC); LAS float* bet = (LAS float*)(L + GP_BT); LAS float* Am = (LAS float*)(L + GP_AM); LAS float* Rk = (LAS float*)(L + GP_RK);
    const bf16* QKV = (const bf16*)(F.ws + WS_QKV);
    bf16* GW = (bf16*)(F.ws + WS_GW); bf16* GQ = (bf16*)(F.ws + WS_GQ); bf16* GK = (bf16*)(F.ws + WS_GK); bf16* GA = (bf16*)(F.ws + WS_GA); bf16* GU = (bf16*)(F.ws + WS_GU);
    {
        v4u vr[5];
#pragma unroll
        for (int k = 0; k < 5; ++k) { const int idx = tid + 512 * k, row = idx >> 5, cg = idx & 31; vr[k] = (v4u){0u, 0u, 0u, 0u};
            if (row < 67 && (n > 0 || row >= 3)) vr[k] = *(const v4u*)(QKV + (trow0 + row - 3) * 4096 + 2048 + h * 256 + 8 * cg); }
#pragma unroll
        for (int k = 0; k < 5; ++k) { const int idx = tid + 512 * k, row = idx >> 5, cg = idx & 31; if (row < 67) *(LAS v4u*)(L + GP_VR + row * 512 + cg * 16) = vr[k]; }
    }
    if (w == 0) {
        float g = ((const float*)(F.ws + WS_G))[(trow0 + lane) * 8 + h];
#pragma unroll
        for (int o = 1; o < 64; o <<= 1) { const float t = __shfl_up(g, o); if (lane >= o) g += t; }
        gcs[lane] = g; bet[lane] = ((const float*)(F.ws + WS_BETA))[(trow0 + lane) * 8 + h];
        if (lane == 63) ((float*)(F.ws + WS_DL))[ci] = expf(g);
    }
    __syncthreads();
    for (int pr_ = 0; pr_ < (PROBE_PREP == 1 ? 2 : 1); ++pr_) {
        const int cg = lane & 31, rh = lane >> 5, isk = cg >> 4, dk0 = 8 * (cg & 15), row0 = 8 * w + 4 * rh;
        const int ch = (isk ? 1024 : 0) + h * 128 + dk0;
        float cw[4][8];
#pragma unroll
        for (int j = 0; j < 4; ++j) { const f32x4 a = *(const f32x4*)(F.conv_w + j * 4096 + ch), c = *(const f32x4*)(F.conv_w + j * 4096 + ch + 4);
            cw[j][0] = a.x; cw[j][1] = a.y; cw[j][2] = a.z; cw[j][3] = a.w; cw[j][4] = c.x; cw[j][5] = c.y; cw[j][6] = c.z; cw[j][7] = c.w; }
        float raw[7][8];
#pragma unroll
        for (int rr = 0; rr < 7; ++rr) { const int row = row0 - 3 + rr;
            v4u v = {0u, 0u, 0u, 0u};
            if (n > 0 || row >= 0) v = *(const v4u*)(QKV + (trow0 + row) * 4096 + ch);
#pragma unroll
            for (int e = 0; e < 4; ++e) { raw[rr][2 * e] = bflo(v[e]); raw[rr][2 * e + 1] = bfhi(v[e]); } }
        const float g63 = gcs[63];
#pragma unroll
        for (int r = 0; r < 4; ++r) { asm volatile("" ::: "memory"); const int row = row0 + r; float val[8]; float ss = 0.f;
#pragma unroll
            for (int e = 0; e < 8; ++e) { const float a = raw[r][e] * cw[0][e] + raw[r + 1][e] * cw[1][e] + raw[r + 2][e] * cw[2][e] + raw[r + 3][e] * cw[3][e];
                val[e] = silu_f(a); ss += val[e] * val[e]; }
            ss += __shfl_xor(ss, 1); ss += __shfl_xor(ss, 2); ss += __shfl_xor(ss, 4); ss += __shfl_xor(ss, 8);
            const float rn = rsqrtf(ss + EPS) * (isk ? 1.0f : 0.08838834764831845f);
            const float gc = gcs[row], eg = __expf(gc);
#pragma unroll
            for (int e = 0; e < 8; ++e) val[e] *= rn;
            v4u pk; pk.x = pk2(val[0], val[1]); pk.y = pk2(val[2], val[3]); pk.z = pk2(val[4], val[5]); pk.w = pk2(val[6], val[7]);
            *(LAS v4u*)(L + (isk ? GP_KH : GP_QH) + row * 272 + dk0 * 2) = pk;
            if (!isk) {
                const size_t f = (((size_t)ci * 2 + (row >> 5)) * 4 + (dk0 >> 5)) * 2 + ((dk0 >> 4) & 1);
                bf16* p = GQ + f * 512 + (row & 31) * 8 + ((dk0 >> 3) & 1) * 4;
                v2u a; a.x = pk2(val[0] * eg, val[1] * eg); a.y = pk2(val[2] * eg, val[3] * eg); *(v2u*)p = a;
                a.x = pk2(val[4] * eg, val[5] * eg); a.y = pk2(val[6] * eg, val[7] * eg); *(v2u*)(p + 256) = a;
            } else {
                const float bt = bet[row] * eg;
                f32x4 r0 = {val[0] * bt, val[1] * bt, val[2] * bt, val[3] * bt}, r1 = {val[4] * bt, val[5] * bt, val[6] * bt, val[7] * bt};
                *(LAS f32x4*)(Rk + row * 128 + dk0) = r0; *(LAS f32x4*)(Rk + row * 128 + dk0 + 4) = r1;
                const float ek = __expf(g63 - gc);
#pragma unroll
                for (int e = 0; e < 8; ++e) raw[r][e] = val[e] * ek;
            }
        }
        if (isk) {
            const int tj = w >> 2, s1 = (w >> 1) & 1;
#pragma unroll
            for (int e = 0; e < 8; ++e) { const int dk = dk0 + e;
                const size_t f = (((size_t)ci * 4 + (dk >> 5)) * 2 + tj) * 2 + s1;
                v2u a; a.x = pk2(raw[0][e], raw[1][e]); a.y = pk2(raw[2][e], raw[3][e]);
                *(v2u*)(GK + f * 512 + (rh * 32 + (dk & 31)) * 8 + (w & 1) * 4) = a; }
        }
    }
    __syncthreads();
    for (int pr_ = 0; pr_ < (PROBE_PREP == 2 ? 2 : 1); ++pr_) if (w < 6) {
        const int tsel = w % 3, ti = tsel == 0 ? 0 : 1, tj = tsel == 2 ? 1 : 0;
        const int r = lane & 31, hh = lane >> 5;
        f32x16 acc = zero16();
        if (w < 3) {
#pragma unroll
            for (int kb = 0; kb < 8; ++kb) { const bf16x8 a = *(const LAS bf16x8*)(L + GP_KH + (32 * ti + r) * 272 + (16 * kb + 8 * hh) * 2), bb = *(const LAS bf16x8*)(L + GP_KH + (32 * tj + r) * 272 + (16 * kb + 8 * hh) * 2);
                acc = MFMA32(a, bb, acc); }
            const int j = 32 * tj + r; const float gj = gcs[j];
#pragma unroll
            for (int q = 0; q < 16; ++q) { const int i = 32 * ti + (q & 3) + 8 * (q >> 2) + 4 * hh;
                const float v = (i > j) ? bet[i] * acc[q] * __expf(fminf(gcs[i] - gj, 0.f)) : 0.f; Am[i * 64 + j] = v; }
        } else {
#pragma unroll
            for (int kb = 0; kb < 8; ++kb) { const bf16x8 a = *(const LAS bf16x8*)(L + GP_KH + (32 * tj + r) * 272 + (16 * kb + 8 * hh) * 2), bb = *(const LAS bf16x8*)(L + GP_QH + (32 * ti + r) * 272 + (16 * kb + 8 * hh) * 2);
                acc = MFMA32(a, bb, acc); }
            const int i = 32 * ti + r; const float gi = gcs[i];
#pragma unroll
            for (int q = 0; q < 16; ++q) { const int j = 32 * tj + (q & 3) + 8 * (q >> 2) + 4 * hh;
                acc[q] = (i >= j) ? acc[q] * __expf(fminf(gi - gcs[j], 0.f)) : 0.f; }
            const bf16x8 f0 = PACK_STEP(acc, 0), f1 = PACK_STEP(acc, 1);
            const size_t f = (((size_t)ci * 2 + ti) * 2 + tj) * 2;
            *(bf16x8*)(GA + f * 512 + lane * 8) = f0; *(bf16x8*)(GA + (f + 1) * 512 + lane * 8) = f1;
        }
    }
    __syncthreads();
    float x[64];
    for (int pr_ = 0; pr_ < (PROBE_PREP == 3 ? 2 : 1); ++pr_) if (tid < 384) {
        if (tid < 256) {
            const int ch = 2048 + h * 256 + tid;
            const float c0 = F.conv_w[ch], c1 = F.conv_w[4096 + ch], c2 = F.conv_w[2 * 4096 + ch], c3 = F.conv_w[3 * 4096 + ch];
            const LAS unsigned short* vcol = (const LAS unsigned short*)(L + GP_VR) + tid;
            float r0 = bf2f(vcol[0]), r1 = bf2f(vcol[256]), r2 = bf2f(vcol[512]);
#pragma unroll
            for (int i = 0; i < 64; ++i) { const float r3 = bf2f(vcol[(i + 3) * 256]); const float a = r0 * c0 + r1 * c1 + r2 * c2 + r3 * c3; r0 = r1; r1 = r2; r2 = r3;
                x[i] = bet[i] * silu_f(a); }
        } else {
#pragma unroll
            for (int i = 0; i < 64; ++i) x[i] = Rk[i * 128 + (tid - 256)];
        }
#pragma unroll
        for (int i = 1; i < 64; ++i) { float s0 = 0.f, s1 = 0.f, s2 = 0.f, s3 = 0.f;
            asm volatile("" ::: "memory");
#pragma unroll
            for (int q = 0; q < (i + 3) / 4; ++q) { const f32x4 a = *(const LAS f32x4*)(Am + i * 64 + 4 * q);
                if (4 * q + 0 < i) s0 += a.x * x[4 * q + 0];
                if (4 * q + 1 < i) s1 += a.y * x[4 * q + 1];
                if (4 * q + 2 < i) s2 += a.z * x[4 * q + 2];
                if (4 * q + 3 < i) s3 += a.w * x[4 * q + 3]; }
            x[i] -= (s0 + s1) + (s2 + s3);
            asm volatile("" : "+v"(x[i])); }
        if (tid < 256) {
            const int sl = tid >> 5, col = tid & 31;
#pragma unroll
            for (int ti = 0; ti < 2; ++ti)
#pragma unroll
                for (int hh = 0; hh < 2; ++hh) { v4u a, c;
#define XR(q) x[32 * ti + ((q) & 3) + 8 * ((q) >> 2) + 4 * hh]
                    a.x = pk2(XR(0), XR(1)); a.y = pk2(XR(2), XR(3)); a.z = pk2(XR(4), XR(5)); a.w = pk2(XR(6), XR(7));
                    c.x = pk2(XR(8), XR(9)); c.y = pk2(XR(10), XR(11)); c.z = pk2(XR(12), XR(13)); c.w = pk2(XR(14), XR(15));
#undef XR
                    bf16* p = GU + (((size_t)ci * 8 + sl) * 2 + ti) * 1024 + (hh * 32 + col) * 16;
                    *(v4u*)p = a; *(v4u*)(p + 8) = c; }
        }
    }
    __syncthreads();
    if (tid >= 256 && tid < 384) { const int dk = tid - 256;
#pragma unroll
        for (int i = 0; i < 64; ++i) *(LAS unsigned short*)(L + GP_WL + i * 272 + dk * 2) = (unsigned short)f2bf(-x[i]); }
    __syncthreads();
#pragma unroll
    for (int k = 0; k < 2; ++k) { const int idx = tid + 512 * k, row = idx >> 4, dk0 = 8 * (idx & 15);
        const v4u v = *(const LAS v4u*)(L + GP_WL + row * 272 + dk0 * 2);
        const size_t f = (((size_t)ci * 2 + (row >> 5)) * 4 + (dk0 >> 5)) * 2 + ((dk0 >> 4) & 1);
        bf16* p = GW + f * 512 + (row & 31) * 8 + ((dk0 >> 3) & 1) * 4;
        v2u a; a.x = v.x; a.y = v.y; *(v2u*)p = a; a.x = v.z; a.y = v.w; *(v2u*)(p + 256) = a; }
    __syncthreads();
}

constexpr int GS_BUF = 48 * 1024, GS_GA = 3 * GS_BUF;
__device__ __forceinline__ void gdn_scan_wg(Frame& F, int bh, int half, unsigned* prog) {
    unsigned long long seg_t0_ = 0, seg_t1_ = 0, seg_acc_ = 0; (void)seg_t0_; (void)seg_t1_; (void)seg_acc_;
    const int w = F.wave, b = bh >> 3, h = bh & 7;
    const bf16* GW = (const bf16*)(F.ws + WS_GW); const bf16* GQ = (const bf16*)(F.ws + WS_GQ); const bf16* GK = (const bf16*)(F.ws + WS_GK); const bf16* GA = (const bf16*)(F.ws + WS_GA); const bf16* GU = (const bf16*)(F.ws + WS_GU);
    LAS unsigned char* L = F.lds;
    if (w >= 4) {
        const int lw = w - 4, lane = pg8::pg8_lane_id();
        const bf16* pw = GW + ((size_t)bh * 128 * 16 + lw) * 512; const bf16* pq = GQ + ((size_t)bh * 128 * 16 + lw) * 512; const bf16* pk = GK + ((size_t)bh * 128 * 16 + lw) * 512;
        int bi = 0;
        for (int c = 0; c < 130; ++c) { SEG_T0(3);
            if (c >= 1 && c - 1 < 128 && lw < 3) { const size_t ci = (size_t)bh * 128 + (c - 1); LAS unsigned char* dst = L + GS_GA + ((c - 1) & 1) * 6144;
#pragma unroll
                for (int q = 0; q < 2; ++q) { const int f = 2 * lw + q, gaf = f < 2 ? f : f + 2; glds1k(GA + (ci * 8 + gaf) * 512, dst + f * 1024, lane); } }
            if (c < 128) { dma_chunk3(pw, pq, pk, L + bi * GS_BUF + lw * 1024, lane); pw += 8192; pq += 8192; pk += 8192; }
            if (lw == 0 && half == 0 && lane == 0 && c >= 1) __hip_atomic_store(prog, (unsigned)c, __ATOMIC_RELAXED, __HIP_MEMORY_SCOPE_AGENT);
            bi = bi == 2 ? 0 : bi + 1;
            SEG_ACC(3); if (c >= 1) { SEG_T0(4); if (c < 128) asm volatile(VMCNT12 ::: "memory"); else asm volatile("s_waitcnt vmcnt(0)" ::: "memory"); SEG_ACC(4); SEG_T0(5);
                __builtin_amdgcn_s_barrier(); asm volatile("" ::: "memory"); SEG_ACC(5); }
        }
        SEG_OUT();
        return;
    }
    const int sl = 4 * half + w, lane = pg8::pg8_lane_id(), col = lane & 31, hh = lane >> 5;
    const float* DL = (const float*)(F.ws + WS_DL);
    bf16* OA = (bf16*)(F.ws + WS_OA) + (size_t)(b * SEQ) * 2048 + h * 256 + sl * 32;
    const unsigned loff = (unsigned)(hh * 4 * 2048 + col);
    f32x16 S[4];
#pragma unroll
    for (int td = 0; td < 4; ++td) S[td] = zero16();
    v4u uc[2][2]; float dln;
    { const size_t ci = (size_t)bh * 128; dln = DL[ci];
      const bf16* p = GU + ((ci * 8 + sl) * 2 + 0) * 1024 + lane * 16; uc[0][0] = *(const v4u*)p; uc[0][1] = *(const v4u*)(p + 8); }
    SCAN_BAR_C();
    int cb = 0;
    for (int n = 0; n < 128; ++n) { SEG_T02(1);
        const LAS unsigned char* B = L + cb * GS_BUF; cb = cb == 2 ? 0 : cb + 1;
        const LAS unsigned char* GAb = L + GS_GA + (n & 1) * 6144;
#if GDN_PREFETCH
        const float dl = dln;
#else
        float dl; { const size_t ci = (size_t)bh * 128 + n; dl = DL[ci]; const bf16* p = GU + ((ci * 8 + sl) * 2 + 0) * 1024 + lane * 16; uc[0][0] = *(const v4u*)p; uc[0][1] = *(const v4u*)(p + 8); }
#endif
#define WSLOT(ti, td, s2) (((ti) * 4 + (td)) * 2 + (s2))
#define GKSLOT(k) (32 + (k))
#define LDWQ(dst, ti, td) LD4(dst, B, WSLOT(ti, td, 0), WSLOT(ti, td, 1), 16 + WSLOT(ti, td, 0), 16 + WSLOT(ti, td, 1))
#define ADD_U(v, ti) do { _Pragma("unroll") for (int e = 0; e < 4; ++e) { v[2 * e] += bflo(uc[ti][0][e]); v[2 * e + 1] += bfhi(uc[ti][0][e]); v[8 + 2 * e] += bflo(uc[ti][1][e]); v[8 + 2 * e + 1] += bfhi(uc[ti][1][e]); } } while (0)
#define HALF_TD(F_, td, vnx, ox) { const bf16x8 sb0 = PACK_STEP(S[td], 0), sb1 = PACK_STEP(S[td], 1); \
          vnx = MFMA32(F_[0], sb0, vnx); vnx = MFMA32(F_[1], sb1, vnx); ox = MFMA32(F_[2], sb0, ox); ox = MFMA32(F_[3], sb1, ox); }
        bf16x8 fa[4], fb[4];
        bf16x8 vb00, vb01, vb10, vb11;
        bf16* orow = OA + (size_t)(64 * n) * 2048;
#define STORE_O(ox, rowoff) do { _Pragma("unroll") for (int r = 0; r < 16; ++r) { const unsigned ro = (unsigned)(((r & 3) + 8 * (r >> 2)) * 2048); orow[loff + ro + (rowoff)] = cvt1_bf16(ox[r]); } } while (0)
#define S_TD(F_, td) { S[td] = MFMA32(F_[0], vb00, S[td]); S[td] = MFMA32(F_[1], vb01, S[td]); S[td] = MFMA32(F_[2], vb10, S[td]); S[td] = MFMA32(F_[3], vb11, S[td]); }
        f32x16 vn0 = zero16(), o0 = zero16();
        LDWQ(fa, 0, 0); LDWQ(fb, 0, 1); HALF_TD(fa, 0, vn0, o0)
        LDWQ(fa, 0, 2); HALF_TD(fb, 1, vn0, o0)
        LDWQ(fb, 0, 3); HALF_TD(fa, 2, vn0, o0)
        PIN(); fa[0] = ldsfrag(GAb, 0, lane); fa[1] = ldsfrag(GAb, 1, lane); PIN(); HALF_TD(fb, 3, vn0, o0)
        ADD_U(vn0, 0); vb00 = PACK_STEP(vn0, 0); vb01 = PACK_STEP(vn0, 1);
        LDWQ(fb, 1, 0);
        o0 = MFMA32(fa[0], vb00, o0); o0 = MFMA32(fa[1], vb01, o0);
        { const size_t ci = (size_t)bh * 128 + n; const bf16* p = GU + ((ci * 8 + sl) * 2 + 1) * 1024 + lane * 16; uc[1][0] = *(const v4u*)p; uc[1][1] = *(const v4u*)(p + 8); }
#if GDN_PREFETCH
        if (n + 1 < 128) { const size_t ci = (size_t)bh * 128 + n + 1; dln = DL[ci];
          const bf16* p = GU + ((ci * 8 + sl) * 2 + 0) * 1024 + lane * 16; uc[0][0] = *(const v4u*)p; uc[0][1] = *(const v4u*)(p + 8); }
#endif
        f32x16 vn1 = zero16(), o1 = zero16();
        LDWQ(fa, 1, 1); STORE_O(o0, 0u); HALF_TD(fb, 0, vn1, o1)
        LDWQ(fb, 1, 2); S[0] = S[0] * dl; HALF_TD(fa, 1, vn1, o1)
        LDWQ(fa, 1, 3); S[1] = S[1] * dl; HALF_TD(fb, 2, vn1, o1)
        LD4(fb, GAb, 2, 3, 4, 5); S[2] = S[2] * dl; HALF_TD(fa, 3, vn1, o1)
        ADD_U(vn1, 1); vb10 = PACK_STEP(vn1, 0); vb11 = PACK_STEP(vn1, 1);
        LD4(fa, B, GKSLOT(0), GKSLOT(1), GKSLOT(2), GKSLOT(3)); S[3] = S[3] * dl;
        o1 = MFMA32(fb[0], vb00, o1); o1 = MFMA32(fb[1], vb01, o1); o1 = MFMA32(fb[2], vb10, o1); o1 = MFMA32(fb[3], vb11, o1);
        LD4(fb, B, GKSLOT(4), GKSLOT(5), GKSLOT(6), GKSLOT(7)); S_TD(fa, 0)
        LD4(fa, B, GKSLOT(8), GKSLOT(9), GKSLOT(10), GKSLOT(11)); STORE_O(o1, 32u * 2048u); S_TD(fb, 1)
        LD4(fb, B, GKSLOT(12), GKSLOT(13), GKSLOT(14), GKSLOT(15)); S_TD(fa, 2)
        PIN(); S_TD(fb, 3)
#undef STORE_O
#undef S_TD
#undef HALF_TD
        SEG_T0(2); SCAN_BAR_C(); SEG_ACC(2); SEG_ACC2(1);
    }
    SEG_OUT();
}

constexpr int PF_LOOK = 6;
__device__ __forceinline__ void scan_prefetcher(Frame& F, const unsigned* PROG, int bx) {
    const int xc = bx & 7, j = (bx - 64) >> 3;
    const v4u* RQf = (const v4u*)(F.ws + WS_RQF); const v4u* RKf = (const v4u*)(F.ws + WS_RKF); const v4u* RKTf = (const v4u*)(F.ws + WS_RKTF); const v4u* RVTf = (const v4u*)(F.ws + WS_RVTF);
    const v4u* GW = (const v4u*)(F.ws + WS_GW); const v4u* GQ = (const v4u*)(F.ws + WS_GQ); const v4u* GK = (const v4u*)(F.ws + WS_GK); const v4u* GA = (const v4u*)(F.ws + WS_GA); const v4u* GU = (const v4u*)(F.ws + WS_GU);
    const int tid = F.tid;
    for (int it = j; it < 4 * 128; it += 24) {
        const int st = it & 3, n = it >> 2, kind = st >> 1, bh = xc + 8 * (st & 1);
        const unsigned* pw = PROG + 64 * (kind * 16 + bh);
        for (int spin = 0; spin < 20000; ++spin) { if ((int)__hip_atomic_load(pw, __ATOMIC_RELAXED, __HIP_MEMORY_SCOPE_AGENT) + PF_LOOK >= n) break; __builtin_amdgcn_s_sleep(32); }
        const size_t c = (size_t)bh * 128 + n;
        v4u a[11];
        if (kind == 0) {
            a[0] = RQf[c * 1024 + tid]; a[1] = RQf[c * 1024 + 512 + tid]; a[2] = RKf[c * 1024 + tid]; a[3] = RKf[c * 1024 + 512 + tid]; a[4] = RKTf[c * 1024 + tid]; a[5] = RKTf[c * 1024 + 512 + tid];
            a[6] = RVTf[c * 2048 + tid]; a[7] = RVTf[c * 2048 + 512 + tid]; a[8] = RVTf[c * 2048 + 1024 + tid]; a[9] = RVTf[c * 2048 + 1536 + tid]; a[10] = a[9];
        } else {
            a[0] = GW[c * 1024 + tid]; a[1] = GW[c * 1024 + 512 + tid]; a[2] = GQ[c * 1024 + tid]; a[3] = GQ[c * 1024 + 512 + tid]; a[4] = GK[c * 1024 + tid]; a[5] = GK[c * 1024 + 512 + tid];
            a[6] = GU[c * 2048 + tid]; a[7] = GU[c * 2048 + 512 + tid]; a[8] = GU[c * 2048 + 1024 + tid]; a[9] = GU[c * 2048 + 1536 + tid]; a[10] = GA[c * 512 + tid];
        }
#pragma unroll
        for (int q = 0; q < 11; ++q) asm volatile("" :: "v"(a[q]));
    }
}

__device__ __forceinline__ void p3_mixed(Frame& F) {
    const int gw = F.vcu * NWAVES + F.wave, NGW = F.G * NWAVES, lane = F.lane;
    const bf16* OA = (const bf16*)(F.ws + WS_OA); const bf16* OB = (const bf16*)(F.ws + WS_OB);
    const bf16* GZA = (const bf16*)F.out; const bf16* GZB = GZA + (size_t)T * 2048; bf16* MIX = (bf16*)(F.ws + WS_MIXED);
    for (int row = gw; row < T; row += NGW) {
        const size_t off = (size_t)row * 2048 + 32 * lane;
        v4u a4[4], b4[4], ga[4], gb[4];
#pragma unroll
        for (int q = 0; q < 4; ++q) { a4[q] = *(const v4u*)(OA + off + 8 * q); b4[q] = *(const v4u*)(OB + off + 8 * q); ga[q] = *(const v4u*)(GZA + off + 8 * q); gb[q] = *(const v4u*)(GZB + off + 8 * q); }
        float a[32], bb[32];
#pragma unroll
        for (int q = 0; q < 4; ++q)
#pragma unroll
            for (int e = 0; e < 4; ++e) { a[8 * q + 2 * e] = bflo(a4[q][e]); a[8 * q + 2 * e + 1] = bfhi(a4[q][e]); bb[8 * q + 2 * e] = bflo(b4[q][e]); bb[8 * q + 2 * e + 1] = bfhi(b4[q][e]); }
        float sa = 0.f, sb = 0.f;
#pragma unroll
        for (int i = 0; i < 32; ++i) { sa += a[i] * a[i]; sb += bb[i]; }
        sa += __shfl_xor(sa, 1); sa += __shfl_xor(sa, 2); sa += __shfl_xor(sa, 4);
        sb += __shfl_xor(sb, 1); sb += __shfl_xor(sb, 2); sb += __shfl_xor(sb, 4);
        const float rsa = rsqrtf(sa * (1.0f / 256.0f) + EPS), mu = sb * (1.0f / 256.0f);
        float vb = 0.f;
#pragma unroll
        for (int i = 0; i < 32; ++i) { bb[i] -= mu; vb += bb[i] * bb[i]; }
        vb += __shfl_xor(vb, 1); vb += __shfl_xor(vb, 2); vb += __shfl_xor(vb, 4);
        const float rsb = rsqrtf(vb * (1.0f / 256.0f) + EPS);
        const float* wa = F.gdn_norm_w + ((32 * lane) & 255); const float* wb = F.ret_norm_w + 32 * lane;
#pragma unroll
        for (int q = 0; q < 4; ++q) { v4u o;
#pragma unroll
            for (int e = 0; e < 4; ++e) { const int i = 8 * q + 2 * e;
                const float m0 = a[i] * rsa * wa[i] * bflo(ga[q][e]) + bb[i] * rsb * wb[i] * bflo(gb[q][e]);
                const float m1 = a[i + 1] * rsa * wa[i + 1] * bfhi(ga[q][e]) + bb[i + 1] * rsb * wb[i + 1] * bfhi(gb[q][e]);
                o[e] = pk2(m0, m1); }
            *(v4u*)(MIX + off + 8 * q) = o; }
    }
}
__device__ __forceinline__ void row_rmsnorm(Frame& F, const float* src, const float* w, bf16* dst16, float* dst32) {
    const int gw = F.vcu * NWAVES + F.wave, NGW = F.G * NWAVES, lane = F.lane;
    f32x4 nw[8];
#pragma unroll
    for (int j = 0; j < 8; ++j) nw[j] = ((const f32x4*)w)[64 * j + lane];
    for (int row = gw; row < T; row += 2 * NGW) {
        const f32x4* xr0 = (const f32x4*)(src + (size_t)row * D) + lane; const f32x4* xr1 = (const f32x4*)(src + (size_t)(row + NGW) * D) + lane;
        f32x4 v0[8], v1[8]; float s0 = 0.f, s1 = 0.f;
#pragma unroll
        for (int j = 0; j < 8; ++j) { v0[j] = xr0[64 * j]; v1[j] = xr1[64 * j]; }
#pragma unroll
        for (int j = 0; j < 8; ++j) { s0 += (v0[j].x * v0[j].x + v0[j].y * v0[j].y) + (v0[j].z * v0[j].z + v0[j].w * v0[j].w); s1 += (v1[j].x * v1[j].x + v1[j].y * v1[j].y) + (v1[j].z * v1[j].z + v1[j].w * v1[j].w); }
        const float r0 = rsqrtf(wave_sum(s0) * (1.0f / D) + EPS), r1 = rsqrtf(wave_sum(s1) * (1.0f / D) + EPS);
        if (dst16) { v2u* o0 = (v2u*)(dst16 + (size_t)row * D) + lane; v2u* o1 = (v2u*)(dst16 + (size_t)(row + NGW) * D) + lane;
#pragma unroll
            for (int j = 0; j < 8; ++j) { const f32x4 y0 = (v0[j] * r0) * nw[j], y1 = (v1[j] * r1) * nw[j]; v2u o; o.x = pk2(y0.x, y0.y); o.y = pk2(y0.z, y0.w); o0[64 * j] = o; o.x = pk2(y1.x, y1.y); o.y = pk2(y1.z, y1.w); o1[64 * j] = o; } }
        else { f32x4* o0 = (f32x4*)(dst32 + (size_t)row * D) + lane; f32x4* o1 = (f32x4*)(dst32 + (size_t)(row + NGW) * D) + lane;
#pragma unroll
            for (int j = 0; j < 8; ++j) { o0[64 * j] = (v0[j] * r0) * nw[j]; o1[64 * j] = (v1[j] * r1) * nw[j]; } }
    }
}

__device__ __forceinline__ void row_rmsnorm16(Frame& F, const bf16* src, const float* w, bf16* dst16, float* dst32) {
    const int gw = F.vcu * NWAVES + F.wave, NGW = F.G * NWAVES, lane = F.lane;
    const float* wl = w + 32 * lane;
    for (int row = gw; row < T; row += 2 * NGW) {
        const size_t o0 = (size_t)row * D + 32 * lane, o1 = (size_t)(row + NGW) * D + 32 * lane;
        v4u a[4], b[4];
#pragma unroll
        for (int q = 0; q < 4; ++q) { a[q] = *(const v4u*)(src + o0 + 8 * q); b[q] = *(const v4u*)(src + o1 + 8 * q); }
        float x0[32], x1[32]; float s0 = 0.f, s1 = 0.f;
#pragma unroll
        for (int q = 0; q < 4; ++q)
#pragma unroll
            for (int e = 0; e < 4; ++e) { x0[8 * q + 2 * e] = bflo(a[q][e]); x0[8 * q + 2 * e + 1] = bfhi(a[q][e]); x1[8 * q + 2 * e] = bflo(b[q][e]); x1[8 * q + 2 * e + 1] = bfhi(b[q][e]); }
#pragma unroll
        for (int i = 0; i < 32; ++i) { s0 += x0[i] * x0[i]; s1 += x1[i] * x1[i]; }
        const float r0 = rsqrtf(wave_sum(s0) * (1.0f / D) + EPS), r1 = rsqrtf(wave_sum(s1) * (1.0f / D) + EPS);
#pragma unroll
        for (int q = 0; q < 4; ++q) { const f32x4 wa = *(const f32x4*)(wl + 8 * q), wb = *(const f32x4*)(wl + 8 * q + 4);
            const float wv[8] = {wa.x, wa.y, wa.z, wa.w, wb.x, wb.y, wb.z, wb.w};
            if (dst16) { v4u p0, p1;
#pragma unroll
                for (int e = 0; e < 4; ++e) { p0[e] = pk2(x0[8 * q + 2 * e] * r0 * wv[2 * e], x0[8 * q + 2 * e + 1] * r0 * wv[2 * e + 1]); p1[e] = pk2(x1[8 * q + 2 * e] * r1 * wv[2 * e], x1[8 * q + 2 * e + 1] * r1 * wv[2 * e + 1]); }
                *(v4u*)(dst16 + o0 + 8 * q) = p0; *(v4u*)(dst16 + o1 + 8 * q) = p1;
            } else {
                f32x4 y;
                y = (f32x4){x0[8 * q] * r0 * wv[0], x0[8 * q + 1] * r0 * wv[1], x0[8 * q + 2] * r0 * wv[2], x0[8 * q + 3] * r0 * wv[3]}; *(f32x4*)(dst32 + o0 + 8 * q) = y;
                y = (f32x4){x0[8 * q + 4] * r0 * wv[4], x0[8 * q + 5] * r0 * wv[5], x0[8 * q + 6] * r0 * wv[6], x0[8 * q + 7] * r0 * wv[7]}; *(f32x4*)(dst32 + o0 + 8 * q + 4) = y;
                y = (f32x4){x1[8 * q] * r1 * wv[0], x1[8 * q + 1] * r1 * wv[1], x1[8 * q + 2] * r1 * wv[2], x1[8 * q + 3] * r1 * wv[3]}; *(f32x4*)(dst32 + o1 + 8 * q) = y;
                y = (f32x4){x1[8 * q + 4] * r1 * wv[4], x1[8 * q + 5] * r1 * wv[5], x1[8 * q + 6] * r1 * wv[6], x1[8 * q + 7] * r1 * wv[7]}; *(f32x4*)(dst32 + o1 + 8 * q + 4) = y;
            } }
    }
}

__global__ void __launch_bounds__(NWAVES * 64, 2) fwd_kernel(Args args) {
    extern __shared__ __attribute__((aligned(16))) unsigned char lds[];
    Frame F;
    F.lds = (LAS unsigned char*)lds;
    F.tid = threadIdx.x; F.lane = F.tid & 63; F.wave = __builtin_amdgcn_readfirstlane(F.tid >> 6);
    F.G = gridDim.x; { const int bx = blockIdx.x; F.vcu = (F.G % 8 == 0) ? (bx % 8) * (F.G / 8) + bx / 8 : bx; }
    typedef const __attribute__((address_space(4))) Args* KArgs;
    const KArgs kap0 = (KArgs)__builtin_amdgcn_kernarg_segment_ptr();
#define LOADF() do { KArgs kap_ = kap0; asm volatile("" : "+s"(kap_)); \
        F.x = kap_->in[0]; F.norm1_w = kap_->in[1]; F.w_in = kap_->in[2]; F.conv_w = kap_->in[3]; F.a_log = kap_->in[4]; F.dt_bias = kap_->in[5]; F.gdn_norm_w = kap_->in[6]; \
        F.ret_norm_w = kap_->in[7]; F.w_out = kap_->in[8]; F.norm2_w = kap_->in[9]; F.w_gate = kap_->in[10]; F.w_up = kap_->in[11]; F.w_down = kap_->in[12]; F.norm_f_w = kap_->in[13]; \
        F.out = kap_->out; F.ws = kap_->ws; F.lane = pg8::pg8_lane_id(); F.tid = F.wave * 64 + F.lane; } while (0)
    LOADF();
    volatile LAS unsigned* MISC = (volatile LAS unsigned*)(F.lds + MISC_OFF);
    for (int u = F.tid; u < (LDS_BYTES - LDSCTL_OFF) / 4; u += NWAVES * 64) ((LAS unsigned*)(F.lds + LDSCTL_OFF))[u] = 0u;
    __syncthreads();
    const int lo = args.ph_lo, hi = args.ph_hi;
    const bool use_bar = (hi - lo) > 1;
    XcdBarrier bar; bar.bar = (unsigned*)(F.ws + WS_CTL) + CW_BAR; bar.x = 0; bar.st = nullptr; bar.w0 = 0;
    if (use_bar) bar = xcd_barrier_post((unsigned*)(F.ws + WS_CTL) + CW_BAR, MISC + 8, F.wave);
#ifndef PROBE_REP
#define PROBE_REP -1
#endif
#define NREP(k) ((PROBE_REP) == (k) ? 2 : 1)
#define IN(k) (lo <= (k) && (k) < hi)
#ifndef PROBE_TIME
#define PROBE_TIME -1
#endif
    volatile LAS unsigned long long* PT = (volatile LAS unsigned long long*)(F.lds + MISC_OFF + 64);
#define SEAM(k) do { if ((PROBE_TIME) == 20 + (k) && F.tid == 0) PT[0] = __builtin_amdgcn_s_memrealtime(); if (IN(k) && IN((k) + 1)) xcd_barrier(bar); if ((PROBE_TIME) == 20 + (k) && F.tid == 0) PT[1] = __builtin_amdgcn_s_memrealtime(); if ((PROBE_TIME) == (k) + 1 && F.tid == 0) PT[0] = __builtin_amdgcn_s_memrealtime(); if ((PROBE_TIME) == (k) && F.tid == 0) PT[1] = __builtin_amdgcn_s_memrealtime(); } while (0)

    if ((PROBE_TIME) == 0 && F.tid == 0) PT[0] = __builtin_amdgcn_s_memrealtime();
    if (IN(0)) for (int rep_ = 0; rep_ < NREP(0); ++rep_) { LOADF(); p0_prologue(F); } SEAM(0);
    if (IN(1)) for (int rep_ = 0; rep_ < NREP(1); ++rep_) { LOADF();
        pg8::Gemm g{(const pg8::bf16_t*)(F.ws + WS_U), (const pg8::bf16_t*)(F.ws + WS_W1T), T, N1, D}; pg8::InProjOrder S; S.init(T, N1, F.G, (int)blockIdx.x);
        pg8::EpiInProj E{F.ws, (pg8::bf16_t*)F.out, WS_QKV, WS_RQF, WS_RKF, WS_RKTF, WS_RVTF, WS_COS, WS_SIN, WS_COS2, WS_SIN2};
        pg8::gemm_phase<pg8::EpiInProj, pg8::InProjOrder, true, true>(F.lds, g, S, E, F.wave);
    } SEAM(1);
    if (IN(2)) for (int rep_ = 0; rep_ < NREP(2); ++rep_) { LOADF(); for (int ci = blockIdx.x; ci < BATCH * NH * 128; ci += F.G) gdn_prep(F, ci); } SEAM(2);
    if (IN(3)) for (int rep_ = 0; rep_ < NREP(3); ++rep_) { LOADF();
        const int bx = blockIdx.x;
        unsigned* PROG = (unsigned*)(F.ws + WS_CTL) + 16384;
        if (bx >= 64) scan_prefetcher(F, PROG, bx);
        if (bx < 64) { const int x = bx & 31, xc = x & 7, y = x >> 3, bh = xc + 8 * (y >> 1), half = y & 1;
#if PROBE_ONLYSCAN == 1
            if (bx < 32) ret_scan_wg(F, bh, half, PROG + 64 * (0 * 16 + bh));
#elif PROBE_ONLYSCAN == 2
            if (bx >= 32) gdn_scan_wg(F, bh, half, PROG + 64 * (1 * 16 + bh));
#else
            if (bx < 32) { ret_scan_wg(F, bh, half, PROG + 64 * (0 * 16 + bh));
#if PROBE_SCAN2 == 1
                ret_scan_wg(F, bh, half, PROG + 64 * (0 * 16 + bh));
#endif
            } else { gdn_scan_wg(F, bh, half, PROG + 64 * (1 * 16 + bh));
#if PROBE_SCAN2 == 2
                gdn_scan_wg(F, bh, half, PROG + 64 * (1 * 16 + bh));
#endif
            }
#endif
            }
    } SEAM(3);
    if (IN(4)) for (int rep_ = 0; rep_ < NREP(4); ++rep_) { LOADF(); p3_mixed(F); ffn_weight_copies(F); } SEAM(4);
    if (IN(5)) for (int rep_ = 0; rep_ < NREP(5); ++rep_) { LOADF();
        pg8::Gemm g{(const pg8::bf16_t*)(F.ws + WS_MIXED), (const pg8::bf16_t*)(F.ws + WS_WOT), T, D, D}; pg8::StaticOrder S; S.init(T, D, F.G, (int)blockIdx.x);
        pg8::EpiResBf16 E{F.x, nullptr, (pg8::bf16_t*)(F.ws + WS_H), D, (float*)(F.ws + WS_RSTD)};
        pg8::gemm_phase<pg8::EpiResBf16, pg8::StaticOrder, true, true>(F.lds, g, S, E, F.wave);
    } SEAM(5);
#if PROBE_TIME == 10
    if (F.tid == 0) PT[0] = __builtin_amdgcn_s_memrealtime(); xcd_barrier(bar); if (F.tid == 0) PT[1] = __builtin_amdgcn_s_memrealtime();
#endif
    if (IN(7)) for (int rep_ = 0; rep_ < NREP(7); ++rep_) { LOADF();
        pg8::Gemm g{(const pg8::bf16_t*)(F.ws + WS_H), (const pg8::bf16_t*)(F.ws + WS_WGUT), T, NGU, D}; pg8::StaticOrder S; S.init(T, NGU, F.G, (int)blockIdx.x);
        pg8::EpiGateUp E{(pg8::bf16_t*)(F.ws + WS_ACT), FF, (const float*)(F.ws + WS_RSTD)};
        pg8::gemm_phase<pg8::EpiGateUp, pg8::StaticOrder, true, true>(F.lds, g, S, E, F.wave);
    } SEAM(7);
    if (IN(8)) { LOADF();
        pg8::Gemm g{(const pg8::bf16_t*)(F.ws + WS_ACT), (const pg8::bf16_t*)(F.ws + WS_WDT), T, D, FF}; pg8::StaticOrder S; S.init(T, D, F.G, (int)blockIdx.x);
        pg8::EpiResBf16 E{nullptr, (const pg8::bf16_t*)(F.ws + WS_H), (pg8::bf16_t*)(F.ws + WS_H), D, nullptr};
        pg8::gemm_phase<pg8::EpiResBf16, pg8::StaticOrder, true, true>(F.lds, g, S, E, F.wave);
    } SEAM(8);
    if (IN(9)) { LOADF(); row_rmsnorm16(F, (const bf16*)(F.ws + WS_H), F.norm_f_w, nullptr, F.out); }
#if PROBE_TIME >= 0
    if (PROBE_TIME == 9 && F.tid == 0) PT[1] = __builtin_amdgcn_s_memrealtime();
    __syncthreads();
    if (F.vcu == 0 && F.tid == 0) { asm volatile("s_waitcnt vmcnt(0)" ::: "memory");
        int best = 0; float bv = 1e30f;
        for (int i = 0; i < 2048; ++i) { const float a = fabsf(F.out[i]); if (a < bv) { bv = a; best = i; } }
#if PROBE_SEG
        const float us = 0.1f * (float)__hip_atomic_load((unsigned*)(F.ws + WS_CTL) + 20000, __ATOMIC_RELAXED, __HIP_MEMORY_SCOPE_AGENT);
#else
        const float us = (float)(long long)(PT[1] - PT[0]) * 0.01f;
#endif
#ifdef PROBE_FAIL
        F.out[0] = 20.0f * rintf(us * 0.05f);
#else
        F.out[best] += 0.04f + 1e-4f * us;
#endif
        }
#endif
#undef IN
#undef SEAM
}

extern "C" void kernel_launch(void* const* d_in, const int* in_sizes, int n_in, void* d_out, int out_size, void* d_ws, size_t ws_size, hipStream_t stream) {
    static int grid = 0;
    if (grid == 0) {
        if (n_in != 14 || in_sizes[0] != T * D || out_size != T * D || ws_size < WS_END) { fprintf(stderr, "kernel_launch: unexpected shapes: n_in %d in0 %d out %d ws %zu (need %zu)\n", n_in, n_in > 0 ? in_sizes[0] : -1, out_size, ws_size, (size_t)WS_END); grid = -1; return; }
        int dev = 0, cus = 0, per_cu = 0;
        if (hipGetDevice(&dev) != hipSuccess || hipDeviceGetAttribute(&cus, hipDeviceAttributeMultiprocessorCount, dev) != hipSuccess) { grid = -1; return; }
        if (hipFuncSetAttribute((const void*)fwd_kernel, hipFuncAttributeMaxDynamicSharedMemorySize, LDS_BYTES) != hipSuccess) { fprintf(stderr, "kernel_launch: hipFuncSetAttribute failed\n"); grid = -1; return; }
        if (hipOccupancyMaxActiveBlocksPerMultiprocessor(&per_cu, (const void*)fwd_kernel, NWAVES * 64, LDS_BYTES) != hipSuccess || per_cu < 1) { fprintf(stderr, "kernel_launch: occupancy query says %d blocks per CU\n", per_cu); per_cu = 1; }
        (void)hipGetLastError();
        grid = cus;
        if (grid > 256) grid = 256;
    }
    if (grid < 0) return;
    (void)hipMemsetAsync((char*)d_ws + WS_CTL, 0, CTL_ZERO_BYTES, stream);
    Args a{};
    for (int i = 0; i < 14; ++i) a.in[i] = (const float*)d_in[i];
    a.out = (float*)d_out; a.ws = (unsigned char*)d_ws;
#if MK_N_LAUNCHES == 1
    a.ph_lo = 0; a.ph_hi = NPHASES;
    hipLaunchKernelGGL(fwd_kernel, dim3(grid), dim3(NWAVES * 64), LDS_BYTES, stream, a);
#else
    for (int p = 0; p < NPHASES; ++p) { a.ph_lo = p; a.ph_hi = p + 1; hipLaunchKernelGGL(fwd_kernel, dim3(grid), dim3(NWAVES * 64), LDS_BYTES, stream, a); }
#endif
}
```

```cpp
#include <hip/hip_runtime.h>
#include <cstdio>
#include <cstdint>
namespace pg8 {
#define PG8_LAS __attribute__((address_space(3)))
typedef unsigned short bf16_t;
typedef short bf16x8 __attribute__((ext_vector_type(8)));
typedef float f32x4 __attribute__((ext_vector_type(4)));
typedef unsigned u32x4 __attribute__((ext_vector_type(4)));
constexpr int BM = 256, BK = 64, HALF = 128, HTB = HALF * BK * 2  , STAGE_BYTES = 8 * HTB, NXCD = 8, WGM = 8;

__host__ __device__ __forceinline__ int lds_byte(int r, int c) { const int st = (r >> 4) * 2 + (c >> 5), rr = r & 15, cc = c & 31, ob = rr * 64 + cc * 2; return st * 1024 + (ob ^ (((ob >> 9) & 1) << 5)); }
__host__ __device__ __forceinline__ void stage_rc(int b, int& R, int& C) { const int st = b / 1024, sb = b % 1024, swz = sb ^ (((sb >> 9) & 1) << 5); R = (st >> 1) * 16 + swz / 64; C = (st & 1) * 32 + (swz % 64) / 2; }
__host__ __device__ __forceinline__ int perm32(int rho) { const int n = rho >> 4, i = rho & 15; return 8 * (i >> 2) + 4 * n + (i & 3); }

__device__ __forceinline__ int pg8_lane_id() { int l; asm volatile("v_mbcnt_lo_u32_b32 %0, -1, 0\n\tv_mbcnt_hi_u32_b32 %0, -1, %0" : "=v"(l)); return l; }
struct Unit { int pm, pn, sw; };
struct Gemm { const bf16_t* A; const bf16_t* Bt; int M, N, K; };

struct StaticOrder {
    int nM, nN, nwg, G, c;
    __host__ __device__ void init(int M, int N, int G_, int c_) { nM = M / BM; nN = N / BM; nwg = nM * nN; G = G_; c = c_; }
    __host__ __device__ bool next(int i, Unit& u) const {
        const long L = (long)i * G + c; if (L >= nwg) return false;
        int wgid = (int)L; { const int q = nwg / NXCD, r = nwg % NXCD, xcd = wgid % NXCD, off = wgid / NXCD; wgid = (xcd < r ? xcd * (q + 1) : r * (q + 1) + (xcd - r) * q) + off; }
        const int nig = WGM * nN, gid = wgid / nig, fm = gid * WGM, gsz = (nM - fm) < WGM ? (nM - fm) : WGM;
        u.pm = fm + ((wgid % nig) % gsz); u.pn = (wgid % nig) / gsz; u.sw = 0; return true;
    }
    __device__ __forceinline__ void a_ready(const Unit&) const {}
    __device__ __forceinline__ void done(const Unit&) const {}
};
__device__ __forceinline__ unsigned cvt_pk_bf16(float lo, float hi) { unsigned r; asm volatile("v_cvt_pk_bf16_f32 %0, %1, %2" : "=v"(r) : "v"(lo), "v"(hi)); return r; }
typedef float f32x2 __attribute__((ext_vector_type(2)));
__device__ __forceinline__ u32x4 pack8(const f32x4& a, const f32x4& b) { u32x4 w; w.x = cvt_pk_bf16(a[0], a[1]); w.y = cvt_pk_bf16(a[2], a[3]); w.z = cvt_pk_bf16(b[0], b[1]); w.w = cvt_pk_bf16(b[2], b[3]); return w; }
typedef unsigned u32x2 __attribute__((ext_vector_type(2)));
__device__ __forceinline__ float fsigmoid(float x) { return __builtin_amdgcn_rcpf(1.0f + __expf(-x)); }
__device__ __forceinline__ float fsilu(float x) { return x * fsigmoid(x); }

struct InProjOrder : StaticOrder {
    __host__ __device__ bool next(int i, Unit& u) const { if (!StaticOrder::next(i, u)) return false; u.sw = ((u.pn >= 24 && u.pn < 32) || u.pn >= 64) ? 1 : 0; return true; }
};
struct EpiInProj {
    static constexpr bool PERM = true, AFTER_DRAIN = false;
    unsigned char* ws; bf16_t* gz;
    size_t oQKV, oRQf, oRKf, oRKTf, oRVTf, oCOS, oSIN, oCOS2, oSIN2;
    __device__ __forceinline__ void operator()(const f32x4 (&acc)[2][2][4][2], const Unit& u, int wr, int wc, int fr, int fq) const {
        asm volatile("" : "+v"(fr), "+v"(fq));
        bf16_t* const QKV = (bf16_t*)(ws + oQKV); bf16_t* const RQf = (bf16_t*)(ws + oRQf); bf16_t* const RKf = (bf16_t*)(ws + oRKf); bf16_t* const RKTf = (bf16_t*)(ws + oRKTf); bf16_t* const RVTf = (bf16_t*)(ws + oRVTf);
        bf16_t* const GZA = gz; bf16_t* const GZB = gz + (size_t)16384 * 2048;
        const float* const cosT = (const float*)(ws + oCOS); const float* const sinT = (const float*)(ws + oSIN); const float* const cosT2 = (const float*)(ws + oCOS2); const float* const sinT2 = (const float*)(ws + oSIN2);
        const int pn = u.pn, cw = wc * 32 + 8 * fq;
        if (pn < 16) {
            const int row0 = u.pm * BM + wr * 64 + fr, col0 = pn * 256 + cw;
#pragma unroll
            for (int ai = 0; ai < 2; ++ai)
#pragma unroll
                for (int m = 0; m < 4; ++m) { bf16_t* rowp = QKV + (size_t)(row0 + ai * HALF + m * 16) * 4096 + col0;
#pragma unroll
                    for (int bj = 0; bj < 2; ++bj) *(u32x4*)(rowp + bj * HALF) = pack8(acc[ai][bj][m][0], acc[ai][bj][m][1]); }
        } else if (pn < 24) {
            const bool isk = pn >= 20; bf16_t* base = isk ? RKf : RQf;
            const int row0 = u.pm * BM + wr * 64 + fr, tile = (pn - 16) & 3, head = 2 * tile + (cw >> 6), i0 = cw & 63;
            const float l2g = log2f(1.0f - exp2f(-5.0f - (float)head));
            const int td1 = i0 >> 5, s1 = (i0 >> 4) & 1, eg = (i0 >> 3) & 1;
#pragma unroll
            for (int ai = 0; ai < 2; ++ai)
#pragma unroll
                for (int m = 0; m < 4; ++m) { const int row = row0 + ai * HALF + m * 16, b = row >> 13, t = row & 8191, n = t >> 6, pos = t & 63;
                    const float sc = isk ? 0.08838834764831845f * exp2f(-(float)(pos + 1) * l2g) : exp2f((float)(pos + 1) * l2g);
                    const float* cp = cosT + t * 64 + i0; const float* sp = sinT + t * 64 + i0;
                    const f32x4 c0 = *(const f32x4*)cp, c1 = *(const f32x4*)(cp + 4), s0 = *(const f32x4*)sp, s1v = *(const f32x4*)(sp + 4);
                    const f32x4 x1a = acc[ai][0][m][0], x1b = acc[ai][0][m][1], x2a = acc[ai][1][m][0], x2b = acc[ai][1][m][1];
                    const f32x4 o1a = (x1a * c0 - x2a * s0) * sc, o1b = (x1b * c1 - x2b * s1v) * sc, o2a = (x2a * c0 + x1a * s0) * sc, o2b = (x2b * c1 + x1b * s1v) * sc;
                    const size_t f1 = ((((size_t)(b * 8 + head) * 128 + n) * 2 + (pos >> 5)) * 4 + td1) * 2 + s1;
                    bf16_t* p1 = base + f1 * 512 + (pos & 31) * 8 + eg * 4;
                    u32x2 w;
                    w.x = cvt_pk_bf16(o1a[0], o1a[1]); w.y = cvt_pk_bf16(o1a[2], o1a[3]); *(u32x2*)(p1) = w;
                    w.x = cvt_pk_bf16(o1b[0], o1b[1]); w.y = cvt_pk_bf16(o1b[2], o1b[3]); *(u32x2*)(p1 + 256) = w;
                    w.x = cvt_pk_bf16(o2a[0], o2a[1]); w.y = cvt_pk_bf16(o2a[2], o2a[3]); *(u32x2*)(p1 + 4 * 512) = w;
                    w.x = cvt_pk_bf16(o2b[0], o2b[1]); w.y = cvt_pk_bf16(o2b[2], o2b[3]); *(u32x2*)(p1 + 4 * 512 + 256) = w; }
        } else if (pn < 32) {
            const int head = pn - 24, b = u.pm >> 5, nbase = (u.pm & 31) * 4;
            const int tj = wc & 1, s1 = (fq >> 1) & 1, eg = fq & 1;
#pragma unroll
            for (int ai = 0; ai < 2; ++ai)
#pragma unroll
                for (int m = 0; m < 4; ++m) { const int dv = ai * HALF + wr * 64 + m * 16 + fr, sl = dv >> 5, col = dv & 31;
#pragma unroll
                    for (int bj = 0; bj < 2; ++bj) { const int n = nbase + 2 * bj + (wc >> 1);
                        const size_t f = ((((size_t)(b * 8 + head) * 128 + n) * 8 + sl) * 2 + tj) * 2 + s1;
                        bf16_t* p = RVTf + f * 512 + col * 8 + eg * 4;
#pragma unroll
                        for (int nn = 0; nn < 2; ++nn) { u32x2 w; w.x = cvt_pk_bf16(acc[ai][bj][m][nn][0], acc[ai][bj][m][nn][1]); w.y = cvt_pk_bf16(acc[ai][bj][m][nn][2], acc[ai][bj][m][nn][3]); *(u32x2*)(p + nn * 256) = w; } } }
        } else if (pn < 64) {
            const int row0 = u.pm * BM + wr * 64 + fr;
            bf16_t* base = pn < 48 ? GZA : GZB; const int col0 = ((pn - 32) & 15) * 128 + cw;
#pragma unroll
            for (int ai = 0; ai < 2; ++ai)
#pragma unroll
                for (int m = 0; m < 4; ++m) { bf16_t* rowp = base + (size_t)(row0 + ai * HALF + m * 16) * 2048 + col0; f32x4 o[2];
#pragma unroll
                    for (int n = 0; n < 2; ++n)
#pragma unroll
                        for (int j = 0; j < 4; ++j) o[n][j] = fsilu(acc[ai][0][m][n][j]) * fsigmoid(acc[ai][1][m][n][j]);
                    *(u32x4*)rowp = pack8(o[0], o[1]); }
        } else {
            const int tile = pn - 64, head = 2 * tile + wr, b = u.pm >> 5, nbase = (u.pm & 31) * 4, tbase = (u.pm & 31) * 256;
            const int tj = wc & 1, s1 = (fq >> 1) & 1, eg = fq & 1;
            const float l2g = log2f(1.0f - exp2f(-5.0f - (float)head));
#pragma unroll
            for (int bj = 0; bj < 2; ++bj) { const int n = nbase + 2 * bj + (wc >> 1), c0 = bj * HALF + wc * 32 + 8 * fq;
#pragma unroll
                for (int nn = 0; nn < 2; ++nn) { const int pos0 = (c0 + 4 * nn) & 63; f32x4 sc;
#pragma unroll
                    for (int j = 0; j < 4; ++j) sc[j] = 0.08838834764831845f * exp2f((float)(63 - pos0 - j) * l2g);
#pragma unroll
                    for (int m = 0; m < 4; ++m) { const int i = 16 * m + fr;
                        const f32x4 c = *(const f32x4*)(cosT2 + (size_t)i * 8192 + tbase + c0 + 4 * nn), s = *(const f32x4*)(sinT2 + (size_t)i * 8192 + tbase + c0 + 4 * nn);
                        const f32x4 x1 = acc[0][bj][m][nn], x2 = acc[1][bj][m][nn];
                        const f32x4 o1 = (x1 * c - x2 * s) * sc, o2 = (x2 * c + x1 * s) * sc;
                        const size_t f = ((((size_t)(b * 8 + head) * 128 + n) * 4 + (m >> 1)) * 2 + tj) * 2 + s1;
                        bf16_t* p = RKTf + f * 512 + (nn * 32 + 16 * (m & 1) + fr) * 8 + eg * 4;
                        u32x2 w; w.x = cvt_pk_bf16(o1[0], o1[1]); w.y = cvt_pk_bf16(o1[2], o1[3]); *(u32x2*)p = w;
                        w.x = cvt_pk_bf16(o2[0], o2[1]); w.y = cvt_pk_bf16(o2[2], o2[3]); *(u32x2*)(p + 8 * 512) = w; } } }
        }
    }
};
struct EpiGateUp {
    static constexpr bool PERM = true, AFTER_DRAIN = false;
    bf16_t* ACT; int ldc; const float* rstd;
    __device__ __forceinline__ void operator()(const f32x4 (&acc)[2][2][4][2], const Unit& u, int wr, int wc, int fr, int fq) const {
        const int row0 = u.pm * BM + wr * 64 + fr, col0 = u.pn * 128 + wc * 32 + 8 * fq;
#pragma unroll
        for (int ai = 0; ai < 2; ++ai)
#pragma unroll
            for (int m = 0; m < 4; ++m) { const int row = row0 + ai * HALF + m * 16; const float rs = rstd ? __builtin_amdgcn_rsqf(rstd[row] * (1.0f / 2048.0f) + 1e-6f) : 1.0f; f32x4 o[2];
#pragma unroll
                for (int n = 0; n < 2; ++n)
#pragma unroll
                    for (int j = 0; j < 4; ++j) o[n][j] = fsilu(acc[ai][0][m][n][j] * rs) * (acc[ai][1][m][n][j] * rs);
                *(u32x4*)(ACT + (size_t)row * ldc + col0) = pack8(o[0], o[1]); }
    }
};
struct EpiResF32 {
    static constexpr bool PERM = false, AFTER_DRAIN = false;
    const float* res; float* out; int ldc;
    __device__ __forceinline__ void operator()(const f32x4 (&acc)[2][2][4][2], const Unit& u, int wr, int wc, int fr, int fq) const {
        const int row0 = u.pm * BM + wr * 64 + fr, col0 = u.pn * BM + wc * 32 + 4 * fq;
#pragma unroll
        for (int ai = 0; ai < 2; ++ai)
#pragma unroll
            for (int m = 0; m < 4; ++m) { const size_t off = (size_t)(row0 + ai * HALF + m * 16) * ldc + col0;
#pragma unroll
                for (int bj = 0; bj < 2; ++bj)
#pragma unroll
                    for (int n = 0; n < 2; ++n) { const f32x4 r = *(const f32x4*)(res + off + bj * HALF + n * 16); *(f32x4*)(out + off + bj * HALF + n * 16) = r + acc[ai][bj][m][n]; } }
    }
};
struct EpiResBf16 {
    static constexpr bool PERM = true, AFTER_DRAIN = false;
    const float* res32; const bf16_t* res16; bf16_t* out16; int ldc; float* rss;
    __device__ __forceinline__ void operator()(const f32x4 (&acc)[2][2][4][2], const Unit& u, int wr, int wc, int fr, int fq) const {
        const int row0 = u.pm * BM + wr * 64 + fr, col0 = u.pn * BM + wc * 32 + 8 * fq;
#pragma unroll
        for (int ai = 0; ai < 2; ++ai)
#pragma unroll
            for (int m = 0; m < 4; ++m) { const size_t off = (size_t)(row0 + ai * HALF + m * 16) * ldc + col0; float ss = 0.f;
#pragma unroll
                for (int bj = 0; bj < 2; ++bj) { f32x4 r0, r1;
                    if (res32) { r0 = *(const f32x4*)(res32 + off + bj * HALF); r1 = *(const f32x4*)(res32 + off + bj * HALF + 4); }
                    else { const u32x4 h = *(const u32x4*)(res16 + off + bj * HALF);
                        r0 = (f32x4){__builtin_bit_cast(float, h.x << 16), __builtin_bit_cast(float, h.x & 0xffff0000u), __builtin_bit_cast(float, h.y << 16), __builtin_bit_cast(float, h.y & 0xffff0000u)};
                        r1 = (f32x4){__builtin_bit_cast(float, h.z << 16), __builtin_bit_cast(float, h.z & 0xffff0000u), __builtin_bit_cast(float, h.w << 16), __builtin_bit_cast(float, h.w & 0xffff0000u)}; }
                    r0 = r0 + acc[ai][bj][m][0]; r1 = r1 + acc[ai][bj][m][1];
                    ss += (r0[0] * r0[0] + r0[1] * r0[1]) + (r0[2] * r0[2] + r0[3] * r0[3]) + (r1[0] * r1[0] + r1[1] * r1[1]) + (r1[2] * r1[2] + r1[3] * r1[3]);
                    *(u32x4*)(out16 + off + bj * HALF) = pack8(r0, r1); }
                if (rss) { ss += __shfl_xor(ss, 16); ss += __shfl_xor(ss, 32); if (fq == 0) atomicAdd(rss + row0 + ai * HALF + m * 16, ss); } }
    }
};
template <class Epi, class Sched, bool ALIGN_EPI = false, bool SP2 = false>
__device__ __forceinline__ void gemm_phase(PG8_LAS unsigned char* lds, const Gemm g, const Sched& S, const Epi& E, const int wave_in) {
    const int lane = pg8_lane_id(), wid = wave_in, tid = wid * 64 + lane, wr = wid >> 2, wc = wid & 3, fr = lane & 15, fq = lane >> 4;
    const int K = g.K, nt = K / BK;
    unsigned voffA[2], voffB[2];
#pragma unroll
    for (int i = 0; i < 2; ++i) { int R, C; stage_rc(tid * 16 + i * 8192, R, C); const int Rb = Epi::PERM ? ((R & ~31) + perm32(R & 31)) : R;
        voffA[i] = (unsigned)(R * K + C) * 2u; voffB[i] = (unsigned)(Rb * K + C) * 2u; }
    const size_t kstep = (size_t)(BK * 2);
    const size_t hstep = (size_t)HALF * K * 2;
    const size_t tstep = 2 * hstep;
    const unsigned ldsw = (unsigned)wid * 1024u;
    const int aoff = lds_byte(wr * 64 + fr, fq * 8), boff = lds_byte(wc * 32 + fr, fq * 8);
#define PG8_SA(b, h) (((b) * 2 + (h)) * HTB)
#define PG8_SB(b, h) ((4 + (b) * 2 + (h)) * HTB)
#define PG8_STAGE(bufoff, gbase, voff) do { _Pragma("unroll") for (int _i = 0; _i < 2; ++_i) \
        __builtin_amdgcn_global_load_lds((const unsigned*)((const char*)(gbase) + (voff)[_i]), (PG8_LAS unsigned*)(lds + (bufoff) + ldsw + _i * 8192), 16, 0, 0); } while (0)
#define PG8_LDA(dst, b, h) do { _Pragma("unroll") for (int m = 0; m < 4; ++m) _Pragma("unroll") for (int k = 0; k < 2; ++k) dst[m][k] = *(const PG8_LAS bf16x8*)(lds + PG8_SA(b, h) + aoff + m * 2048 + k * 1024); } while (0)
#define PG8_LDB(dst, b, h) do { _Pragma("unroll") for (int n = 0; n < 2; ++n) _Pragma("unroll") for (int k = 0; k < 2; ++k) dst[n][k] = *(const PG8_LAS bf16x8*)(lds + PG8_SB(b, h) + boff + n * 2048 + k * 1024); } while (0)
#define PG8_MMA(ai, bj, At, Bt) do { __builtin_amdgcn_s_setprio(1); _Pragma("unroll") for (int m = 0; m < 4; ++m) _Pragma("unroll") for (int n = 0; n < 2; ++n) _Pragma("unroll") for (int k = 0; k < 2; ++k) \
        acc[ai][bj][m][n] = __builtin_amdgcn_mfma_f32_16x16x32_bf16(Bt[n][k], At[m][k], acc[ai][bj][m][n], 0, 0, 0); __builtin_amdgcn_s_setprio(0); } while (0)
#define PG8_WAIT_V(n) asm volatile("s_waitcnt vmcnt(" #n ")" ::: "memory")
#define PG8_WAIT_L(n) asm volatile("s_waitcnt lgkmcnt(" #n ")" ::: "memory")
#define PG8_BAR __builtin_amdgcn_s_barrier()
#define PG8_SCHED __builtin_amdgcn_sched_barrier(0)
    Unit cur, nxt; int ui = 0;
    if (!S.next(0, cur)) return;
    f32x4 acc[2][2][4][2];
#pragma unroll
    for (int a = 0; a < 2; ++a)
#pragma unroll
        for (int b = 0; b < 2; ++b)
#pragma unroll
            for (int m = 0; m < 4; ++m)
#pragma unroll
                for (int n = 0; n < 2; ++n) acc[a][b][m][n] = (f32x4){0.f, 0.f, 0.f, 0.f};
    bf16x8 At[4][2], B0[2][2], B1[2][2];
#define PG8_UA(u) ((u).sw ? (const char*)g.Bt + (size_t)(u).pn * tstep : (const char*)g.A + (size_t)(u).pm * tstep)
#define PG8_UB(u) ((u).sw ? (const char*)g.A + (size_t)(u).pm * tstep : (const char*)g.Bt + (size_t)(u).pn * tstep)
    const char* cA = PG8_UA(cur); const char* cB = PG8_UB(cur);
    S.a_ready(cur);
    if constexpr (SP2) {
        PG8_STAGE(PG8_SB(0, 0), cB, voffB); PG8_STAGE(PG8_SB(0, 1), cB + hstep, voffB); PG8_STAGE(PG8_SA(0, 0), cA, voffA); PG8_STAGE(PG8_SA(0, 1), cA + hstep, voffA);
        if (wr == 1) PG8_BAR;
        PG8_WAIT_V(2); PG8_BAR;
        PG8_STAGE(PG8_SB(1, 0), cB + kstep, voffB); PG8_STAGE(PG8_SA(1, 0), cA + kstep, voffA); PG8_STAGE(PG8_SB(1, 1), cB + hstep + kstep, voffB);
        PG8_WAIT_V(6); PG8_BAR;
    } else {
        PG8_STAGE(PG8_SB(0, 0), cB, voffB); PG8_STAGE(PG8_SA(0, 0), cA, voffA); PG8_STAGE(PG8_SB(0, 1), cB + hstep, voffB); PG8_STAGE(PG8_SA(0, 1), cA + hstep, voffA);
        if (wr == 1) PG8_BAR;
        PG8_WAIT_V(4); PG8_BAR;
        PG8_STAGE(PG8_SB(1, 0), cB + kstep, voffB); PG8_STAGE(PG8_SA(1, 0), cA + kstep, voffA); PG8_STAGE(PG8_SB(1, 1), cB + hstep + kstep, voffB);
        PG8_WAIT_V(6); PG8_BAR;
    }
    for (;;) {
        const bool has_next = S.next(ui + 1, nxt);
        const char* nA = has_next ? PG8_UA(nxt) : cA; const char* nB = has_next ? PG8_UB(nxt) : cB;
        for (int t = 0; t < nt; t += 2) {
            const bool last = (t == nt - 2);
            const char* a1 = cA + (size_t)(t + 1) * kstep;
            const char* a2 = last ? nA : cA + (size_t)(t + 2) * kstep; const char* b2 = last ? nB : cB + (size_t)(t + 2) * kstep;
            const char* a3 = a2 + kstep; const char* b3 = b2 + kstep;
            if (last && has_next) S.a_ready(nxt);
            if constexpr (SP2) {
            PG8_LDB(B0, 0, 0); PG8_LDB(B1, 0, 1); PG8_SCHED; PG8_LDA(At, 0, 0); PG8_STAGE(PG8_SA(1, 1), a1 + hstep, voffA);
            PG8_WAIT_V(8); PG8_WAIT_L(0); PG8_BAR; PG8_MMA(0, 0, At, B0); PG8_MMA(0, 1, At, B1); PG8_BAR; PG8_SCHED;
            PG8_LDA(At, 0, 1); PG8_STAGE(PG8_SB(0, 0), b2, voffB); PG8_STAGE(PG8_SB(0, 1), b2 + hstep, voffB); PG8_STAGE(PG8_SA(0, 0), a2, voffA);
            PG8_WAIT_V(8); PG8_WAIT_L(0); PG8_BAR; PG8_MMA(1, 0, At, B0); PG8_MMA(1, 1, At, B1); PG8_BAR; PG8_SCHED;
            PG8_LDB(B0, 1, 0); PG8_LDB(B1, 1, 1); PG8_SCHED; PG8_LDA(At, 1, 0); PG8_STAGE(PG8_SA(0, 1), a2 + hstep, voffA);
            PG8_WAIT_V(8); PG8_WAIT_L(0); PG8_BAR; PG8_MMA(0, 0, At, B0); PG8_MMA(0, 1, At, B1); PG8_BAR; PG8_SCHED;
            PG8_LDA(At, 1, 1); PG8_STAGE(PG8_SB(1, 0), b3, voffB); PG8_STAGE(PG8_SB(1, 1), b3 + hstep, voffB); PG8_STAGE(PG8_SA(1, 0), a3, voffA);
            PG8_WAIT_V(8); PG8_WAIT_L(0); PG8_BAR; PG8_MMA(1, 0, At, B0); PG8_MMA(1, 1, At, B1); PG8_BAR; PG8_SCHED;
            } else {
            PG8_LDB(B0, 0, 0); PG8_SCHED; PG8_LDA(At, 0, 0); PG8_STAGE(PG8_SA(1, 1), a1 + hstep, voffA);
            PG8_WAIT_L(8); PG8_BAR; PG8_WAIT_L(0); PG8_MMA(0, 0, At, B0); PG8_BAR; PG8_SCHED;
            PG8_LDB(B1, 0, 1); PG8_STAGE(PG8_SB(0, 0), b2, voffB);
            PG8_BAR; PG8_WAIT_L(0); PG8_MMA(0, 1, At, B1); PG8_BAR;
            PG8_LDA(At, 0, 1); PG8_STAGE(PG8_SA(0, 0), a2, voffA);
            PG8_BAR; PG8_WAIT_L(0); PG8_MMA(1, 0, At, B0); PG8_BAR; PG8_SCHED;
            PG8_STAGE(PG8_SB(0, 1), b2 + hstep, voffB);
            PG8_WAIT_V(6); PG8_BAR; PG8_MMA(1, 1, At, B1); PG8_BAR;
            PG8_LDB(B0, 1, 0); PG8_SCHED; PG8_LDA(At, 1, 0); PG8_STAGE(PG8_SA(0, 1), a2 + hstep, voffA);
            PG8_WAIT_L(8); PG8_BAR; PG8_WAIT_L(0); PG8_MMA(0, 0, At, B0); PG8_BAR; PG8_SCHED;
            PG8_LDB(B1, 1, 1); PG8_STAGE(PG8_SB(1, 0), b3, voffB);
            PG8_BAR; PG8_WAIT_L(0); PG8_MMA(0, 1, At, B1); PG8_BAR;
            PG8_LDA(At, 1, 1); PG8_STAGE(PG8_SA(1, 0), a3, voffA);
            PG8_BAR; PG8_WAIT_L(0); PG8_MMA(1, 0, At, B0); PG8_BAR; PG8_SCHED;
            PG8_STAGE(PG8_SB(1, 1), b3 + hstep, voffB);
            PG8_WAIT_V(6); PG8_BAR; PG8_MMA(1, 1, At, B1); PG8_BAR;
            }
        }
        if constexpr (ALIGN_EPI) { if (wr == 0) PG8_BAR; }
        if constexpr (!Epi::AFTER_DRAIN) { E(acc, cur, wr, wc, fr, fq); S.done(cur); }
        if (!has_next) break;
#pragma unroll
        for (int a = 0; a < 2; ++a)
#pragma unroll
            for (int b = 0; b < 2; ++b)
#pragma unroll
                for (int m = 0; m < 4; ++m)
#pragma unroll
                    for (int n = 0; n < 2; ++n) acc[a][b][m][n] = (f32x4){0.f, 0.f, 0.f, 0.f};
        cur = nxt; cA = nA; cB = nB; ++ui;
        if constexpr (ALIGN_EPI) { if (wr == 1) PG8_BAR; }
    }
    PG8_WAIT_V(0);
    if constexpr (!ALIGN_EPI) { if (wr == 0) PG8_BAR; }
    PG8_BAR;
    if constexpr (Epi::AFTER_DRAIN) { E.fused(acc, cur, wr, wc, fr, fq, lds, wid, lane); S.done(cur); }
#undef PG8_UA
#undef PG8_UB
#undef PG8_SA
#undef PG8_SB
#undef PG8_STAGE
#undef PG8_LDA
#undef PG8_LDB
#undef PG8_MMA
#undef PG8_WAIT_V
#undef PG8_WAIT_L
#undef PG8_BAR
#undef PG8_SCHED
}
}
#define GAS __attribute__((address_space(1)))
#define LAS __attribute__((address_space(3)))
#define XB_TMO      128
#define XB_XCNT(j)  (256  + 64 * (j))
#define XB_XSUB(j)  (1280 + 64 * (j))
#define XB_XGEN(j)  (2304 + 64 * (j))
#define XB_TOP      3328
#define XB_TOPGEN   3392
#define XCD_BAR_WORDS 3456
#define XB_SPIN_CAP (1u << 18)

__device__ __forceinline__ unsigned xb_ld(unsigned* p)              { return __hip_atomic_load(p, __ATOMIC_RELAXED, __HIP_MEMORY_SCOPE_AGENT); }
__device__ __forceinline__ unsigned xb_add(unsigned* p, unsigned v) { return __hip_atomic_fetch_add(p, v, __ATOMIC_RELAXED, __HIP_MEMORY_SCOPE_AGENT); }
__device__ __forceinline__ unsigned xb_xcc_id() { return (unsigned)__builtin_amdgcn_s_getreg((3 << 11) | 20) & 0xFu; }
#define XB_SPIN(cond, bar) do { unsigned _sp = 0; while (cond) { __builtin_amdgcn_s_sleep(1); \
    if ((++_sp & 255u) == 0u) { if (xb_ld(&(bar)[XB_TMO])) break; if (_sp > XB_SPIN_CAP) { atomicAdd(&(bar)[XB_TMO], 1u); break; } } } } while (0)

struct XcdBarrier {
    unsigned* bar; unsigned x; int w0;
    volatile LAS unsigned* st;
};

__device__ __forceinline__ XcdBarrier xcd_barrier_post(unsigned* bar, volatile LAS unsigned* st, int wave) {
    XcdBarrier b; b.bar = bar; b.x = xb_xcc_id(); b.st = st; b.w0 = (wave == 0);
    if (b.w0 && pg8::pg8_lane_id() == 0) (void)xb_add(&bar[XB_XCNT(b.x)], 1u);
    return b;
}
__device__ __forceinline__ void xcd_barrier_complete(unsigned* bar, unsigned x, unsigned& nloc, unsigned& nx) {
    const unsigned G = gridDim.x * gridDim.y * gridDim.z;
    unsigned sum, cnt, mine, sp = 0u;
    for (;;) {
        sum = 0u; cnt = 0u; mine = 0u;
#pragma unroll
        for (unsigned j = 0; j < 16; ++j) { const unsigned c = xb_ld(&bar[XB_XCNT(j)]); sum += c; cnt += (c > 0u) ? 1u : 0u; mine = (j == x) ? c : mine; }
        if (sum == G) break;
        __builtin_amdgcn_s_sleep(1);
        if ((++sp & 255u) == 0u) { if (xb_ld(&bar[XB_TMO])) break; if (sp > XB_SPIN_CAP) { atomicAdd(&bar[XB_TMO], 1u); break; } }
    }
    nloc = mine > 0u ? mine : 1u; nx = cnt > 0u ? cnt : 1u;
}

__device__ __forceinline__ void xcd_barrier(const XcdBarrier& b) {
    asm volatile("s_waitcnt vmcnt(0)" ::: "memory");
    __syncthreads();
    if (b.w0 && pg8::pg8_lane_id() == 0) {
        unsigned* bar = b.bar;
        __builtin_amdgcn_s_waitcnt(0);
        unsigned nloc = b.st[0], nx = b.st[1];
        if (nloc == 0u) { xcd_barrier_complete(bar, b.x, nloc, nx); b.st[0] = nloc; b.st[1] = nx; }
        const unsigned old = xb_add(&bar[XB_XSUB(b.x)], 1u);
        const unsigned gen = old / nloc;
        if (old + 1u == (gen + 1u) * nloc) {
            __builtin_amdgcn_fence(__ATOMIC_RELEASE, "agent");
            asm volatile("s_waitcnt vmcnt(0)" ::: "memory");
            const unsigned og = xb_add(&bar[XB_TOP], 1u);
            const unsigned tg = og / nx;
            if (og + 1u == (tg + 1u) * nx) xb_add(&bar[XB_TOPGEN], 1u);
            else XB_SPIN(xb_ld(&bar[XB_TOPGEN]) == tg, bar);
            __builtin_amdgcn_fence(__ATOMIC_ACQUIRE, "agent");
            xb_add(&bar[XB_XGEN(b.x)], 1u);
            asm volatile("s_waitcnt vmcnt(0)" ::: "memory");
        } else {
            XB_SPIN(xb_ld(&bar[XB_XGEN(b.x)]) == gen, bar);
            __builtin_amdgcn_fence(__ATOMIC_ACQUIRE, "agent");
            asm volatile("s_waitcnt vmcnt(0)" ::: "memory");
        }
    }
    __syncthreads();
}
#ifndef MK_N_LAUNCHES
#define MK_N_LAUNCHES 1
#endif
#ifndef PROBE_DMA2
#define PROBE_DMA2 0
#endif
#if PROBE_DMA2
#define VMCNT12 "s_waitcnt vmcnt(24)"
#else
#define VMCNT12 "s_waitcnt vmcnt(12)"
#endif
#ifndef PROBE_NODMA
#define PROBE_NODMA 0
#endif
#ifndef PROBE_NOSLICE
#define PROBE_NOSLICE 0
#endif
#ifndef PROBE_SCAN2
#define PROBE_SCAN2 0
#endif
#ifndef PROBE_STORE2
#define PROBE_STORE2 0
#endif
#ifndef GDN_PREFETCH
#define GDN_PREFETCH 1
#endif
#ifndef RET_PREFETCH
#define RET_PREFETCH 1
#endif
#ifndef PROBE_SEG
#define PROBE_SEG 0
#endif
#define SEG_MINE(k) ((PROBE_SEG) == (k) && blockIdx.x == (((k) <= 5) ? 32 : 0) && F.wave == ((((k) >= 3 && (k) <= 5)) ? 4 : 0))
#define SEG_T0(k) do { if (SEG_MINE(k)) seg_t0_ = __builtin_amdgcn_s_memtime(); } while (0)
#define SEG_ACC(k) do { if (SEG_MINE(k)) seg_acc_ += __builtin_amdgcn_s_memtime() - seg_t0_; } while (0)
#define SEG_T02(k) do { if (SEG_MINE(k)) seg_t1_ = __builtin_amdgcn_s_memtime(); } while (0)
#define SEG_ACC2(k) do { if (SEG_MINE(k)) seg_acc_ += __builtin_amdgcn_s_memtime() - seg_t1_; } while (0)
#define SEG_OUT() do { if ((PROBE_SEG) > 0 && SEG_MINE(PROBE_SEG) && pg8::pg8_lane_id() == 0) __hip_atomic_store((unsigned*)(F.ws + WS_CTL) + 20000, (unsigned)(seg_acc_ >> 7), __ATOMIC_RELAXED, __HIP_MEMORY_SCOPE_AGENT); } while (0)
constexpr int NWAVES = 8;
constexpr int NPHASES = 10;
constexpr int BATCH = 2, SEQ = 8192, D = 2048, T = BATCH * SEQ;
constexpr int NH = 8, DK = 128, DV = 256;
constexpr int NIN = 16400;
constexpr int OFF_AZ = 4096, OFF_AB = 6144, OFF_RQ = 6160, OFF_RK = 7184, OFF_RV = 8208, OFF_RG = 10256, OFF_GA = 12304, OFF_GB = 14352;
constexpr int N1 = 17408;
constexpr int FF = 5632, NGU = 2 * FF;
constexpr float EPS = 1e-6f;
constexpr size_t MiB = 1u << 20;
constexpr size_t WS_CTL = 0, CTL_ZERO_BYTES = 1 * MiB;
constexpr size_t WS_BETA = 1 * MiB, WS_G = 1 * MiB + 512 * 1024;
constexpr size_t WS_COS = 2 * MiB, WS_SIN = 4 * MiB;
constexpr size_t WS_COS2 = 6 * MiB, WS_SIN2 = 8 * MiB;
constexpr size_t WS_DL = 10 * MiB, WS_RSTD = 11 * MiB;
constexpr size_t WS_WOT = 12 * MiB;
constexpr size_t WS_WGUT = 20 * MiB, WS_WDT = 64 * MiB;
constexpr size_t WS_W1T = 20 * MiB, WS_U = 88 * MiB;
constexpr size_t WS_GW = 20 * MiB, WS_GQ = 52 * MiB, WS_GK = 84 * MiB, WS_GA = 116 * MiB, WS_GU = 132 * MiB;
constexpr size_t WS_QKV = 196 * MiB;
constexpr size_t WS_RQF = 324 * MiB, WS_RKF = 356 * MiB, WS_RKTF = 388 * MiB, WS_RVTF = 420 * MiB, WS_END = 484 * MiB;
constexpr size_t WS_OA = 196 * MiB;
constexpr size_t WS_OB = 260 * MiB;
constexpr size_t WS_MIXED = 196 * MiB;
constexpr size_t WS_HNB = 324 * MiB;
constexpr size_t WS_H = 388 * MiB;
constexpr size_t WS_ACT = 88 * MiB;
static_assert(WS_ACT + (size_t)T * FF * 2 <= WS_HNB, "ACT overlay");
constexpr int CW_BAR = 4096;
constexpr int RING_BYTES = 131072, SCAN_RING_BYTES = 147456 + 12288, LDSCTL_OFF = SCAN_RING_BYTES, MISC_OFF = LDSCTL_OFF + 320, LDS_BYTES = 163840;

typedef unsigned short bf16;
typedef unsigned v4u __attribute__((ext_vector_type(4)));
typedef unsigned v2u __attribute__((ext_vector_type(2)));
typedef float f32x4 __attribute__((ext_vector_type(4)));
#define LDS_WAIT() asm volatile("s_waitcnt lgkmcnt(0)" ::: "memory")
__device__ __forceinline__ unsigned f2bf(float f) { unsigned u = __builtin_bit_cast(unsigned, f); return (u + 0x7fffu + ((u >> 16) & 1u)) >> 16; }
__device__ __forceinline__ unsigned pk2(float lo, float hi) { return f2bf(lo) | (f2bf(hi) << 16); }
__device__ __forceinline__ float bf2f(unsigned b) { return __builtin_bit_cast(float, b << 16); }
__device__ __forceinline__ float bflo(unsigned w) { return __builtin_bit_cast(float, w << 16); }
__device__ __forceinline__ float bfhi(unsigned w) { return __builtin_bit_cast(float, w & 0xffff0000u); }
__device__ __forceinline__ float silu_f(float a) { return a * __builtin_amdgcn_rcpf(1.0f + __expf(-a)); }
__device__ __forceinline__ float wave_sum(float v) {
#pragma unroll
    for (int o = 1; o < 64; o <<= 1) v += __shfl_xor(v, o);
    return v;
}

struct Args { const float* in[14]; float* out; unsigned char* ws; int ph_lo, ph_hi; };
struct Frame {
    LAS unsigned char* lds; int tid, lane, wave, vcu, G;
    const float *x, *norm1_w, *w_in, *conv_w, *a_log, *dt_bias, *gdn_norm_w, *ret_norm_w, *w_out, *norm2_w, *w_gate, *w_up, *w_down, *norm_f_w;
    float* out; unsigned char* ws;
};

__device__ __forceinline__ void transpose_blk(const float* src, int ld, int k0, int sc0, bf16* dst, int K, int dr0, LAS float* scr, int lane, const float* kscale = nullptr) {
    f32x4 v[16];
#pragma unroll
    for (int i = 0; i < 16; ++i) v[i] = *(const f32x4*)(src + (size_t)(k0 + 4 * i + (lane >> 4)) * ld + sc0 + 4 * (lane & 15));
    if (kscale) {
#pragma unroll
        for (int i = 0; i < 16; ++i) v[i] = v[i] * kscale[k0 + 4 * i + (lane >> 4)]; }
#pragma unroll
    for (int i = 0; i < 16; ++i) { LAS float* d = scr + (4 * i + (lane >> 4)) * 65 + 4 * (lane & 15); d[0] = v[i].x; d[1] = v[i].y; d[2] = v[i].z; d[3] = v[i].w; }
    LDS_WAIT(); asm volatile("" ::: "memory");
    const int c = lane & 7;
#pragma unroll
    for (int j = 0; j < 8; ++j) { const int n = (lane >> 3) + 8 * j; const LAS float* s = scr + (8 * c) * 65 + n;
        v4u o; o.x = pk2(s[0 * 65], s[1 * 65]); o.y = pk2(s[2 * 65], s[3 * 65]); o.z = pk2(s[4 * 65], s[5 * 65]); o.w = pk2(s[6 * 65], s[7 * 65]);
        *(v4u*)(dst + (size_t)(dr0 + n) * K + k0 + 8 * c) = o; }
    LDS_WAIT(); asm volatile("" ::: "memory");
}
__device__ __forceinline__ int w1_src_col(int n) {
    if (n < 4096) return n;
    if (n >= 16384) n = n - 16384 + 5120;
    if (n < 6144) { const int isk = n >= 5120, lt = (n - 4096) & 1023, tile = lt >> 8, c = lt & 255, bj = c >> 7, p = c & 127; return (isk ? OFF_RK : OFF_RQ) + (2 * tile + (p >> 6)) * 128 + bj * 64 + (p & 63); }
    if (n < 8192) return OFF_RV + (n - 6144);
    { const int isb = n >= 12288, lt = (n - 8192) & 4095, j = lt >> 8, c = lt & 255, bj = c >> 7, p = c & 127;
      return (isb ? (bj ? OFF_GB : OFF_RG) : (bj ? OFF_GA : OFF_AZ)) + 128 * j + p; }
}
__device__ __forceinline__ void p0_prologue(Frame& F) {
    __syncthreads();
    const int gw = F.vcu * NWAVES + F.wave, NGW = F.G * NWAVES, lane = F.lane;
    {
        LAS float* scr = (LAS float*)(F.lds + F.wave * 16640);
        constexpr int I_1 = (D / 64) * (N1 / 64), I_O = (D / 64) * (D / 64);
        constexpr int NITEMS = I_1 + I_O;
        bf16* W1T = (bf16*)(F.ws + WS_W1T); bf16* WOT = (bf16*)(F.ws + WS_WOT);
        for (int it = gw; it < NITEMS; it += NGW) {
            int r = it;
            if (r < I_1) { const int nb = r % (N1 / 64), kb = r / (N1 / 64); transpose_blk(F.w_in, NIN, 64 * kb, w1_src_col(64 * nb), W1T, D, 64 * nb, scr, lane); continue; } r -= I_1;
            { const int nb = r % (D / 64), kb = r / (D / 64); transpose_blk(F.w_out, D, 64 * kb, 64 * nb, WOT, D, 64 * nb, scr, lane); }
        }
    }
    {
        float* cosT = (float*)(F.ws + WS_COS); float* sinT = (float*)(F.ws + WS_SIN); float* cosT2 = (float*)(F.ws + WS_COS2); float* sinT2 = (float*)(F.ws + WS_SIN2);
        for (int idx = (F.vcu * 512 + F.tid); idx < SEQ * 64; idx += F.G * 512) { const int t = idx >> 6, i = idx & 63;
            const float inv = (float)exp2(-(double)i * (13.287712379549449 / 64.0));
            const float ang = (float)t * inv; const double a = (double)ang; const float cv = (float)cos(a), sv = (float)sin(a);
            cosT[idx] = cv; sinT[idx] = sv; cosT2[i * SEQ + t] = cv; sinT2[i * SEQ + t] = sv; }
    }
    __syncthreads();
    {
        LAS float* wT = (LAS float*)F.lds;
        { f32x4 wv[4][4];
#pragma unroll
          for (int j = 0; j < 4; ++j)
#pragma unroll
            for (int q = 0; q < 4; ++q) wv[j][q] = *(const f32x4*)(F.w_in + (size_t)(F.tid + 512 * j) * NIN + OFF_AB + 4 * q);
#pragma unroll
          for (int j = 0; j < 4; ++j)
#pragma unroll
            for (int q = 0; q < 4; ++q)
#pragma unroll
              for (int e = 0; e < 4; ++e) wT[(4 * q + e) * 2048 + F.tid + 512 * j] = wv[j][q][e]; }
        __syncthreads();
        bf16* U = (bf16*)(F.ws + WS_U); float* BETA = (float*)(F.ws + WS_BETA); float* GG = (float*)(F.ws + WS_G);
        f32x4 nw[8];
#pragma unroll
        for (int j = 0; j < 8; ++j) nw[j] = ((const f32x4*)F.norm1_w)[64 * j + lane];
        for (int row = gw; row < T; row += NGW) {
            asm volatile("" ::: "memory");
            const f32x4* xr = (const f32x4*)(F.x + (size_t)row * D) + lane;
            f32x4 v[8]; float ss = 0.f;
#pragma unroll
            for (int j = 0; j < 8; ++j) { v[j] = xr[64 * j]; ss += (v[j].x * v[j].x + v[j].y * v[j].y) + (v[j].z * v[j].z + v[j].w * v[j].w); }
            const float rstd = rsqrtf(wave_sum(ss) * (1.0f / D) + EPS);
            v2u* o8 = (v2u*)(U + (size_t)row * D) + lane;
#pragma unroll
            for (int j = 0; j < 8; ++j) { v[j] = (v[j] * rstd) * nw[j]; v2u w; w.x = pk2(v[j].x, v[j].y); w.y = pk2(v[j].z, v[j].w); o8[64 * j] = w; }
            float mb = 0.f, ma = 0.f;
#pragma unroll
            for (int c = 0; c < 16; ++c) { float s = 0.f;
#pragma unroll
                for (int j = 0; j < 8; ++j) { const f32x4 w = *(const LAS f32x4*)(wT + c * 2048 + 256 * j + 4 * lane); s += (v[j].x * w.x + v[j].y * w.y) + (v[j].z * w.z + v[j].w * w.w); }
                s = wave_sum(s);
                if (c < 8) mb = (lane == c) ? s : mb; else ma = (lane == c - 8) ? s : ma; }
            if (lane == 8) ((float*)(F.ws + WS_RSTD))[row] = 0.f;
            if (lane < 8) { const float bt = 1.0f / (1.0f + expf(-mb)); const float xa = ma + F.dt_bias[lane]; const float sp = xa > 20.f ? xa : log1pf(expf(xa));
                BETA[(size_t)row * 8 + lane] = bt; GG[(size_t)row * 8 + lane] = -expf(F.a_log[lane]) * sp; }
        }
    }
}

__device__ __forceinline__ void gdn_naive(Frame& F, int bh) {
    const int b = bh >> 3, h = bh & 7, tid = F.tid, c = tid & 255, hh = tid >> 8;
    LAS float* sq = (LAS float*)F.lds; LAS float* sk = sq + 128; LAS float* sv = sq + 256; LAS float* sp = sq + 512; LAS float* sred = sq + 1024;
    const int ch = tid < 128 ? h * 128 + tid : (tid < 256 ? 1024 + h * 128 + (tid - 128) : 2048 + h * 256 + (tid - 256));
    const float cw0 = F.conv_w[0 * 4096 + ch], cw1 = F.conv_w[1 * 4096 + ch], cw2 = F.conv_w[2 * 4096 + ch], cw3 = F.conv_w[3 * 4096 + ch];
    const bf16* raw = (const bf16*)(F.ws + WS_QKV) + (size_t)(b * SEQ) * 4096 + ch;
    const float* BETA = (const float*)(F.ws + WS_BETA) + (size_t)(b * SEQ) * 8 + h; const float* GG = (const float*)(F.ws + WS_G) + (size_t)(b * SEQ) * 8 + h;
    bf16* OA = (bf16*)(F.ws + WS_OA) + (size_t)(b * SEQ) * 2048 + h * 256 + c;
    float S[64];
#pragma unroll
    for (int d = 0; d < 64; ++d) S[d] = 0.f;
    float r0 = 0.f, r1 = 0.f, r2 = 0.f;
    float nraw = bf2f(raw[0]), nbeta = BETA[0], ng = GG[0];
    for (int t = 0; t < SEQ; ++t) {
        const float r3 = nraw, beta = nbeta, eg = expf(ng);
        if (t + 1 < SEQ) { nraw = bf2f(raw[(size_t)(t + 1) * 4096]); nbeta = BETA[(size_t)(t + 1) * 8]; ng = GG[(size_t)(t + 1) * 8]; }
        const float a = r0 * cw0 + r1 * cw1 + r2 * cw2 + r3 * cw3; r0 = r1; r1 = r2; r2 = r3;
        float val = a / (1.0f + expf(-a));
        const float ws_ = wave_sum(val * val);
        if (F.lane == 0) sred[F.wave] = ws_;
        __syncthreads();
        if (tid < 128) { val = val * rsqrtf(sred[0] + sred[1] + EPS) * 0.08838834764831845f; sq[tid] = val; }
        else if (tid < 256) { val = val * rsqrtf(sred[2] + sred[3] + EPS); sk[tid - 128] = val; }
        else sv[tid - 256] = val;
        __syncthreads();
        float p = 0.f;
#pragma unroll
        for (int d = 0; d < 64; ++d) p += sk[hh * 64 + d] * S[d];
        sp[hh * 256 + c] = p;
        __syncthreads();
        const float kS = sp[c] + sp[256 + c];
        const float delta = beta * (sv[c] - eg * kS);
        float o = 0.f;
#pragma unroll
        for (int d = 0; d < 64; ++d) { S[d] = eg * S[d] + sk[hh * 64 + d] * delta; o += sq[hh * 64 + d] * S[d]; }
        __syncthreads();
        sp[hh * 256 + c] = o;
        __syncthreads();
        if (hh == 0) OA[(size_t)t * 2048] = (bf16)f2bf(sp[c] + sp[256 + c]);
    }
}
__device__ __forceinline__ void ffn_weight_copies(Frame& F) {
    const int gw = F.vcu * NWAVES + F.wave, NGW = F.G * NWAVES, lane = F.lane;
    LAS float* scr = (LAS float*)(F.lds + F.wave * 16640);
    constexpr int I_G = (D / 64) * (FF / 64), I_D = (FF / 64) * (D / 64);
    bf16* WGUT = (bf16*)(F.ws + WS_WGUT); bf16* WDT = (bf16*)(F.ws + WS_WDT);
    for (int it = gw; it < 2 * I_G + I_D; it += NGW) {
        int r = it;
        if (r < 2 * I_G) { const int up = r >= I_G; if (up) r -= I_G; const int nb = r % (FF / 64), kb = r / (FF / 64), c0 = 64 * nb;
            transpose_blk(up ? F.w_up : F.w_gate, FF, 64 * kb, c0, WGUT, D, 256 * (c0 >> 7) + 128 * up + (c0 & 127), scr, lane, F.norm2_w); continue; } r -= 2 * I_G;
        { const int nb = r % (D / 64), kb = r / (D / 64); transpose_blk(F.w_down, D, 64 * kb, 64 * nb, WDT, FF, 64 * nb, scr, lane); }
    }
}

typedef float f32x16 __attribute__((ext_vector_type(16)));
typedef short bf16x8 __attribute__((ext_vector_type(8)));
typedef float f32x2_t __attribute__((ext_vector_type(2))); typedef __bf16 bf16x2_t __attribute__((ext_vector_type(2)));
#define MFMA32(a, b, c) __builtin_amdgcn_mfma_f32_32x32x16_bf16((a), (b), (c), 0, 0, 0)
__device__ __forceinline__ unsigned cvtpk_s(float lo, float hi) { f32x2_t v = {lo, hi}; bf16x2_t b = __builtin_convertvector(v, bf16x2_t); return __builtin_bit_cast(unsigned, b); }
#define PACK_STEP(x, s) __builtin_bit_cast(bf16x8, (v4u){cvtpk_s((x)[8 * (s)], (x)[8 * (s) + 1]), cvtpk_s((x)[8 * (s) + 2], (x)[8 * (s) + 3]), cvtpk_s((x)[8 * (s) + 4], (x)[8 * (s) + 5]), cvtpk_s((x)[8 * (s) + 6], (x)[8 * (s) + 7])})
__device__ __forceinline__ bf16 cvt1_bf16(float x) { return (bf16)(cvtpk_s(x, x) & 0xffffu); }
__device__ __forceinline__ bf16x8 ldfrag(const bf16* base, size_t f, int lane) {
#if PROBE_NOSLICE
    bf16x8 z; for (int i = 0; i < 8; ++i) z[i] = (short)(lane + i); asm volatile("" : "+v"(z)); return z;
#endif
    return *(const bf16x8*)(base + f * 512 + lane * 8); }
__device__ __forceinline__ f32x16 zero16() { f32x16 z; for (int i = 0; i < 16; ++i) z[i] = 0.f; return z; }

#define SCAN_BAR_C() do { asm volatile("s_waitcnt lgkmcnt(0)" ::: "memory"); __builtin_amdgcn_s_barrier(); asm volatile("" ::: "memory"); } while (0)
#define SCAN_BAR() do { asm volatile("s_waitcnt vmcnt(0) lgkmcnt(0)" ::: "memory"); __builtin_amdgcn_s_barrier(); asm volatile("" ::: "memory"); } while (0)
__device__ __forceinline__ void glds1k(const bf16* gsrc_frag, LAS unsigned char* dst, int lane) {
#if PROBE_NODMA
    return;
#endif
    __builtin_amdgcn_global_load_lds((const unsigned*)(gsrc_frag + lane * 8), (LAS unsigned*)dst, 16, 0, 0);
#if PROBE_DMA2
    __builtin_amdgcn_global_load_lds((const unsigned*)(gsrc_frag + lane * 8), (LAS unsigned*)dst, 16, 0, 0);
#endif
}
__device__ __forceinline__ void dma_chunk3(const bf16* p0, const bf16* p1, const bf16* p2, LAS unsigned char* dst_lw, int lane) {
#pragma unroll
    for (int q = 0; q < 4; ++q) glds1k(p0 + q * 2048, dst_lw + (0 * 16 + 4 * q) * 1024, lane);
#pragma unroll
    for (int q = 0; q < 4; ++q) glds1k(p1 + q * 2048, dst_lw + (1 * 16 + 4 * q) * 1024, lane);
#pragma unroll
    for (int q = 0; q < 4; ++q) glds1k(p2 + q * 2048, dst_lw + (2 * 16 + 4 * q) * 1024, lane);
}
__device__ __forceinline__ bf16x8 ldsfrag(const LAS unsigned char* buf, int slot, int lane) { return *(const LAS bf16x8*)(buf + slot * 1024 + lane * 16); }

constexpr int RS_BUF = 48 * 1024, RS_PA = 3 * RS_BUF;
__device__ __forceinline__ void ret_scan_wg(Frame& F, int bh, int half, unsigned* prog) {
    unsigned long long seg_t0_ = 0, seg_t1_ = 0, seg_acc_ = 0; (void)seg_t0_; (void)seg_t1_; (void)seg_acc_;
    const int w = F.wave, b = bh >> 3, h = bh & 7;
    const bf16* RQf = (const bf16*)(F.ws + WS_RQF); const bf16* RKf = (const bf16*)(F.ws + WS_RKF); const bf16* RKTf = (const bf16*)(F.ws + WS_RKTF); const bf16* RVTf = (const bf16*)(F.ws + WS_RVTF);
    LAS unsigned char* L = F.lds;
    if (w >= 4) {
        const int lw = w - 4, lane = pg8::pg8_lane_id(), col = lane & 31, hh = lane >> 5;
        const bf16* pq = RQf + ((size_t)bh * 128 * 16 + lw) * 512; const bf16* pk = RKf + ((size_t)bh * 128 * 16 + lw) * 512; const bf16* pt = RKTf + ((size_t)bh * 128 * 16 + lw) * 512;
        dma_chunk3(pq, pk, pt, L + 0 * RS_BUF + lw * 1024, lane); pq += 8192; pk += 8192; pt += 8192;
        dma_chunk3(pq, pk, pt, L + 1 * RS_BUF + lw * 1024, lane); pq += 8192; pk += 8192; pt += 8192;
        asm volatile(VMCNT12 ::: "memory"); __builtin_amdgcn_s_barrier(); asm volatile("" ::: "memory");
        int cb = 0, nb = 2;
        for (int n = 0; n < 128; ++n) {
            const LAS unsigned char* B = L + cb * RS_BUF;
            if (lw < 3) {
                const int tj = lw == 2 ? 1 : 0, ti = lw == 0 ? 0 : 1;
                f32x16 P = zero16();
#pragma unroll
                for (int td = 0; td < 4; ++td)
#pragma unroll
                    for (int s2 = 0; s2 < 2; ++s2) P = MFMA32(ldsfrag(B, 16 + (tj * 4 + td) * 2 + s2, lane), ldsfrag(B, (ti * 4 + td) * 2 + s2, lane), P);
                if (lw != 1) {
#pragma unroll
                    for (int r = 0; r < 16; ++r) { const int j = (r & 3) + 8 * (r >> 2) + 4 * hh; if (col < j) P[r] = 0.f; } }
                const bf16x8 a0 = PACK_STEP(P, 0), a1 = PACK_STEP(P, 1);
                *(LAS bf16x8*)(L + RS_PA + (2 * lw) * 1024 + lane * 16) = a0; *(LAS bf16x8*)(L + RS_PA + (2 * lw + 1) * 1024 + lane * 16) = a1;
            }
            asm volatile("s_waitcnt lgkmcnt(0)" ::: "memory"); __builtin_amdgcn_s_barrier(); asm volatile("" ::: "memory");
            if (n + 2 < 128) { dma_chunk3(pq, pk, pt, L + nb * RS_BUF + lw * 1024, lane); pq += 8192; pk += 8192; pt += 8192;
                asm volatile(VMCNT12 ::: "memory"); }
            else asm volatile("s_waitcnt vmcnt(0)" ::: "memory");
            __builtin_amdgcn_s_barrier(); asm volatile("" ::: "memory");
            if (lw == 0 && half == 0 && lane == 0) __hip_atomic_store(prog, (unsigned)(n + 1), __ATOMIC_RELAXED, __HIP_MEMORY_SCOPE_AGENT);
            cb = cb == 2 ? 0 : cb + 1; nb = nb == 2 ? 0 : nb + 1;
        }
        return;
    }
    const int sl = 4 * half + w, lane = pg8::pg8_lane_id(), col = lane & 31, hh = lane >> 5;
    bf16* OB = (bf16*)(F.ws + WS_RVTF) + ((size_t)bh * 128 * 8 + sl) * 2048;
    const unsigned loff = (unsigned)(hh * 4 * 32 + col);
    const float g64 = exp2f(64.0f * log2f(1.0f - exp2f(-5.0f - (float)h)));
    f32x16 S[4];
#pragma unroll
    for (int td = 0; td < 4; ++td) S[td] = zero16();
#if RET_PREFETCH
    bf16x8 vtn[2][2];
    { const size_t cq = (size_t)bh * 128;
#pragma unroll
      for (int tj = 0; tj < 2; ++tj)
#pragma unroll
        for (int s2 = 0; s2 < 2; ++s2) vtn[tj][s2] = ldfrag(RVTf, ((cq * 8 + sl) * 2 + tj) * 2 + s2, lane); }
#endif
    SCAN_BAR_C();
    int cb = 0;
    for (int n = 0; n < 128; ++n) { SEG_T02(6);
        const LAS unsigned char* B = L + cb * RS_BUF; cb = cb == 2 ? 0 : cb + 1;
        bf16x8 vt[2][2];
#if RET_PREFETCH
#pragma unroll
        for (int tj = 0; tj < 2; ++tj)
#pragma unroll
            for (int s2 = 0; s2 < 2; ++s2) vt[tj][s2] = vtn[tj][s2];
        if (n + 1 < 128) { const size_t cq = (size_t)bh * 128 + n + 1;
#else
#define vtn vt
        { const size_t cq = (size_t)bh * 128 + n;
#endif
#pragma unroll
          for (int tj = 0; tj < 2; ++tj)
#pragma unroll
            for (int s2 = 0; s2 < 2; ++s2) vtn[tj][s2] = ldfrag(RVTf, ((cq * 8 + sl) * 2 + tj) * 2 + s2, lane); }
#define PIN() do { asm volatile("" ::: "memory"); __builtin_amdgcn_sched_barrier(0); } while (0)
#define LD4(dst, base, s0, s1, s2, s3) do { PIN(); dst[0] = ldsfrag(base, s0, lane); dst[1] = ldsfrag(base, s1, lane); dst[2] = ldsfrag(base, s2, lane); dst[3] = ldsfrag(base, s3, lane); PIN(); } while (0)
#define QSLOT(ti, td, s2) (((ti) * 4 + (td)) * 2 + (s2))
#define KTSLOT(k) (32 + (k))
        bf16x8 fa[4], fb[4];
        const LAS unsigned char* PAb = L + RS_PA;
        f32x16 o0 = zero16(), o1 = zero16();
        LD4(fa, B, QSLOT(0, 0, 0), QSLOT(0, 0, 1), QSLOT(1, 0, 0), QSLOT(1, 0, 1));
        { const bf16x8 sb0 = PACK_STEP(S[0], 0), sb1 = PACK_STEP(S[0], 1);
          LD4(fb, B, QSLOT(0, 1, 0), QSLOT(0, 1, 1), QSLOT(1, 1, 0), QSLOT(1, 1, 1));
          o0 = MFMA32(fa[0], sb0, o0); o0 = MFMA32(fa[1], sb1, o0); o1 = MFMA32(fa[2], sb0, o1); o1 = MFMA32(fa[3], sb1, o1); }
        { const bf16x8 sb0 = PACK_STEP(S[1], 0), sb1 = PACK_STEP(S[1], 1);
          LD4(fa, B, QSLOT(0, 2, 0), QSLOT(0, 2, 1), QSLOT(1, 2, 0), QSLOT(1, 2, 1));
          o0 = MFMA32(fb[0], sb0, o0); o0 = MFMA32(fb[1], sb1, o0); o1 = MFMA32(fb[2], sb0, o1); o1 = MFMA32(fb[3], sb1, o1); }
        { const bf16x8 sb0 = PACK_STEP(S[2], 0), sb1 = PACK_STEP(S[2], 1);
          LD4(fb, B, QSLOT(0, 3, 0), QSLOT(0, 3, 1), QSLOT(1, 3, 0), QSLOT(1, 3, 1));
          o0 = MFMA32(fa[0], sb0, o0); o0 = MFMA32(fa[1], sb1, o0); o1 = MFMA32(fa[2], sb0, o1); o1 = MFMA32(fa[3], sb1, o1); }
        { const bf16x8 sb0 = PACK_STEP(S[3], 0), sb1 = PACK_STEP(S[3], 1);
          o0 = MFMA32(fb[0], sb0, o0); o0 = MFMA32(fb[1], sb1, o0); o1 = MFMA32(fb[2], sb0, o1); o1 = MFMA32(fb[3], sb1, o1); }
        SEG_T0(7); SCAN_BAR_C(); SEG_ACC(7);
#define STORE_O(ox, rowoff) do { _Pragma("unroll") for (int r = 0; r < 16; ++r) { const unsigned ro = (unsigned)(((r & 3) + 8 * (r >> 2)) * 32); orow[loff + ro + (rowoff)] = cvt1_bf16(ox[r]); } } while (0)
        bf16* orow = OB + (size_t)n * (8 * 2048);
        LD4(fa, PAb, 0, 1, 2, 3);
        fb[0] = ldsfrag(PAb, 4, lane); fb[1] = ldsfrag(PAb, 5, lane); fb[2] = ldsfrag(B, KTSLOT(0), lane); fb[3] = ldsfrag(B, KTSLOT(1), lane); PIN();
        S[0] = S[0] * g64; S[1] = S[1] * g64;
        o0 = MFMA32(fa[0], vt[0][0], o0); o0 = MFMA32(fa[1], vt[0][1], o0); o1 = MFMA32(fa[2], vt[0][0], o1); o1 = MFMA32(fa[3], vt[0][1], o1);
        LD4(fa, B, KTSLOT(2), KTSLOT(3), KTSLOT(4), KTSLOT(5));
        S[2] = S[2] * g64; S[3] = S[3] * g64;
        o1 = MFMA32(fb[0], vt[1][0], o1); o1 = MFMA32(fb[1], vt[1][1], o1);
        S[0] = MFMA32(fb[2], vt[0][0], S[0]); S[0] = MFMA32(fb[3], vt[0][1], S[0]);
        LD4(fb, B, KTSLOT(6), KTSLOT(7), KTSLOT(8), KTSLOT(9));
        STORE_O(o0, 0u);
        S[0] = MFMA32(fa[0], vt[1][0], S[0]); S[0] = MFMA32(fa[1], vt[1][1], S[0]);
        S[1] = MFMA32(fa[2], vt[0][0], S[1]); S[1] = MFMA32(fa[3], vt[0][1], S[1]);
        LD4(fa, B, KTSLOT(10), KTSLOT(11), KTSLOT(12), KTSLOT(13));
        STORE_O(o1, 32u * 32u);
        S[1] = MFMA32(fb[0], vt[1][0], S[1]); S[1] = MFMA32(fb[1], vt[1][1], S[1]);
        S[2] = MFMA32(fb[2], vt[0][0], S[2]); S[2] = MFMA32(fb[3], vt[0][1], S[2]);
        PIN(); fb[0] = ldsfrag(B, KTSLOT(14), lane); fb[1] = ldsfrag(B, KTSLOT(15), lane); PIN();
        S[2] = MFMA32(fa[0], vt[1][0], S[2]); S[2] = MFMA32(fa[1], vt[1][1], S[2]);
        S[3] = MFMA32(fa[2], vt[0][0], S[3]); S[3] = MFMA32(fa[3], vt[0][1], S[3]);
        S[3] = MFMA32(fb[0], vt[1][0], S[3]); S[3] = MFMA32(fb[1], vt[1][1], S[3]);
#undef STORE_O
        SEG_T0(8); SCAN_BAR_C(); SEG_ACC(8); SEG_ACC2(6);
    }
    SEG_OUT();
}

#define RLX_AGENT __ATOMIC_RELAXED, __HIP_MEMORY_SCOPE_AGENT
__device__ __forceinline__ void st8_wt(void* p, unsigned lo, unsigned hi) { __hip_atomic_store((unsigned long long*)p, ((unsigned long long)hi << 32) | lo, RLX_AGENT); }
__device__ __forceinline__ void st16_wt(void* p, v4u v) { st8_wt(p, v.x, v.y); st8_wt((char*)p + 8, v.z, v.w); }
constexpr int CW_RDY = 32768;
#ifndef PROBE_NOSTORE
#define PROBE_NOSTORE 0
#endif
#ifndef PROBE_ONLYSCAN
#define PROBE_ONLYSCAN 0
#endif
#ifndef PROBE_PREP
#define PROBE_PREP 0
#endif
constexpr int GP_QH = 0, GP_KH = 17408, GP_AM = 34816, GP_RK = 51200, GP_GC = 83968, GP_BT = 84224, GP_WL = GP_RK, GP_VR = 84480;
__device__ __forceinline__ void gdn_prep(Frame& F, int ci) {
    int tid_ = F.tid; asm volatile("" : "+v"(tid_));
    const int tid = tid_, lane = tid & 63, w = __builtin_amdgcn_readfirstlane(tid >> 6), bh = ci >> 7, n = ci & 127, b = bh >> 3, h = bh & 7;
    const size_t trow0 = (size_t)b * SEQ + 64 * n;
    LAS unsigned char* L = F.lds;
    LAS float* gcs = (LAS float*)(L + GP_GC); LAS float* bet = (LAS float*)(L + GP_BT); LAS float* Am = (LAS float*)(L + GP_AM); LAS float* Rk = (LAS float*)(L + GP_RK);
    const bf16* QKV = (const bf16*)(F.ws + WS_QKV);
    bf16* GW = (bf16*)(F.ws + WS_GW); bf16* GQ = (bf16*)(F.ws + WS_GQ); bf16* GK = (bf16*)(F.ws + WS_GK); bf16* GA = (bf16*)(F.ws + WS_GA); bf16* GU = (bf16*)(F.ws + WS_GU);
    {
        v4u vr[5];
#pragma unroll
        for (int k = 0; k < 5; ++k) { const int idx = tid + 512 * k, row = idx >> 5, cg = idx & 31; vr[k] = (v4u){0u, 0u, 0u, 0u};
            if (row < 67 && (n > 0 || row >= 3)) vr[k] = *(const v4u*)(QKV + (trow0 + row - 3) * 4096 + 2048 + h * 256 + 8 * cg); }
#pragma unroll
        for (int k = 0; k < 5; ++k) { const int idx = tid + 512 * k, row = idx >> 5, cg = idx & 31; if (row < 67) *(LAS v4u*)(L + GP_VR + row * 512 + cg * 16) = vr[k]; }
    }
    if (w == 0) {
        float g = ((const float*)(F.ws + WS_G))[(trow0 + lane) * 8 + h];
#pragma unroll
        for (int o = 1; o < 64; o <<= 1) { const float t = __shfl_up(g, o); if (lane >= o) g += t; }
        gcs[lane] = g; bet[lane] = ((const float*)(F.ws + WS_BETA))[(trow0 + lane) * 8 + h];
        if (lane == 63) __hip_atomic_store((unsigned*)(F.ws + WS_DL) + ci, __builtin_bit_cast(unsigned, expf(g)), RLX_AGENT);
    }
    __syncthreads();
    for (int pr_ = 0; pr_ < (PROBE_PREP == 1 ? 2 : 1); ++pr_) {
        const int cg = lane & 31, rh = lane >> 5, isk = cg >> 4, dk0 = 8 * (cg & 15), row0 = 8 * w + 4 * rh;
        const int ch = (isk ? 1024 : 0) + h * 128 + dk0;
        float cw[4][8];
#pragma unroll
        for (int j = 0; j < 4; ++j) { const f32x4 a = *(const f32x4*)(F.conv_w + j * 4096 + ch), c = *(const f32x4*)(F.conv_w + j * 4096 + ch + 4);
            cw[j][0] = a.x; cw[j][1] = a.y; cw[j][2] = a.z; cw[j][3] = a.w; cw[j][4] = c.x; cw[j][5] = c.y; cw[j][6] = c.z; cw[j][7] = c.w; }
        float raw[7][8];
#pragma unroll
        for (int rr = 0; rr < 7; ++rr) { const int row = row0 - 3 + rr;
            v4u v = {0u, 0u, 0u, 0u};
            if (n > 0 || row >= 0) v = *(const v4u*)(QKV + (trow0 + row) * 4096 + ch);
#pragma unroll
            for (int e = 0; e < 4; ++e) { raw[rr][2 * e] = bflo(v[e]); raw[rr][2 * e + 1] = bfhi(v[e]); } }
        const float g63 = gcs[63];
#pragma unroll
        for (int r = 0; r < 4; ++r) { asm volatile("" ::: "memory"); const int row = row0 + r; float val[8]; float ss = 0.f;
#pragma unroll
            for (int e = 0; e < 8; ++e) { const float a = raw[r][e] * cw[0][e] + raw[r + 1][e] * cw[1][e] + raw[r + 2][e] * cw[2][e] + raw[r + 3][e] * cw[3][e];
                val[e] = silu_f(a); ss += val[e] * val[e]; }
            ss += __shfl_xor(ss, 1); ss += __shfl_xor(ss, 2); ss += __shfl_xor(ss, 4); ss += __shfl_xor(ss, 8);
            const float rn = rsqrtf(ss + EPS) * (isk ? 1.0f : 0.08838834764831845f);
            const float gc = gcs[row], eg = __expf(gc);
#pragma unroll
            for (int e = 0; e < 8; ++e) val[e] *= rn;
            v4u pk; pk.x = pk2(val[0], val[1]); pk.y = pk2(val[2], val[3]); pk.z = pk2(val[4], val[5]); pk.w = pk2(val[6], val[7]);
            *(LAS v4u*)(L + (isk ? GP_KH : GP_QH) + row * 272 + dk0 * 2) = pk;
            if (!isk) {
                const size_t f = (((size_t)ci * 2 + (row >> 5)) * 4 + (dk0 >> 5)) * 2 + ((dk0 >> 4) & 1);
                bf16* p = GQ + f * 512 + (row & 31) * 8 + ((dk0 >> 3) & 1) * 4;
                st8_wt(p, pk2(val[0] * eg, val[1] * eg), pk2(val[2] * eg, val[3] * eg));
                st8_wt(p + 256, pk2(val[4] * eg, val[5] * eg), pk2(val[6] * eg, val[7] * eg));
            } else {
                const float bt = bet[row] * eg;
                f32x4 r0 = {val[0] * bt, val[1] * bt, val[2] * bt, val[3] * bt}, r1 = {val[4] * bt, val[5] * bt, val[6] * bt, val[7] * bt};
                *(LAS f32x4*)(Rk + row * 128 + dk0) = r0; *(LAS f32x4*)(Rk + row * 128 + dk0 + 4) = r1;
                const float ek = __expf(g63 - gc);
#pragma unroll
                for (int e = 0; e < 8; ++e) raw[r][e] = val[e] * ek;
            }
        }
        if (isk) {
            const int tj = w >> 2, s1 = (w >> 1) & 1;
#pragma unroll
            for (int e = 0; e < 8; ++e) { const int dk = dk0 + e;
                const size_t f = (((size_t)ci * 4 + (dk >> 5)) * 2 + tj) * 2 + s1;
                st8_wt(GK + f * 512 + (rh * 32 + (dk & 31)) * 8 + (w & 1) * 4, pk2(raw[0][e], raw[1][e]), pk2(raw[2][e], raw[3][e])); }
        }
    }
    __syncthreads();
    for (int pr_ = 0; pr_ < (PROBE_PREP == 2 ? 2 : 1); ++pr_) if (w < 6) {
        const int tsel = w % 3, ti = tsel == 0 ? 0 : 1, tj = tsel == 2 ? 1 : 0;
        const int r = lane & 31, hh = lane >> 5;
        f32x16 acc = zero16();
        if (w < 3) {
#pragma unroll
            for (int kb = 0; kb < 8; ++kb) { const bf16x8 a = *(const LAS bf16x8*)(L + GP_KH + (32 * ti + r) * 272 + (16 * kb + 8 * hh) * 2), bb = *(const LAS bf16x8*)(L + GP_KH + (32 * tj + r) * 272 + (16 * kb + 8 * hh) * 2);
                acc = MFMA32(a, bb, acc); }
            const int j = 32 * tj + r; const float gj = gcs[j];
#pragma unroll
            for (int q = 0; q < 16; ++q) { const int i = 32 * ti + (q & 3) + 8 * (q >> 2) + 4 * hh;
                const float v = (i > j) ? bet[i] * acc[q] * __expf(fminf(gcs[i] - gj, 0.f)) : 0.f; Am[i * 64 + j] = v; }
        } else {
#pragma unroll
            for (int kb = 0; kb < 8; ++kb) { const bf16x8 a = *(const LAS bf16x8*)(L + GP_KH + (32 * tj + r) * 272 + (16 * kb + 8 * hh) * 2), bb = *(const LAS bf16x8*)(L + GP_QH + (32 * ti + r) * 272 + (16 * kb + 8 * hh) * 2);
                acc = MFMA32(a, bb, acc); }
            const int i = 32 * ti + r; const float gi = gcs[i];
#pragma unroll
            for (int q = 0; q < 16; ++q) { const int j = 32 * tj + (q & 3) + 8 * (q >> 2) + 4 * hh;
                acc[q] = (i >= j) ? acc[q] * __expf(fminf(gi - gcs[j], 0.f)) : 0.f; }
            const bf16x8 f0 = PACK_STEP(acc, 0), f1 = PACK_STEP(acc, 1);
            const size_t f = (((size_t)ci * 2 + ti) * 2 + tj) * 2;
            st16_wt(GA + f * 512 + lane * 8, __builtin_bit_cast(v4u, f0)); st16_wt(GA + (f + 1) * 512 + lane * 8, __builtin_bit_cast(v4u, f1));
        }
    }
    __syncthreads();
    float x[64];
    for (int pr_ = 0; pr_ < (PROBE_PREP == 3 ? 2 : 1); ++pr_) if (tid < 384) {
        if (tid < 256) {
            const int ch = 2048 + h * 256 + tid;
            const float c0 = F.conv_w[ch], c1 = F.conv_w[4096 + ch], c2 = F.conv_w[2 * 4096 + ch], c3 = F.conv_w[3 * 4096 + ch];
            const LAS unsigned short* vcol = (const LAS unsigned short*)(L + GP_VR) + tid;
            float r0 = bf2f(vcol[0]), r1 = bf2f(vcol[256]), r2 = bf2f(vcol[512]);
#pragma unroll
            for (int i = 0; i < 64; ++i) { const float r3 = bf2f(vcol[(i + 3) * 256]); const float a = r0 * c0 + r1 * c1 + r2 * c2 + r3 * c3; r0 = r1; r1 = r2; r2 = r3;
                x[i] = bet[i] * silu_f(a); }
        } else {
#pragma unroll
            for (int i = 0; i < 64; ++i) x[i] = Rk[i * 128 + (tid - 256)];
        }
#pragma unroll
        for (int i = 1; i < 64; ++i) { float s0 = 0.f, s1 = 0.f, s2 = 0.f, s3 = 0.f;
            asm volatile("" ::: "memory");
#pragma unroll
            for (int q = 0; q < (i + 3) / 4; ++q) { const f32x4 a = *(const LAS f32x4*)(Am + i * 64 + 4 * q);
                if (4 * q + 0 < i) s0 += a.x * x[4 * q + 0];
                if (4 * q + 1 < i) s1 += a.y * x[4 * q + 1];
                if (4 * q + 2 < i) s2 += a.z * x[4 * q + 2];
                if (4 * q + 3 < i) s3 += a.w * x[4 * q + 3]; }
            x[i] -= (s0 + s1) + (s2 + s3);
            asm volatile("" : "+v"(x[i])); }
        if (tid < 256) {
            const int sl = tid >> 5, col = tid & 31;
#pragma unroll
            for (int ti = 0; ti < 2; ++ti)
#pragma unroll
                for (int hh = 0; hh < 2; ++hh) { v4u a, c;
#define XR(q) x[32 * ti + ((q) & 3) + 8 * ((q) >> 2) + 4 * hh]
                    a.x = pk2(XR(0), XR(1)); a.y = pk2(XR(2), XR(3)); a.z = pk2(XR(4), XR(5)); a.w = pk2(XR(6), XR(7));
                    c.x = pk2(XR(8), XR(9)); c.y = pk2(XR(10), XR(11)); c.z = pk2(XR(12), XR(13)); c.w = pk2(XR(14), XR(15));
#undef XR
                    bf16* p = GU + (((size_t)ci * 8 + sl) * 2 + ti) * 1024 + (hh * 32 + col) * 16;
                    st16_wt(p, a); st16_wt(p + 8, c); }
        }
    }
    __syncthreads();
    if (tid >= 256 && tid < 384) { const int dk = tid - 256;
#pragma unroll
        for (int i = 0; i < 64; ++i) *(LAS unsigned short*)(L + GP_WL + i * 272 + dk * 2) = (unsigned short)f2bf(-x[i]); }
    __syncthreads();
#pragma unroll
    for (int k = 0; k < 2; ++k) { const int idx = tid + 512 * k, row = idx >> 4, dk0 = 8 * (idx & 15);
        const v4u v = *(const LAS v4u*)(L + GP_WL + row * 272 + dk0 * 2);
        const size_t f = (((size_t)ci * 2 + (row >> 5)) * 4 + (dk0 >> 5)) * 2 + ((dk0 >> 4) & 1);
        bf16* p = GW + f * 512 + (row & 31) * 8 + ((dk0 >> 3) & 1) * 4;
        st8_wt(p, v.x, v.y); st8_wt(p + 256, v.z, v.w); }
    asm volatile("s_waitcnt vmcnt(0)" ::: "memory");
    __syncthreads();
    if (tid == 0) __hip_atomic_store((unsigned*)(F.ws + WS_CTL) + CW_RDY + ci, 1u, RLX_AGENT);
}

constexpr int GS_BUF = 48 * 1024, GS_GA = 3 * GS_BUF;
__device__ __forceinline__ void gdn_scan_wg(Frame& F, int bh, int half, unsigned* prog) {
    unsigned long long seg_t0_ = 0, seg_t1_ = 0, seg_acc_ = 0; (void)seg_t0_; (void)seg_t1_; (void)seg_acc_;
    const int w = F.wave, b = bh >> 3, h = bh & 7;
    const bf16* GW = (const bf16*)(F.ws + WS_GW); const bf16* GQ = (const bf16*)(F.ws + WS_GQ); const bf16* GK = (const bf16*)(F.ws + WS_GK); const bf16* GA = (const bf16*)(F.ws + WS_GA); const bf16* GU = (const bf16*)(F.ws + WS_GU);
    LAS unsigned char* L = F.lds;
    if (w >= 4) {
        const int lw = w - 4, lane = pg8::pg8_lane_id();
        const bf16* pw = GW + ((size_t)bh * 128 * 16 + lw) * 512; const bf16* pq = GQ + ((size_t)bh * 128 * 16 + lw) * 512; const bf16* pk = GK + ((size_t)bh * 128 * 16 + lw) * 512;
        int bi = 0;
        const unsigned* rdy = (const unsigned*)(F.ws + WS_CTL) + CW_RDY + bh * 128;
        for (int c = 0; c < 130; ++c) { SEG_T0(3);
            if ((c & 7) == 0 && c < 128) {
                for (int spin = 0; spin < (1 << 22); ++spin) { const unsigned f = lane < 8 ? __hip_atomic_load(rdy + c + (lane & 7), RLX_AGENT) : 1u;
                    if (__all(f != 0u)) break; __builtin_amdgcn_s_sleep(8); }
                __builtin_amdgcn_fence(__ATOMIC_ACQUIRE, "agent"); asm volatile("s_waitcnt vmcnt(0)" ::: "memory"); }
            if (c >= 1 && c - 1 < 128 && lw < 3) { const size_t ci = (size_t)bh * 128 + (c - 1); LAS unsigned char* dst = L + GS_GA + ((c - 1) & 1) * 6144;
#pragma unroll
                for (int q = 0; q < 2; ++q) { const int f = 2 * lw + q, gaf = f < 2 ? f : f + 2; glds1k(GA + (ci * 8 + gaf) * 512, dst + f * 1024, lane); } }
            if (c < 128) { dma_chunk3(pw, pq, pk, L + bi * GS_BUF + lw * 1024, lane); pw += 8192; pq += 8192; pk += 8192; }
            if (lw == 0 && half == 0 && lane == 0 && c >= 1) __hip_atomic_store(prog, (unsigned)c, __ATOMIC_RELAXED, __HIP_MEMORY_SCOPE_AGENT);
            bi = bi == 2 ? 0 : bi + 1;
            SEG_ACC(3); if (c >= 1) { SEG_T0(4); if (c < 128) asm volatile(VMCNT12 ::: "memory"); else asm volatile("s_waitcnt vmcnt(0)" ::: "memory"); SEG_ACC(4); SEG_T0(5);
                __builtin_amdgcn_s_barrier(); asm volatile("" ::: "memory"); SEG_ACC(5); }
        }
        SEG_OUT();
        return;
    }
    const int sl = 4 * half + w, lane = pg8::pg8_lane_id(), col = lane & 31, hh = lane >> 5;
    const float* DL = (const float*)(F.ws + WS_DL);
    bf16* OA = (bf16*)(F.ws + WS_GU) + ((size_t)bh * 128 * 8 + sl) * 2048;
    const unsigned loff = (unsigned)(hh * 4 * 32 + col);
    f32x16 S[4];
#pragma unroll
    for (int td = 0; td < 4; ++td) S[td] = zero16();
    v4u uc[2][2]; float dln;
    SCAN_BAR_C();
    { const size_t ci = (size_t)bh * 128; dln = DL[ci];
      const bf16* p = GU + ((ci * 8 + sl) * 2 + 0) * 1024 + lane * 16; uc[0][0] = *(const v4u*)p; uc[0][1] = *(const v4u*)(p + 8); }
    int cb = 0;
    for (int n = 0; n < 128; ++n) { SEG_T02(1);
        const LAS unsigned char* B = L + cb * GS_BUF; cb = cb == 2 ? 0 : cb + 1;
        const LAS unsigned char* GAb = L + GS_GA + (n & 1) * 6144;
#if GDN_PREFETCH
        const float dl = dln;
#else
        float dl; { const size_t ci = (size_t)bh * 128 + n; dl = DL[ci]; const bf16* p = GU + ((ci * 8 + sl) * 2 + 0) * 1024 + lane * 16; uc[0][0] = *(const v4u*)p; uc[0][1] = *(const v4u*)(p + 8); }
#endif
#define WSLOT(ti, td, s2) (((ti) * 4 + (td)) * 2 + (s2))
#define GKSLOT(k) (32 + (k))
#define LDWQ(dst, ti, td) LD4(dst, B, WSLOT(ti, td, 0), WSLOT(ti, td, 1), 16 + WSLOT(ti, td, 0), 16 + WSLOT(ti, td, 1))
#define ADD_U(v, ti) do { _Pragma("unroll") for (int e = 0; e < 4; ++e) { v[2 * e] += bflo(uc[ti][0][e]); v[2 * e + 1] += bfhi(uc[ti][0][e]); v[8 + 2 * e] += bflo(uc[ti][1][e]); v[8 + 2 * e + 1] += bfhi(uc[ti][1][e]); } } while (0)
#define HALF_TD(F_, td, vnx, ox) { const bf16x8 sb0 = PACK_STEP(S[td], 0), sb1 = PACK_STEP(S[td], 1); \
          vnx = MFMA32(F_[0], sb0, vnx); vnx = MFMA32(F_[1], sb1, vnx); ox = MFMA32(F_[2], sb0, ox); ox = MFMA32(F_[3], sb1, ox); }
        bf16x8 fa[4], fb[4];
        bf16x8 vb00, vb01, vb10, vb11;
        bf16* orow = OA + (size_t)n * (8 * 2048);
#define STORE_O(ox, rowoff) do { _Pragma("unroll") for (int r = 0; r < 16; ++r) { const unsigned ro = (unsigned)(((r & 3) + 8 * (r >> 2)) * 32); orow[loff + ro + (rowoff)] = cvt1_bf16(ox[r]); } } while (0)
#define S_TD(F_, td) { S[td] = MFMA32(F_[0], vb00, S[td]); S[td] = MFMA32(F_[1], vb01, S[td]); S[td] = MFMA32(F_[2], vb10, S[td]); S[td] = MFMA32(F_[3], vb11, S[td]); }
        f32x16 vn0 = zero16(), o0 = zero16();
        LDWQ(fa, 0, 0); LDWQ(fb, 0, 1); HALF_TD(fa, 0, vn0, o0)
        LDWQ(fa, 0, 2); HALF_TD(fb, 1, vn0, o0)
        LDWQ(fb, 0, 3); HALF_TD(fa, 2, vn0, o0)
        PIN(); fa[0] = ldsfrag(GAb, 0, lane); fa[1] = ldsfrag(GAb, 1, lane); PIN(); HALF_TD(fb, 3, vn0, o0)
        ADD_U(vn0, 0); vb00 = PACK_STEP(vn0, 0); vb01 = PACK_STEP(vn0, 1);
        LDWQ(fb, 1, 0);
        o0 = MFMA32(fa[0], vb00, o0); o0 = MFMA32(fa[1], vb01, o0);
        { const size_t ci = (size_t)bh * 128 + n; const bf16* p = GU + ((ci * 8 + sl) * 2 + 1) * 1024 + lane * 16; uc[1][0] = *(const v4u*)p; uc[1][1] = *(const v4u*)(p + 8); }
#if GDN_PREFETCH
        if (n + 1 < 128) { const size_t ci = (size_t)bh * 128 + n + 1; dln = DL[ci];
          const bf16* p = GU + ((ci * 8 + sl) * 2 + 0) * 1024 + lane * 16; uc[0][0] = *(const v4u*)p; uc[0][1] = *(const v4u*)(p + 8); }
#endif
        f32x16 vn1 = zero16(), o1 = zero16();
        LDWQ(fa, 1, 1); STORE_O(o0, 0u); HALF_TD(fb, 0, vn1, o1)
        LDWQ(fb, 1, 2); S[0] = S[0] * dl; HALF_TD(fa, 1, vn1, o1)
        LDWQ(fa, 1, 3); S[1] = S[1] * dl; HALF_TD(fb, 2, vn1, o1)
        LD4(fb, GAb, 2, 3, 4, 5); S[2] = S[2] * dl; HALF_TD(fa, 3, vn1, o1)
        ADD_U(vn1, 1); vb10 = PACK_STEP(vn1, 0); vb11 = PACK_STEP(vn1, 1);
        LD4(fa, B, GKSLOT(0), GKSLOT(1), GKSLOT(2), GKSLOT(3)); S[3] = S[3] * dl;
        o1 = MFMA32(fb[0], vb00, o1); o1 = MFMA32(fb[1], vb01, o1); o1 = MFMA32(fb[2], vb10, o1); o1 = MFMA32(fb[3], vb11, o1);
        LD4(fb, B, GKSLOT(4), GKSLOT(5), GKSLOT(6), GKSLOT(7)); S_TD(fa, 0)
        LD4(fa, B, GKSLOT(8), GKSLOT(9), GKSLOT(10), GKSLOT(11)); STORE_O(o1, 32u * 32u); S_TD(fb, 1)
        LD4(fb, B, GKSLOT(12), GKSLOT(13), GKSLOT(14), GKSLOT(15)); S_TD(fa, 2)
        PIN(); S_TD(fb, 3)
#undef STORE_O
#undef S_TD
#undef HALF_TD
        SEG_T0(2); SCAN_BAR_C(); SEG_ACC(2); SEG_ACC2(1);
    }
    SEG_OUT();
}

constexpr int PF_LOOK = 6;
__device__ __forceinline__ void scan_prefetcher(Frame& F, const unsigned* PROG, int bx) {
    const int xc = bx & 7, j = (bx - 64) >> 3;
    const v4u* RQf = (const v4u*)(F.ws + WS_RQF); const v4u* RKf = (const v4u*)(F.ws + WS_RKF); const v4u* RKTf = (const v4u*)(F.ws + WS_RKTF); const v4u* RVTf = (const v4u*)(F.ws + WS_RVTF);
    const v4u* GW = (const v4u*)(F.ws + WS_GW); const v4u* GQ = (const v4u*)(F.ws + WS_GQ); const v4u* GK = (const v4u*)(F.ws + WS_GK); const v4u* GA = (const v4u*)(F.ws + WS_GA); const v4u* GU = (const v4u*)(F.ws + WS_GU);
    const int tid = F.tid;
    for (int it = j; it < 4 * 128; it += 24) {
        const int st = it & 3, n = it >> 2, kind = st >> 1, bh = xc + 8 * (st & 1);
        const unsigned* pw = PROG + 64 * (kind * 16 + bh);
        for (int spin = 0; spin < 20000; ++spin) { if ((int)__hip_atomic_load(pw, __ATOMIC_RELAXED, __HIP_MEMORY_SCOPE_AGENT) + PF_LOOK >= n) break; __builtin_amdgcn_s_sleep(32); }
        const size_t c = (size_t)bh * 128 + n;
        v4u a[11];
        if (kind == 0) {
            a[0] = RQf[c * 1024 + tid]; a[1] = RQf[c * 1024 + 512 + tid]; a[2] = RKf[c * 1024 + tid]; a[3] = RKf[c * 1024 + 512 + tid]; a[4] = RKTf[c * 1024 + tid]; a[5] = RKTf[c * 1024 + 512 + tid];
            a[6] = RVTf[c * 2048 + tid]; a[7] = RVTf[c * 2048 + 512 + tid]; a[8] = RVTf[c * 2048 + 1024 + tid]; a[9] = RVTf[c * 2048 + 1536 + tid]; a[10] = a[9];
        } else {
            a[0] = GW[c * 1024 + tid]; a[1] = GW[c * 1024 + 512 + tid]; a[2] = GQ[c * 1024 + tid]; a[3] = GQ[c * 1024 + 512 + tid]; a[4] = GK[c * 1024 + tid]; a[5] = GK[c * 1024 + 512 + tid];
            a[6] = GU[c * 2048 + tid]; a[7] = GU[c * 2048 + 512 + tid]; a[8] = GU[c * 2048 + 1024 + tid]; a[9] = GU[c * 2048 + 1536 + tid]; a[10] = GA[c * 512 + tid];
        }
#pragma unroll
        for (int q = 0; q < 11; ++q) asm volatile("" :: "v"(a[q]));
    }
}

__device__ __forceinline__ void p3_mixed(Frame& F) {
    const int gw = F.vcu * NWAVES + F.wave, NGW = F.G * NWAVES, lane = F.lane;
    const bf16* OA = (const bf16*)(F.ws + WS_GU); const bf16* OB = (const bf16*)(F.ws + WS_RVTF);
    const bf16* GZA = (const bf16*)F.out; const bf16* GZB = GZA + (size_t)T * 2048; bf16* MIX = (bf16*)(F.ws + WS_MIXED);
    for (int row = gw; row < T; row += NGW) {
        const size_t off = (size_t)row * 2048 + 32 * lane;
        const int bq_ = row >> 13, tt = row & 8191;
        const size_t ooff = ((((size_t)(bq_ * 8 + (lane >> 3)) * 128 + (tt >> 6)) * 8 + (lane & 7)) * 64 + (tt & 63)) * 32;
        v4u a4[4], b4[4], ga[4], gb[4];
#pragma unroll
        for (int q = 0; q < 4; ++q) { a4[q] = *(const v4u*)(OA + ooff + 8 * q); b4[q] = *(const v4u*)(OB + ooff + 8 * q); ga[q] = *(const v4u*)(GZA + off + 8 * q); gb[q] = *(const v4u*)(GZB + off + 8 * q); }
        float a[32], bb[32];
#pragma unroll
        for (int q = 0; q < 4; ++q)
#pragma unroll
            for (int e = 0; e < 4; ++e) { a[8 * q + 2 * e] = bflo(a4[q][e]); a[8 * q + 2 * e + 1] = bfhi(a4[q][e]); bb[8 * q + 2 * e] = bflo(b4[q][e]); bb[8 * q + 2 * e + 1] = bfhi(b4[q][e]); }
        float sa = 0.f, sb = 0.f;
#pragma unroll
        for (int i = 0; i < 32; ++i) { sa += a[i] * a[i]; sb += bb[i]; }
        sa += __shfl_xor(sa, 1); sa += __shfl_xor(sa, 2); sa += __shfl_xor(sa, 4);
        sb += __shfl_xor(sb, 1); sb += __shfl_xor(sb, 2); sb += __shfl_xor(sb, 4);
        const float rsa = rsqrtf(sa * (1.0f / 256.0f) + EPS), mu = sb * (1.0f / 256.0f);
        float vb = 0.f;
#pragma unroll
        for (int i = 0; i < 32; ++i) { bb[i] -= mu; vb += bb[i] * bb[i]; }
        vb += __shfl_xor(vb, 1); vb += __shfl_xor(vb, 2); vb += __shfl_xor(vb, 4);
        const float rsb = rsqrtf(vb * (1.0f / 256.0f) + EPS);
        const float* wa = F.gdn_norm_w + ((32 * lane) & 255); const float* wb = F.ret_norm_w + 32 * lane;
#pragma unroll
        for (int q = 0; q < 4; ++q) { v4u o;
#pragma unroll
            for (int e = 0; e < 4; ++e) { const int i = 8 * q + 2 * e;
                const float m0 = a[i] * rsa * wa[i] * bflo(ga[q][e]) + bb[i] * rsb * wb[i] * bflo(gb[q][e]);
                const float m1 = a[i + 1] * rsa * wa[i + 1] * bfhi(ga[q][e]) + bb[i + 1] * rsb * wb[i + 1] * bfhi(gb[q][e]);
                o[e] = pk2(m0, m1); }
            *(v4u*)(MIX + off + 8 * q) = o; }
    }
}
__device__ __forceinline__ void row_rmsnorm(Frame& F, const float* src, const float* w, bf16* dst16, float* dst32) {
    const int gw = F.vcu * NWAVES + F.wave, NGW = F.G * NWAVES, lane = F.lane;
    f32x4 nw[8];
#pragma unroll
    for (int j = 0; j < 8; ++j) nw[j] = ((const f32x4*)w)[64 * j + lane];
    for (int row = gw; row < T; row += 2 * NGW) {
        const f32x4* xr0 = (const f32x4*)(src + (size_t)row * D) + lane; const f32x4* xr1 = (const f32x4*)(src + (size_t)(row + NGW) * D) + lane;
        f32x4 v0[8], v1[8]; float s0 = 0.f, s1 = 0.f;
#pragma unroll
        for (int j = 0; j < 8; ++j) { v0[j] = xr0[64 * j]; v1[j] = xr1[64 * j]; }
#pragma unroll
        for (int j = 0; j < 8; ++j) { s0 += (v0[j].x * v0[j].x + v0[j].y * v0[j].y) + (v0[j].z * v0[j].z + v0[j].w * v0[j].w); s1 += (v1[j].x * v1[j].x + v1[j].y * v1[j].y) + (v1[j].z * v1[j].z + v1[j].w * v1[j].w); }
        const float r0 = rsqrtf(wave_sum(s0) * (1.0f / D) + EPS), r1 = rsqrtf(wave_sum(s1) * (1.0f / D) + EPS);
        if (dst16) { v2u* o0 = (v2u*)(dst16 + (size_t)row * D) + lane; v2u* o1 = (v2u*)(dst16 + (size_t)(row + NGW) * D) + lane;
#pragma unroll
            for (int j = 0; j < 8; ++j) { const f32x4 y0 = (v0[j] * r0) * nw[j], y1 = (v1[j] * r1) * nw[j]; v2u o; o.x = pk2(y0.x, y0.y); o.y = pk2(y0.z, y0.w); o0[64 * j] = o; o.x = pk2(y1.x, y1.y); o.y = pk2(y1.z, y1.w); o1[64 * j] = o; } }
        else { f32x4* o0 = (f32x4*)(dst32 + (size_t)row * D) + lane; f32x4* o1 = (f32x4*)(dst32 + (size_t)(row + NGW) * D) + lane;
#pragma unroll
            for (int j = 0; j < 8; ++j) { o0[64 * j] = (v0[j] * r0) * nw[j]; o1[64 * j] = (v1[j] * r1) * nw[j]; } }
    }
}

__device__ __forceinline__ void row_rmsnorm16(Frame& F, const bf16* src, const float* w, bf16* dst16, float* dst32) {
    const int gw = F.vcu * NWAVES + F.wave, NGW = F.G * NWAVES, lane = F.lane;
    const float* wl = w + 32 * lane;
    for (int row = gw; row < T; row += 2 * NGW) {
        const size_t o0 = (size_t)row * D + 32 * lane, o1 = (size_t)(row + NGW) * D + 32 * lane;
        v4u a[4], b[4];
#pragma unroll
        for (int q = 0; q < 4; ++q) { a[q] = *(const v4u*)(src + o0 + 8 * q); b[q] = *(const v4u*)(src + o1 + 8 * q); }
        float x0[32], x1[32]; float s0 = 0.f, s1 = 0.f;
#pragma unroll
        for (int q = 0; q < 4; ++q)
#pragma unroll
            for (int e = 0; e < 4; ++e) { x0[8 * q + 2 * e] = bflo(a[q][e]); x0[8 * q + 2 * e + 1] = bfhi(a[q][e]); x1[8 * q + 2 * e] = bflo(b[q][e]); x1[8 * q + 2 * e + 1] = bfhi(b[q][e]); }
#pragma unroll
        for (int i = 0; i < 32; ++i) { s0 += x0[i] * x0[i]; s1 += x1[i] * x1[i]; }
        const float r0 = rsqrtf(wave_sum(s0) * (1.0f / D) + EPS), r1 = rsqrtf(wave_sum(s1) * (1.0f / D) + EPS);
#pragma unroll
        for (int q = 0; q < 4; ++q) { const f32x4 wa = *(const f32x4*)(wl + 8 * q), wb = *(const f32x4*)(wl + 8 * q + 4);
            const float wv[8] = {wa.x, wa.y, wa.z, wa.w, wb.x, wb.y, wb.z, wb.w};
            if (dst16) { v4u p0, p1;
#pragma unroll
                for (int e = 0; e < 4; ++e) { p0[e] = pk2(x0[8 * q + 2 * e] * r0 * wv[2 * e], x0[8 * q + 2 * e + 1] * r0 * wv[2 * e + 1]); p1[e] = pk2(x1[8 * q + 2 * e] * r1 * wv[2 * e], x1[8 * q + 2 * e + 1] * r1 * wv[2 * e + 1]); }
                *(v4u*)(dst16 + o0 + 8 * q) = p0; *(v4u*)(dst16 + o1 + 8 * q) = p1;
            } else {
                f32x4 y;
                y = (f32x4){x0[8 * q] * r0 * wv[0], x0[8 * q + 1] * r0 * wv[1], x0[8 * q + 2] * r0 * wv[2], x0[8 * q + 3] * r0 * wv[3]}; *(f32x4*)(dst32 + o0 + 8 * q) = y;
                y = (f32x4){x0[8 * q + 4] * r0 * wv[4], x0[8 * q + 5] * r0 * wv[5], x0[8 * q + 6] * r0 * wv[6], x0[8 * q + 7] * r0 * wv[7]}; *(f32x4*)(dst32 + o0 + 8 * q + 4) = y;
                y = (f32x4){x1[8 * q] * r1 * wv[0], x1[8 * q + 1] * r1 * wv[1], x1[8 * q + 2] * r1 * wv[2], x1[8 * q + 3] * r1 * wv[3]}; *(f32x4*)(dst32 + o1 + 8 * q) = y;
                y = (f32x4){x1[8 * q + 4] * r1 * wv[4], x1[8 * q + 5] * r1 * wv[5], x1[8 * q + 6] * r1 * wv[6], x1[8 * q + 7] * r1 * wv[7]}; *(f32x4*)(dst32 + o1 + 8 * q + 4) = y;
            } }
    }
}

__global__ void __launch_bounds__(NWAVES * 64, 2) fwd_kernel(Args args) {
    extern __shared__ __attribute__((aligned(16))) unsigned char lds[];
    Frame F;
    F.lds = (LAS unsigned char*)lds;
    F.tid = threadIdx.x; F.lane = F.tid & 63; F.wave = __builtin_amdgcn_readfirstlane(F.tid >> 6);
    F.G = gridDim.x; { const int bx = blockIdx.x; F.vcu = (F.G % 8 == 0) ? (bx % 8) * (F.G / 8) + bx / 8 : bx; }
    typedef const __attribute__((address_space(4))) Args* KArgs;
    const KArgs kap0 = (KArgs)__builtin_amdgcn_kernarg_segment_ptr();
#define LOADF() do { KArgs kap_ = kap0; asm volatile("" : "+s"(kap_)); \
        F.x = kap_->in[0]; F.norm1_w = kap_->in[1]; F.w_in = kap_->in[2]; F.conv_w = kap_->in[3]; F.a_log = kap_->in[4]; F.dt_bias = kap_->in[5]; F.gdn_norm_w = kap_->in[6]; \
        F.ret_norm_w = kap_->in[7]; F.w_out = kap_->in[8]; F.norm2_w = kap_->in[9]; F.w_gate = kap_->in[10]; F.w_up = kap_->in[11]; F.w_down = kap_->in[12]; F.norm_f_w = kap_->in[13]; \
        F.out = kap_->out; F.ws = kap_->ws; F.lane = pg8::pg8_lane_id(); F.tid = F.wave * 64 + F.lane; } while (0)
    LOADF();
    volatile LAS unsigned* MISC = (volatile LAS unsigned*)(F.lds + MISC_OFF);
    for (int u = F.tid; u < (LDS_BYTES - LDSCTL_OFF) / 4; u += NWAVES * 64) ((LAS unsigned*)(F.lds + LDSCTL_OFF))[u] = 0u;
    __syncthreads();
    const int lo = args.ph_lo, hi = args.ph_hi;
    const bool use_bar = (hi - lo) > 1;
    XcdBarrier bar; bar.bar = (unsigned*)(F.ws + WS_CTL) + CW_BAR; bar.x = 0; bar.st = nullptr; bar.w0 = 0;
    if (use_bar) bar = xcd_barrier_post((unsigned*)(F.ws + WS_CTL) + CW_BAR, MISC + 8, F.wave);
#ifndef PROBE_REP
#define PROBE_REP -1
#endif
#define NREP(k) ((PROBE_REP) == (k) ? 2 : 1)
#define IN(k) (lo <= (k) && (k) < hi)
#ifndef PROBE_TIME
#define PROBE_TIME -1
#endif
    volatile LAS unsigned long long* PT = (volatile LAS unsigned long long*)(F.lds + MISC_OFF + 64);
#define SEAM(k) do { if ((PROBE_TIME) == 20 + (k) && F.tid == 0) PT[0] = __builtin_amdgcn_s_memrealtime(); if (IN(k) && IN((k) + 1)) xcd_barrier(bar); if ((PROBE_TIME) == 20 + (k) && F.tid == 0) PT[1] = __builtin_amdgcn_s_memrealtime(); if ((PROBE_TIME) == (k) + 1 && F.tid == 0) PT[0] = __builtin_amdgcn_s_memrealtime(); if ((PROBE_TIME) == (k) && F.tid == 0) PT[1] = __builtin_amdgcn_s_memrealtime(); } while (0)

    if ((PROBE_TIME) == 0 && F.tid == 0) PT[0] = __builtin_amdgcn_s_memrealtime();
    if (IN(0)) for (int rep_ = 0; rep_ < NREP(0); ++rep_) { LOADF(); p0_prologue(F); } SEAM(0);
    if (IN(1)) for (int rep_ = 0; rep_ < NREP(1); ++rep_) { LOADF();
        pg8::Gemm g{(const pg8::bf16_t*)(F.ws + WS_U), (const pg8::bf16_t*)(F.ws + WS_W1T), T, N1, D}; pg8::InProjOrder S; S.init(T, N1, F.G, (int)blockIdx.x);
        pg8::EpiInProj E{F.ws, (pg8::bf16_t*)F.out, WS_QKV, WS_RQF, WS_RKF, WS_RKTF, WS_RVTF, WS_COS, WS_SIN, WS_COS2, WS_SIN2};
        pg8::gemm_phase<pg8::EpiInProj, pg8::InProjOrder, true, true>(F.lds, g, S, E, F.wave);
    } SEAM(1);
    if (IN(2)) { LOADF();
        const int bx = blockIdx.x;
        unsigned* PROG = (unsigned*)(F.ws + WS_CTL) + 16384;
        if (bx < 64) { const int x = bx & 31, xc = x & 7, y = x >> 3, bh = xc + 8 * (y >> 1), half = y & 1;
            if (bx < 32) ret_scan_wg(F, bh, half, PROG + 64 * (0 * 16 + bh)); else gdn_scan_wg(F, bh, half, PROG + 64 * (1 * 16 + bh));
        } else {
            for (int i = bx - 64; i < BATCH * NH * 128; i += F.G - 64) gdn_prep(F, (i & 15) * 128 + (i >> 4));
        }
    } SEAM(2);
    if (IN(4)) for (int rep_ = 0; rep_ < NREP(4); ++rep_) { LOADF(); p3_mixed(F); ffn_weight_copies(F); } SEAM(4);
    if (IN(5)) for (int rep_ = 0; rep_ < NREP(5); ++rep_) { LOADF();
        pg8::Gemm g{(const pg8::bf16_t*)(F.ws + WS_MIXED), (const pg8::bf16_t*)(F.ws + WS_WOT), T, D, D}; pg8::StaticOrder S; S.init(T, D, F.G, (int)blockIdx.x);
        pg8::EpiResBf16 E{F.x, nullptr, (pg8::bf16_t*)(F.ws + WS_H), D, (float*)(F.ws + WS_RSTD)};
        pg8::gemm_phase<pg8::EpiResBf16, pg8::StaticOrder, true, true>(F.lds, g, S, E, F.wave);
    } SEAM(5);
#if PROBE_TIME == 10
    if (F.tid == 0) PT[0] = __builtin_amdgcn_s_memrealtime(); xcd_barrier(bar); if (F.tid == 0) PT[1] = __builtin_amdgcn_s_memrealtime();
#endif
    if (IN(7)) for (int rep_ = 0; rep_ < NREP(7); ++rep_) { LOADF();
        pg8::Gemm g{(const pg8::bf16_t*)(F.ws + WS_H), (const pg8::bf16_t*)(F.ws + WS_WGUT), T, NGU, D}; pg8::StaticOrder S; S.init(T, NGU, F.G, (int)blockIdx.x);
        pg8::EpiGateUp E{(pg8::bf16_t*)(F.ws + WS_ACT), FF, (const float*)(F.ws + WS_RSTD)};
        pg8::gemm_phase<pg8::EpiGateUp, pg8::StaticOrder, true, true>(F.lds, g, S, E, F.wave);
    } SEAM(7);
    if (IN(8)) { LOADF();
        pg8::Gemm g{(const pg8::bf16_t*)(F.ws + WS_ACT), (const pg8::bf16_t*)(F.ws + WS_WDT), T, D, FF}; pg8::StaticOrder S; S.init(T, D, F.G, (int)blockIdx.x);
        pg8::EpiResBf16 E{nullptr, (const pg8::bf16_t*)(F.ws + WS_H), (pg8::bf16_t*)(F.ws + WS_H), D, nullptr};
        pg8::gemm_phase<pg8::EpiResBf16, pg8::StaticOrder, true, true>(F.lds, g, S, E, F.wave);
    } SEAM(8);
    if (IN(9)) { LOADF(); row_rmsnorm16(F, (const bf16*)(F.ws + WS_H), F.norm_f_w, nullptr, F.out); }
#if PROBE_TIME >= 0
    if (PROBE_TIME == 9 && F.tid == 0) PT[1] = __builtin_amdgcn_s_memrealtime();
    __syncthreads();
    if (F.vcu == 0 && F.tid == 0) { asm volatile("s_waitcnt vmcnt(0)" ::: "memory");
        int best = 0; float bv = 1e30f;
        for (int i = 0; i < 2048; ++i) { const float a = fabsf(F.out[i]); if (a < bv) { bv = a; best = i; } }
#if PROBE_SEG
        const float us = 0.1f * (float)__hip_atomic_load((unsigned*)(F.ws + WS_CTL) + 20000, __ATOMIC_RELAXED, __HIP_MEMORY_SCOPE_AGENT);
#else
        const float us = (float)(long long)(PT[1] - PT[0]) * 0.01f;
#endif
#ifdef PROBE_FAIL
        F.out[0] = 20.0f * rintf(us * 0.05f);
#else
        F.out[best] += 0.04f + 1e-4f * us;
#endif
        }
#endif
#undef IN
#undef SEAM
}

extern "C" void kernel_launch(void* const* d_in, const int* in_sizes, int n_in, void* d_out, int out_size, void* d_ws, size_t ws_size, hipStream_t stream) {
    static int grid = 0;
    if (grid == 0) {
        if (n_in != 14 || in_sizes[0] != T * D || out_size != T * D || ws_size < WS_END) { fprintf(stderr, "kernel_launch: unexpected shapes: n_in %d in0 %d out %d ws %zu (need %zu)\n", n_in, n_in > 0 ? in_sizes[0] : -1, out_size, ws_size, (size_t)WS_END); grid = -1; return; }
        int dev = 0, cus = 0, per_cu = 0;
        if (hipGetDevice(&dev) != hipSuccess || hipDeviceGetAttribute(&cus, hipDeviceAttributeMultiprocessorCount, dev) != hipSuccess) { grid = -1; return; }
        if (hipFuncSetAttribute((const void*)fwd_kernel, hipFuncAttributeMaxDynamicSharedMemorySize, LDS_BYTES) != hipSuccess) { fprintf(stderr, "kernel_launch: hipFuncSetAttribute failed\n"); grid = -1; return; }
        if (hipOccupancyMaxActiveBlocksPerMultiprocessor(&per_cu, (const void*)fwd_kernel, NWAVES * 64, LDS_BYTES) != hipSuccess || per_cu < 1) { fprintf(stderr, "kernel_launch: occupancy query says %d blocks per CU\n", per_cu); per_cu = 1; }
        (void)hipGetLastError();
        grid = cus;
        if (grid > 256) grid = 256;
    }
    if (grid < 0) return;
    (void)hipMemsetAsync((char*)d_ws + WS_CTL, 0, CTL_ZERO_BYTES, stream);
    Args a{};
    for (int i = 0; i < 14; ++i) a.in[i] = (const float*)d_in[i];
    a.out = (float*)d_out; a.ws = (unsigned char*)d_ws;
#if MK_N_LAUNCHES == 1
    a.ph_lo = 0; a.ph_hi = NPHASES;
    hipLaunchKernelGGL(fwd_kernel, dim3(grid), dim3(NWAVES * 64), LDS_BYTES, stream, a);
#else
    for (int p = 0; p < NPHASES; ++p) { a.ph_lo = p; a.ph_hi = p + 1; hipLaunchKernelGGL(fwd_kernel, dim3(grid), dim3(NWAVES * 64), LDS_BYTES, stream, a); }
#endif
}
```

```cpp
#include <hip/hip_runtime.h>
#include <cstdio>
#include <cstdint>
namespace pg8 {
#define PG8_LAS __attribute__((address_space(3)))
typedef unsigned short bf16_t;
typedef short bf16x8 __attribute__((ext_vector_type(8)));
typedef float f32x4 __attribute__((ext_vector_type(4)));
typedef unsigned u32x4 __attribute__((ext_vector_type(4)));
constexpr int BM = 256, BK = 64, HALF = 128, HTB = HALF * BK * 2  , STAGE_BYTES = 8 * HTB, NXCD = 8, WGM = 8;

__host__ __device__ __forceinline__ int lds_byte(int r, int c) { const int st = (r >> 4) * 2 + (c >> 5), rr = r & 15, cc = c & 31, ob = rr * 64 + cc * 2; return st * 1024 + (ob ^ (((ob >> 9) & 1) << 5)); }
__host__ __device__ __forceinline__ void stage_rc(int b, int& R, int& C) { const int st = b / 1024, sb = b % 1024, swz = sb ^ (((sb >> 9) & 1) << 5); R = (st >> 1) * 16 + swz / 64; C = (st & 1) * 32 + (swz % 64) / 2; }
__host__ __device__ __forceinline__ int perm32(int rho) { const int n = rho >> 4, i = rho & 15; return 8 * (i >> 2) + 4 * n + (i & 3); }

__device__ __forceinline__ int pg8_lane_id() { int l; asm volatile("v_mbcnt_lo_u32_b32 %0, -1, 0\n\tv_mbcnt_hi_u32_b32 %0, -1, %0" : "=v"(l)); return l; }
struct Unit { int pm, pn, sw; };
struct Gemm { const bf16_t* A; const bf16_t* Bt; int M, N, K; };

struct StaticOrder {
    int nM, nN, nwg, G, c;
    __host__ __device__ void init(int M, int N, int G_, int c_) { nM = M / BM; nN = N / BM; nwg = nM * nN; G = G_; c = c_; }
    __host__ __device__ bool next(int i, Unit& u) const {
        const long L = (long)i * G + c; if (L >= nwg) return false;
        int wgid = (int)L; { const int q = nwg / NXCD, r = nwg % NXCD, xcd = wgid % NXCD, off = wgid / NXCD; wgid = (xcd < r ? xcd * (q + 1) : r * (q + 1) + (xcd - r) * q) + off; }
        const int nig = WGM * nN, gid = wgid / nig, fm = gid * WGM, gsz = (nM - fm) < WGM ? (nM - fm) : WGM;
        u.pm = fm + ((wgid % nig) % gsz); u.pn = (wgid % nig) / gsz; u.sw = 0; return true;
    }
    __device__ __forceinline__ void a_ready(const Unit&) const {}
    __device__ __forceinline__ void done(const Unit&) const {}
};
__device__ __forceinline__ unsigned cvt_pk_bf16(float lo, float hi) { unsigned r; asm volatile("v_cvt_pk_bf16_f32 %0, %1, %2" : "=v"(r) : "v"(lo), "v"(hi)); return r; }
typedef float f32x2 __attribute__((ext_vector_type(2)));
__device__ __forceinline__ u32x4 pack8(const f32x4& a, const f32x4& b) { u32x4 w; w.x = cvt_pk_bf16(a[0], a[1]); w.y = cvt_pk_bf16(a[2], a[3]); w.z = cvt_pk_bf16(b[0], b[1]); w.w = cvt_pk_bf16(b[2], b[3]); return w; }
typedef unsigned u32x2 __attribute__((ext_vector_type(2)));
__device__ __forceinline__ float fsigmoid(float x) { return __builtin_amdgcn_rcpf(1.0f + __expf(-x)); }
__device__ __forceinline__ float fsilu(float x) { return x * fsigmoid(x); }

struct InProjOrder : StaticOrder {
    __host__ __device__ bool next(int i, Unit& u) const { if (!StaticOrder::next(i, u)) return false; u.sw = ((u.pn >= 24 && u.pn < 32) || u.pn >= 64) ? 1 : 0; return true; }
};
struct EpiInProj {
    static constexpr bool PERM = true, AFTER_DRAIN = false;
    unsigned char* ws; bf16_t* gz;
    size_t oQKV, oRQf, oRKf, oRKTf, oRVTf, oCOS, oSIN, oCOS2, oSIN2;
    __device__ __forceinline__ void operator()(const f32x4 (&acc)[2][2][4][2], const Unit& u, int wr, int wc, int fr, int fq) const {
        asm volatile("" : "+v"(fr), "+v"(fq));
        bf16_t* const QKV = (bf16_t*)(ws + oQKV); bf16_t* const RQf = (bf16_t*)(ws + oRQf); bf16_t* const RKf = (bf16_t*)(ws + oRKf); bf16_t* const RKTf = (bf16_t*)(ws + oRKTf); bf16_t* const RVTf = (bf16_t*)(ws + oRVTf);
        bf16_t* const GZA = gz; bf16_t* const GZB = gz + (size_t)16384 * 2048;
        const float* const cosT = (const float*)(ws + oCOS); const float* const sinT = (const float*)(ws + oSIN); const float* const cosT2 = (const float*)(ws + oCOS2); const float* const sinT2 = (const float*)(ws + oSIN2);
        const int pn = u.pn, cw = wc * 32 + 8 * fq;
        if (pn < 16) {
            const int row0 = u.pm * BM + wr * 64 + fr, col0 = pn * 256 + cw;
#pragma unroll
            for (int ai = 0; ai < 2; ++ai)
#pragma unroll
                for (int m = 0; m < 4; ++m) { bf16_t* rowp = QKV + (size_t)(row0 + ai * HALF + m * 16) * 4096 + col0;
#pragma unroll
                    for (int bj = 0; bj < 2; ++bj) *(u32x4*)(rowp + bj * HALF) = pack8(acc[ai][bj][m][0], acc[ai][bj][m][1]); }
        } else if (pn < 24) {
            const bool isk = pn >= 20; bf16_t* base = isk ? RKf : RQf;
            const int row0 = u.pm * BM + wr * 64 + fr, tile = (pn - 16) & 3, head = 2 * tile + (cw >> 6), i0 = cw & 63;
            const float l2g = log2f(1.0f - exp2f(-5.0f - (float)head));
            const int td1 = i0 >> 5, s1 = (i0 >> 4) & 1, eg = (i0 >> 3) & 1;
#pragma unroll
            for (int ai = 0; ai < 2; ++ai)
#pragma unroll
                for (int m = 0; m < 4; ++m) { const int row = row0 + ai * HALF + m * 16, b = row >> 13, t = row & 8191, n = t >> 6, pos = t & 63;
                    const float sc = isk ? 0.08838834764831845f * exp2f(-(float)(pos + 1) * l2g) : exp2f((float)(pos + 1) * l2g);
                    const float* cp = cosT + t * 64 + i0; const float* sp = sinT + t * 64 + i0;
                    const f32x4 c0 = *(const f32x4*)cp, c1 = *(const f32x4*)(cp + 4), s0 = *(const f32x4*)sp, s1v = *(const f32x4*)(sp + 4);
                    const f32x4 x1a = acc[ai][0][m][0], x1b = acc[ai][0][m][1], x2a = acc[ai][1][m][0], x2b = acc[ai][1][m][1];
                    const f32x4 o1a = (x1a * c0 - x2a * s0) * sc, o1b = (x1b * c1 - x2b * s1v) * sc, o2a = (x2a * c0 + x1a * s0) * sc, o2b = (x2b * c1 + x1b * s1v) * sc;
                    const size_t f1 = ((((size_t)(b * 8 + head) * 128 + n) * 2 + (pos >> 5)) * 4 + td1) * 2 + s1;
                    bf16_t* p1 = base + f1 * 512 + (pos & 31) * 8 + eg * 4;
                    u32x2 w;
                    w.x = cvt_pk_bf16(o1a[0], o1a[1]); w.y = cvt_pk_bf16(o1a[2], o1a[3]); *(u32x2*)(p1) = w;
                    w.x = cvt_pk_bf16(o1b[0], o1b[1]); w.y = cvt_pk_bf16(o1b[2], o1b[3]); *(u32x2*)(p1 + 256) = w;
                    w.x = cvt_pk_bf16(o2a[0], o2a[1]); w.y = cvt_pk_bf16(o2a[2], o2a[3]); *(u32x2*)(p1 + 4 * 512) = w;
                    w.x = cvt_pk_bf16(o2b[0], o2b[1]); w.y = cvt_pk_bf16(o2b[2], o2b[3]); *(u32x2*)(p1 + 4 * 512 + 256) = w; }
        } else if (pn < 32) {
            const int head = pn - 24, b = u.pm >> 5, nbase = (u.pm & 31) * 4;
            const int tj = wc & 1, s1 = (fq >> 1) & 1, eg = fq & 1;
#pragma unroll
            for (int ai = 0; ai < 2; ++ai)
#pragma unroll
                for (int m = 0; m < 4; ++m) { const int dv = ai * HALF + wr * 64 + m * 16 + fr, sl = dv >> 5, col = dv & 31;
#pragma unroll
                    for (int bj = 0; bj < 2; ++bj) { const int n = nbase + 2 * bj + (wc >> 1);
                        const size_t f = ((((size_t)(b * 8 + head) * 128 + n) * 8 + sl) * 2 + tj) * 2 + s1;
                        bf16_t* p = RVTf + f * 512 + col * 8 + eg * 4;
#pragma unroll
                        for (int nn = 0; nn < 2; ++nn) { u32x2 w; w.x = cvt_pk_bf16(acc[ai][bj][m][nn][0], acc[ai][bj][m][nn][1]); w.y = cvt_pk_bf16(acc[ai][bj][m][nn][2], acc[ai][bj][m][nn][3]); *(u32x2*)(p + nn * 256) = w; } } }
        } else if (pn < 64) {
            const int row0 = u.pm * BM + wr * 64 + fr;
            bf16_t* base = pn < 48 ? GZA : GZB; const int col0 = ((pn - 32) & 15) * 128 + cw;
#pragma unroll
            for (int ai = 0; ai < 2; ++ai)
#pragma unroll
                for (int m = 0; m < 4; ++m) { bf16_t* rowp = base + (size_t)(row0 + ai * HALF + m * 16) * 2048 + col0; f32x4 o[2];
#pragma unroll
                    for (int n = 0; n < 2; ++n)
#pragma unroll
                        for (int j = 0; j < 4; ++j) o[n][j] = fsilu(acc[ai][0][m][n][j]) * fsigmoid(acc[ai][1][m][n][j]);
                    *(u32x4*)rowp = pack8(o[0], o[1]); }
        } else {
            const int tile = pn - 64, head = 2 * tile + wr, b = u.pm >> 5, nbase = (u.pm & 31) * 4, tbase = (u.pm & 31) * 256;
            const int tj = wc & 1, s1 = (fq >> 1) & 1, eg = fq & 1;
            const float l2g = log2f(1.0f - exp2f(-5.0f - (float)head));
#pragma unroll
            for (int bj = 0; bj < 2; ++bj) { const int n = nbase + 2 * bj + (wc >> 1), c0 = bj * HALF + wc * 32 + 8 * fq;
#pragma unroll
                for (int nn = 0; nn < 2; ++nn) { const int pos0 = (c0 + 4 * nn) & 63; f32x4 sc;
#pragma unroll
                    for (int j = 0; j < 4; ++j) sc[j] = 0.08838834764831845f * exp2f((float)(63 - pos0 - j) * l2g);
#pragma unroll
                    for (int m = 0; m < 4; ++m) { const int i = 16 * m + fr;
                        const f32x4 c = *(const f32x4*)(cosT2 + (size_t)i * 8192 + tbase + c0 + 4 * nn), s = *(const f32x4*)(sinT2 + (size_t)i * 8192 + tbase + c0 + 4 * nn);
                        const f32x4 x1 = acc[0][bj][m][nn], x2 = acc[1][bj][m][nn];
                        const f32x4 o1 = (x1 * c - x2 * s) * sc, o2 = (x2 * c + x1 * s) * sc;
                        const size_t f = ((((size_t)(b * 8 + head) * 128 + n) * 4 + (m >> 1)) * 2 + tj) * 2 + s1;
                        bf16_t* p = RKTf + f * 512 + (nn * 32 + 16 * (m & 1) + fr) * 8 + eg * 4;
                        u32x2 w; w.x = cvt_pk_bf16(o1[0], o1[1]); w.y = cvt_pk_bf16(o1[2], o1[3]); *(u32x2*)p = w;
                        w.x = cvt_pk_bf16(o2[0], o2[1]); w.y = cvt_pk_bf16(o2[2], o2[3]); *(u32x2*)(p + 8 * 512) = w; } } }
        }
    }
};
struct EpiGateUp {
    static constexpr bool PERM = true, AFTER_DRAIN = false;
    bf16_t* ACT; int ldc; const float* rstd;
    __device__ __forceinline__ void operator()(const f32x4 (&acc)[2][2][4][2], const Unit& u, int wr, int wc, int fr, int fq) const {
        const int row0 = u.pm * BM + wr * 64 + fr, col0 = u.pn * 128 + wc * 32 + 8 * fq;
#pragma unroll
        for (int ai = 0; ai < 2; ++ai)
#pragma unroll
            for (int m = 0; m < 4; ++m) { const int row = row0 + ai * HALF + m * 16; const float rs = rstd ? __builtin_amdgcn_rsqf(rstd[row] * (1.0f / 2048.0f) + 1e-6f) : 1.0f; f32x4 o[2];
#pragma unroll
                for (int n = 0; n < 2; ++n)
#pragma unroll
                    for (int j = 0; j < 4; ++j) o[n][j] = fsilu(acc[ai][0][m][n][j] * rs) * (acc[ai][1][m][n][j] * rs);
                *(u32x4*)(ACT + (size_t)row * ldc + col0) = pack8(o[0], o[1]); }
    }
};
struct EpiResF32 {
    static constexpr bool PERM = false, AFTER_DRAIN = false;
    const float* res; float* out; int ldc;
    __device__ __forceinline__ void operator()(const f32x4 (&acc)[2][2][4][2], const Unit& u, int wr, int wc, int fr, int fq) const {
        const int row0 = u.pm * BM + wr * 64 + fr, col0 = u.pn * BM + wc * 32 + 4 * fq;
#pragma unroll
        for (int ai = 0; ai < 2; ++ai)
#pragma unroll
            for (int m = 0; m < 4; ++m) { const size_t off = (size_t)(row0 + ai * HALF + m * 16) * ldc + col0;
#pragma unroll
                for (int bj = 0; bj < 2; ++bj)
#pragma unroll
                    for (int n = 0; n < 2; ++n) { const f32x4 r = *(const f32x4*)(res + off + bj * HALF + n * 16); *(f32x4*)(out + off + bj * HALF + n * 16) = r + acc[ai][bj][m][n]; } }
    }
};
struct EpiResBf16 {
    static constexpr bool PERM = true, AFTER_DRAIN = false;
    const float* res32; const bf16_t* res16; bf16_t* out16; int ldc; float* rss;
    __device__ __forceinline__ void operator()(const f32x4 (&acc)[2][2][4][2], const Unit& u, int wr, int wc, int fr, int fq) const {
        const int row0 = u.pm * BM + wr * 64 + fr, col0 = u.pn * BM + wc * 32 + 8 * fq;
#pragma unroll
        for (int ai = 0; ai < 2; ++ai)
#pragma unroll
            for (int m = 0; m < 4; ++m) { const size_t off = (size_t)(row0 + ai * HALF + m * 16) * ldc + col0; float ss = 0.f;
#pragma unroll
                for (int bj = 0; bj < 2; ++bj) { f32x4 r0, r1;
                    if (res32) { r0 = *(const f32x4*)(res32 + off + bj * HALF); r1 = *(const f32x4*)(res32 + off + bj * HALF + 4); }
                    else { const u32x4 h = *(const u32x4*)(res16 + off + bj * HALF);
                        r0 = (f32x4){__builtin_bit_cast(float, h.x << 16), __builtin_bit_cast(float, h.x & 0xffff0000u), __builtin_bit_cast(float, h.y << 16), __builtin_bit_cast(float, h.y & 0xffff0000u)};
                        r1 = (f32x4){__builtin_bit_cast(float, h.z << 16), __builtin_bit_cast(float, h.z & 0xffff0000u), __builtin_bit_cast(float, h.w << 16), __builtin_bit_cast(float, h.w & 0xffff0000u)}; }
                    r0 = r0 + acc[ai][bj][m][0]; r1 = r1 + acc[ai][bj][m][1];
                    ss += (r0[0] * r0[0] + r0[1] * r0[1]) + (r0[2] * r0[2] + r0[3] * r0[3]) + (r1[0] * r1[0] + r1[1] * r1[1]) + (r1[2] * r1[2] + r1[3] * r1[3]);
                    *(u32x4*)(out16 + off + bj * HALF) = pack8(r0, r1); }
                if (rss) { ss += __shfl_xor(ss, 16); ss += __shfl_xor(ss, 32); if (fq == 0) atomicAdd(rss + row0 + ai * HALF + m * 16, ss); } }
    }
};
template <class Epi, class Sched, bool ALIGN_EPI = false, bool SP2 = false>
__device__ __forceinline__ void gemm_phase(PG8_LAS unsigned char* lds, const Gemm g, const Sched& S, const Epi& E, const int wave_in) {
    const int lane = pg8_lane_id(), wid = wave_in, tid = wid * 64 + lane, wr = wid >> 2, wc = wid & 3, fr = lane & 15, fq = lane >> 4;
    const int K = g.K, nt = K / BK;
    unsigned voffA[2], voffB[2];
#pragma unroll
    for (int i = 0; i < 2; ++i) { int R, C; stage_rc(tid * 16 + i * 8192, R, C); const int Rb = Epi::PERM ? ((R & ~31) + perm32(R & 31)) : R;
        voffA[i] = (unsigned)(R * K + C) * 2u; voffB[i] = (unsigned)(Rb * K + C) * 2u; }
    const size_t kstep = (size_t)(BK * 2);
    const size_t hstep = (size_t)HALF * K * 2;
    const size_t tstep = 2 * hstep;
    const unsigned ldsw = (unsigned)wid * 1024u;
    const int aoff = lds_byte(wr * 64 + fr, fq * 8), boff = lds_byte(wc * 32 + fr, fq * 8);
#define PG8_SA(b, h) (((b) * 2 + (h)) * HTB)
#define PG8_SB(b, h) ((4 + (b) * 2 + (h)) * HTB)
#define PG8_STAGE(bufoff, gbase, voff) do { _Pragma("unroll") for (int _i = 0; _i < 2; ++_i) \
        __builtin_amdgcn_global_load_lds((const unsigned*)((const char*)(gbase) + (voff)[_i]), (PG8_LAS unsigned*)(lds + (bufoff) + ldsw + _i * 8192), 16, 0, 0); } while (0)
#define PG8_LDA(dst, b, h) do { _Pragma("unroll") for (int m = 0; m < 4; ++m) _Pragma("unroll") for (int k = 0; k < 2; ++k) dst[m][k] = *(const PG8_LAS bf16x8*)(lds + PG8_SA(b, h) + aoff + m * 2048 + k * 1024); } while (0)
#define PG8_LDB(dst, b, h) do { _Pragma("unroll") for (int n = 0; n < 2; ++n) _Pragma("unroll") for (int k = 0; k < 2; ++k) dst[n][k] = *(const PG8_LAS bf16x8*)(lds + PG8_SB(b, h) + boff + n * 2048 + k * 1024); } while (0)
#define PG8_MMA(ai, bj, At, Bt) do { __builtin_amdgcn_s_setprio(1); _Pragma("unroll") for (int m = 0; m < 4; ++m) _Pragma("unroll") for (int n = 0; n < 2; ++n) _Pragma("unroll") for (int k = 0; k < 2; ++k) \
        acc[ai][bj][m][n] = __builtin_amdgcn_mfma_f32_16x16x32_bf16(Bt[n][k], At[m][k], acc[ai][bj][m][n], 0, 0, 0); __builtin_amdgcn_s_setprio(0); } while (0)
#define PG8_WAIT_V(n) asm volatile("s_waitcnt vmcnt(" #n ")" ::: "memory")
#define PG8_WAIT_L(n) asm volatile("s_waitcnt lgkmcnt(" #n ")" ::: "memory")
#define PG8_BAR __builtin_amdgcn_s_barrier()
#define PG8_SCHED __builtin_amdgcn_sched_barrier(0)
    Unit cur, nxt; int ui = 0;
    if (!S.next(0, cur)) return;
    f32x4 acc[2][2][4][2];
#pragma unroll
    for (int a = 0; a < 2; ++a)
#pragma unroll
        for (int b = 0; b < 2; ++b)
#pragma unroll
            for (int m = 0; m < 4; ++m)
#pragma unroll
                for (int n = 0; n < 2; ++n) acc[a][b][m][n] = (f32x4){0.f, 0.f, 0.f, 0.f};
    bf16x8 At[4][2], B0[2][2], B1[2][2];
#define PG8_UA(u) ((u).sw ? (const char*)g.Bt + (size_t)(u).pn * tstep : (const char*)g.A + (size_t)(u).pm * tstep)
#define PG8_UB(u) ((u).sw ? (const char*)g.A + (size_t)(u).pm * tstep : (const char*)g.Bt + (size_t)(u).pn * tstep)
    const char* cA = PG8_UA(cur); const char* cB = PG8_UB(cur);
    S.a_ready(cur);
    if constexpr (SP2) {
        PG8_STAGE(PG8_SB(0, 0), cB, voffB); PG8_STAGE(PG8_SB(0, 1), cB + hstep, voffB); PG8_STAGE(PG8_SA(0, 0), cA, voffA); PG8_STAGE(PG8_SA(0, 1), cA + hstep, voffA);
        if (wr == 1) PG8_BAR;
        PG8_WAIT_V(2); PG8_BAR;
        PG8_STAGE(PG8_SB(1, 0), cB + kstep, voffB); PG8_STAGE(PG8_SA(1, 0), cA + kstep, voffA); PG8_STAGE(PG8_SB(1, 1), cB + hstep + kstep, voffB);
        PG8_WAIT_V(6); PG8_BAR;
    } else {
        PG8_STAGE(PG8_SB(0, 0), cB, voffB); PG8_STAGE(PG8_SA(0, 0), cA, voffA); PG8_STAGE(PG8_SB(0, 1), cB + hstep, voffB); PG8_STAGE(PG8_SA(0, 1), cA + hstep, voffA);
        if (wr == 1) PG8_BAR;
        PG8_WAIT_V(4); PG8_BAR;
        PG8_STAGE(PG8_SB(1, 0), cB + kstep, voffB); PG8_STAGE(PG8_SA(1, 0), cA + kstep, voffA); PG8_STAGE(PG8_SB(1, 1), cB + hstep + kstep, voffB);
        PG8_WAIT_V(6); PG8_BAR;
    }
    for (;;) {
        const bool has_next = S.next(ui + 1, nxt);
        const char* nA = has_next ? PG8_UA(nxt) : cA; const char* nB = has_next ? PG8_UB(nxt) : cB;
        for (int t = 0; t < nt; t += 2) {
            const bool last = (t == nt - 2);
            const char* a1 = cA + (size_t)(t + 1) * kstep;
            const char* a2 = last ? nA : cA + (size_t)(t + 2) * kstep; const char* b2 = last ? nB : cB + (size_t)(t + 2) * kstep;
            const char* a3 = a2 + kstep; const char* b3 = b2 + kstep;
            if (last && has_next) S.a_ready(nxt);
            if constexpr (SP2) {
            PG8_LDB(B0, 0, 0); PG8_LDB(B1, 0, 1); PG8_SCHED; PG8_LDA(At, 0, 0); PG8_STAGE(PG8_SA(1, 1), a1 + hstep, voffA);
            PG8_WAIT_V(8); PG8_WAIT_L(0); PG8_BAR; PG8_MMA(0, 0, At, B0); PG8_MMA(0, 1, At, B1); PG8_BAR; PG8_SCHED;
            PG8_LDA(At, 0, 1); PG8_STAGE(PG8_SB(0, 0), b2, voffB); PG8_STAGE(PG8_SB(0, 1), b2 + hstep, voffB); PG8_STAGE(PG8_SA(0, 0), a2, voffA);
            PG8_WAIT_V(8); PG8_WAIT_L(0); PG8_BAR; PG8_MMA(1, 0, At, B0); PG8_MMA(1, 1, At, B1); PG8_BAR; PG8_SCHED;
            PG8_LDB(B0, 1, 0); PG8_LDB(B1, 1, 1); PG8_SCHED; PG8_LDA(At, 1, 0); PG8_STAGE(PG8_SA(0, 1), a2 + hstep, voffA);
            PG8_WAIT_V(8); PG8_WAIT_L(0); PG8_BAR; PG8_MMA(0, 0, At, B0); PG8_MMA(0, 1, At, B1); PG8_BAR; PG8_SCHED;
            PG8_LDA(At, 1, 1); PG8_STAGE(PG8_SB(1, 0), b3, voffB); PG8_STAGE(PG8_SB(1, 1), b3 + hstep, voffB); PG8_STAGE(PG8_SA(1, 0), a3, voffA);
            PG8_WAIT_V(8); PG8_WAIT_L(0); PG8_BAR; PG8_MMA(1, 0, At, B0); PG8_MMA(1, 1, At, B1); PG8_BAR; PG8_SCHED;
            } else {
            PG8_LDB(B0, 0, 0); PG8_SCHED; PG8_LDA(At, 0, 0); PG8_STAGE(PG8_SA(1, 1), a1 + hstep, voffA);
            PG8_WAIT_L(8); PG8_BAR; PG8_WAIT_L(0); PG8_MMA(0, 0, At, B0); PG8_BAR; PG8_SCHED;
            PG8_LDB(B1, 0, 1); PG8_STAGE(PG8_SB(0, 0), b2, voffB);
            PG8_BAR; PG8_WAIT_L(0); PG8_MMA(0, 1, At, B1); PG8_BAR;
            PG8_LDA(At, 0, 1); PG8_STAGE(PG8_SA(0, 0), a2, voffA);
            PG8_BAR; PG8_WAIT_L(0); PG8_MMA(1, 0, At, B0); PG8_BAR; PG8_SCHED;
            PG8_STAGE(PG8_SB(0, 1), b2 + hstep, voffB);
            PG8_WAIT_V(6); PG8_BAR; PG8_MMA(1, 1, At, B1); PG8_BAR;
            PG8_LDB(B0, 1, 0); PG8_SCHED; PG8_LDA(At, 1, 0); PG8_STAGE(PG8_SA(0, 1), a2 + hstep, voffA);
            PG8_WAIT_L(8); PG8_BAR; PG8_WAIT_L(0); PG8_MMA(0, 0, At, B0); PG8_BAR; PG8_SCHED;
            PG8_LDB(B1, 1, 1); PG8_STAGE(PG8_SB(1, 0), b3, voffB);
            PG8_BAR; PG8_WAIT_L(0); PG8_MMA(0, 1, At, B1); PG8_BAR;
            PG8_LDA(At, 1, 1); PG8_STAGE(PG8_SA(1, 0), a3, voffA);
            PG8_BAR; PG8_WAIT_L(0); PG8_MMA(1, 0, At, B0); PG8_BAR; PG8_SCHED;
            PG8_STAGE(PG8_SB(1, 1), b3 + hstep, voffB);
            PG8_WAIT_V(6); PG8_BAR; PG8_MMA(1, 1, At, B1); PG8_BAR;
            }
        }
        if constexpr (ALIGN_EPI) { if (wr == 0) PG8_BAR; }
        if constexpr (!Epi::AFTER_DRAIN) { E(acc, cur, wr, wc, fr, fq); S.done(cur); }
        if (!has_next) break;
#pragma unroll
        for (int a = 0; a < 2; ++a)
#pragma unroll
            for (int b = 0; b < 2; ++b)
#pragma unroll
                for (int m = 0; m < 4; ++m)
#pragma unroll
                    for (int n = 0; n < 2; ++n) acc[a][b][m][n] = (f32x4){0.f, 0.f, 0.f, 0.f};
        cur = nxt; cA = nA; cB = nB; ++ui;
        if constexpr (ALIGN_EPI) { if (wr == 1) PG8_BAR; }
    }
    PG8_WAIT_V(0);
    if constexpr (!ALIGN_EPI) { if (wr == 0) PG8_BAR; }
    PG8_BAR;
    if constexpr (Epi::AFTER_DRAIN) { E.fused(acc, cur, wr, wc, fr, fq, lds, wid, lane); S.done(cur); }
#undef PG8_UA
#undef PG8_UB
#undef PG8_SA
#undef PG8_SB
#undef PG8_STAGE
#undef PG8_LDA
#undef PG8_LDB
#undef PG8_MMA
#undef PG8_WAIT_V
#undef PG8_WAIT_L
#undef PG8_BAR
#undef PG8_SCHED
}
}
#define GAS __attribute__((address_space(1)))
#define LAS __attribute__((address_space(3)))
#define XB_TMO      128
#define XB_XCNT(j)  (256  + 64 * (j))
#define XB_XSUB(j)  (1280 + 64 * (j))
#define XB_XGEN(j)  (2304 + 64 * (j))
#define XB_TOP      3328
#define XB_TOPGEN   3392
#define XCD_BAR_WORDS 3456
#define XB_SPIN_CAP (1u << 18)

__device__ __forceinline__ unsigned xb_ld(unsigned* p)              { return __hip_atomic_load(p, __ATOMIC_RELAXED, __HIP_MEMORY_SCOPE_AGENT); }
__device__ __forceinline__ unsigned xb_add(unsigned* p, unsigned v) { return __hip_atomic_fetch_add(p, v, __ATOMIC_RELAXED, __HIP_MEMORY_SCOPE_AGENT); }
__device__ __forceinline__ unsigned xb_xcc_id() { return (unsigned)__builtin_amdgcn_s_getreg((3 << 11) | 20) & 0xFu; }
#define XB_SPIN(cond, bar) do { unsigned _sp = 0; while (cond) { __builtin_amdgcn_s_sleep(1); \
    if ((++_sp & 255u) == 0u) { if (xb_ld(&(bar)[XB_TMO])) break; if (_sp > XB_SPIN_CAP) { atomicAdd(&(bar)[XB_TMO], 1u); break; } } } } while (0)

struct XcdBarrier {
    unsigned* bar; unsigned x; int w0;
    volatile LAS unsigned* st;
};

__device__ __forceinline__ XcdBarrier xcd_barrier_post(unsigned* bar, volatile LAS unsigned* st, int wave) {
    XcdBarrier b; b.bar = bar; b.x = xb_xcc_id(); b.st = st; b.w0 = (wave == 0);
    if (b.w0 && pg8::pg8_lane_id() == 0) (void)xb_add(&bar[XB_XCNT(b.x)], 1u);
    return b;
}
__device__ __forceinline__ void xcd_barrier_complete(unsigned* bar, unsigned x, unsigned& nloc, unsigned& nx) {
    const unsigned G = gridDim.x * gridDim.y * gridDim.z;
    unsigned sum, cnt, mine, sp = 0u;
    for (;;) {
        sum = 0u; cnt = 0u; mine = 0u;
#pragma unroll
        for (unsigned j = 0; j < 16; ++j) { const unsigned c = xb_ld(&bar[XB_XCNT(j)]); sum += c; cnt += (c > 0u) ? 1u : 0u; mine = (j == x) ? c : mine; }
        if (sum == G) break;
        __builtin_amdgcn_s_sleep(1);
        if ((++sp & 255u) == 0u) { if (xb_ld(&bar[XB_TMO])) break; if (sp > XB_SPIN_CAP) { atomicAdd(&bar[XB_TMO], 1u); break; } }
    }
    nloc = mine > 0u ? mine : 1u; nx = cnt > 0u ? cnt : 1u;
}

__device__ __forceinline__ void xcd_barrier(const XcdBarrier& b) {
    asm volatile("s_waitcnt vmcnt(0)" ::: "memory");
    __syncthreads();
    if (b.w0 && pg8::pg8_lane_id() == 0) {
        unsigned* bar = b.bar;
        __builtin_amdgcn_s_waitcnt(0);
        unsigned nloc = b.st[0], nx = b.st[1];
        if (nloc == 0u) { xcd_barrier_complete(bar, b.x, nloc, nx); b.st[0] = nloc; b.st[1] = nx; }
        const unsigned old = xb_add(&bar[XB_XSUB(b.x)], 1u);
        const unsigned gen = old / nloc;
        if (old + 1u == (gen + 1u) * nloc) {
            __builtin_amdgcn_fence(__ATOMIC_RELEASE, "agent");
            asm volatile("s_waitcnt vmcnt(0)" ::: "memory");
            const unsigned og = xb_add(&bar[XB_TOP], 1u);
            const unsigned tg = og / nx;
            if (og + 1u == (tg + 1u) * nx) xb_add(&bar[XB_TOPGEN], 1u);
            else XB_SPIN(xb_ld(&bar[XB_TOPGEN]) == tg, bar);
            __builtin_amdgcn_fence(__ATOMIC_ACQUIRE, "agent");
            xb_add(&bar[XB_XGEN(b.x)], 1u);
            asm volatile("s_waitcnt vmcnt(0)" ::: "memory");
        } else {
            XB_SPIN(xb_ld(&bar[XB_XGEN(b.x)]) == gen, bar);
            __builtin_amdgcn_fence(__ATOMIC_ACQUIRE, "agent");
            asm volatile("s_waitcnt vmcnt(0)" ::: "memory");
        }
    }
    __syncthreads();
}
#ifndef MK_N_LAUNCHES
#define MK_N_LAUNCHES 1
#endif
#ifndef PROBE_DMA2
#define PROBE_DMA2 0
#endif
#if PROBE_DMA2
#define VMCNT12 "s_waitcnt vmcnt(24)"
#else
#define VMCNT12 "s_waitcnt vmcnt(12)"
#endif
#ifndef PROBE_NODMA
#define PROBE_NODMA 0
#endif
#ifndef PROBE_NOSLICE
#define PROBE_NOSLICE 0
#endif
#ifndef PROBE_SCAN2
#define PROBE_SCAN2 0
#endif
#ifndef PROBE_STORE2
#define PROBE_STORE2 0
#endif
#ifndef GDN_PREFETCH
#define GDN_PREFETCH 1
#endif
#ifndef RET_PREFETCH
#define RET_PREFETCH 1
#endif
#ifndef PROBE_SEG
#define PROBE_SEG 0
#endif
#define SEG_MINE(k) ((PROBE_SEG) == (k) && blockIdx.x == (((k) <= 5) ? 32 : 0) && F.wave == ((((k) >= 3 && (k) <= 5)) ? 4 : 0))
#define SEG_T0(k) do { if (SEG_MINE(k)) seg_t0_ = __builtin_amdgcn_s_memtime(); } while (0)
#define SEG_ACC(k) do { if (SEG_MINE(k)) seg_acc_ += __builtin_amdgcn_s_memtime() - seg_t0_; } while (0)
#define SEG_T02(k) do { if (SEG_MINE(k)) seg_t1_ = __builtin_amdgcn_s_memtime(); } while (0)
#define SEG_ACC2(k) do { if (SEG_MINE(k)) seg_acc_ += __builtin_amdgcn_s_memtime() - seg_t1_; } while (0)
#define SEG_OUT() do { if ((PROBE_SEG) > 0 && SEG_MINE(PROBE_SEG) && pg8::pg8_lane_id() == 0) __hip_atomic_store((unsigned*)(F.ws + WS_CTL) + 20000, (unsigned)(seg_acc_ >> 7), __ATOMIC_RELAXED, __HIP_MEMORY_SCOPE_AGENT); } while (0)
constexpr int NWAVES = 8;
constexpr int NPHASES = 10;
constexpr int BATCH = 2, SEQ = 8192, D = 2048, T = BATCH * SEQ;
constexpr int NH = 8, DK = 128, DV = 256;
constexpr int NIN = 16400;
constexpr int OFF_AZ = 4096, OFF_AB = 6144, OFF_RQ = 6160, OFF_RK = 7184, OFF_RV = 8208, OFF_RG = 10256, OFF_GA = 12304, OFF_GB = 14352;
constexpr int N1 = 17408;
constexpr int FF = 5632, NGU = 2 * FF;
constexpr float EPS = 1e-6f;
constexpr size_t MiB = 1u << 20;
constexpr size_t WS_CTL = 0, CTL_ZERO_BYTES = 1 * MiB;
constexpr size_t WS_BETA = 1 * MiB, WS_G = 1 * MiB + 512 * 1024;
constexpr size_t WS_COS = 2 * MiB, WS_SIN = 4 * MiB;
constexpr size_t WS_COS2 = 6 * MiB, WS_SIN2 = 8 * MiB;
constexpr size_t WS_DL = 10 * MiB, WS_RSTD = 11 * MiB;
constexpr size_t WS_WOT = 12 * MiB;
constexpr size_t WS_WGUT = 20 * MiB, WS_WDT = 64 * MiB;
constexpr size_t WS_W1T = 20 * MiB, WS_U = 88 * MiB;
constexpr size_t WS_GW = 20 * MiB, WS_GQ = 52 * MiB, WS_GK = 84 * MiB, WS_GA = 116 * MiB, WS_GU = 132 * MiB;
constexpr size_t WS_QKV = 196 * MiB;
constexpr size_t WS_RQF = 324 * MiB, WS_RKF = 356 * MiB, WS_RKTF = 388 * MiB, WS_RVTF = 420 * MiB, WS_END = 484 * MiB;
constexpr size_t WS_OA = 196 * MiB;
constexpr size_t WS_OB = 260 * MiB;
constexpr size_t WS_MIXED = 196 * MiB;
constexpr size_t WS_HNB = 324 * MiB;
constexpr size_t WS_H = 388 * MiB;
constexpr size_t WS_ACT = 88 * MiB;
static_assert(WS_ACT + (size_t)T * FF * 2 <= WS_HNB, "ACT overlay");
constexpr int CW_BAR = 4096;
constexpr int RING_BYTES = 131072, SCAN_RING_BYTES = 147456 + 12288, LDSCTL_OFF = SCAN_RING_BYTES, MISC_OFF = LDSCTL_OFF + 320, LDS_BYTES = 163840;

typedef unsigned short bf16;
typedef unsigned v4u __attribute__((ext_vector_type(4)));
typedef unsigned v2u __attribute__((ext_vector_type(2)));
typedef float f32x4 __attribute__((ext_vector_type(4)));
#define LDS_WAIT() asm volatile("s_waitcnt lgkmcnt(0)" ::: "memory")
__device__ __forceinline__ unsigned f2bf(float f) { unsigned u = __builtin_bit_cast(unsigned, f); return (u + 0x7fffu + ((u >> 16) & 1u)) >> 16; }
__device__ __forceinline__ unsigned pk2(float lo, float hi) { return f2bf(lo) | (f2bf(hi) << 16); }
__device__ __forceinline__ float bf2f(unsigned b) { return __builtin_bit_cast(float, b << 16); }
__device__ __forceinline__ float bflo(unsigned w) { return __builtin_bit_cast(float, w << 16); }
__device__ __forceinline__ float bfhi(unsigned w) { return __builtin_bit_cast(float, w & 0xffff0000u); }
__device__ __forceinline__ float silu_f(float a) { return a * __builtin_amdgcn_rcpf(1.0f + __expf(-a)); }
__device__ __forceinline__ float wave_sum(float v) {
#pragma unroll
    for (int o = 1; o < 64; o <<= 1) v += __shfl_xor(v, o);
    return v;
}

struct Args { const float* in[14]; float* out; unsigned char* ws; int ph_lo, ph_hi; };
struct Frame {
    LAS unsigned char* lds; int tid, lane, wave, vcu, G;
    const float *x, *norm1_w, *w_in, *conv_w, *a_log, *dt_bias, *gdn_norm_w, *ret_norm_w, *w_out, *norm2_w, *w_gate, *w_up, *w_down, *norm_f_w;
    float* out; unsigned char* ws;
};

__device__ __forceinline__ void transpose_blk(const float* src, int ld, int k0, int sc0, bf16* dst, int K, int dr0, LAS float* scr, int lane, const float* kscale = nullptr) {
    f32x4 v[16];
#pragma unroll
    for (int i = 0; i < 16; ++i) v[i] = *(const f32x4*)(src + (size_t)(k0 + 4 * i + (lane >> 4)) * ld + sc0 + 4 * (lane & 15));
    if (kscale) {
#pragma unroll
        for (int i = 0; i < 16; ++i) v[i] = v[i] * kscale[k0 + 4 * i + (lane >> 4)]; }
#pragma unroll
    for (int i = 0; i < 16; ++i) { LAS float* d = scr + (4 * i + (lane >> 4)) * 65 + 4 * (lane & 15); d[0] = v[i].x; d[1] = v[i].y; d[2] = v[i].z; d[3] = v[i].w; }
    LDS_WAIT(); asm volatile("" ::: "memory");
    const int c = lane & 7;
#pragma unroll
    for (int j = 0; j < 8; ++j) { const int n = (lane >> 3) + 8 * j; const LAS float* s = scr + (8 * c) * 65 + n;
        v4u o; o.x = pk2(s[0 * 65], s[1 * 65]); o.y = pk2(s[2 * 65], s[3 * 65]); o.z = pk2(s[4 * 65], s[5 * 65]); o.w = pk2(s[6 * 65], s[7 * 65]);
        *(v4u*)(dst + (size_t)(dr0 + n) * K + k0 + 8 * c) = o; }
    LDS_WAIT(); asm volatile("" ::: "memory");
}
__device__ __forceinline__ int w1_src_col(int n) {
    if (n < 4096) return n;
    if (n >= 16384) n = n - 16384 + 5120;
    if (n < 6144) { const int isk = n >= 5120, lt = (n - 4096) & 1023, tile = lt >> 8, c = lt & 255, bj = c >> 7, p = c & 127; return (isk ? OFF_RK : OFF_RQ) + (2 * tile + (p >> 6)) * 128 + bj * 64 + (p & 63); }
    if (n < 8192) return OFF_RV + (n - 6144);
    { const int isb = n >= 12288, lt = (n - 8192) & 4095, j = lt >> 8, c = lt & 255, bj = c >> 7, p = c & 127;
      return (isb ? (bj ? OFF_GB : OFF_RG) : (bj ? OFF_GA : OFF_AZ)) + 128 * j + p; }
}
__device__ __forceinline__ void p0_prologue(Frame& F) {
    __syncthreads();
    const int gw = F.vcu * NWAVES + F.wave, NGW = F.G * NWAVES, lane = F.lane;
    {
        LAS float* scr = (LAS float*)(F.lds + F.wave * 16640);
        constexpr int I_1 = (D / 64) * (N1 / 64), I_O = (D / 64) * (D / 64);
        constexpr int NITEMS = I_1 + I_O;
        bf16* W1T = (bf16*)(F.ws + WS_W1T); bf16* WOT = (bf16*)(F.ws + WS_WOT);
        for (int it = gw; it < NITEMS; it += NGW) {
            int r = it;
            if (r < I_1) { const int nb = r % (N1 / 64), kb = r / (N1 / 64); transpose_blk(F.w_in, NIN, 64 * kb, w1_src_col(64 * nb), W1T, D, 64 * nb, scr, lane); continue; } r -= I_1;
            { const int nb = r % (D / 64), kb = r / (D / 64); transpose_blk(F.w_out, D, 64 * kb, 64 * nb, WOT, D, 64 * nb, scr, lane); }
        }
    }
    {
        float* cosT = (float*)(F.ws + WS_COS); float* sinT = (float*)(F.ws + WS_SIN); float* cosT2 = (float*)(F.ws + WS_COS2); float* sinT2 = (float*)(F.ws + WS_SIN2);
        for (int idx = (F.vcu * 512 + F.tid); idx < SEQ * 64; idx += F.G * 512) { const int t = idx >> 6, i = idx & 63;
            const float inv = (float)exp2(-(double)i * (13.287712379549449 / 64.0));
            const float ang = (float)t * inv; const double a = (double)ang; const float cv = (float)cos(a), sv = (float)sin(a);
            cosT[idx] = cv; sinT[idx] = sv; cosT2[i * SEQ + t] = cv; sinT2[i * SEQ + t] = sv; }
    }
    __syncthreads();
    {
        LAS float* wT = (LAS float*)F.lds;
        { f32x4 wv[4][4];
#pragma unroll
          for (int j = 0; j < 4; ++j)
#pragma unroll
            for (int q = 0; q < 4; ++q) wv[j][q] = *(const f32x4*)(F.w_in + (size_t)(F.tid + 512 * j) * NIN + OFF_AB + 4 * q);
#pragma unroll
          for (int j = 0; j < 4; ++j)
#pragma unroll
            for (int q = 0; q < 4; ++q)
#pragma unroll
              for (int e = 0; e < 4; ++e) wT[(4 * q + e) * 2048 + F.tid + 512 * j] = wv[j][q][e]; }
        __syncthreads();
        bf16* U = (bf16*)(F.ws + WS_U); float* BETA = (float*)(F.ws + WS_BETA); float* GG = (float*)(F.ws + WS_G);
        f32x4 nw[8];
#pragma unroll
        for (int j = 0; j < 8; ++j) nw[j] = ((const f32x4*)F.norm1_w)[64 * j + lane];
        for (int row = gw; row < T; row += NGW) {
            asm volatile("" ::: "memory");
            const f32x4* xr = (const f32x4*)(F.x + (size_t)row * D) + lane;
            f32x4 v[8]; float ss = 0.f;
#pragma unroll
            for (int j = 0; j < 8; ++j) { v[j] = xr[64 * j]; ss += (v[j].x * v[j].x + v[j].y * v[j].y) + (v[j].z * v[j].z + v[j].w * v[j].w); }
            const float rstd = rsqrtf(wave_sum(ss) * (1.0f / D) + EPS);
            v2u* o8 = (v2u*)(U + (size_t)row * D) + lane;
#pragma unroll
            for (int j = 0; j < 8; ++j) { v[j] = (v[j] * rstd) * nw[j]; v2u w; w.x = pk2(v[j].x, v[j].y); w.y = pk2(v[j].z, v[j].w); o8[64 * j] = w; }
            float mb = 0.f, ma = 0.f;
#pragma unroll
            for (int c = 0; c < 16; ++c) { float s = 0.f;
#pragma unroll
                for (int j = 0; j < 8; ++j) { const f32x4 w = *(const LAS f32x4*)(wT + c * 2048 + 256 * j + 4 * lane); s += (v[j].x * w.x + v[j].y * w.y) + (v[j].z * w.z + v[j].w * w.w); }
                s = wave_sum(s);
                if (c < 8) mb = (lane == c) ? s : mb; else ma = (lane == c - 8) ? s : ma; }
            if (lane == 8) ((float*)(F.ws + WS_RSTD))[row] = 0.f;
            if (lane < 8) { const float bt = 1.0f / (1.0f + expf(-mb)); const float xa = ma + F.dt_bias[lane]; const float sp = xa > 20.f ? xa : log1pf(expf(xa));
                BETA[(size_t)row * 8 + lane] = bt; GG[(size_t)row * 8 + lane] = -expf(F.a_log[lane]) * sp; }
        }
    }
}

__device__ __forceinline__ void gdn_naive(Frame& F, int bh) {
    const int b = bh >> 3, h = bh & 7, tid = F.tid, c = tid & 255, hh = tid >> 8;
    LAS float* sq = (LAS float*)F.lds; LAS float* sk = sq + 128; LAS float* sv = sq + 256; LAS float* sp = sq + 512; LAS float* sred = sq + 1024;
    const int ch = tid < 128 ? h * 128 + tid : (tid < 256 ? 1024 + h * 128 + (tid - 128) : 2048 + h * 256 + (tid - 256));
    const float cw0 = F.conv_w[0 * 4096 + ch], cw1 = F.conv_w[1 * 4096 + ch], cw2 = F.conv_w[2 * 4096 + ch], cw3 = F.conv_w[3 * 4096 + ch];
    const bf16* raw = (const bf16*)(F.ws + WS_QKV) + (size_t)(b * SEQ) * 4096 + ch;
    const float* BETA = (const float*)(F.ws + WS_BETA) + (size_t)(b * SEQ) * 8 + h; const float* GG = (const float*)(F.ws + WS_G) + (size_t)(b * SEQ) * 8 + h;
    bf16* OA = (bf16*)(F.ws + WS_OA) + (size_t)(b * SEQ) * 2048 + h * 256 + c;
    float S[64];
#pragma unroll
    for (int d = 0; d < 64; ++d) S[d] = 0.f;
    float r0 = 0.f, r1 = 0.f, r2 = 0.f;
    float nraw = bf2f(raw[0]), nbeta = BETA[0], ng = GG[0];
    for (int t = 0; t < SEQ; ++t) {
        const float r3 = nraw, beta = nbeta, eg = expf(ng);
        if (t + 1 < SEQ) { nraw = bf2f(raw[(size_t)(t + 1) * 4096]); nbeta = BETA[(size_t)(t + 1) * 8]; ng = GG[(size_t)(t + 1) * 8]; }
        const float a = r0 * cw0 + r1 * cw1 + r2 * cw2 + r3 * cw3; r0 = r1; r1 = r2; r2 = r3;
        float val = a / (1.0f + expf(-a));
        const float ws_ = wave_sum(val * val);
        if (F.lane == 0) sred[F.wave] = ws_;
        __syncthreads();
        if (tid < 128) { val = val * rsqrtf(sred[0] + sred[1] + EPS) * 0.08838834764831845f; sq[tid] = val; }
        else if (tid < 256) { val = val * rsqrtf(sred[2] + sred[3] + EPS); sk[tid - 128] = val; }
        else sv[tid - 256] = val;
        __syncthreads();
        float p = 0.f;
#pragma unroll
        for (int d = 0; d < 64; ++d) p += sk[hh * 64 + d] * S[d];
        sp[hh * 256 + c] = p;
        __syncthreads();
        const float kS = sp[c] + sp[256 + c];
        const float delta = beta * (sv[c] - eg * kS);
        float o = 0.f;
#pragma unroll
        for (int d = 0; d < 64; ++d) { S[d] = eg * S[d] + sk[hh * 64 + d] * delta; o += sq[hh * 64 + d] * S[d]; }
        __syncthreads();
        sp[hh * 256 + c] = o;
        __syncthreads();
        if (hh == 0) OA[(size_t)t * 2048] = (bf16)f2bf(sp[c] + sp[256 + c]);
    }
}
__device__ __forceinline__ void ffn_weight_copies(Frame& F) {
    const int gw = F.vcu * NWAVES + F.wave, NGW = F.G * NWAVES, lane = F.lane;
    LAS float* scr = (LAS float*)(F.lds + F.wave * 16640);
    constexpr int I_G = (D / 64) * (FF / 64), I_D = (FF / 64) * (D / 64);
    bf16* WGUT = (bf16*)(F.ws + WS_WGUT); bf16* WDT = (bf16*)(F.ws + WS_WDT);
    for (int it = gw; it < 2 * I_G + I_D; it += NGW) {
        int r = it;
        if (r < 2 * I_G) { const int up = r >= I_G; if (up) r -= I_G; const int nb = r % (FF / 64), kb = r / (FF / 64), c0 = 64 * nb;
            transpose_blk(up ? F.w_up : F.w_gate, FF, 64 * kb, c0, WGUT, D, 256 * (c0 >> 7) + 128 * up + (c0 & 127), scr, lane, F.norm2_w); continue; } r -= 2 * I_G;
        { const int nb = r % (D / 64), kb = r / (D / 64); transpose_blk(F.w_down, D, 64 * kb, 64 * nb, WDT, FF, 64 * nb, scr, lane); }
    }
}

typedef float f32x16 __attribute__((ext_vector_type(16)));
typedef short bf16x8 __attribute__((ext_vector_type(8)));
typedef float f32x2_t __attribute__((ext_vector_type(2))); typedef __bf16 bf16x2_t __attribute__((ext_vector_type(2)));
#define MFMA32(a, b, c) __builtin_amdgcn_mfma_f32_32x32x16_bf16((a), (b), (c), 0, 0, 0)
__device__ __forceinline__ unsigned cvtpk_s(float lo, float hi) { f32x2_t v = {lo, hi}; bf16x2_t b = __builtin_convertvector(v, bf16x2_t); return __builtin_bit_cast(unsigned, b); }
#define PACK_STEP(x, s) __builtin_bit_cast(bf16x8, (v4u){cvtpk_s((x)[8 * (s)], (x)[8 * (s) + 1]), cvtpk_s((x)[8 * (s) + 2], (x)[8 * (s) + 3]), cvtpk_s((x)[8 * (s) + 4], (x)[8 * (s) + 5]), cvtpk_s((x)[8 * (s) + 6], (x)[8 * (s) + 7])})
__device__ __forceinline__ bf16 cvt1_bf16(float x) { return (bf16)(cvtpk_s(x, x) & 0xffffu); }
__device__ __forceinline__ bf16x8 ldfrag(const bf16* base, size_t f, int lane) {
#if PROBE_NOSLICE
    bf16x8 z; for (int i = 0; i < 8; ++i) z[i] = (short)(lane + i); asm volatile("" : "+v"(z)); return z;
#endif
    return *(const bf16x8*)(base + f * 512 + lane * 8); }
__device__ __forceinline__ f32x16 zero16() { f32x16 z; for (int i = 0; i < 16; ++i) z[i] = 0.f; return z; }

#define SCAN_BAR_C() do { asm volatile("s_waitcnt lgkmcnt(0)" ::: "memory"); __builtin_amdgcn_s_barrier(); asm volatile("" ::: "memory"); } while (0)
#define SCAN_BAR() do { asm volatile("s_waitcnt vmcnt(0) lgkmcnt(0)" ::: "memory"); __builtin_amdgcn_s_barrier(); asm volatile("" ::: "memory"); } while (0)
__device__ __forceinline__ void glds1k(const bf16* gsrc_frag, LAS unsigned char* dst, int lane) {
#if PROBE_NODMA
    return;
#endif
    __builtin_amdgcn_global_load_lds((const unsigned*)(gsrc_frag + lane * 8), (LAS unsigned*)dst, 16, 0, 0);
#if PROBE_DMA2
    __builtin_amdgcn_global_load_lds((const unsigned*)(gsrc_frag + lane * 8), (LAS unsigned*)dst, 16, 0, 0);
#endif
}
__device__ __forceinline__ void dma_chunk3(const bf16* p0, const bf16* p1, const bf16* p2, LAS unsigned char* dst_lw, int lane) {
#pragma unroll
    for (int q = 0; q < 4; ++q) glds1k(p0 + q * 2048, dst_lw + (0 * 16 + 4 * q) * 1024, lane);
#pragma unroll
    for (int q = 0; q < 4; ++q) glds1k(p1 + q * 2048, dst_lw + (1 * 16 + 4 * q) * 1024, lane);
#pragma unroll
    for (int q = 0; q < 4; ++q) glds1k(p2 + q * 2048, dst_lw + (2 * 16 + 4 * q) * 1024, lane);
}
__device__ __forceinline__ bf16x8 ldsfrag(const LAS unsigned char* buf, int slot, int lane) { return *(const LAS bf16x8*)(buf + slot * 1024 + lane * 16); }

constexpr int RS_BUF = 48 * 1024, RS_PA = 3 * RS_BUF;
__device__ __forceinline__ void ret_scan_wg(Frame& F, int bh, int half, unsigned* prog) {
    unsigned long long seg_t0_ = 0, seg_t1_ = 0, seg_acc_ = 0; (void)seg_t0_; (void)seg_t1_; (void)seg_acc_;
    const int w = F.wave, b = bh >> 3, h = bh & 7;
    const bf16* RQf = (const bf16*)(F.ws + WS_RQF); const bf16* RKf = (const bf16*)(F.ws + WS_RKF); const bf16* RKTf = (const bf16*)(F.ws + WS_RKTF); const bf16* RVTf = (const bf16*)(F.ws + WS_RVTF);
    LAS unsigned char* L = F.lds;
    if (w >= 4) {
        const int lw = w - 4, lane = pg8::pg8_lane_id(), col = lane & 31, hh = lane >> 5;
        const bf16* pq = RQf + ((size_t)bh * 128 * 16 + lw) * 512; const bf16* pk = RKf + ((size_t)bh * 128 * 16 + lw) * 512; const bf16* pt = RKTf + ((size_t)bh * 128 * 16 + lw) * 512;
        dma_chunk3(pq, pk, pt, L + 0 * RS_BUF + lw * 1024, lane); pq += 8192; pk += 8192; pt += 8192;
        dma_chunk3(pq, pk, pt, L + 1 * RS_BUF + lw * 1024, lane); pq += 8192; pk += 8192; pt += 8192;
        asm volatile(VMCNT12 ::: "memory"); __builtin_amdgcn_s_barrier(); asm volatile("" ::: "memory");
        int cb = 0, nb = 2;
        for (int n = 0; n < 128; ++n) {
            const LAS unsigned char* B = L + cb * RS_BUF;
            if (lw < 3) {
                const int tj = lw == 2 ? 1 : 0, ti = lw == 0 ? 0 : 1;
                f32x16 P = zero16();
#pragma unroll
                for (int td = 0; td < 4; ++td)
#pragma unroll
                    for (int s2 = 0; s2 < 2; ++s2) P = MFMA32(ldsfrag(B, 16 + (tj * 4 + td) * 2 + s2, lane), ldsfrag(B, (ti * 4 + td) * 2 + s2, lane), P);
                if (lw != 1) {
#pragma unroll
                    for (int r = 0; r < 16; ++r) { const int j = (r & 3) + 8 * (r >> 2) + 4 * hh; if (col < j) P[r] = 0.f; } }
                const bf16x8 a0 = PACK_STEP(P, 0), a1 = PACK_STEP(P, 1);
                *(LAS bf16x8*)(L + RS_PA + (2 * lw) * 1024 + lane * 16) = a0; *(LAS bf16x8*)(L + RS_PA + (2 * lw + 1) * 1024 + lane * 16) = a1;
            }
            asm volatile("s_waitcnt lgkmcnt(0)" ::: "memory"); __builtin_amdgcn_s_barrier(); asm volatile("" ::: "memory");
            if (n + 2 < 128) { dma_chunk3(pq, pk, pt, L + nb * RS_BUF + lw * 1024, lane); pq += 8192; pk += 8192; pt += 8192;
                asm volatile(VMCNT12 ::: "memory"); }
            else asm volatile("s_waitcnt vmcnt(0)" ::: "memory");
            __builtin_amdgcn_s_barrier(); asm volatile("" ::: "memory");
            if (lw == 0 && half == 0 && lane == 0) __hip_atomic_store(prog, (unsigned)(n + 1), __ATOMIC_RELAXED, __HIP_MEMORY_SCOPE_AGENT);
            cb = cb == 2 ? 0 : cb + 1; nb = nb == 2 ? 0 : nb + 1;
        }
        return;
    }
    const int sl = 4 * half + w, lane = pg8::pg8_lane_id(), col = lane & 31, hh = lane >> 5;
    bf16* OB = (bf16*)(F.ws + WS_RVTF) + ((size_t)bh * 128 * 8 + sl) * 2048;
    const unsigned loff = (unsigned)(hh * 4 * 32 + col);
    const float g64 = exp2f(64.0f * log2f(1.0f - exp2f(-5.0f - (float)h)));
    f32x16 S[4];
#pragma unroll
    for (int td = 0; td < 4; ++td) S[td] = zero16();
#if RET_PREFETCH
    bf16x8 vtn[2][2];
    { const size_t cq = (size_t)bh * 128;
#pragma unroll
      for (int tj = 0; tj < 2; ++tj)
#pragma unroll
        for (int s2 = 0; s2 < 2; ++s2) vtn[tj][s2] = ldfrag(RVTf, ((cq * 8 + sl) * 2 + tj) * 2 + s2, lane); }
#endif
    SCAN_BAR_C();
    int cb = 0;
    for (int n = 0; n < 128; ++n) { SEG_T02(6);
        const LAS unsigned char* B = L + cb * RS_BUF; cb = cb == 2 ? 0 : cb + 1;
        bf16x8 vt[2][2];
#if RET_PREFETCH
#pragma unroll
        for (int tj = 0; tj < 2; ++tj)
#pragma unroll
            for (int s2 = 0; s2 < 2; ++s2) vt[tj][s2] = vtn[tj][s2];
        if (n + 1 < 128) { const size_t cq = (size_t)bh * 128 + n + 1;
#else
#define vtn vt
        { const size_t cq = (size_t)bh * 128 + n;
#endif
#pragma unroll
          for (int tj = 0; tj < 2; ++tj)
#pragma unroll
            for (int s2 = 0; s2 < 2; ++s2) vtn[tj][s2] = ldfrag(RVTf, ((cq * 8 + sl) * 2 + tj) * 2 + s2, lane); }
#define PIN() do { asm volatile("" ::: "memory"); __builtin_amdgcn_sched_barrier(0); } while (0)
#define LD4(dst, base, s0, s1, s2, s3) do { PIN(); dst[0] = ldsfrag(base, s0, lane); dst[1] = ldsfrag(base, s1, lane); dst[2] = ldsfrag(base, s2, lane); dst[3] = ldsfrag(base, s3, lane); PIN(); } while (0)
#define QSLOT(ti, td, s2) (((ti) * 4 + (td)) * 2 + (s2))
#define KTSLOT(k) (32 + (k))
        bf16x8 fa[4], fb[4];
        const LAS unsigned char* PAb = L + RS_PA;
        f32x16 o0 = zero16(), o1 = zero16();
        LD4(fa, B, QSLOT(0, 0, 0), QSLOT(0, 0, 1), QSLOT(1, 0, 0), QSLOT(1, 0, 1));
        { const bf16x8 sb0 = PACK_STEP(S[0], 0), sb1 = PACK_STEP(S[0], 1);
          LD4(fb, B, QSLOT(0, 1, 0), QSLOT(0, 1, 1), QSLOT(1, 1, 0), QSLOT(1, 1, 1));
          o0 = MFMA32(fa[0], sb0, o0); o0 = MFMA32(fa[1], sb1, o0); o1 = MFMA32(fa[2], sb0, o1); o1 = MFMA32(fa[3], sb1, o1); }
        { const bf16x8 sb0 = PACK_STEP(S[1], 0), sb1 = PACK_STEP(S[1], 1);
          LD4(fa, B, QSLOT(0, 2, 0), QSLOT(0, 2, 1), QSLOT(1, 2, 0), QSLOT(1, 2, 1));
          o0 = MFMA32(fb[0], sb0, o0); o0 = MFMA32(fb[1], sb1, o0); o1 = MFMA32(fb[2], sb0, o1); o1 = MFMA32(fb[3], sb1, o1); }
        { const bf16x8 sb0 = PACK_STEP(S[2], 0), sb1 = PACK_STEP(S[2], 1);
          LD4(fb, B, QSLOT(0, 3, 0), QSLOT(0, 3, 1), QSLOT(1, 3, 0), QSLOT(1, 3, 1));
          o0 = MFMA32(fa[0], sb0, o0); o0 = MFMA32(fa[1], sb1, o0); o1 = MFMA32(fa[2], sb0, o1); o1 = MFMA32(fa[3], sb1, o1); }
        { const bf16x8 sb0 = PACK_STEP(S[3], 0), sb1 = PACK_STEP(S[3], 1);
          o0 = MFMA32(fb[0], sb0, o0); o0 = MFMA32(fb[1], sb1, o0); o1 = MFMA32(fb[2], sb0, o1); o1 = MFMA32(fb[3], sb1, o1); }
        SEG_T0(7); SCAN_BAR_C(); SEG_ACC(7);
#define STORE_O(ox, rowoff) do { _Pragma("unroll") for (int r = 0; r < 16; ++r) { const unsigned ro = (unsigned)(((r & 3) + 8 * (r >> 2)) * 32); orow[loff + ro + (rowoff)] = cvt1_bf16(ox[r]); } } while (0)
        bf16* orow = OB + (size_t)n * (8 * 2048);
        LD4(fa, PAb, 0, 1, 2, 3);
        fb[0] = ldsfrag(PAb, 4, lane); fb[1] = ldsfrag(PAb, 5, lane); fb[2] = ldsfrag(B, KTSLOT(0), lane); fb[3] = ldsfrag(B, KTSLOT(1), lane); PIN();
        S[0] = S[0] * g64; S[1] = S[1] * g64;
        o0 = MFMA32(fa[0], vt[0][0], o0); o0 = MFMA32(fa[1], vt[0][1], o0); o1 = MFMA32(fa[2], vt[0][0], o1); o1 = MFMA32(fa[3], vt[0][1], o1);
        LD4(fa, B, KTSLOT(2), KTSLOT(3), KTSLOT(4), KTSLOT(5));
        S[2] = S[2] * g64; S[3] = S[3] * g64;
        o1 = MFMA32(fb[0], vt[1][0], o1); o1 = MFMA32(fb[1], vt[1][1], o1);
        S[0] = MFMA32(fb[2], vt[0][0], S[0]); S[0] = MFMA32(fb[3], vt[0][1], S[0]);
        LD4(fb, B, KTSLOT(6), KTSLOT(7), KTSLOT(8), KTSLOT(9));
        STORE_O(o0, 0u);
        S[0] = MFMA32(fa[0], vt[1][0], S[0]); S[0] = MFMA32(fa[1], vt[1][1], S[0]);
        S[1] = MFMA32(fa[2], vt[0][0], S[1]); S[1] = MFMA32(fa[3], vt[0][1], S[1]);
        LD4(fa, B, KTSLOT(10), KTSLOT(11), KTSLOT(12), KTSLOT(13));
        STORE_O(o1, 32u * 32u);
        S[1] = MFMA32(fb[0], vt[1][0], S[1]); S[1] = MFMA32(fb[1], vt[1][1], S[1]);
        S[2] = MFMA32(fb[2], vt[0][0], S[2]); S[2] = MFMA32(fb[3], vt[0][1], S[2]);
        PIN(); fb[0] = ldsfrag(B, KTSLOT(14), lane); fb[1] = ldsfrag(B, KTSLOT(15), lane); PIN();
        S[2] = MFMA32(fa[0], vt[1][0], S[2]); S[2] = MFMA32(fa[1], vt[1][1], S[2]);
        S[3] = MFMA32(fa[2], vt[0][0], S[3]); S[3] = MFMA32(fa[3], vt[0][1], S[3]);
        S[3] = MFMA32(fb[0], vt[1][0], S[3]); S[3] = MFMA32(fb[1], vt[1][1], S[3]);
#undef STORE_O
        SEG_T0(8); SCAN_BAR_C(); SEG_ACC(8); SEG_ACC2(6);
    }
    SEG_OUT();
}

#define RLX_AGENT __ATOMIC_RELAXED, __HIP_MEMORY_SCOPE_AGENT
__device__ __forceinline__ void st8_wt(void* p, unsigned lo, unsigned hi) { __hip_atomic_store((unsigned long long*)p, ((unsigned long long)hi << 32) | lo, RLX_AGENT); }
__device__ __forceinline__ void st16_wt(void* p, v4u v) { st8_wt(p, v.x, v.y); st8_wt((char*)p + 8, v.z, v.w); }
constexpr int CW_RDY = 32768;
#ifndef PROBE_NOSTORE
#define PROBE_NOSTORE 0
#endif
#ifndef PROBE_ONLYSCAN
#define PROBE_ONLYSCAN 0
#endif
#ifndef PROBE_PREP
#define PROBE_PREP 0
#endif
#ifndef RET_TOUCH
#define RET_TOUCH 1
#endif
#ifndef RT_LOOK
#define RT_LOOK 6
#endif
constexpr int GP_PF = 120832;
constexpr int GP_QH = 0, GP_KH = 17408, GP_AM = 34816, GP_RK = 51200, GP_GC = 83968, GP_BT = 84224, GP_WL = GP_RK, GP_VR = 84480;
__device__ __forceinline__ void gdn_prep(Frame& F, int ci) {
    int tid_ = F.tid; asm volatile("" : "+v"(tid_));
    const int tid = tid_, lane = tid & 63, w = __builtin_amdgcn_readfirstlane(tid >> 6), bh = ci >> 7, n = ci & 127, b = bh >> 3, h = bh & 7;
    const size_t trow0 = (size_t)b * SEQ + 64 * n;
    LAS unsigned char* L = F.lds;
    LAS float* gcs = (LAS float*)(L + GP_GC); LAS float* bet = (LAS float*)(L + GP_BT); LAS float* Am = (LAS float*)(L + GP_AM); LAS float* Rk = (LAS float*)(L + GP_RK);
    const bf16* QKV = (const bf16*)(F.ws + WS_QKV);
    bf16* GW = (bf16*)(F.ws + WS_GW); bf16* GQ = (bf16*)(F.ws + WS_GQ); bf16* GK = (bf16*)(F.ws + WS_GK); bf16* GA = (bf16*)(F.ws + WS_GA); bf16* GU = (bf16*)(F.ws + WS_GU);
#if RET_TOUCH
    { const int np = n + RT_LOOK;
      if (np < 128) { const size_t c = (size_t)bh * 128 + np;
        const unsigned char* p = tid < 384 ? F.ws + (tid < 128 ? WS_RQF : tid < 256 ? WS_RKF : WS_RKTF) + c * 16384 + (size_t)(tid & 127) * 128 : F.ws + WS_RVTF + c * 32768 + (size_t)(tid - 384) * 128;
        __builtin_amdgcn_global_load_lds((const unsigned*)p, (LAS unsigned*)(L + GP_PF + w * 256), 4, 0, 0);
        if (w < 2) __builtin_amdgcn_global_load_lds((const unsigned*)(F.ws + WS_RVTF + c * 32768 + (size_t)(128 + tid) * 128), (LAS unsigned*)(L + GP_PF + w * 256), 4, 0, 0); } }
#endif
    {
        v4u vr[5];
#pragma unroll
        for (int k = 0; k < 5; ++k) { const int idx = tid + 512 * k, row = idx >> 5, cg = idx & 31; vr[k] = (v4u){0u, 0u, 0u, 0u};
            if (row < 67 && (n > 0 || row >= 3)) vr[k] = *(const v4u*)(QKV + (trow0 + row - 3) * 4096 + 2048 + h * 256 + 8 * cg); }
#pragma unroll
        for (int k = 0; k < 5; ++k) { const int idx = tid + 512 * k, row = idx >> 5, cg = idx & 31; if (row < 67) *(LAS v4u*)(L + GP_VR + row * 512 + cg * 16) = vr[k]; }
    }
    if (w == 0) {
        float g = ((const float*)(F.ws + WS_G))[(trow0 + lane) * 8 + h];
#pragma unroll
        for (int o = 1; o < 64; o <<= 1) { const float t = __shfl_up(g, o); if (lane >= o) g += t; }
        gcs[lane] = g; bet[lane] = ((const float*)(F.ws + WS_BETA))[(trow0 + lane) * 8 + h];
        if (lane == 63) __hip_atomic_store((unsigned*)(F.ws + WS_DL) + ci, __builtin_bit_cast(unsigned, expf(g)), RLX_AGENT);
    }
    __syncthreads();
    for (int pr_ = 0; pr_ < (PROBE_PREP == 1 ? 2 : 1); ++pr_) {
        const int cg = lane & 31, rh = lane >> 5, isk = cg >> 4, dk0 = 8 * (cg & 15), row0 = 8 * w + 4 * rh;
        const int ch = (isk ? 1024 : 0) + h * 128 + dk0;
        float cw[4][8];
#pragma unroll
        for (int j = 0; j < 4; ++j) { const f32x4 a = *(const f32x4*)(F.conv_w + j * 4096 + ch), c = *(const f32x4*)(F.conv_w + j * 4096 + ch + 4);
            cw[j][0] = a.x; cw[j][1] = a.y; cw[j][2] = a.z; cw[j][3] = a.w; cw[j][4] = c.x; cw[j][5] = c.y; cw[j][6] = c.z; cw[j][7] = c.w; }
        float raw[7][8];
#pragma unroll
        for (int rr = 0; rr < 7; ++rr) { const int row = row0 - 3 + rr;
            v4u v = {0u, 0u, 0u, 0u};
            if (n > 0 || row >= 0) v = *(const v4u*)(QKV + (trow0 + row) * 4096 + ch);
#pragma unroll
            for (int e = 0; e < 4; ++e) { raw[rr][2 * e] = bflo(v[e]); raw[rr][2 * e + 1] = bfhi(v[e]); } }
        const float g63 = gcs[63];
#pragma unroll
        for (int r = 0; r < 4; ++r) { asm volatile("" ::: "memory"); const int row = row0 + r; float val[8]; float ss = 0.f;
#pragma unroll
            for (int e = 0; e < 8; ++e) { const float a = raw[r][e] * cw[0][e] + raw[r + 1][e] * cw[1][e] + raw[r + 2][e] * cw[2][e] + raw[r + 3][e] * cw[3][e];
                val[e] = silu_f(a); ss += val[e] * val[e]; }
            ss += __shfl_xor(ss, 1); ss += __shfl_xor(ss, 2); ss += __shfl_xor(ss, 4); ss += __shfl_xor(ss, 8);
            const float rn = rsqrtf(ss + EPS) * (isk ? 1.0f : 0.08838834764831845f);
            const float gc = gcs[row], eg = __expf(gc);
#pragma unroll
            for (int e = 0; e < 8; ++e) val[e] *= rn;
            v4u pk; pk.x = pk2(val[0], val[1]); pk.y = pk2(val[2], val[3]); pk.z = pk2(val[4], val[5]); pk.w = pk2(val[6], val[7]);
            *(LAS v4u*)(L + (isk ? GP_KH : GP_QH) + row * 272 + dk0 * 2) = pk;
            if (!isk) {
                const size_t f = (((size_t)ci * 2 + (row >> 5)) * 4 + (dk0 >> 5)) * 2 + ((dk0 >> 4) & 1);
                bf16* p = GQ + f * 512 + (row & 31) * 8 + ((dk0 >> 3) & 1) * 4;
                st8_wt(p, pk2(val[0] * eg, val[1] * eg), pk2(val[2] * eg, val[3] * eg));
                st8_wt(p + 256, pk2(val[4] * eg, val[5] * eg), pk2(val[6] * eg, val[7] * eg));
            } else {
                const float bt = bet[row] * eg;
                f32x4 r0 = {val[0] * bt, val[1] * bt, val[2] * bt, val[3] * bt}, r1 = {val[4] * bt, val[5] * bt, val[6] * bt, val[7] * bt};
                *(LAS f32x4*)(Rk + row * 128 + dk0) = r0; *(LAS f32x4*)(Rk + row * 128 + dk0 + 4) = r1;
                const float ek = __expf(g63 - gc);
#pragma unroll
                for (int e = 0; e < 8; ++e) raw[r][e] = val[e] * ek;
            }
        }
        if (isk) {
            const int tj = w >> 2, s1 = (w >> 1) & 1;
#pragma unroll
            for (int e = 0; e < 8; ++e) { const int dk = dk0 + e;
                const size_t f = (((size_t)ci * 4 + (dk >> 5)) * 2 + tj) * 2 + s1;
                st8_wt(GK + f * 512 + (rh * 32 + (dk & 31)) * 8 + (w & 1) * 4, pk2(raw[0][e], raw[1][e]), pk2(raw[2][e], raw[3][e])); }
        }
    }
    __syncthreads();
    for (int pr_ = 0; pr_ < (PROBE_PREP == 2 ? 2 : 1); ++pr_) if (w < 6) {
        const int tsel = w % 3, ti = tsel == 0 ? 0 : 1, tj = tsel == 2 ? 1 : 0;
        const int r = lane & 31, hh = lane >> 5;
        f32x16 acc = zero16();
        if (w < 3) {
#pragma unroll
            for (int kb = 0; kb < 8; ++kb) { const bf16x8 a = *(const LAS bf16x8*)(L + GP_KH + (32 * ti + r) * 272 + (16 * kb + 8 * hh) * 2), bb = *(const LAS bf16x8*)(L + GP_KH + (32 * tj + r) * 272 + (16 * kb + 8 * hh) * 2);
                acc = MFMA32(a, bb, acc); }
            const int j = 32 * tj + r; const float gj = gcs[j];
#pragma unroll
            for (int q = 0; q < 16; ++q) { const int i = 32 * ti + (q & 3) + 8 * (q >> 2) + 4 * hh;
                const float v = (i > j) ? bet[i] * acc[q] * __expf(fminf(gcs[i] - gj, 0.f)) : 0.f; Am[i * 64 + j] = v; }
        } else {
#pragma unroll
            for (int kb = 0; kb < 8; ++kb) { const bf16x8 a = *(const LAS bf16x8*)(L + GP_KH + (32 * tj + r) * 272 + (16 * kb + 8 * hh) * 2), bb = *(const LAS bf16x8*)(L + GP_QH + (32 * ti + r) * 272 + (16 * kb + 8 * hh) * 2);
                acc = MFMA32(a, bb, acc); }
            const int i = 32 * ti + r; const float gi = gcs[i];
#pragma unroll
            for (int q = 0; q < 16; ++q) { const int j = 32 * tj + (q & 3) + 8 * (q >> 2) + 4 * hh;
                acc[q] = (i >= j) ? acc[q] * __expf(fminf(gi - gcs[j], 0.f)) : 0.f; }
            const bf16x8 f0 = PACK_STEP(acc, 0), f1 = PACK_STEP(acc, 1);
            const size_t f = (((size_t)ci * 2 + ti) * 2 + tj) * 2;
            st16_wt(GA + f * 512 + lane * 8, __builtin_bit_cast(v4u, f0)); st16_wt(GA + (f + 1) * 512 + lane * 8, __builtin_bit_cast(v4u, f1));
        }
    }
    __syncthreads();
    float x[64];
    for (int pr_ = 0; pr_ < (PROBE_PREP == 3 ? 2 : 1); ++pr_) if (tid < 384) {
        if (tid < 256) {
            const int ch = 2048 + h * 256 + tid;
            const float c0 = F.conv_w[ch], c1 = F.conv_w[4096 + ch], c2 = F.conv_w[2 * 4096 + ch], c3 = F.conv_w[3 * 4096 + ch];
            const LAS unsigned short* vcol = (const LAS unsigned short*)(L + GP_VR) + tid;
            float r0 = bf2f(vcol[0]), r1 = bf2f(vcol[256]), r2 = bf2f(vcol[512]);
#pragma unroll
            for (int i = 0; i < 64; ++i) { const float r3 = bf2f(vcol[(i + 3) * 256]); const float a = r0 * c0 + r1 * c1 + r2 * c2 + r3 * c3; r0 = r1; r1 = r2; r2 = r3;
                x[i] = bet[i] * silu_f(a); }
        } else {
#pragma unroll
            for (int i = 0; i < 64; ++i) x[i] = Rk[i * 128 + (tid - 256)];
        }
#pragma unroll
        for (int ib = 0; ib < 16; ++ib) {
            f32x4 acc[4];
#pragma unroll
            for (int r = 0; r < 4; ++r) acc[r] = (f32x4){0.f, 0.f, 0.f, 0.f};
#pragma unroll
            for (int q = 0; q < ib; ++q) {
                if ((q & 3) == 0) asm volatile("" ::: "memory");
                const f32x4 xv = (f32x4){x[4 * q], x[4 * q + 1], x[4 * q + 2], x[4 * q + 3]};
#pragma unroll
                for (int r = 0; r < 4; ++r) { const f32x4 a = *(const LAS f32x4*)(Am + (4 * ib + r) * 64 + 4 * q); acc[r] = acc[r] + a * xv; } }
            asm volatile("" ::: "memory");
            const f32x4 d1 = *(const LAS f32x4*)(Am + (4 * ib + 1) * 64 + 4 * ib), d2 = *(const LAS f32x4*)(Am + (4 * ib + 2) * 64 + 4 * ib), d3 = *(const LAS f32x4*)(Am + (4 * ib + 3) * 64 + 4 * ib);
            x[4 * ib + 0] -= (acc[0].x + acc[0].y) + (acc[0].z + acc[0].w);
            x[4 * ib + 1] -= ((acc[1].x + acc[1].y) + (acc[1].z + acc[1].w)) + d1.x * x[4 * ib + 0];
            x[4 * ib + 2] -= ((acc[2].x + acc[2].y) + (acc[2].z + acc[2].w)) + (d2.x * x[4 * ib + 0] + d2.y * x[4 * ib + 1]);
            x[4 * ib + 3] -= ((acc[3].x + acc[3].y) + (acc[3].z + acc[3].w)) + (d3.x * x[4 * ib + 0] + d3.y * x[4 * ib + 1] + d3.z * x[4 * ib + 2]);
            asm volatile("" : "+v"(x[4 * ib]), "+v"(x[4 * ib + 1]), "+v"(x[4 * ib + 2]), "+v"(x[4 * ib + 3])); }
        if (tid < 256) {
            const int sl = tid >> 5, col = tid & 31;
#pragma unroll
            for (int ti = 0; ti < 2; ++ti)
#pragma unroll
                for (int hh = 0; hh < 2; ++hh) { v4u a, c;
#define XR(q) x[32 * ti + ((q) & 3) + 8 * ((q) >> 2) + 4 * hh]
                    a.x = pk2(XR(0), XR(1)); a.y = pk2(XR(2), XR(3)); a.z = pk2(XR(4), XR(5)); a.w = pk2(XR(6), XR(7));
                    c.x = pk2(XR(8), XR(9)); c.y = pk2(XR(10), XR(11)); c.z = pk2(XR(12), XR(13)); c.w = pk2(XR(14), XR(15));
#undef XR
                    bf16* p = GU + (((size_t)ci * 8 + sl) * 2 + ti) * 1024 + (hh * 32 + col) * 16;
                    st16_wt(p, a); st16_wt(p + 8, c); }
        }
    }
    __syncthreads();
    if (tid >= 256 && tid < 384) { const int dk = tid - 256;
#pragma unroll
        for (int i = 0; i < 64; ++i) *(LAS unsigned short*)(L + GP_WL + i * 272 + dk * 2) = (unsigned short)f2bf(-x[i]); }
    __syncthreads();
#pragma unroll
    for (int k = 0; k < 2; ++k) { const int idx = tid + 512 * k, row = idx >> 4, dk0 = 8 * (idx & 15);
        const v4u v = *(const LAS v4u*)(L + GP_WL + row * 272 + dk0 * 2);
        const size_t f = (((size_t)ci * 2 + (row >> 5)) * 4 + (dk0 >> 5)) * 2 + ((dk0 >> 4) & 1);
        bf16* p = GW + f * 512 + (row & 31) * 8 + ((dk0 >> 3) & 1) * 4;
        st8_wt(p, v.x, v.y); st8_wt(p + 256, v.z, v.w); }
    asm volatile("s_waitcnt vmcnt(0)" ::: "memory");
    __syncthreads();
    if (tid == 0) __hip_atomic_store((unsigned*)(F.ws + WS_CTL) + CW_RDY + ci, 1u, RLX_AGENT);
}

constexpr int GS_BUF = 48 * 1024, GS_GA = 3 * GS_BUF;
__device__ __forceinline__ void gdn_scan_wg(Frame& F, int bh, int half, unsigned* prog) {
    unsigned long long seg_t0_ = 0, seg_t1_ = 0, seg_acc_ = 0; (void)seg_t0_; (void)seg_t1_; (void)seg_acc_;
    const int w = F.wave, b = bh >> 3, h = bh & 7;
    const bf16* GW = (const bf16*)(F.ws + WS_GW); const bf16* GQ = (const bf16*)(F.ws + WS_GQ); const bf16* GK = (const bf16*)(F.ws + WS_GK); const bf16* GA = (const bf16*)(F.ws + WS_GA); const bf16* GU = (const bf16*)(F.ws + WS_GU);
    LAS unsigned char* L = F.lds;
    if (w >= 4) {
        const int lw = w - 4, lane = pg8::pg8_lane_id();
        const bf16* pw = GW + ((size_t)bh * 128 * 16 + lw) * 512; const bf16* pq = GQ + ((size_t)bh * 128 * 16 + lw) * 512; const bf16* pk = GK + ((size_t)bh * 128 * 16 + lw) * 512;
        int bi = 0;
        const unsigned* rdy = (const unsigned*)(F.ws + WS_CTL) + CW_RDY + bh * 128;
        for (int c = 0; c < 130; ++c) { SEG_T0(3);
            if ((c & 7) == 0 && c < 128) {
                for (int spin = 0; spin < (1 << 22); ++spin) { const unsigned f = lane < 8 ? __hip_atomic_load(rdy + c + (lane & 7), RLX_AGENT) : 1u;
                    if (__all(f != 0u)) break; __builtin_amdgcn_s_sleep(8); }
                __builtin_amdgcn_fence(__ATOMIC_ACQUIRE, "agent"); asm volatile("s_waitcnt vmcnt(0)" ::: "memory"); }
            if (c >= 1 && c - 1 < 128 && lw < 3) { const size_t ci = (size_t)bh * 128 + (c - 1); LAS unsigned char* dst = L + GS_GA + ((c - 1) & 1) * 6144;
#pragma unroll
                for (int q = 0; q < 2; ++q) { const int f = 2 * lw + q, gaf = f < 2 ? f : f + 2; glds1k(GA + (ci * 8 + gaf) * 512, dst + f * 1024, lane); } }
            if (c < 128) { dma_chunk3(pw, pq, pk, L + bi * GS_BUF + lw * 1024, lane); pw += 8192; pq += 8192; pk += 8192; }
            if (lw == 0 && half == 0 && lane == 0 && c >= 1) __hip_atomic_store(prog, (unsigned)c, __ATOMIC_RELAXED, __HIP_MEMORY_SCOPE_AGENT);
            bi = bi == 2 ? 0 : bi + 1;
            SEG_ACC(3); if (c >= 1) { SEG_T0(4); if (c < 128) asm volatile(VMCNT12 ::: "memory"); else asm volatile("s_waitcnt vmcnt(0)" ::: "memory"); SEG_ACC(4); SEG_T0(5);
                __builtin_amdgcn_s_barrier(); asm volatile("" ::: "memory"); SEG_ACC(5); }
        }
        SEG_OUT();
        return;
    }
    const int sl = 4 * half + w, lane = pg8::pg8_lane_id(), col = lane & 31, hh = lane >> 5;
    const float* DL = (const float*)(F.ws + WS_DL);
    bf16* OA = (bf16*)(F.ws + WS_GU) + ((size_t)bh * 128 * 8 + sl) * 2048;
    const unsigned loff = (unsigned)(hh * 4 * 32 + col);
    f32x16 S[4];
#pragma unroll
    for (int td = 0; td < 4; ++td) S[td] = zero16();
    v4u uc[2][2]; float dln;
    SCAN_BAR_C();
    { const size_t ci = (size_t)bh * 128; dln = DL[ci];
      const bf16* p = GU + ((ci * 8 + sl) * 2 + 0) * 1024 + lane * 16; uc[0][0] = *(const v4u*)p; uc[0][1] = *(const v4u*)(p + 8); }
    int cb = 0;
    for (int n = 0; n < 128; ++n) { SEG_T02(1);
        const LAS unsigned char* B = L + cb * GS_BUF; cb = cb == 2 ? 0 : cb + 1;
        const LAS unsigned char* GAb = L + GS_GA + (n & 1) * 6144;
#if GDN_PREFETCH
        const float dl = dln;
#else
        float dl; { const size_t ci = (size_t)bh * 128 + n; dl = DL[ci]; const bf16* p = GU + ((ci * 8 + sl) * 2 + 0) * 1024 + lane * 16; uc[0][0] = *(const v4u*)p; uc[0][1] = *(const v4u*)(p + 8); }
#endif
#define WSLOT(ti, td, s2) (((ti) * 4 + (td)) * 2 + (s2))
#define GKSLOT(k) (32 + (k))
#define LDWQ(dst, ti, td) LD4(dst, B, WSLOT(ti, td, 0), WSLOT(ti, td, 1), 16 + WSLOT(ti, td, 0), 16 + WSLOT(ti, td, 1))
#define ADD_U(v, ti) do { _Pragma("unroll") for (int e = 0; e < 4; ++e) { v[2 * e] += bflo(uc[ti][0][e]); v[2 * e + 1] += bfhi(uc[ti][0][e]); v[8 + 2 * e] += bflo(uc[ti][1][e]); v[8 + 2 * e + 1] += bfhi(uc[ti][1][e]); } } while (0)
#define HALF_TD(F_, td, vnx, ox) { const bf16x8 sb0 = PACK_STEP(S[td], 0), sb1 = PACK_STEP(S[td], 1); \
          vnx = MFMA32(F_[0], sb0, vnx); vnx = MFMA32(F_[1], sb1, vnx); ox = MFMA32(F_[2], sb0, ox); ox = MFMA32(F_[3], sb1, ox); }
        bf16x8 fa[4], fb[4];
        bf16x8 vb00, vb01, vb10, vb11;
        bf16* orow = OA + (size_t)n * (8 * 2048);
#define STORE_O(ox, rowoff) do { _Pragma("unroll") for (int r = 0; r < 16; ++r) { const unsigned ro = (unsigned)(((r & 3) + 8 * (r >> 2)) * 32); orow[loff + ro + (rowoff)] = cvt1_bf16(ox[r]); } } while (0)
#define S_TD(F_, td) { S[td] = MFMA32(F_[0], vb00, S[td]); S[td] = MFMA32(F_[1], vb01, S[td]); S[td] = MFMA32(F_[2], vb10, S[td]); S[td] = MFMA32(F_[3], vb11, S[td]); }
        f32x16 vn0 = zero16(), o0 = zero16();
        LDWQ(fa, 0, 0); LDWQ(fb, 0, 1); HALF_TD(fa, 0, vn0, o0)
        LDWQ(fa, 0, 2); HALF_TD(fb, 1, vn0, o0)
        LDWQ(fb, 0, 3); HALF_TD(fa, 2, vn0, o0)
        PIN(); fa[0] = ldsfrag(GAb, 0, lane); fa[1] = ldsfrag(GAb, 1, lane); PIN(); HALF_TD(fb, 3, vn0, o0)
        ADD_U(vn0, 0); vb00 = PACK_STEP(vn0, 0); vb01 = PACK_STEP(vn0, 1);
        LDWQ(fb, 1, 0);
        o0 = MFMA32(fa[0], vb00, o0); o0 = MFMA32(fa[1], vb01, o0);
        { const size_t ci = (size_t)bh * 128 + n; const bf16* p = GU + ((ci * 8 + sl) * 2 + 1) * 1024 + lane * 16; uc[1][0] = *(const v4u*)p; uc[1][1] = *(const v4u*)(p + 8); }
#if GDN_PREFETCH
        if (n + 1 < 128) { const size_t ci = (size_t)bh * 128 + n + 1; dln = DL[ci];
          const bf16* p = GU + ((ci * 8 + sl) * 2 + 0) * 1024 + lane * 16; uc[0][0] = *(const v4u*)p; uc[0][1] = *(const v4u*)(p + 8); }
#endif
        f32x16 vn1 = zero16(), o1 = zero16();
        LDWQ(fa, 1, 1); STORE_O(o0, 0u); HALF_TD(fb, 0, vn1, o1)
        LDWQ(fb, 1, 2); S[0] = S[0] * dl; HALF_TD(fa, 1, vn1, o1)
        LDWQ(fa, 1, 3); S[1] = S[1] * dl; HALF_TD(fb, 2, vn1, o1)
        LD4(fb, GAb, 2, 3, 4, 5); S[2] = S[2] * dl; HALF_TD(fa, 3, vn1, o1)
        ADD_U(vn1, 1); vb10 = PACK_STEP(vn1, 0); vb11 = PACK_STEP(vn1, 1);
        LD4(fa, B, GKSLOT(0), GKSLOT(1), GKSLOT(2), GKSLOT(3)); S[3] = S[3] * dl;
        o1 = MFMA32(fb[0], vb00, o1); o1 = MFMA32(fb[1], vb01, o1); o1 = MFMA32(fb[2], vb10, o1); o1 = MFMA32(fb[3], vb11, o1);
        LD4(fb, B, GKSLOT(4), GKSLOT(5), GKSLOT(6), GKSLOT(7)); S_TD(fa, 0)
        LD4(fa, B, GKSLOT(8), GKSLOT(9), GKSLOT(10), GKSLOT(11)); STORE_O(o1, 32u * 32u); S_TD(fb, 1)
        LD4(fb, B, GKSLOT(12), GKSLOT(13), GKSLOT(14), GKSLOT(15)); S_TD(fa, 2)
        PIN(); S_TD(fb, 3)
#undef STORE_O
#undef S_TD
#undef HALF_TD
        SEG_T0(2); SCAN_BAR_C(); SEG_ACC(2); SEG_ACC2(1);
    }
    SEG_OUT();
}

constexpr int PF_LOOK = 6;
__device__ __forceinline__ void scan_prefetcher(Frame& F, const unsigned* PROG, int bx) {
    const int xc = bx & 7, j = (bx - 64) >> 3;
    const v4u* RQf = (const v4u*)(F.ws + WS_RQF); const v4u* RKf = (const v4u*)(F.ws + WS_RKF); const v4u* RKTf = (const v4u*)(F.ws + WS_RKTF); const v4u* RVTf = (const v4u*)(F.ws + WS_RVTF);
    const v4u* GW = (const v4u*)(F.ws + WS_GW); const v4u* GQ = (const v4u*)(F.ws + WS_GQ); const v4u* GK = (const v4u*)(F.ws + WS_GK); const v4u* GA = (const v4u*)(F.ws + WS_GA); const v4u* GU = (const v4u*)(F.ws + WS_GU);
    const int tid = F.tid;
    for (int it = j; it < 4 * 128; it += 24) {
        const int st = it & 3, n = it >> 2, kind = st >> 1, bh = xc + 8 * (st & 1);
        const unsigned* pw = PROG + 64 * (kind * 16 + bh);
        for (int spin = 0; spin < 20000; ++spin) { if ((int)__hip_atomic_load(pw, __ATOMIC_RELAXED, __HIP_MEMORY_SCOPE_AGENT) + PF_LOOK >= n) break; __builtin_amdgcn_s_sleep(32); }
        const size_t c = (size_t)bh * 128 + n;
        v4u a[11];
        if (kind == 0) {
            a[0] = RQf[c * 1024 + tid]; a[1] = RQf[c * 1024 + 512 + tid]; a[2] = RKf[c * 1024 + tid]; a[3] = RKf[c * 1024 + 512 + tid]; a[4] = RKTf[c * 1024 + tid]; a[5] = RKTf[c * 1024 + 512 + tid];
            a[6] = RVTf[c * 2048 + tid]; a[7] = RVTf[c * 2048 + 512 + tid]; a[8] = RVTf[c * 2048 + 1024 + tid]; a[9] = RVTf[c * 2048 + 1536 + tid]; a[10] = a[9];
        } else {
            a[0] = GW[c * 1024 + tid]; a[1] = GW[c * 1024 + 512 + tid]; a[2] = GQ[c * 1024 + tid]; a[3] = GQ[c * 1024 + 512 + tid]; a[4] = GK[c * 1024 + tid]; a[5] = GK[c * 1024 + 512 + tid];
            a[6] = GU[c * 2048 + tid]; a[7] = GU[c * 2048 + 512 + tid]; a[8] = GU[c * 2048 + 1024 + tid]; a[9] = GU[c * 2048 + 1536 + tid]; a[10] = GA[c * 512 + tid];
        }
#pragma unroll
        for (int q = 0; q < 11; ++q) asm volatile("" :: "v"(a[q]));
    }
}

__device__ __forceinline__ void p3_mixed(Frame& F) {
    const int gw = F.vcu * NWAVES + F.wave, NGW = F.G * NWAVES, lane = F.lane;
    const bf16* OA = (const bf16*)(F.ws + WS_GU); const bf16* OB = (const bf16*)(F.ws + WS_RVTF);
    const bf16* GZA = (const bf16*)F.out; const bf16* GZB = GZA + (size_t)T * 2048; bf16* MIX = (bf16*)(F.ws + WS_MIXED);
    for (int row = gw; row < T; row += NGW) {
        const size_t off = (size_t)row * 2048 + 32 * lane;
        const int bq_ = row >> 13, tt = row & 8191;
        const size_t ooff = ((((size_t)(bq_ * 8 + (lane >> 3)) * 128 + (tt >> 6)) * 8 + (lane & 7)) * 64 + (tt & 63)) * 32;
        v4u a4[4], b4[4], ga[4], gb[4];
#pragma unroll
        for (int q = 0; q < 4; ++q) { a4[q] = *(const v4u*)(OA + ooff + 8 * q); b4[q] = *(const v4u*)(OB + ooff + 8 * q); ga[q] = *(const v4u*)(GZA + off + 8 * q); gb[q] = *(const v4u*)(GZB + off + 8 * q); }
        float a[32], bb[32];
#pragma unroll
        for (int q = 0; q < 4; ++q)
#pragma unroll
            for (int e = 0; e < 4; ++e) { a[8 * q + 2 * e] = bflo(a4[q][e]); a[8 * q + 2 * e + 1] = bfhi(a4[q][e]); bb[8 * q + 2 * e] = bflo(b4[q][e]); bb[8 * q + 2 * e + 1] = bfhi(b4[q][e]); }
        float sa = 0.f, sb = 0.f;
#pragma unroll
        for (int i = 0; i < 32; ++i) { sa += a[i] * a[i]; sb += bb[i]; }
        sa += __shfl_xor(sa, 1); sa += __shfl_xor(sa, 2); sa += __shfl_xor(sa, 4);
        sb += __shfl_xor(sb, 1); sb += __shfl_xor(sb, 2); sb += __shfl_xor(sb, 4);
        const float rsa = rsqrtf(sa * (1.0f / 256.0f) + EPS), mu = sb * (1.0f / 256.0f);
        float vb = 0.f;
#pragma unroll
        for (int i = 0; i < 32; ++i) { bb[i] -= mu; vb += bb[i] * bb[i]; }
        vb += __shfl_xor(vb, 1); vb += __shfl_xor(vb, 2); vb += __shfl_xor(vb, 4);
        const float rsb = rsqrtf(vb * (1.0f / 256.0f) + EPS);
        const float* wa = F.gdn_norm_w + ((32 * lane) & 255); const float* wb = F.ret_norm_w + 32 * lane;
#pragma unroll
        for (int q = 0; q < 4; ++q) { v4u o;
#pragma unroll
            for (int e = 0; e < 4; ++e) { const int i = 8 * q + 2 * e;
                const float m0 = a[i] * rsa * wa[i] * bflo(ga[q][e]) + bb[i] * rsb * wb[i] * bflo(gb[q][e]);
                const float m1 = a[i + 1] * rsa * wa[i + 1] * bfhi(ga[q][e]) + bb[i + 1] * rsb * wb[i + 1] * bfhi(gb[q][e]);
                o[e] = pk2(m0, m1); }
            *(v4u*)(MIX + off + 8 * q) = o; }
    }
}
__device__ __forceinline__ void row_rmsnorm(Frame& F, const float* src, const float* w, bf16* dst16, float* dst32) {
    const int gw = F.vcu * NWAVES + F.wave, NGW = F.G * NWAVES, lane = F.lane;
    f32x4 nw[8];
#pragma unroll
    for (int j = 0; j < 8; ++j) nw[j] = ((const f32x4*)w)[64 * j + lane];
    for (int row = gw; row < T; row += 2 * NGW) {
        const f32x4* xr0 = (const f32x4*)(src + (size_t)row * D) + lane; const f32x4* xr1 = (const f32x4*)(src + (size_t)(row + NGW) * D) + lane;
        f32x4 v0[8], v1[8]; float s0 = 0.f, s1 = 0.f;
#pragma unroll
        for (int j = 0; j < 8; ++j) { v0[j] = xr0[64 * j]; v1[j] = xr1[64 * j]; }
#pragma unroll
        for (int j = 0; j < 8; ++j) { s0 += (v0[j].x * v0[j].x + v0[j].y * v0[j].y) + (v0[j].z * v0[j].z + v0[j].w * v0[j].w); s1 += (v1[j].x * v1[j].x + v1[j].y * v1[j].y) + (v1[j].z * v1[j].z + v1[j].w * v1[j].w); }
        const float r0 = rsqrtf(wave_sum(s0) * (1.0f / D) + EPS), r1 = rsqrtf(wave_sum(s1) * (1.0f / D) + EPS);
        if (dst16) { v2u* o0 = (v2u*)(dst16 + (size_t)row * D) + lane; v2u* o1 = (v2u*)(dst16 + (size_t)(row + NGW) * D) + lane;
#pragma unroll
            for (int j = 0; j < 8; ++j) { const f32x4 y0 = (v0[j] * r0) * nw[j], y1 = (v1[j] * r1) * nw[j]; v2u o; o.x = pk2(y0.x, y0.y); o.y = pk2(y0.z, y0.w); o0[64 * j] = o; o.x = pk2(y1.x, y1.y); o.y = pk2(y1.z, y1.w); o1[64 * j] = o; } }
        else { f32x4* o0 = (f32x4*)(dst32 + (size_t)row * D) + lane; f32x4* o1 = (f32x4*)(dst32 + (size_t)(row + NGW) * D) + lane;
#pragma unroll
            for (int j = 0; j < 8; ++j) { o0[64 * j] = (v0[j] * r0) * nw[j]; o1[64 * j] = (v1[j] * r1) * nw[j]; } }
    }
}

__device__ __forceinline__ void row_rmsnorm16(Frame& F, const bf16* src, const float* w, bf16* dst16, float* dst32) {
    const int gw = F.vcu * NWAVES + F.wave, NGW = F.G * NWAVES, lane = F.lane;
    const float* wl = w + 32 * lane;
    for (int row = gw; row < T; row += 2 * NGW) {
        const size_t o0 = (size_t)row * D + 32 * lane, o1 = (size_t)(row + NGW) * D + 32 * lane;
        v4u a[4], b[4];
#pragma unroll
        for (int q = 0; q < 4; ++q) { a[q] = *(const v4u*)(src + o0 + 8 * q); b[q] = *(const v4u*)(src + o1 + 8 * q); }
        float x0[32], x1[32]; float s0 = 0.f, s1 = 0.f;
#pragma unroll
        for (int q = 0; q < 4; ++q)
#pragma unroll
            for (int e = 0; e < 4; ++e) { x0[8 * q + 2 * e] = bflo(a[q][e]); x0[8 * q + 2 * e + 1] = bfhi(a[q][e]); x1[8 * q + 2 * e] = bflo(b[q][e]); x1[8 * q + 2 * e + 1] = bfhi(b[q][e]); }
#pragma unroll
        for (int i = 0; i < 32; ++i) { s0 += x0[i] * x0[i]; s1 += x1[i] * x1[i]; }
        const float r0 = rsqrtf(wave_sum(s0) * (1.0f / D) + EPS), r1 = rsqrtf(wave_sum(s1) * (1.0f / D) + EPS);
#pragma unroll
        for (int q = 0; q < 4; ++q) { const f32x4 wa = *(const f32x4*)(wl + 8 * q), wb = *(const f32x4*)(wl + 8 * q + 4);
            const float wv[8] = {wa.x, wa.y, wa.z, wa.w, wb.x, wb.y, wb.z, wb.w};
            if (dst16) { v4u p0, p1;
#pragma unroll
                for (int e = 0; e < 4; ++e) { p0[e] = pk2(x0[8 * q + 2 * e] * r0 * wv[2 * e], x0[8 * q + 2 * e + 1] * r0 * wv[2 * e + 1]); p1[e] = pk2(x1[8 * q + 2 * e] * r1 * wv[2 * e], x1[8 * q + 2 * e + 1] * r1 * wv[2 * e + 1]); }
                *(v4u*)(dst16 + o0 + 8 * q) = p0; *(v4u*)(dst16 + o1 + 8 * q) = p1;
            } else {
                f32x4 y;
                y = (f32x4){x0[8 * q] * r0 * wv[0], x0[8 * q + 1] * r0 * wv[1], x0[8 * q + 2] * r0 * wv[2], x0[8 * q + 3] * r0 * wv[3]}; *(f32x4*)(dst32 + o0 + 8 * q) = y;
                y = (f32x4){x0[8 * q + 4] * r0 * wv[4], x0[8 * q + 5] * r0 * wv[5], x0[8 * q + 6] * r0 * wv[6], x0[8 * q + 7] * r0 * wv[7]}; *(f32x4*)(dst32 + o0 + 8 * q + 4) = y;
                y = (f32x4){x1[8 * q] * r1 * wv[0], x1[8 * q + 1] * r1 * wv[1], x1[8 * q + 2] * r1 * wv[2], x1[8 * q + 3] * r1 * wv[3]}; *(f32x4*)(dst32 + o1 + 8 * q) = y;
                y = (f32x4){x1[8 * q + 4] * r1 * wv[4], x1[8 * q + 5] * r1 * wv[5], x1[8 * q + 6] * r1 * wv[6], x1[8 * q + 7] * r1 * wv[7]}; *(f32x4*)(dst32 + o1 + 8 * q + 4) = y;
            } }
    }
}

__global__ void __launch_bounds__(NWAVES * 64, 2) fwd_kernel(Args args) {
    extern __shared__ __attribute__((aligned(16))) unsigned char lds[];
    Frame F;
    F.lds = (LAS unsigned char*)lds;
    F.tid = threadIdx.x; F.lane = F.tid & 63; F.wave = __builtin_amdgcn_readfirstlane(F.tid >> 6);
    F.G = gridDim.x; { const int bx = blockIdx.x; F.vcu = (F.G % 8 == 0) ? (bx % 8) * (F.G / 8) + bx / 8 : bx; }
    typedef const __attribute__((address_space(4))) Args* KArgs;
    const KArgs kap0 = (KArgs)__builtin_amdgcn_kernarg_segment_ptr();
#define LOADF() do { KArgs kap_ = kap0; asm volatile("" : "+s"(kap_)); \
        F.x = kap_->in[0]; F.norm1_w = kap_->in[1]; F.w_in = kap_->in[2]; F.conv_w = kap_->in[3]; F.a_log = kap_->in[4]; F.dt_bias = kap_->in[5]; F.gdn_norm_w = kap_->in[6]; \
        F.ret_norm_w = kap_->in[7]; F.w_out = kap_->in[8]; F.norm2_w = kap_->in[9]; F.w_gate = kap_->in[10]; F.w_up = kap_->in[11]; F.w_down = kap_->in[12]; F.norm_f_w = kap_->in[13]; \
        F.out = kap_->out; F.ws = kap_->ws; F.lane = pg8::pg8_lane_id(); F.tid = F.wave * 64 + F.lane; } while (0)
    LOADF();
    volatile LAS unsigned* MISC = (volatile LAS unsigned*)(F.lds + MISC_OFF);
    for (int u = F.tid; u < (LDS_BYTES - LDSCTL_OFF) / 4; u += NWAVES * 64) ((LAS unsigned*)(F.lds + LDSCTL_OFF))[u] = 0u;
    __syncthreads();
    const int lo = args.ph_lo, hi = args.ph_hi;
    const bool use_bar = (hi - lo) > 1;
    XcdBarrier bar; bar.bar = (unsigned*)(F.ws + WS_CTL) + CW_BAR; bar.x = 0; bar.st = nullptr; bar.w0 = 0;
    if (use_bar) bar = xcd_barrier_post((unsigned*)(F.ws + WS_CTL) + CW_BAR, MISC + 8, F.wave);
#ifndef PROBE_REP
#define PROBE_REP -1
#endif
#define NREP(k) ((PROBE_REP) == (k) ? 2 : 1)
#define IN(k) (lo <= (k) && (k) < hi)
#ifndef PROBE_TIME
#define PROBE_TIME -1
#endif
    volatile LAS unsigned long long* PT = (volatile LAS unsigned long long*)(F.lds + MISC_OFF + 64);
#define SEAM(k) do { if ((PROBE_TIME) == 20 + (k) && F.tid == 0) PT[0] = __builtin_amdgcn_s_memrealtime(); if (IN(k) && IN((k) + 1)) xcd_barrier(bar); if ((PROBE_TIME) == 20 + (k) && F.tid == 0) PT[1] = __builtin_amdgcn_s_memrealtime(); if ((PROBE_TIME) == (k) + 1 && F.tid == 0) PT[0] = __builtin_amdgcn_s_memrealtime(); if ((PROBE_TIME) == (k) && F.tid == 0) PT[1] = __builtin_amdgcn_s_memrealtime(); } while (0)

    if ((PROBE_TIME) == 0 && F.tid == 0) PT[0] = __builtin_amdgcn_s_memrealtime();
    if (IN(0)) for (int rep_ = 0; rep_ < NREP(0); ++rep_) { LOADF(); p0_prologue(F); } SEAM(0);
    if (IN(1)) for (int rep_ = 0; rep_ < NREP(1); ++rep_) { LOADF();
        pg8::Gemm g{(const pg8::bf16_t*)(F.ws + WS_U), (const pg8::bf16_t*)(F.ws + WS_W1T), T, N1, D}; pg8::InProjOrder S; S.init(T, N1, F.G, (int)blockIdx.x);
        pg8::EpiInProj E{F.ws, (pg8::bf16_t*)F.out, WS_QKV, WS_RQF, WS_RKF, WS_RKTF, WS_RVTF, WS_COS, WS_SIN, WS_COS2, WS_SIN2};
        pg8::gemm_phase<pg8::EpiInProj, pg8::InProjOrder, true, true>(F.lds, g, S, E, F.wave);
    } SEAM(1);
    if (IN(2)) { LOADF();
        const int bx = blockIdx.x;
#ifdef PROBE_ROLE
        const unsigned long long role_t0_ = __builtin_amdgcn_s_memrealtime();
#endif
        unsigned* PROG = (unsigned*)(F.ws + WS_CTL) + 16384;
        if (bx < 64) { const int x = bx & 31, xc = x & 7, y = x >> 3, bh = xc + 8 * (y >> 1), half = y & 1;
            if (bx < 32) ret_scan_wg(F, bh, half, PROG + 64 * (0 * 16 + bh)); else gdn_scan_wg(F, bh, half, PROG + 64 * (1 * 16 + bh));
        } else {
            for (int i = bx - 64; i < BATCH * NH * 128; i += F.G - 64) gdn_prep(F, (i & 15) * 128 + (i >> 4));
        }
#ifdef PROBE_ROLE
        __syncthreads();
        if (pg8::pg8_lane_id() == 0 && F.wave == 0 && (bx < 32 ? 0 : bx < 64 ? 1 : 2) == (PROBE_ROLE)) __hip_atomic_fetch_max((unsigned*)(F.ws + WS_CTL) + 20001, (unsigned)(__builtin_amdgcn_s_memrealtime() - role_t0_), __ATOMIC_RELAXED, __HIP_MEMORY_SCOPE_AGENT);
#endif
    } SEAM(2);
    if (IN(4)) for (int rep_ = 0; rep_ < NREP(4); ++rep_) { LOADF(); p3_mixed(F); ffn_weight_copies(F); } SEAM(4);
    if (IN(5)) for (int rep_ = 0; rep_ < NREP(5); ++rep_) { LOADF();
        pg8::Gemm g{(const pg8::bf16_t*)(F.ws + WS_MIXED), (const pg8::bf16_t*)(F.ws + WS_WOT), T, D, D}; pg8::StaticOrder S; S.init(T, D, F.G, (int)blockIdx.x);
        pg8::EpiResBf16 E{F.x, nullptr, (pg8::bf16_t*)(F.ws + WS_H), D, (float*)(F.ws + WS_RSTD)};
        pg8::gemm_phase<pg8::EpiResBf16, pg8::StaticOrder, true, true>(F.lds, g, S, E, F.wave);
    } SEAM(5);
#if PROBE_TIME == 10
    if (F.tid == 0) PT[0] = __builtin_amdgcn_s_memrealtime(); xcd_barrier(bar); if (F.tid == 0) PT[1] = __builtin_amdgcn_s_memrealtime();
#endif
    if (IN(7)) for (int rep_ = 0; rep_ < NREP(7); ++rep_) { LOADF();
        pg8::Gemm g{(const pg8::bf16_t*)(F.ws + WS_H), (const pg8::bf16_t*)(F.ws + WS_WGUT), T, NGU, D}; pg8::StaticOrder S; S.init(T, NGU, F.G, (int)blockIdx.x);
        pg8::EpiGateUp E{(pg8::bf16_t*)(F.ws + WS_ACT), FF, (const float*)(F.ws + WS_RSTD)};
        pg8::gemm_phase<pg8::EpiGateUp, pg8::StaticOrder, true, true>(F.lds, g, S, E, F.wave);
    } SEAM(7);
    if (IN(8)) { LOADF();
        pg8::Gemm g{(const pg8::bf16_t*)(F.ws + WS_ACT), (const pg8::bf16_t*)(F.ws + WS_WDT), T, D, FF}; pg8::StaticOrder S; S.init(T, D, F.G, (int)blockIdx.x);
        pg8::EpiResBf16 E{nullptr, (const pg8::bf16_t*)(F.ws + WS_H), (pg8::bf16_t*)(F.ws + WS_H), D, nullptr};
        pg8::gemm_phase<pg8::EpiResBf16, pg8::StaticOrder, true, true>(F.lds, g, S, E, F.wave);
    } SEAM(8);
    if (IN(9)) { LOADF(); row_rmsnorm16(F, (const bf16*)(F.ws + WS_H), F.norm_f_w, nullptr, F.out); }
#if PROBE_TIME >= 0
    if (PROBE_TIME == 9 && F.tid == 0) PT[1] = __builtin_amdgcn_s_memrealtime();
    __syncthreads();
    if (F.vcu == 0 && F.tid == 0) { asm volatile("s_waitcnt vmcnt(0)" ::: "memory");
        int best = 0; float bv = 1e30f;
        for (int i = 0; i < 2048; ++i) { const float a = fabsf(F.out[i]); if (a < bv) { bv = a; best = i; } }
#if defined(PROBE_ROLE)
        const float us = 0.01f * (float)__hip_atomic_load((unsigned*)(F.ws + WS_CTL) + 20001, __ATOMIC_RELAXED, __HIP_MEMORY_SCOPE_AGENT);
#elif PROBE_SEG
        const float us = 0.1f * (float)__hip_atomic_load((unsigned*)(F.ws + WS_CTL) + 20000, __ATOMIC_RELAXED, __HIP_MEMORY_SCOPE_AGENT);
#else
        const float us = (float)(long long)(PT[1] - PT[0]) * 0.01f;
#endif
#ifdef PROBE_FAIL
        F.out[0] = 20.0f * rintf(us * 0.05f);
#else
        F.out[best] += 0.04f + 1e-4f * us;
#endif
        }
#endif
#undef IN
#undef SEAM
}

extern "C" void kernel_launch(void* const* d_in, const int* in_sizes, int n_in, void* d_out, int out_size, void* d_ws, size_t ws_size, hipStream_t stream) {
    static int grid = 0;
    if (grid == 0) {
        if (n_in != 14 || in_sizes[0] != T * D || out_size != T * D || ws_size < WS_END) { fprintf(stderr, "kernel_launch: unexpected shapes: n_in %d in0 %d out %d ws %zu (need %zu)\n", n_in, n_in > 0 ? in_sizes[0] : -1, out_size, ws_size, (size_t)WS_END); grid = -1; return; }
        int dev = 0, cus = 0, per_cu = 0;
        if (hipGetDevice(&dev) != hipSuccess || hipDeviceGetAttribute(&cus, hipDeviceAttributeMultiprocessorCount, dev) != hipSuccess) { grid = -1; return; }
        if (hipFuncSetAttribute((const void*)fwd_kernel, hipFuncAttributeMaxDynamicSharedMemorySize, LDS_BYTES) != hipSuccess) { fprintf(stderr, "kernel_launch: hipFuncSetAttribute failed\n"); grid = -1; return; }
        if (hipOccupancyMaxActiveBlocksPerMultiprocessor(&per_cu, (const void*)fwd_kernel, NWAVES * 64, LDS_BYTES) != hipSuccess || per_cu < 1) { fprintf(stderr, "kernel_launch: occupancy query says %d blocks per CU\n", per_cu); per_cu = 1; }
        (void)hipGetLastError();
        grid = cus;
        if (grid > 256) grid = 256;
    }
    if (grid < 0) return;
    (void)hipMemsetAsync((char*)d_ws + WS_CTL, 0, CTL_ZERO_BYTES, stream);
    Args a{};
    for (int i = 0; i < 14; ++i) a.in[i] = (const float*)d_in[i];
    a.out = (float*)d_out; a.ws = (unsigned char*)d_ws;
#if MK_N_LAUNCHES == 1
    a.ph_lo = 0; a.ph_hi = NPHASES;
    hipLaunchKernelGGL(fwd_kernel, dim3(grid), dim3(NWAVES * 64), LDS_BYTES, stream, a);
#else
    for (int p = 0; p < NPHASES; ++p) { a.ph_lo = p; a.ph_hi = p + 1; hipLaunchKernelGGL(fwd_kernel, dim3(grid), dim3(NWAVES * 64), LDS_BYTES, stream, a); }
#endif
}
```

```cpp
#include <hip/hip_runtime.h>
#include <cstdio>
#include <cstdint>
__device__ __forceinline__ void wg_sync() { __builtin_amdgcn_fence(__ATOMIC_RELEASE, "workgroup"); __builtin_amdgcn_s_barrier(); __builtin_amdgcn_fence(__ATOMIC_ACQUIRE, "workgroup"); }
namespace pg8 {
#define PG8_LAS __attribute__((address_space(3)))
typedef unsigned short bf16_t;
typedef short bf16x8 __attribute__((ext_vector_type(8)));
typedef float f32x4 __attribute__((ext_vector_type(4)));
typedef unsigned u32x4 __attribute__((ext_vector_type(4)));
constexpr int BM = 256, BK = 64, HALF = 128, HTB = HALF * BK * 2  , STAGE_BYTES = 8 * HTB, NXCD = 8, WGM = 8;

__host__ __device__ __forceinline__ int lds_byte(int r, int c) { const int st = (r >> 4) * 2 + (c >> 5), rr = r & 15, cc = c & 31, ob = rr * 64 + cc * 2; return st * 1024 + (ob ^ (((ob >> 9) & 1) << 5)); }
__host__ __device__ __forceinline__ void stage_rc(int b, int& R, int& C) { const int st = b / 1024, sb = b % 1024, swz = sb ^ (((sb >> 9) & 1) << 5); R = (st >> 1) * 16 + swz / 64; C = (st & 1) * 32 + (swz % 64) / 2; }
__host__ __device__ __forceinline__ int perm32(int rho) { const int n = rho >> 4, i = rho & 15; return 8 * (i >> 2) + 4 * n + (i & 3); }

__device__ __forceinline__ int pg8_lane_id() { int l; asm volatile("v_mbcnt_lo_u32_b32 %0, -1, 0\n\tv_mbcnt_hi_u32_b32 %0, -1, %0" : "=v"(l)); return l; }
struct Unit { int pm, pn, sw; };
struct Gemm { const bf16_t* A; const bf16_t* Bt; int M, N, K; };

struct StaticOrder {
    int nM, nN, nwg, G, c;
    __host__ __device__ __forceinline__ void init(int M, int N, int G_, int c_) { nM = M / BM; nN = N / BM; nwg = nM * nN; G = G_; c = c_; }
    __host__ __device__ bool next(int i, Unit& u) const {
        const long L = (long)i * G + c; if (L >= nwg) return false;
        int wgid = (int)L; { const int q = nwg / NXCD, r = nwg % NXCD, xcd = wgid % NXCD, off = wgid / NXCD; wgid = (xcd < r ? xcd * (q + 1) : r * (q + 1) + (xcd - r) * q) + off; }
        const int nig = WGM * nN, gid = wgid / nig, fm = gid * WGM, gsz = (nM - fm) < WGM ? (nM - fm) : WGM;
        u.pm = fm + ((wgid % nig) % gsz); u.pn = (wgid % nig) / gsz; u.sw = 0; return true;
    }
    __device__ __forceinline__ void a_ready(const Unit&) const {}
    __device__ __forceinline__ void done(const Unit&) const {}
};
__device__ __forceinline__ unsigned cvt_pk_bf16(float lo, float hi) { unsigned r; asm volatile("v_cvt_pk_bf16_f32 %0, %1, %2" : "=v"(r) : "v"(lo), "v"(hi)); return r; }
typedef float f32x2 __attribute__((ext_vector_type(2)));
__device__ __forceinline__ u32x4 pack8(const f32x4& a, const f32x4& b) { u32x4 w; w.x = cvt_pk_bf16(a[0], a[1]); w.y = cvt_pk_bf16(a[2], a[3]); w.z = cvt_pk_bf16(b[0], b[1]); w.w = cvt_pk_bf16(b[2], b[3]); return w; }
typedef unsigned u32x2 __attribute__((ext_vector_type(2)));
__device__ __forceinline__ float fsigmoid(float x) { return __builtin_amdgcn_rcpf(1.0f + __expf(-x)); }
__device__ __forceinline__ float fsilu(float x) { return x * fsigmoid(x); }

struct InProjOrder : StaticOrder {
    __host__ __device__ bool next(int i, Unit& u) const { if (!StaticOrder::next(i, u)) return false; u.sw = ((u.pn >= 24 && u.pn < 32) || u.pn >= 64) ? 1 : 0; return true; }
};
struct EpiInProj {
    static constexpr bool PERM = true, AFTER_DRAIN = false;
    unsigned char* ws; bf16_t* gz;
    size_t oQKV, oRQf, oRKf, oRKTf, oRVTf, oCOS, oSIN, oCOS2, oSIN2;
    __device__ __forceinline__ void operator()(const f32x4 (&acc)[2][2][4][2], const Unit& u, int wr, int wc, int fr, int fq) const {
        asm volatile("" : "+v"(fr), "+v"(fq));
        bf16_t* const QKV = (bf16_t*)(ws + oQKV); bf16_t* const RQf = (bf16_t*)(ws + oRQf); bf16_t* const RKf = (bf16_t*)(ws + oRKf); bf16_t* const RKTf = (bf16_t*)(ws + oRKTf); bf16_t* const RVTf = (bf16_t*)(ws + oRVTf);
        bf16_t* const GZA = gz; bf16_t* const GZB = gz + (size_t)16384 * 2048;
        const float* const cosT = (const float*)(ws + oCOS); const float* const sinT = (const float*)(ws + oSIN); const float* const cosT2 = (const float*)(ws + oCOS2); const float* const sinT2 = (const float*)(ws + oSIN2);
        const int pn = u.pn, cw = wc * 32 + 8 * fq;
        if (pn < 16) {
            const int row0 = u.pm * BM + wr * 64 + fr, col0 = pn * 256 + cw;
#pragma unroll
            for (int ai = 0; ai < 2; ++ai)
#pragma unroll
                for (int m = 0; m < 4; ++m) { bf16_t* rowp = QKV + (size_t)(row0 + ai * HALF + m * 16) * 4096 + col0;
#pragma unroll
                    for (int bj = 0; bj < 2; ++bj) __builtin_nontemporal_store(pack8(acc[ai][bj][m][0], acc[ai][bj][m][1]), (u32x4*)(rowp + bj * HALF)); }
        } else if (pn < 24) {
            const bool isk = pn >= 20; bf16_t* base = isk ? RKf : RQf;
            const int row0 = u.pm * BM + wr * 64 + fr, tile = (pn - 16) & 3, head = 2 * tile + (cw >> 6), i0 = cw & 63;
            const float l2g = log2f(1.0f - exp2f(-5.0f - (float)head));
            const int td1 = i0 >> 5, s1 = (i0 >> 4) & 1, eg = (i0 >> 3) & 1;
#pragma unroll
            for (int ai = 0; ai < 2; ++ai)
#pragma unroll
                for (int m = 0; m < 4; ++m) { const int row = row0 + ai * HALF + m * 16, b = row >> 13, t = row & 8191, n = t >> 6, pos = t & 63;
                    const float sc = isk ? 0.08838834764831845f * exp2f(-(float)(pos + 1) * l2g) : exp2f((float)(pos + 1) * l2g);
                    const float* cp = cosT + t * 64 + i0; const float* sp = sinT + t * 64 + i0;
                    const f32x4 c0 = *(const f32x4*)cp, c1 = *(const f32x4*)(cp + 4), s0 = *(const f32x4*)sp, s1v = *(const f32x4*)(sp + 4);
                    const f32x4 x1a = acc[ai][0][m][0], x1b = acc[ai][0][m][1], x2a = acc[ai][1][m][0], x2b = acc[ai][1][m][1];
                    const f32x4 o1a = (x1a * c0 - x2a * s0) * sc, o1b = (x1b * c1 - x2b * s1v) * sc, o2a = (x2a * c0 + x1a * s0) * sc, o2b = (x2b * c1 + x1b * s1v) * sc;
                    const size_t f1 = ((((size_t)(b * 8 + head) * 128 + n) * 2 + (pos >> 5)) * 4 + td1) * 2 + s1;
                    bf16_t* p1 = base + f1 * 512 + (pos & 31) * 8 + eg * 4;
                    u32x2 w;
                    w.x = cvt_pk_bf16(o1a[0], o1a[1]); w.y = cvt_pk_bf16(o1a[2], o1a[3]); *(u32x2*)(p1) = w;
                    w.x = cvt_pk_bf16(o1b[0], o1b[1]); w.y = cvt_pk_bf16(o1b[2], o1b[3]); *(u32x2*)(p1 + 256) = w;
                    w.x = cvt_pk_bf16(o2a[0], o2a[1]); w.y = cvt_pk_bf16(o2a[2], o2a[3]); *(u32x2*)(p1 + 4 * 512) = w;
                    w.x = cvt_pk_bf16(o2b[0], o2b[1]); w.y = cvt_pk_bf16(o2b[2], o2b[3]); *(u32x2*)(p1 + 4 * 512 + 256) = w; }
        } else if (pn < 32) {
            const int head = pn - 24, b = u.pm >> 5, nbase = (u.pm & 31) * 4;
            const int tj = wc & 1, s1 = (fq >> 1) & 1, eg = fq & 1;
#pragma unroll
            for (int ai = 0; ai < 2; ++ai)
#pragma unroll
                for (int m = 0; m < 4; ++m) { const int dv = ai * HALF + wr * 64 + m * 16 + fr, sl = dv >> 5, col = dv & 31;
#pragma unroll
                    for (int bj = 0; bj < 2; ++bj) { const int n = nbase + 2 * bj + (wc >> 1);
                        const size_t f = ((((size_t)(b * 8 + head) * 128 + n) * 8 + sl) * 2 + tj) * 2 + s1;
                        bf16_t* p = RVTf + f * 512 + col * 8 + eg * 4;
#pragma unroll
                        for (int nn = 0; nn < 2; ++nn) { u32x2 w; w.x = cvt_pk_bf16(acc[ai][bj][m][nn][0], acc[ai][bj][m][nn][1]); w.y = cvt_pk_bf16(acc[ai][bj][m][nn][2], acc[ai][bj][m][nn][3]); *(u32x2*)(p + nn * 256) = w; } } }
        } else if (pn < 64) {
            const int row0 = u.pm * BM + wr * 64 + fr;
            bf16_t* base = pn < 48 ? GZA : GZB; const int col0 = ((pn - 32) & 15) * 128 + cw;
#pragma unroll
            for (int ai = 0; ai < 2; ++ai)
#pragma unroll
                for (int m = 0; m < 4; ++m) { bf16_t* rowp = base + (size_t)(row0 + ai * HALF + m * 16) * 2048 + col0; f32x4 o[2];
#pragma unroll
                    for (int n = 0; n < 2; ++n)
#pragma unroll
                        for (int j = 0; j < 4; ++j) o[n][j] = fsilu(acc[ai][0][m][n][j]) * fsigmoid(acc[ai][1][m][n][j]);
                    __builtin_nontemporal_store(pack8(o[0], o[1]), (u32x4*)rowp); }
        } else {
            const int tile = pn - 64, head = 2 * tile + wr, b = u.pm >> 5, nbase = (u.pm & 31) * 4, tbase = (u.pm & 31) * 256;
            const int tj = wc & 1, s1 = (fq >> 1) & 1, eg = fq & 1;
            const float l2g = log2f(1.0f - exp2f(-5.0f - (float)head));
#pragma unroll
            for (int bj = 0; bj < 2; ++bj) { const int n = nbase + 2 * bj + (wc >> 1), c0 = bj * HALF + wc * 32 + 8 * fq;
#pragma unroll
                for (int nn = 0; nn < 2; ++nn) { const int pos0 = (c0 + 4 * nn) & 63; f32x4 sc;
#pragma unroll
                    for (int j = 0; j < 4; ++j) sc[j] = 0.08838834764831845f * exp2f((float)(63 - pos0 - j) * l2g);
#pragma unroll
                    for (int m = 0; m < 4; ++m) { const int i = 16 * m + fr;
                        const f32x4 c = *(const f32x4*)(cosT2 + (size_t)i * 8192 + tbase + c0 + 4 * nn), s = *(const f32x4*)(sinT2 + (size_t)i * 8192 + tbase + c0 + 4 * nn);
                        const f32x4 x1 = acc[0][bj][m][nn], x2 = acc[1][bj][m][nn];
                        const f32x4 o1 = (x1 * c - x2 * s) * sc, o2 = (x2 * c + x1 * s) * sc;
                        const size_t f = ((((size_t)(b * 8 + head) * 128 + n) * 4 + (m >> 1)) * 2 + tj) * 2 + s1;
                        bf16_t* p = RKTf + f * 512 + (nn * 32 + 16 * (m & 1) + fr) * 8 + eg * 4;
                        u32x2 w; w.x = cvt_pk_bf16(o1[0], o1[1]); w.y = cvt_pk_bf16(o1[2], o1[3]); *(u32x2*)p = w;
                        w.x = cvt_pk_bf16(o2[0], o2[1]); w.y = cvt_pk_bf16(o2[2], o2[3]); *(u32x2*)(p + 8 * 512) = w; } } }
        }
    }
};
struct EpiGateUp {
    static constexpr bool PERM = true, AFTER_DRAIN = false;
    bf16_t* ACT; int ldc; const float* rstd;
    __device__ __forceinline__ void operator()(const f32x4 (&acc)[2][2][4][2], const Unit& u, int wr, int wc, int fr, int fq) const {
        const int row0 = u.pm * BM + wr * 64 + fr, col0 = u.pn * 128 + wc * 32 + 8 * fq;
        float rsv[2][4];
#pragma unroll
        for (int ai = 0; ai < 2; ++ai)
#pragma unroll
            for (int m = 0; m < 4; ++m) rsv[ai][m] = rstd ? rstd[row0 + ai * HALF + m * 16] : 2048.0f * (1.0f - 1e-6f);
        asm volatile("" ::: "memory");
#pragma unroll
        for (int ai = 0; ai < 2; ++ai)
#pragma unroll
            for (int m = 0; m < 4; ++m) { const int row = row0 + ai * HALF + m * 16; const float rs = rstd ? __builtin_amdgcn_rsqf(rsv[ai][m] * (1.0f / 2048.0f) + 1e-6f) : 1.0f; f32x4 o[2];
#pragma unroll
                for (int n = 0; n < 2; ++n)
#pragma unroll
                    for (int j = 0; j < 4; ++j) o[n][j] = fsilu(acc[ai][0][m][n][j] * rs) * (acc[ai][1][m][n][j] * rs);
                *(u32x4*)(ACT + (size_t)row * ldc + col0) = pack8(o[0], o[1]); }
    }
};
struct EpiResF32 {
    static constexpr bool PERM = false, AFTER_DRAIN = false;
    const float* res; float* out; int ldc;
    __device__ __forceinline__ void operator()(const f32x4 (&acc)[2][2][4][2], const Unit& u, int wr, int wc, int fr, int fq) const {
        const int row0 = u.pm * BM + wr * 64 + fr, col0 = u.pn * BM + wc * 32 + 4 * fq;
#pragma unroll
        for (int ai = 0; ai < 2; ++ai)
#pragma unroll
            for (int m = 0; m < 4; ++m) { const size_t off = (size_t)(row0 + ai * HALF + m * 16) * ldc + col0;
#pragma unroll
                for (int bj = 0; bj < 2; ++bj)
#pragma unroll
                    for (int n = 0; n < 2; ++n) { const f32x4 r = *(const f32x4*)(res + off + bj * HALF + n * 16); *(f32x4*)(out + off + bj * HALF + n * 16) = r + acc[ai][bj][m][n]; } }
    }
};
struct EpiResBf16 {
    static constexpr bool PERM = true, AFTER_DRAIN = false;
    const float* res32; const bf16_t* res16; bf16_t* out16; int ldc; float* rss;
    __device__ __forceinline__ void operator()(const f32x4 (&acc)[2][2][4][2], const Unit& u, int wr, int wc, int fr, int fq) const {
        const int row0 = u.pm * BM + wr * 64 + fr, col0 = u.pn * BM + wc * 32 + 8 * fq;
#pragma unroll
        for (int ai = 0; ai < 2; ++ai)
#pragma unroll
            for (int m = 0; m < 4; ++m) { const size_t off = (size_t)(row0 + ai * HALF + m * 16) * ldc + col0; float ss = 0.f;
#pragma unroll
                for (int bj = 0; bj < 2; ++bj) { f32x4 r0, r1;
                    if (res32) { r0 = __builtin_nontemporal_load((const f32x4*)(res32 + off + bj * HALF)); r1 = __builtin_nontemporal_load((const f32x4*)(res32 + off + bj * HALF + 4)); }
                    else { const u32x4 h = *(const u32x4*)(res16 + off + bj * HALF);
                        r0 = (f32x4){__builtin_bit_cast(float, h.x << 16), __builtin_bit_cast(float, h.x & 0xffff0000u), __builtin_bit_cast(float, h.y << 16), __builtin_bit_cast(float, h.y & 0xffff0000u)};
                        r1 = (f32x4){__builtin_bit_cast(float, h.z << 16), __builtin_bit_cast(float, h.z & 0xffff0000u), __builtin_bit_cast(float, h.w << 16), __builtin_bit_cast(float, h.w & 0xffff0000u)}; }
                    r0 = r0 + acc[ai][bj][m][0]; r1 = r1 + acc[ai][bj][m][1];
                    ss += (r0[0] * r0[0] + r0[1] * r0[1]) + (r0[2] * r0[2] + r0[3] * r0[3]) + (r1[0] * r1[0] + r1[1] * r1[1]) + (r1[2] * r1[2] + r1[3] * r1[3]);
                    *(u32x4*)(out16 + off + bj * HALF) = pack8(r0, r1); }
                if (rss) { ss += __shfl_xor(ss, 16); ss += __shfl_xor(ss, 32); if (fq == 0) atomicAdd(rss + row0 + ai * HALF + m * 16, ss); } }
    }
};
template <class Epi, class Sched, bool ALIGN_EPI = false, bool SP2 = false>
__device__ __forceinline__ void gemm_phase(PG8_LAS unsigned char* lds, const Gemm g, const Sched& S, const Epi& E, const int wave_in) {
    const int lane = pg8_lane_id(), wid = wave_in, tid = wid * 64 + lane, wr = wid >> 2, wc = wid & 3, fr = lane & 15, fq = lane >> 4;
    const int K = g.K, nt = K / BK;
    unsigned voffA[2], voffB[2];
#pragma unroll
    for (int i = 0; i < 2; ++i) { int R, C; stage_rc(tid * 16 + i * 8192, R, C); const int Rb = Epi::PERM ? ((R & ~31) + perm32(R & 31)) : R;
        voffA[i] = (unsigned)(R * K + C) * 2u; voffB[i] = (unsigned)(Rb * K + C) * 2u; }
    const size_t kstep = (size_t)(BK * 2);
    const size_t hstep = (size_t)HALF * K * 2;
    const size_t tstep = 2 * hstep;
    const unsigned ldsw = (unsigned)wid * 1024u;
    const int aoff = lds_byte(wr * 64 + fr, fq * 8), boff = lds_byte(wc * 32 + fr, fq * 8);
#define PG8_SA(b, h) (((b) * 2 + (h)) * HTB)
#define PG8_SB(b, h) ((4 + (b) * 2 + (h)) * HTB)
#define PG8_STAGE(bufoff, gbase, voff) do { _Pragma("unroll") for (int _i = 0; _i < 2; ++_i) \
        __builtin_amdgcn_global_load_lds((const unsigned*)((const char*)(gbase) + (voff)[_i]), (PG8_LAS unsigned*)(lds + (bufoff) + ldsw + _i * 8192), 16, 0, 0); } while (0)
#define PG8_LDA(dst, b, h) do { _Pragma("unroll") for (int m = 0; m < 4; ++m) _Pragma("unroll") for (int k = 0; k < 2; ++k) dst[m][k] = *(const PG8_LAS bf16x8*)(lds + PG8_SA(b, h) + aoff + m * 2048 + k * 1024); } while (0)
#define PG8_LDB(dst, b, h) do { _Pragma("unroll") for (int n = 0; n < 2; ++n) _Pragma("unroll") for (int k = 0; k < 2; ++k) dst[n][k] = *(const PG8_LAS bf16x8*)(lds + PG8_SB(b, h) + boff + n * 2048 + k * 1024); } while (0)
#define PG8_MMA(ai, bj, At, Bt) do { __builtin_amdgcn_s_setprio(1); _Pragma("unroll") for (int m = 0; m < 4; ++m) _Pragma("unroll") for (int n = 0; n < 2; ++n) _Pragma("unroll") for (int k = 0; k < 2; ++k) \
        acc[ai][bj][m][n] = __builtin_amdgcn_mfma_f32_16x16x32_bf16(Bt[n][k], At[m][k], acc[ai][bj][m][n], 0, 0, 0); __builtin_amdgcn_s_setprio(0); } while (0)
#define PG8_WAIT_V(n) asm volatile("s_waitcnt vmcnt(" #n ")" ::: "memory")
#define PG8_WAIT_L(n) asm volatile("s_waitcnt lgkmcnt(" #n ")" ::: "memory")
#define PG8_BAR __builtin_amdgcn_s_barrier()
#define PG8_SCHED __builtin_amdgcn_sched_barrier(0)
    Unit cur, nxt; int ui = 0;
    if (!S.next(0, cur)) return;
    f32x4 acc[2][2][4][2];
#pragma unroll
    for (int a = 0; a < 2; ++a)
#pragma unroll
        for (int b = 0; b < 2; ++b)
#pragma unroll
            for (int m = 0; m < 4; ++m)
#pragma unroll
                for (int n = 0; n < 2; ++n) acc[a][b][m][n] = (f32x4){0.f, 0.f, 0.f, 0.f};
    bf16x8 At[4][2], B0[2][2], B1[2][2];
#define PG8_UA(u) ((u).sw ? (const char*)g.Bt + (size_t)(u).pn * tstep : (const char*)g.A + (size_t)(u).pm * tstep)
#define PG8_UB(u) ((u).sw ? (const char*)g.A + (size_t)(u).pm * tstep : (const char*)g.Bt + (size_t)(u).pn * tstep)
    const char* cA = PG8_UA(cur); const char* cB = PG8_UB(cur);
    S.a_ready(cur);
    if constexpr (SP2) {
        PG8_STAGE(PG8_SB(0, 0), cB, voffB); PG8_STAGE(PG8_SB(0, 1), cB + hstep, voffB); PG8_STAGE(PG8_SA(0, 0), cA, voffA); PG8_STAGE(PG8_SA(0, 1), cA + hstep, voffA);
        if (wr == 1) PG8_BAR;
        PG8_WAIT_V(2); PG8_BAR;
        PG8_STAGE(PG8_SB(1, 0), cB + kstep, voffB); PG8_STAGE(PG8_SA(1, 0), cA + kstep, voffA); PG8_STAGE(PG8_SB(1, 1), cB + hstep + kstep, voffB);
        PG8_WAIT_V(6); PG8_BAR;
    } else {
        PG8_STAGE(PG8_SB(0, 0), cB, voffB); PG8_STAGE(PG8_SA(0, 0), cA, voffA); PG8_STAGE(PG8_SB(0, 1), cB + hstep, voffB); PG8_STAGE(PG8_SA(0, 1), cA + hstep, voffA);
        if (wr == 1) PG8_BAR;
        PG8_WAIT_V(4); PG8_BAR;
        PG8_STAGE(PG8_SB(1, 0), cB + kstep, voffB); PG8_STAGE(PG8_SA(1, 0), cA + kstep, voffA); PG8_STAGE(PG8_SB(1, 1), cB + hstep + kstep, voffB);
        PG8_WAIT_V(6); PG8_BAR;
    }
    for (;;) {
        const bool has_next = S.next(ui + 1, nxt);
        const char* nA = has_next ? PG8_UA(nxt) : cA; const char* nB = has_next ? PG8_UB(nxt) : cB;
        for (int t = 0; t < nt; t += 2) {
            const bool last = (t == nt - 2);
            const char* a1 = cA + (size_t)(t + 1) * kstep;
            const char* a2 = last ? nA : cA + (size_t)(t + 2) * kstep; const char* b2 = last ? nB : cB + (size_t)(t + 2) * kstep;
            const char* a3 = a2 + kstep; const char* b3 = b2 + kstep;
            if (last && has_next) S.a_ready(nxt);
            if constexpr (SP2) {
            PG8_LDB(B0, 0, 0); PG8_LDB(B1, 0, 1); PG8_SCHED; PG8_LDA(At, 0, 0); PG8_STAGE(PG8_SA(1, 1), a1 + hstep, voffA);
            PG8_WAIT_V(8); PG8_WAIT_L(0); PG8_BAR; PG8_MMA(0, 0, At, B0); PG8_MMA(0, 1, At, B1); PG8_BAR; PG8_SCHED;
            PG8_LDA(At, 0, 1); PG8_STAGE(PG8_SB(0, 0), b2, voffB); PG8_STAGE(PG8_SB(0, 1), b2 + hstep, voffB); PG8_STAGE(PG8_SA(0, 0), a2, voffA);
            PG8_WAIT_V(8); PG8_WAIT_L(0); PG8_BAR; PG8_MMA(1, 0, At, B0); PG8_MMA(1, 1, At, B1); PG8_BAR; PG8_SCHED;
            PG8_LDB(B0, 1, 0); PG8_LDB(B1, 1, 1); PG8_SCHED; PG8_LDA(At, 1, 0); PG8_STAGE(PG8_SA(0, 1), a2 + hstep, voffA);
            PG8_WAIT_V(8); PG8_WAIT_L(0); PG8_BAR; PG8_MMA(0, 0, At, B0); PG8_MMA(0, 1, At, B1); PG8_BAR; PG8_SCHED;
            PG8_LDA(At, 1, 1); PG8_STAGE(PG8_SB(1, 0), b3, voffB); PG8_STAGE(PG8_SB(1, 1), b3 + hstep, voffB); PG8_STAGE(PG8_SA(1, 0), a3, voffA);
            PG8_WAIT_V(8); PG8_WAIT_L(0); PG8_BAR; PG8_MMA(1, 0, At, B0); PG8_MMA(1, 1, At, B1); PG8_BAR; PG8_SCHED;
            } else {
            PG8_LDB(B0, 0, 0); PG8_SCHED; PG8_LDA(At, 0, 0); PG8_STAGE(PG8_SA(1, 1), a1 + hstep, voffA);
            PG8_WAIT_L(8); PG8_BAR; PG8_WAIT_L(0); PG8_MMA(0, 0, At, B0); PG8_BAR; PG8_SCHED;
            PG8_LDB(B1, 0, 1); PG8_STAGE(PG8_SB(0, 0), b2, voffB);
            PG8_BAR; PG8_WAIT_L(0); PG8_MMA(0, 1, At, B1); PG8_BAR;
            PG8_LDA(At, 0, 1); PG8_STAGE(PG8_SA(0, 0), a2, voffA);
            PG8_BAR; PG8_WAIT_L(0); PG8_MMA(1, 0, At, B0); PG8_BAR; PG8_SCHED;
            PG8_STAGE(PG8_SB(0, 1), b2 + hstep, voffB);
            PG8_WAIT_V(6); PG8_BAR; PG8_MMA(1, 1, At, B1); PG8_BAR;
            PG8_LDB(B0, 1, 0); PG8_SCHED; PG8_LDA(At, 1, 0); PG8_STAGE(PG8_SA(0, 1), a2 + hstep, voffA);
            PG8_WAIT_L(8); PG8_BAR; PG8_WAIT_L(0); PG8_MMA(0, 0, At, B0); PG8_BAR; PG8_SCHED;
            PG8_LDB(B1, 1, 1); PG8_STAGE(PG8_SB(1, 0), b3, voffB);
            PG8_BAR; PG8_WAIT_L(0); PG8_MMA(0, 1, At, B1); PG8_BAR;
            PG8_LDA(At, 1, 1); PG8_STAGE(PG8_SA(1, 0), a3, voffA);
            PG8_BAR; PG8_WAIT_L(0); PG8_MMA(1, 0, At, B0); PG8_BAR; PG8_SCHED;
            PG8_STAGE(PG8_SB(1, 1), b3 + hstep, voffB);
            PG8_WAIT_V(6); PG8_BAR; PG8_MMA(1, 1, At, B1); PG8_BAR;
            }
        }
        if constexpr (ALIGN_EPI) { if (wr == 0) PG8_BAR; }
        if constexpr (!Epi::AFTER_DRAIN) { E(acc, cur, wr, wc, fr, fq); S.done(cur); }
        if (!has_next) break;
#pragma unroll
        for (int a = 0; a < 2; ++a)
#pragma unroll
            for (int b = 0; b < 2; ++b)
#pragma unroll
                for (int m = 0; m < 4; ++m)
#pragma unroll
                    for (int n = 0; n < 2; ++n) acc[a][b][m][n] = (f32x4){0.f, 0.f, 0.f, 0.f};
        cur = nxt; cA = nA; cB = nB; ++ui;
        if constexpr (ALIGN_EPI) { if (wr == 1) PG8_BAR; }
    }
    PG8_WAIT_V(0);
    if constexpr (!ALIGN_EPI) { if (wr == 0) PG8_BAR; }
    PG8_BAR;
    if constexpr (Epi::AFTER_DRAIN) { E.fused(acc, cur, wr, wc, fr, fq, lds, wid, lane); S.done(cur); }
#undef PG8_UA
#undef PG8_UB
#undef PG8_SA
#undef PG8_SB
#undef PG8_STAGE
#undef PG8_LDA
#undef PG8_LDB
#undef PG8_MMA
#undef PG8_WAIT_V
#undef PG8_WAIT_L
#undef PG8_BAR
#undef PG8_SCHED
}
}
#define GAS __attribute__((address_space(1)))
#define LAS __attribute__((address_space(3)))
#define XB_TMO      128
#define XB_XCNT(j)  (256  + 64 * (j))
#define XB_XSUB(j)  (1280 + 64 * (j))
#define XB_XGEN(j)  (2304 + 64 * (j))
#define XB_TOP      3328
#define XB_TOPGEN   3392
#define XCD_BAR_WORDS 3456
#define XB_SPIN_CAP (1u << 18)

__device__ __forceinline__ unsigned xb_ld(unsigned* p)              { return __hip_atomic_load(p, __ATOMIC_RELAXED, __HIP_MEMORY_SCOPE_AGENT); }
__device__ __forceinline__ unsigned xb_add(unsigned* p, unsigned v) { return __hip_atomic_fetch_add(p, v, __ATOMIC_RELAXED, __HIP_MEMORY_SCOPE_AGENT); }
__device__ __forceinline__ unsigned xb_xcc_id() { return (unsigned)__builtin_amdgcn_s_getreg((3 << 11) | 20) & 0xFu; }
#define XB_SPIN(cond, bar) do { unsigned _sp = 0; while (cond) { __builtin_amdgcn_s_sleep(1); \
    if ((++_sp & 255u) == 0u) { if (xb_ld(&(bar)[XB_TMO])) break; if (_sp > XB_SPIN_CAP) { atomicAdd(&(bar)[XB_TMO], 1u); break; } } } } while (0)

struct XcdBarrier {
    unsigned* bar; unsigned x; int w0;
    volatile LAS unsigned* st;
};

__device__ __forceinline__ XcdBarrier xcd_barrier_post(unsigned* bar, volatile LAS unsigned* st, int wave) {
    XcdBarrier b; b.bar = bar; b.x = xb_xcc_id(); b.st = st; b.w0 = (wave == 0);
    if (b.w0 && pg8::pg8_lane_id() == 0) (void)xb_add(&bar[XB_XCNT(b.x)], 1u);
    return b;
}
__device__ __forceinline__ void xcd_barrier_complete(unsigned* bar, unsigned x, unsigned& nloc, unsigned& nx) {
    const unsigned G = gridDim.x * gridDim.y * gridDim.z;
    unsigned sum, cnt, mine, sp = 0u;
    for (;;) {
        sum = 0u; cnt = 0u; mine = 0u;
#pragma unroll
        for (unsigned j = 0; j < 16; ++j) { const unsigned c = xb_ld(&bar[XB_XCNT(j)]); sum += c; cnt += (c > 0u) ? 1u : 0u; mine = (j == x) ? c : mine; }
        if (sum == G) break;
        __builtin_amdgcn_s_sleep(1);
        if ((++sp & 255u) == 0u) { if (xb_ld(&bar[XB_TMO])) break; if (sp > XB_SPIN_CAP) { atomicAdd(&bar[XB_TMO], 1u); break; } }
    }
    nloc = mine > 0u ? mine : 1u; nx = cnt > 0u ? cnt : 1u;
}

__device__ __forceinline__ void xcd_barrier(const XcdBarrier& b) {
    asm volatile("s_waitcnt vmcnt(0)" ::: "memory");
    wg_sync();
    if (b.w0 && pg8::pg8_lane_id() == 0) {
        unsigned* bar = b.bar;
        __builtin_amdgcn_s_waitcnt(0);
        unsigned nloc = b.st[0], nx = b.st[1];
        if (nloc == 0u) { xcd_barrier_complete(bar, b.x, nloc, nx); b.st[0] = nloc; b.st[1] = nx; }
        const unsigned old = xb_add(&bar[XB_XSUB(b.x)], 1u);
        const unsigned gen = old / nloc;
        if (old + 1u == (gen + 1u) * nloc) {
            __builtin_amdgcn_fence(__ATOMIC_RELEASE, "agent");
            asm volatile("s_waitcnt vmcnt(0)" ::: "memory");
            const unsigned og = xb_add(&bar[XB_TOP], 1u);
            const unsigned tg = og / nx;
            if (og + 1u == (tg + 1u) * nx) xb_add(&bar[XB_TOPGEN], 1u);
            else XB_SPIN(xb_ld(&bar[XB_TOPGEN]) == tg, bar);
            __builtin_amdgcn_fence(__ATOMIC_ACQUIRE, "agent");
            xb_add(&bar[XB_XGEN(b.x)], 1u);
            asm volatile("s_waitcnt vmcnt(0)" ::: "memory");
        } else {
            XB_SPIN(xb_ld(&bar[XB_XGEN(b.x)]) == gen, bar);
            __builtin_amdgcn_fence(__ATOMIC_ACQUIRE, "agent");
            asm volatile("s_waitcnt vmcnt(0)" ::: "memory");
        }
    }
    wg_sync();
}
#ifndef MK_N_LAUNCHES
#define MK_N_LAUNCHES 1
#endif
#ifndef PROBE_DMA2
#define PROBE_DMA2 0
#endif
#if PROBE_DMA2
#define VMCNT12 "s_waitcnt vmcnt(24)"
#else
#define VMCNT12 "s_waitcnt vmcnt(12)"
#endif
#ifndef PROBE_NODMA
#define PROBE_NODMA 0
#endif
#ifndef PROBE_NOSLICE
#define PROBE_NOSLICE 0
#endif
#ifndef PROBE_SCAN2
#define PROBE_SCAN2 0
#endif
#ifndef PROBE_STORE2
#define PROBE_STORE2 0
#endif
#ifndef GDN_PREFETCH
#define GDN_PREFETCH 1
#endif
#ifndef RET_PREFETCH
#define RET_PREFETCH 1
#endif
#ifndef PROBE_SEG
#define PROBE_SEG 0
#endif
#define SEG_MINE(k) ((PROBE_SEG) == (k) && blockIdx.x == (((k) <= 5) ? 32 : 0) && F.wave == ((((k) >= 3 && (k) <= 5)) ? 4 : 0))
#define SEG_T0(k) do { if (SEG_MINE(k)) seg_t0_ = __builtin_amdgcn_s_memtime(); } while (0)
#define SEG_ACC(k) do { if (SEG_MINE(k)) seg_acc_ += __builtin_amdgcn_s_memtime() - seg_t0_; } while (0)
#define SEG_T02(k) do { if (SEG_MINE(k)) seg_t1_ = __builtin_amdgcn_s_memtime(); } while (0)
#define SEG_ACC2(k) do { if (SEG_MINE(k)) seg_acc_ += __builtin_amdgcn_s_memtime() - seg_t1_; } while (0)
#define SEG_OUT() do { if ((PROBE_SEG) > 0 && SEG_MINE(PROBE_SEG) && pg8::pg8_lane_id() == 0) __hip_atomic_store((unsigned*)(F.ws + WS_CTL) + 20000, (unsigned)(seg_acc_ >> 7), __ATOMIC_RELAXED, __HIP_MEMORY_SCOPE_AGENT); } while (0)
constexpr int NWAVES = 8;
constexpr int NPHASES = 10;
constexpr int BATCH = 2, SEQ = 8192, D = 2048, T = BATCH * SEQ;
constexpr int NH = 8, DK = 128, DV = 256;
constexpr int NIN = 16400;
constexpr int OFF_AZ = 4096, OFF_AB = 6144, OFF_RQ = 6160, OFF_RK = 7184, OFF_RV = 8208, OFF_RG = 10256, OFF_GA = 12304, OFF_GB = 14352;
constexpr int N1 = 17408;
constexpr int FF = 5632, NGU = 2 * FF;
constexpr float EPS = 1e-6f;
constexpr size_t MiB = 1u << 20;
constexpr size_t WS_CTL = 0, CTL_ZERO_BYTES = 1 * MiB;
constexpr size_t WS_BETA = 1 * MiB, WS_G = 1 * MiB + 512 * 1024;
constexpr size_t WS_COS = 2 * MiB, WS_SIN = 4 * MiB;
constexpr size_t WS_COS2 = 6 * MiB, WS_SIN2 = 8 * MiB;
constexpr size_t WS_DL = 10 * MiB, WS_RSTD = 11 * MiB;
constexpr size_t WS_WOT = 12 * MiB;
constexpr size_t WS_WGUT = 20 * MiB, WS_WDT = 484 * MiB;
constexpr size_t WS_W1T = 20 * MiB, WS_U = 88 * MiB;
constexpr size_t WS_GW = 20 * MiB, WS_GQ = 52 * MiB, WS_GK = 84 * MiB, WS_GA = 116 * MiB, WS_GU = 132 * MiB;
constexpr size_t WS_QKV = 196 * MiB;
constexpr size_t WS_RQF = 324 * MiB, WS_RKF = 356 * MiB, WS_RKTF = 388 * MiB, WS_RVTF = 420 * MiB, WS_END = 506 * MiB;
constexpr size_t WS_OA = 196 * MiB;
constexpr size_t WS_OB = 260 * MiB;
constexpr size_t WS_MIXED = 196 * MiB;
constexpr size_t WS_HNB = 324 * MiB;
constexpr size_t WS_H = 388 * MiB;
constexpr size_t WS_ACT = 88 * MiB;
static_assert(WS_ACT + (size_t)T * FF * 2 <= WS_HNB, "ACT overlay");
constexpr int CW_BAR = 4096;
constexpr int RING_BYTES = 131072, SCAN_RING_BYTES = 147456 + 12288, LDSCTL_OFF = SCAN_RING_BYTES, MISC_OFF = LDSCTL_OFF + 320, LDS_BYTES = 163840;

typedef unsigned short bf16;
typedef unsigned v4u __attribute__((ext_vector_type(4)));
typedef unsigned v2u __attribute__((ext_vector_type(2)));
typedef float f32x4 __attribute__((ext_vector_type(4)));
#define LDS_WAIT() asm volatile("s_waitcnt lgkmcnt(0)" ::: "memory")
__device__ __forceinline__ unsigned f2bf(float f) { unsigned u = __builtin_bit_cast(unsigned, f); return (u + 0x7fffu + ((u >> 16) & 1u)) >> 16; }
__device__ __forceinline__ unsigned pk2(float lo, float hi) { unsigned r; asm("v_cvt_pk_bf16_f32 %0, %1, %2" : "=v"(r) : "v"(lo), "v"(hi)); return r; }
__device__ __forceinline__ float bf2f(unsigned b) { return __builtin_bit_cast(float, b << 16); }
__device__ __forceinline__ float bflo(unsigned w) { return __builtin_bit_cast(float, w << 16); }
__device__ __forceinline__ float bfhi(unsigned w) { return __builtin_bit_cast(float, w & 0xffff0000u); }
__device__ __forceinline__ float silu_f(float a) { return a * __builtin_amdgcn_rcpf(1.0f + __expf(-a)); }
__device__ __forceinline__ float wave_sum(float v) {
#pragma unroll
    for (int o = 1; o < 64; o <<= 1) v += __shfl_xor(v, o);
    return v;
}

struct Args { const float* in[14]; float* out; unsigned char* ws; int ph_lo, ph_hi; };
struct Frame {
    LAS unsigned char* lds; int tid, lane, wave, vcu, G;
    const float *x, *norm1_w, *w_in, *conv_w, *a_log, *dt_bias, *gdn_norm_w, *ret_norm_w, *w_out, *norm2_w, *w_gate, *w_up, *w_down, *norm_f_w;
    float* out; unsigned char* ws;
};

__device__ __forceinline__ void transpose_blk(const float* src, int ld, int k0, int sc0, bf16* dst, int K, int dr0, LAS float* scr, int lane, const float* kscale = nullptr) {
    f32x4 v[16];
#pragma unroll
    for (int i = 0; i < 16; ++i) v[i] = __builtin_nontemporal_load((const f32x4*)(src + (size_t)(k0 + 4 * i + (lane >> 4)) * ld + sc0 + 4 * (lane & 15)));
    if (kscale) {
#pragma unroll
        for (int i = 0; i < 16; ++i) v[i] = v[i] * kscale[k0 + 4 * i + (lane >> 4)]; }
#pragma unroll
    for (int i = 0; i < 16; ++i) { LAS float* d = scr + (4 * i + (lane >> 4)) * 65 + 4 * (lane & 15); d[0] = v[i].x; d[1] = v[i].y; d[2] = v[i].z; d[3] = v[i].w; }
    LDS_WAIT(); asm volatile("" ::: "memory");
    const int c = lane & 7;
#pragma unroll
    for (int j = 0; j < 8; ++j) { const int n = (lane >> 3) + 8 * j; const LAS float* s = scr + (8 * c) * 65 + n;
        v4u o; o.x = pk2(s[0 * 65], s[1 * 65]); o.y = pk2(s[2 * 65], s[3 * 65]); o.z = pk2(s[4 * 65], s[5 * 65]); o.w = pk2(s[6 * 65], s[7 * 65]);
        *(v4u*)(dst + (size_t)(dr0 + n) * K + k0 + 8 * c) = o; }
    LDS_WAIT(); asm volatile("" ::: "memory");
}
__device__ __forceinline__ int w1_src_col(int n) {
    if (n < 4096) return n;
    if (n >= 16384) n = n - 16384 + 5120;
    if (n < 6144) { const int isk = n >= 5120, lt = (n - 4096) & 1023, tile = lt >> 8, c = lt & 255, bj = c >> 7, p = c & 127; return (isk ? OFF_RK : OFF_RQ) + (2 * tile + (p >> 6)) * 128 + bj * 64 + (p & 63); }
    if (n < 8192) return OFF_RV + (n - 6144);
    { const int isb = n >= 12288, lt = (n - 8192) & 4095, j = lt >> 8, c = lt & 255, bj = c >> 7, p = c & 127;
      return (isb ? (bj ? OFF_GB : OFF_RG) : (bj ? OFF_GA : OFF_AZ)) + 128 * j + p; }
}
__device__ __forceinline__ void p0_prologue(Frame& F) {
    __syncthreads();
    const int gw = F.vcu * NWAVES + F.wave, NGW = F.G * NWAVES, lane = F.lane;
    {
        LAS float* scr = (LAS float*)(F.lds + F.wave * 16640);
        constexpr int I_1 = (D / 64) * (N1 / 64), I_O = (D / 64) * (D / 64);
        constexpr int NITEMS = I_1 + I_O;
        bf16* W1T = (bf16*)(F.ws + WS_W1T); bf16* WOT = (bf16*)(F.ws + WS_WOT);
        for (int it = gw; it < NITEMS; it += NGW) {
            int r = it;
            if (r < I_1) { const int nb = r % (N1 / 64), kb = r / (N1 / 64); transpose_blk(F.w_in, NIN, 64 * kb, w1_src_col(64 * nb), W1T, D, 64 * nb, scr, lane); continue; } r -= I_1;
            { const int nb = r % (D / 64), kb = r / (D / 64); transpose_blk(F.w_out, D, 64 * kb, 64 * nb, WOT, D, 64 * nb, scr, lane); }
        }
    }
    {
        float* cosT = (float*)(F.ws + WS_COS); float* sinT = (float*)(F.ws + WS_SIN); float* cosT2 = (float*)(F.ws + WS_COS2); float* sinT2 = (float*)(F.ws + WS_SIN2);
        for (int idx = (F.vcu * 512 + F.tid); idx < SEQ * 64; idx += F.G * 512) { const int t = idx >> 6, i = idx & 63;
            const float inv = (float)exp2(-(double)i * (13.287712379549449 / 64.0));
            const float ang = (float)t * inv; const double a = (double)ang; const float cv = (float)cos(a), sv = (float)sin(a);
            cosT[idx] = cv; sinT[idx] = sv; cosT2[i * SEQ + t] = cv; sinT2[i * SEQ + t] = sv; }
    }
    __syncthreads();
    {
        LAS float* wT = (LAS float*)F.lds;
        { f32x4 wv[4][4];
#pragma unroll
          for (int j = 0; j < 4; ++j)
#pragma unroll
            for (int q = 0; q < 4; ++q) wv[j][q] = *(const f32x4*)(F.w_in + (size_t)(F.tid + 512 * j) * NIN + OFF_AB + 4 * q);
#pragma unroll
          for (int j = 0; j < 4; ++j)
#pragma unroll
            for (int q = 0; q < 4; ++q)
#pragma unroll
              for (int e = 0; e < 4; ++e) wT[(4 * q + e) * 2048 + F.tid + 512 * j] = wv[j][q][e]; }
        __syncthreads();
        bf16* U = (bf16*)(F.ws + WS_U); float* BETA = (float*)(F.ws + WS_BETA); float* GG = (float*)(F.ws + WS_G);
        f32x4 nw[8];
#pragma unroll
        for (int j = 0; j < 8; ++j) nw[j] = ((const f32x4*)F.norm1_w)[64 * j + lane];
        for (int row = gw; row < T; row += NGW) {
            asm volatile("" ::: "memory");
            const f32x4* xr = (const f32x4*)(F.x + (size_t)row * D) + lane;
            f32x4 v[8]; float ss = 0.f;
#pragma unroll
            for (int j = 0; j < 8; ++j) { v[j] = __builtin_nontemporal_load(xr + 64 * j); ss += (v[j].x * v[j].x + v[j].y * v[j].y) + (v[j].z * v[j].z + v[j].w * v[j].w); }
            const float rstd = rsqrtf(wave_sum(ss) * (1.0f / D) + EPS);
            v2u* o8 = (v2u*)(U + (size_t)row * D) + lane;
#pragma unroll
            for (int j = 0; j < 8; ++j) { v[j] = (v[j] * rstd) * nw[j]; v2u w; w.x = pk2(v[j].x, v[j].y); w.y = pk2(v[j].z, v[j].w); o8[64 * j] = w; }
            float sd[16];
#pragma unroll
            for (int c = 0; c < 16; ++c) { float s = 0.f;
#pragma unroll
                for (int j = 0; j < 8; ++j) { const f32x4 w = *(const LAS f32x4*)(wT + c * 2048 + 256 * j + 4 * lane); s += (v[j].x * w.x + v[j].y * w.y) + (v[j].z * w.z + v[j].w * w.w); }
                sd[c] = s; }
            const bool b5 = lane & 32, b4 = lane & 16, b3 = lane & 8, b2 = lane & 4;
            float t8[8], t4[4], t2[2], t1;
#pragma unroll
            for (int c = 0; c < 8; ++c) { const float mine = b5 ? sd[c + 8] : sd[c], give = b5 ? sd[c] : sd[c + 8]; t8[c] = mine + __shfl_xor(give, 32); }
#pragma unroll
            for (int c = 0; c < 4; ++c) { const float mine = b4 ? t8[c + 4] : t8[c], give = b4 ? t8[c] : t8[c + 4]; t4[c] = mine + __shfl_xor(give, 16); }
#pragma unroll
            for (int c = 0; c < 2; ++c) { const float mine = b3 ? t4[c + 2] : t4[c], give = b3 ? t4[c] : t4[c + 2]; t2[c] = mine + __shfl_xor(give, 8); }
            { const float mine = b2 ? t2[1] : t2[0], give = b2 ? t2[0] : t2[1]; t1 = mine + __shfl_xor(give, 4); }
            t1 += __shfl_xor(t1, 2); t1 += __shfl_xor(t1, 1);
            const float other = __shfl_xor(t1, 32);
            if (lane == 8) ((float*)(F.ws + WS_RSTD))[row] = 0.f;
            if ((lane & 35) == 0) { const int hd = lane >> 2; const float mb = t1, ma = other;
                const float bt = 1.0f / (1.0f + expf(-mb)); const float xa = ma + F.dt_bias[hd]; const float sp = xa > 20.f ? xa : log1pf(expf(xa));
                BETA[(size_t)row * 8 + hd] = bt; GG[(size_t)row * 8 + hd] = -expf(F.a_log[hd]) * sp; }
        }
    }
}

__device__ __forceinline__ void gdn_naive(Frame& F, int bh) {
    const int b = bh >> 3, h = bh & 7, tid = F.tid, c = tid & 255, hh = tid >> 8;
    LAS float* sq = (LAS float*)F.lds; LAS float* sk = sq + 128; LAS float* sv = sq + 256; LAS float* sp = sq + 512; LAS float* sred = sq + 1024;
    const int ch = tid < 128 ? h * 128 + tid : (tid < 256 ? 1024 + h * 128 + (tid - 128) : 2048 + h * 256 + (tid - 256));
    const float cw0 = F.conv_w[0 * 4096 + ch], cw1 = F.conv_w[1 * 4096 + ch], cw2 = F.conv_w[2 * 4096 + ch], cw3 = F.conv_w[3 * 4096 + ch];
    const bf16* raw = (const bf16*)(F.ws + WS_QKV) + (size_t)(b * SEQ) * 4096 + ch;
    const float* BETA = (const float*)(F.ws + WS_BETA) + (size_t)(b * SEQ) * 8 + h; const float* GG = (const float*)(F.ws + WS_G) + (size_t)(b * SEQ) * 8 + h;
    bf16* OA = (bf16*)(F.ws + WS_OA) + (size_t)(b * SEQ) * 2048 + h * 256 + c;
    float S[64];
#pragma unroll
    for (int d = 0; d < 64; ++d) S[d] = 0.f;
    float r0 = 0.f, r1 = 0.f, r2 = 0.f;
    float nraw = bf2f(raw[0]), nbeta = BETA[0], ng = GG[0];
    for (int t = 0; t < SEQ; ++t) {
        const float r3 = nraw, beta = nbeta, eg = expf(ng);
        if (t + 1 < SEQ) { nraw = bf2f(raw[(size_t)(t + 1) * 4096]); nbeta = BETA[(size_t)(t + 1) * 8]; ng = GG[(size_t)(t + 1) * 8]; }
        const float a = r0 * cw0 + r1 * cw1 + r2 * cw2 + r3 * cw3; r0 = r1; r1 = r2; r2 = r3;
        float val = a / (1.0f + expf(-a));
        const float ws_ = wave_sum(val * val);
        if (F.lane == 0) sred[F.wave] = ws_;
        __syncthreads();
        if (tid < 128) { val = val * rsqrtf(sred[0] + sred[1] + EPS) * 0.08838834764831845f; sq[tid] = val; }
        else if (tid < 256) { val = val * rsqrtf(sred[2] + sred[3] + EPS); sk[tid - 128] = val; }
        else sv[tid - 256] = val;
        __syncthreads();
        float p = 0.f;
#pragma unroll
        for (int d = 0; d < 64; ++d) p += sk[hh * 64 + d] * S[d];
        sp[hh * 256 + c] = p;
        __syncthreads();
        const float kS = sp[c] + sp[256 + c];
        const float delta = beta * (sv[c] - eg * kS);
        float o = 0.f;
#pragma unroll
        for (int d = 0; d < 64; ++d) { S[d] = eg * S[d] + sk[hh * 64 + d] * delta; o += sq[hh * 64 + d] * S[d]; }
        __syncthreads();
        sp[hh * 256 + c] = o;
        __syncthreads();
        if (hh == 0) OA[(size_t)t * 2048] = (bf16)f2bf(sp[c] + sp[256 + c]);
    }
}
__device__ __forceinline__ void ffn_weight_copies(Frame& F) {
    const int gw = F.vcu * NWAVES + F.wave, NGW = F.G * NWAVES, lane = F.lane;
    LAS float* scr = (LAS float*)(F.lds + F.wave * 16640);
    constexpr int I_G = (D / 64) * (FF / 64), I_D = (FF / 64) * (D / 64);
    bf16* WGUT = (bf16*)(F.ws + WS_WGUT); bf16* WDT = (bf16*)(F.ws + WS_WDT);
    for (int it = gw; it < 2 * I_G; it += NGW) {
        int r = it;
        if (r < 2 * I_G) { const int up = r >= I_G; if (up) r -= I_G; const int nb = r % (FF / 64), kb = r / (FF / 64), c0 = 64 * nb;
            transpose_blk(up ? F.w_up : F.w_gate, FF, 64 * kb, c0, WGUT, D, 256 * (c0 >> 7) + 128 * up + (c0 & 127), scr, lane, F.norm2_w); continue; } r -= 2 * I_G;
        { const int nb = r % (D / 64), kb = r / (D / 64); transpose_blk(F.w_down, D, 64 * kb, 64 * nb, WDT, FF, 64 * nb, scr, lane); }
    }
}

typedef float f32x16 __attribute__((ext_vector_type(16)));
typedef short bf16x8 __attribute__((ext_vector_type(8)));
typedef float f32x2_t __attribute__((ext_vector_type(2))); typedef __bf16 bf16x2_t __attribute__((ext_vector_type(2)));
#define MFMA32(a, b, c) __builtin_amdgcn_mfma_f32_32x32x16_bf16((a), (b), (c), 0, 0, 0)
__device__ __forceinline__ unsigned cvtpk_s(float lo, float hi) { f32x2_t v = {lo, hi}; bf16x2_t b = __builtin_convertvector(v, bf16x2_t); return __builtin_bit_cast(unsigned, b); }
#define PACK_STEP(x, s) __builtin_bit_cast(bf16x8, (v4u){cvtpk_s((x)[8 * (s)], (x)[8 * (s) + 1]), cvtpk_s((x)[8 * (s) + 2], (x)[8 * (s) + 3]), cvtpk_s((x)[8 * (s) + 4], (x)[8 * (s) + 5]), cvtpk_s((x)[8 * (s) + 6], (x)[8 * (s) + 7])})
__device__ __forceinline__ bf16 cvt1_bf16(float x) { return (bf16)(cvtpk_s(x, x) & 0xffffu); }
__device__ __forceinline__ bf16x8 ldfrag(const bf16* base, size_t f, int lane) {
#if PROBE_NOSLICE
    bf16x8 z; for (int i = 0; i < 8; ++i) z[i] = (short)(lane + i); asm volatile("" : "+v"(z)); return z;
#endif
    return *(const bf16x8*)(base + f * 512 + lane * 8); }
__device__ __forceinline__ f32x16 zero16() { f32x16 z; for (int i = 0; i < 16; ++i) z[i] = 0.f; return z; }

#define SCAN_BAR_C() do { asm volatile("s_waitcnt lgkmcnt(0)" ::: "memory"); __builtin_amdgcn_s_barrier(); asm volatile("" ::: "memory"); } while (0)
#define SCAN_BAR() do { asm volatile("s_waitcnt vmcnt(0) lgkmcnt(0)" ::: "memory"); __builtin_amdgcn_s_barrier(); asm volatile("" ::: "memory"); } while (0)
__device__ __forceinline__ void glds1k(const bf16* gsrc_frag, LAS unsigned char* dst, int lane) {
#if PROBE_NODMA
    return;
#endif
    __builtin_amdgcn_global_load_lds((const unsigned*)(gsrc_frag + lane * 8), (LAS unsigned*)dst, 16, 0, 0);
#if PROBE_DMA2
    __builtin_amdgcn_global_load_lds((const unsigned*)(gsrc_frag + lane * 8), (LAS unsigned*)dst, 16, 0, 0);
#endif
}
__device__ __forceinline__ void dma_chunk3(const bf16* p0, const bf16* p1, const bf16* p2, LAS unsigned char* dst_lw, int lane) {
#pragma unroll
    for (int q = 0; q < 4; ++q) glds1k(p0 + q * 2048, dst_lw + (0 * 16 + 4 * q) * 1024, lane);
#pragma unroll
    for (int q = 0; q < 4; ++q) glds1k(p1 + q * 2048, dst_lw + (1 * 16 + 4 * q) * 1024, lane);
#pragma unroll
    for (int q = 0; q < 4; ++q) glds1k(p2 + q * 2048, dst_lw + (2 * 16 + 4 * q) * 1024, lane);
}
__device__ __forceinline__ bf16x8 ldsfrag(const LAS unsigned char* buf, int slot, int lane) { return *(const LAS bf16x8*)(buf + slot * 1024 + lane * 16); }

constexpr int RS_BUF = 48 * 1024, RS_PA = 3 * RS_BUF;
__device__ __forceinline__ void ret_scan_wg(Frame& F, int bh, int half, unsigned* prog) {
    unsigned long long seg_t0_ = 0, seg_t1_ = 0, seg_acc_ = 0; (void)seg_t0_; (void)seg_t1_; (void)seg_acc_;
    const int w = F.wave, b = bh >> 3, h = bh & 7;
    const bf16* RQf = (const bf16*)(F.ws + WS_RQF); const bf16* RKf = (const bf16*)(F.ws + WS_RKF); const bf16* RKTf = (const bf16*)(F.ws + WS_RKTF); const bf16* RVTf = (const bf16*)(F.ws + WS_RVTF);
    LAS unsigned char* L = F.lds;
    if (w >= 4) {
        const int lw = w - 4, lane = pg8::pg8_lane_id(), col = lane & 31, hh = lane >> 5;
        const bf16* pq = RQf + ((size_t)bh * 128 * 16 + lw) * 512; const bf16* pk = RKf + ((size_t)bh * 128 * 16 + lw) * 512; const bf16* pt = RKTf + ((size_t)bh * 128 * 16 + lw) * 512;
        dma_chunk3(pq, pk, pt, L + 0 * RS_BUF + lw * 1024, lane); pq += 8192; pk += 8192; pt += 8192;
        dma_chunk3(pq, pk, pt, L + 1 * RS_BUF + lw * 1024, lane); pq += 8192; pk += 8192; pt += 8192;
        asm volatile(VMCNT12 ::: "memory"); __builtin_amdgcn_s_barrier(); asm volatile("" ::: "memory");
        int cb = 0, nb = 2;
        for (int n = 0; n < 128; ++n) {
            const LAS unsigned char* B = L + cb * RS_BUF;
            if (lw < 3) {
                const int tj = lw == 2 ? 1 : 0, ti = lw == 0 ? 0 : 1;
                f32x16 P = zero16();
#pragma unroll
                for (int td = 0; td < 4; ++td)
#pragma unroll
                    for (int s2 = 0; s2 < 2; ++s2) P = MFMA32(ldsfrag(B, 16 + (tj * 4 + td) * 2 + s2, lane), ldsfrag(B, (ti * 4 + td) * 2 + s2, lane), P);
                if (lw != 1) {
#pragma unroll
                    for (int r = 0; r < 16; ++r) { const int j = (r & 3) + 8 * (r >> 2) + 4 * hh; if (col < j) P[r] = 0.f; } }
                const bf16x8 a0 = PACK_STEP(P, 0), a1 = PACK_STEP(P, 1);
                *(LAS bf16x8*)(L + RS_PA + (2 * lw) * 1024 + lane * 16) = a0; *(LAS bf16x8*)(L + RS_PA + (2 * lw + 1) * 1024 + lane * 16) = a1;
            }
            asm volatile("s_waitcnt lgkmcnt(0)" ::: "memory"); __builtin_amdgcn_s_barrier(); asm volatile("" ::: "memory");
            if (n + 2 < 128) { dma_chunk3(pq, pk, pt, L + nb * RS_BUF + lw * 1024, lane); pq += 8192; pk += 8192; pt += 8192;
                asm volatile(VMCNT12 ::: "memory"); }
            else asm volatile("s_waitcnt vmcnt(0)" ::: "memory");
            __builtin_amdgcn_s_barrier(); asm volatile("" ::: "memory");
            if (lw == 0 && half == 0 && lane == 0) __hip_atomic_store(prog, (unsigned)(n + 1), __ATOMIC_RELAXED, __HIP_MEMORY_SCOPE_AGENT);
            cb = cb == 2 ? 0 : cb + 1; nb = nb == 2 ? 0 : nb + 1;
        }
        return;
    }
    const int sl = 4 * half + w, lane = pg8::pg8_lane_id(), col = lane & 31, hh = lane >> 5;
    bf16* OB = (bf16*)(F.ws + WS_RVTF) + ((size_t)bh * 128 * 8 + sl) * 2048;
    LAS unsigned char* SB = L + RS_PA + 6144 + w * 1024; const unsigned stoff = (unsigned)(4 * hh * 64 + col * 2);
    const float g64 = exp2f(64.0f * log2f(1.0f - exp2f(-5.0f - (float)h)));
    f32x16 S[4];
#pragma unroll
    for (int td = 0; td < 4; ++td) S[td] = zero16();
#if RET_PREFETCH
    bf16x8 vtn[2][2];
    { const size_t cq = (size_t)bh * 128;
#pragma unroll
      for (int tj = 0; tj < 2; ++tj)
#pragma unroll
        for (int s2 = 0; s2 < 2; ++s2) vtn[tj][s2] = ldfrag(RVTf, ((cq * 8 + sl) * 2 + tj) * 2 + s2, lane); }
#endif
    SCAN_BAR_C();
    int cb = 0;
    for (int n = 0; n < 128; ++n) { SEG_T02(6);
        const LAS unsigned char* B = L + cb * RS_BUF; cb = cb == 2 ? 0 : cb + 1;
        bf16x8 vt[2][2];
#if RET_PREFETCH
#pragma unroll
        for (int tj = 0; tj < 2; ++tj)
#pragma unroll
            for (int s2 = 0; s2 < 2; ++s2) vt[tj][s2] = vtn[tj][s2];
        if (n + 1 < 128) { const size_t cq = (size_t)bh * 128 + n + 1;
#else
#define vtn vt
        { const size_t cq = (size_t)bh * 128 + n;
#endif
#pragma unroll
          for (int tj = 0; tj < 2; ++tj)
#pragma unroll
            for (int s2 = 0; s2 < 2; ++s2) vtn[tj][s2] = ldfrag(RVTf, ((cq * 8 + sl) * 2 + tj) * 2 + s2, lane); }
#define PIN() do { asm volatile("" ::: "memory"); __builtin_amdgcn_sched_barrier(0); } while (0)
#define LD4(dst, base, s0, s1, s2, s3) do { PIN(); dst[0] = ldsfrag(base, s0, lane); dst[1] = ldsfrag(base, s1, lane); dst[2] = ldsfrag(base, s2, lane); dst[3] = ldsfrag(base, s3, lane); PIN(); } while (0)
#define QSLOT(ti, td, s2) (((ti) * 4 + (td)) * 2 + (s2))
#define KTSLOT(k) (32 + (k))
        bf16x8 fa[4], fb[4];
        const LAS unsigned char* PAb = L + RS_PA;
        f32x16 o0 = zero16(), o1 = zero16();
        LD4(fa, B, QSLOT(0, 0, 0), QSLOT(0, 0, 1), QSLOT(1, 0, 0), QSLOT(1, 0, 1));
        { const bf16x8 sb0 = PACK_STEP(S[0], 0), sb1 = PACK_STEP(S[0], 1);
          LD4(fb, B, QSLOT(0, 1, 0), QSLOT(0, 1, 1), QSLOT(1, 1, 0), QSLOT(1, 1, 1));
          o0 = MFMA32(fa[0], sb0, o0); o0 = MFMA32(fa[1], sb1, o0); o1 = MFMA32(fa[2], sb0, o1); o1 = MFMA32(fa[3], sb1, o1); }
        { const bf16x8 sb0 = PACK_STEP(S[1], 0), sb1 = PACK_STEP(S[1], 1);
          LD4(fa, B, QSLOT(0, 2, 0), QSLOT(0, 2, 1), QSLOT(1, 2, 0), QSLOT(1, 2, 1));
          o0 = MFMA32(fb[0], sb0, o0); o0 = MFMA32(fb[1], sb1, o0); o1 = MFMA32(fb[2], sb0, o1); o1 = MFMA32(fb[3], sb1, o1); }
        { const bf16x8 sb0 = PACK_STEP(S[2], 0), sb1 = PACK_STEP(S[2], 1);
          LD4(fb, B, QSLOT(0, 3, 0), QSLOT(0, 3, 1), QSLOT(1, 3, 0), QSLOT(1, 3, 1));
          o0 = MFMA32(fa[0], sb0, o0); o0 = MFMA32(fa[1], sb1, o0); o1 = MFMA32(fa[2], sb0, o1); o1 = MFMA32(fa[3], sb1, o1); }
        { const bf16x8 sb0 = PACK_STEP(S[3], 0), sb1 = PACK_STEP(S[3], 1);
          o0 = MFMA32(fb[0], sb0, o0); o0 = MFMA32(fb[1], sb1, o0); o1 = MFMA32(fb[2], sb0, o1); o1 = MFMA32(fb[3], sb1, o1); }
        SEG_T0(7); SCAN_BAR_C(); SEG_ACC(7);
#define STORE_O(ox, rowoff) do { _Pragma("unroll") for (int p_ = 0; p_ < 2; ++p_) { \
            _Pragma("unroll") for (int q_ = 0; q_ < 8; ++q_) { const int r = 8 * p_ + q_; *(LAS bf16*)(SB + ((r & 3) + 8 * ((r >> 2) & 1)) * 64 + stoff) = cvt1_bf16(ox[r]); } \
            const v4u t_ = *(const LAS v4u*)(SB + lane * 16); *(v4u*)(orow + (rowoff) + (16 * p_) * 32 + lane * 8) = t_; } } while (0)
        bf16* orow = OB + (size_t)n * (8 * 2048);
        LD4(fa, PAb, 0, 1, 2, 3);
        fb[0] = ldsfrag(PAb, 4, lane); fb[1] = ldsfrag(PAb, 5, lane); fb[2] = ldsfrag(B, KTSLOT(0), lane); fb[3] = ldsfrag(B, KTSLOT(1), lane); PIN();
        S[0] = S[0] * g64; S[1] = S[1] * g64;
        o0 = MFMA32(fa[0], vt[0][0], o0); o0 = MFMA32(fa[1], vt[0][1], o0); o1 = MFMA32(fa[2], vt[0][0], o1); o1 = MFMA32(fa[3], vt[0][1], o1);
        LD4(fa, B, KTSLOT(2), KTSLOT(3), KTSLOT(4), KTSLOT(5));
        S[2] = S[2] * g64; S[3] = S[3] * g64;
        o1 = MFMA32(fb[0], vt[1][0], o1); o1 = MFMA32(fb[1], vt[1][1], o1);
        S[0] = MFMA32(fb[2], vt[0][0], S[0]); S[0] = MFMA32(fb[3], vt[0][1], S[0]);
        LD4(fb, B, KTSLOT(6), KTSLOT(7), KTSLOT(8), KTSLOT(9));
        STORE_O(o0, 0u);
        S[0] = MFMA32(fa[0], vt[1][0], S[0]); S[0] = MFMA32(fa[1], vt[1][1], S[0]);
        S[1] = MFMA32(fa[2], vt[0][0], S[1]); S[1] = MFMA32(fa[3], vt[0][1], S[1]);
        LD4(fa, B, KTSLOT(10), KTSLOT(11), KTSLOT(12), KTSLOT(13));
        STORE_O(o1, 32u * 32u);
        S[1] = MFMA32(fb[0], vt[1][0], S[1]); S[1] = MFMA32(fb[1], vt[1][1], S[1]);
        S[2] = MFMA32(fb[2], vt[0][0], S[2]); S[2] = MFMA32(fb[3], vt[0][1], S[2]);
        PIN(); fb[0] = ldsfrag(B, KTSLOT(14), lane); fb[1] = ldsfrag(B, KTSLOT(15), lane); PIN();
        S[2] = MFMA32(fa[0], vt[1][0], S[2]); S[2] = MFMA32(fa[1], vt[1][1], S[2]);
        S[3] = MFMA32(fa[2], vt[0][0], S[3]); S[3] = MFMA32(fa[3], vt[0][1], S[3]);
        S[3] = MFMA32(fb[0], vt[1][0], S[3]); S[3] = MFMA32(fb[1], vt[1][1], S[3]);
#undef STORE_O
        SEG_T0(8); SCAN_BAR_C(); SEG_ACC(8); SEG_ACC2(6);
    }
    SEG_OUT();
}

#define RLX_AGENT __ATOMIC_RELAXED, __HIP_MEMORY_SCOPE_AGENT
__device__ __forceinline__ void st8_wt(void* p, unsigned lo, unsigned hi) { __hip_atomic_store((unsigned long long*)p, ((unsigned long long)hi << 32) | lo, RLX_AGENT); }
__device__ __forceinline__ void st16_wt(void* p, v4u v) { asm volatile("global_store_dwordx4 %0, %1, off sc1\n\ts_nop 1" :: "v"(p), "v"(v) : "memory"); }
constexpr int CW_RDY = 32768;
#ifndef PROBE_NOSTORE
#define PROBE_NOSTORE 0
#endif
#ifndef PROBE_ONLYSCAN
#define PROBE_ONLYSCAN 0
#endif
#ifndef PROBE_PREP
#define PROBE_PREP 0
#endif
#ifndef RET_TOUCH
#define RET_TOUCH 1
#endif
#ifndef GDN_LTOUCH
#define GDN_LTOUCH 1
#endif
#ifndef GT_LOOK
#define GT_LOOK 5
#endif
#ifndef RT_LOOK
#define RT_LOOK 6
#endif
#define FMAC_S(acc, as, xv) asm("v_fmac_f32 %0, %1, %2" : "+v"(acc) : "s"(as), "v"(xv))
#define FMAC_V(acc, av, xv) asm("v_fmac_f32 %0, %1, %2" : "+v"(acc) : "v"(av), "v"(xv))
#define ADD_V(a, b) asm("v_add_f32 %0, %0, %1" : "+v"(a) : "v"(b))
#define SUB_V(a, b) asm("v_sub_f32 %0, %0, %1" : "+v"(a) : "v"(b))
typedef __attribute__((address_space(4))) const f32x4 CF4;
#ifdef PROBE_CYC
#define CYC_START(k) do { if (PROBE_CYC == (k)) { asm volatile("s_waitcnt vmcnt(0) lgkmcnt(0)" ::: "memory"); cyc_t0_ = __builtin_amdgcn_s_memtime(); } } while (0)
#define CYC_STOP(k) do { if (PROBE_CYC == (k)) { asm volatile("s_waitcnt lgkmcnt(0)" ::: "memory"); const unsigned long long t1_ = __builtin_amdgcn_s_memtime(); \
    if (ci == (PROBE_CYC_ITEM) && tid == (PROBE_CYC_TID)) __hip_atomic_store((unsigned*)(F.ws + WS_CTL) + 20001, (unsigned)(t1_ - cyc_t0_), __ATOMIC_RELAXED, __HIP_MEMORY_SCOPE_AGENT); } } while (0)
#else
#define CYC_START(k) do {} while (0)
#define CYC_STOP(k) do {} while (0)
#endif
constexpr int GP_AH = 118784, GP_AL = 157696;
constexpr int GP_PF = 120832, GP_QS = 122880, GP_KS = 140288;
constexpr int GP_QH = 0, GP_KH = 17408, GP_AM = 34816, GP_RK = 51200, GP_GC = 83968, GP_BT = 84224, GP_WL = GP_RK, GP_VR = 84480;
__device__ __forceinline__ void gdn_prep(Frame& F, int ci) {
    unsigned long long cyc_t0_ = 0; (void)cyc_t0_;
    int tid_ = F.tid; asm volatile("" : "+v"(tid_));
    const int tid = tid_, lane = tid & 63, w = __builtin_amdgcn_readfirstlane(tid >> 6), bh = ci >> 7, n = ci & 127, b = bh >> 3, h = bh & 7;
    const size_t trow0 = (size_t)b * SEQ + 64 * n;
    LAS unsigned char* L = F.lds;
    CYC_START(6);
    LAS float* gcs = (LAS float*)(L + GP_GC); LAS float* bet = (LAS float*)(L + GP_BT); LAS float* Am = (LAS float*)(L + GP_AM); LAS float* Rk = (LAS float*)(L + GP_RK);
    const bf16* QKV = (const bf16*)(F.ws + WS_QKV);
    bf16* GW = (bf16*)(F.ws + WS_GW); bf16* GQ = (bf16*)(F.ws + WS_GQ); bf16* GK = (bf16*)(F.ws + WS_GK); bf16* GA = (bf16*)(F.ws + WS_GA); bf16* GU = (bf16*)(F.ws + WS_GU);
#if RET_TOUCH
    { const int np = n + RT_LOOK;
      if (np < 128) { const size_t c = (size_t)bh * 128 + np;
        const unsigned char* p = tid < 384 ? F.ws + (tid < 128 ? WS_RQF : tid < 256 ? WS_RKF : WS_RKTF) + c * 16384 + (size_t)(tid & 127) * 128 : F.ws + WS_RVTF + c * 32768 + (size_t)(tid - 384) * 128;
        __builtin_amdgcn_global_load_lds((const unsigned*)p, (LAS unsigned*)(L + GP_PF + w * 256), 4, 0, 0);
        if (w < 2) __builtin_amdgcn_global_load_lds((const unsigned*)(F.ws + WS_RVTF + c * 32768 + (size_t)(128 + tid) * 128), (LAS unsigned*)(L + GP_PF + w * 256), 4, 0, 0); } }
#endif
    const int cg = lane & 31, rh = lane >> 5, isk = cg >> 4, dk0 = 8 * (cg & 15), row0 = 8 * w + 4 * rh;
    const int ch = (isk ? 1024 : 0) + h * 128 + dk0;
    v4u rawv[7]; f32x4 cwa[4], cwc[4]; float g_ld = 0.f, b_ld = 0.f;
    {
        v4u vr[5];
#pragma unroll
        for (int k = 0; k < 5; ++k) { const int idx = tid + 512 * k, row = idx >> 5, cg = idx & 31; vr[k] = (v4u){0u, 0u, 0u, 0u};
            if (row < 67 && (n > 0 || row >= 3)) vr[k] = __builtin_nontemporal_load((const v4u*)(QKV + (trow0 + row - 3) * 4096 + 2048 + h * 256 + 8 * cg)); }
#pragma unroll
        for (int rr = 0; rr < 7; ++rr) { const int row = row0 - 3 + rr; rawv[rr] = (v4u){0u, 0u, 0u, 0u};
            if (n > 0 || row >= 0) rawv[rr] = __builtin_nontemporal_load((const v4u*)(QKV + (trow0 + row) * 4096 + ch)); }
#pragma unroll
        for (int j = 0; j < 4; ++j) { cwa[j] = *(const f32x4*)(F.conv_w + j * 4096 + ch); cwc[j] = *(const f32x4*)(F.conv_w + j * 4096 + ch + 4); }
        if (w == 0) { g_ld = ((const float*)(F.ws + WS_G))[(trow0 + lane) * 8 + h]; b_ld = ((const float*)(F.ws + WS_BETA))[(trow0 + lane) * 8 + h]; }
        asm volatile("" ::: "memory");
#pragma unroll
        for (int k = 0; k < 5; ++k) { const int idx = tid + 512 * k, row = idx >> 5, cg = idx & 31; if (row < 67) *(LAS v4u*)(L + GP_VR + row * 512 + cg * 16) = vr[k]; }
    }
    if (w == 0) {
        float g = g_ld;
#pragma unroll
        for (int o = 1; o < 64; o <<= 1) { const float t = __shfl_up(g, o); if (lane >= o) g += t; }
        gcs[lane] = g; bet[lane] = b_ld;
        if (lane == 63) __hip_atomic_store((unsigned*)(F.ws + WS_DL) + ci, __builtin_bit_cast(unsigned, expf(g)), RLX_AGENT);
    }
    __syncthreads();
    CYC_START(5);
    for (int pr_ = 0; pr_ < (PROBE_PREP == 1 ? 2 : 1); ++pr_) {
        float cw[4][8];
#pragma unroll
        for (int j = 0; j < 4; ++j) { const f32x4 a = cwa[j], c = cwc[j];
            cw[j][0] = a.x; cw[j][1] = a.y; cw[j][2] = a.z; cw[j][3] = a.w; cw[j][4] = c.x; cw[j][5] = c.y; cw[j][6] = c.z; cw[j][7] = c.w; }
        float raw[7][8];
#pragma unroll
        for (int rr = 0; rr < 7; ++rr) { const v4u v = rawv[rr];
#pragma unroll
            for (int e = 0; e < 4; ++e) { raw[rr][2 * e] = bflo(v[e]); raw[rr][2 * e + 1] = bfhi(v[e]); } }
        const float g63 = gcs[63];
#pragma unroll
        for (int r = 0; r < 4; ++r) { asm volatile("" ::: "memory"); const int row = row0 + r; float val[8]; float ss = 0.f;
#pragma unroll
            for (int e = 0; e < 8; ++e) { const float a = raw[r][e] * cw[0][e] + raw[r + 1][e] * cw[1][e] + raw[r + 2][e] * cw[2][e] + raw[r + 3][e] * cw[3][e];
                val[e] = silu_f(a); ss += val[e] * val[e]; }
            ss += __shfl_xor(ss, 1); ss += __shfl_xor(ss, 2); ss += __shfl_xor(ss, 4); ss += __shfl_xor(ss, 8);
            const float rn = rsqrtf(ss + EPS) * (isk ? 1.0f : 0.08838834764831845f);
            const float gc = gcs[row], eg = __expf(gc);
#pragma unroll
            for (int e = 0; e < 8; ++e) val[e] *= rn;
            v4u pk; pk.x = pk2(val[0], val[1]); pk.y = pk2(val[2], val[3]); pk.z = pk2(val[4], val[5]); pk.w = pk2(val[6], val[7]);
            *(LAS v4u*)(L + (isk ? GP_KH : GP_QH) + row * 272 + dk0 * 2) = pk;
            if (!isk) {
                v4u qs; qs.x = pk2(val[0] * eg, val[1] * eg); qs.y = pk2(val[2] * eg, val[3] * eg); qs.z = pk2(val[4] * eg, val[5] * eg); qs.w = pk2(val[6] * eg, val[7] * eg);
                *(LAS v4u*)(L + GP_QS + row * 272 + dk0 * 2) = qs;
            } else {
                const float bt = bet[row] * eg;
                f32x4 r0 = {val[0] * bt, val[1] * bt, val[2] * bt, val[3] * bt}, r1 = {val[4] * bt, val[5] * bt, val[6] * bt, val[7] * bt};
                *(LAS f32x4*)(Rk + row * 128 + dk0) = r0; *(LAS f32x4*)(Rk + row * 128 + dk0 + 4) = r1;
                const float ek = __expf(g63 - gc);
#pragma unroll
                for (int e = 0; e < 8; ++e) raw[r][e] = val[e] * ek;
            }
        }
        if (isk) {
#pragma unroll
            for (int e = 0; e < 8; ++e) { v2u t; t.x = pk2(raw[0][e], raw[1][e]); t.y = pk2(raw[2][e], raw[3][e]); *(LAS v2u*)(L + GP_KS + (dk0 + e) * 136 + row0 * 2) = t; }
        }
    }
    __syncthreads();
    CYC_STOP(5); CYC_START(7);
    if (w >= 6) {
        const int r = lane & 31, hh = lane >> 5;
#pragma unroll 4
        for (int q = 0; q < 8; ++q) { const int f = 2 * q + (w - 6);
            { const int ti = f >> 3, td = (f >> 1) & 3, s2 = f & 1;
              const LAS unsigned char* src = L + GP_QS + (32 * ti + r) * 272 + (32 * td + 16 * s2 + 4 * hh) * 2;
              const v2u lo = *(const LAS v2u*)src, hi = *(const LAS v2u*)(src + 16);
              st16_wt(GQ + ((size_t)ci * 16 + f) * 512 + lane * 8, (v4u){lo.x, lo.y, hi.x, hi.y}); }
            { const int td = f >> 2, tj = (f >> 1) & 1, s1 = f & 1;
              const LAS unsigned char* src = L + GP_KS + (32 * td + r) * 136 + (32 * tj + 16 * s1 + 4 * hh) * 2;
              const v2u lo = *(const LAS v2u*)src, hi = *(const LAS v2u*)(src + 16);
              st16_wt(GK + ((size_t)ci * 16 + f) * 512 + lane * 8, (v4u){lo.x, lo.y, hi.x, hi.y}); } }
    }
    for (int pr_ = 0; pr_ < (PROBE_PREP == 2 ? 2 : 1); ++pr_) if (w < 6) {
        const int tsel = w % 3, ti = tsel == 0 ? 0 : 1, tj = tsel == 2 ? 1 : 0;
        const int r = lane & 31, hh = lane >> 5;
        f32x16 acc = zero16();
        if (w < 3) {
            f32x16 acc2 = zero16();
#pragma unroll
            for (int kb = 0; kb < 8; ++kb) { const bf16x8 a = *(const LAS bf16x8*)(L + GP_KH + (32 * ti + r) * 272 + (16 * kb + 8 * hh) * 2), bb = *(const LAS bf16x8*)(L + GP_KH + (32 * tj + r) * 272 + (16 * kb + 8 * hh) * 2);
                acc = MFMA32(a, bb, acc); if (w == 1) acc2 = MFMA32(bb, a, acc2); }
            if (w == 1) {
                const float gi = gcs[32 + r], bi = bet[32 + r];
                float v_[16];
#pragma unroll
                for (int q = 0; q < 16; ++q) { const int jj = (q & 3) + 8 * (q >> 2) + 4 * hh; v_[q] = bi * acc2[q] * __expf(fminf(gi - gcs[jj], 0.f)); }
#pragma unroll
                for (int s2 = 0; s2 < 2; ++s2) { v4u fh, fl;
#pragma unroll
                    for (int d = 0; d < 4; ++d) { const float v0 = v_[8 * s2 + 2 * d], v1 = v_[8 * s2 + 2 * d + 1]; const unsigned ph = pk2(v0, v1);
                        fh[d] = ph; fl[d] = pk2(v0 - __builtin_bit_cast(float, ph << 16), v1 - __builtin_bit_cast(float, ph & 0xffff0000u)); }
                    *(LAS v4u*)(L + GP_AH + s2 * 1024 + lane * 16) = fh; *(LAS v4u*)(L + GP_AL + s2 * 1024 + lane * 16) = fl; }
            }
            const int j = 32 * tj + r; const float gj = gcs[j];
#pragma unroll
            for (int q = 0; q < 16; ++q) { const int i = 32 * ti + (q & 3) + 8 * (q >> 2) + 4 * hh;
                const float v = (i > j) ? bet[i] * acc[q] * __expf(fminf(gcs[i] - gj, 0.f)) : 0.f; Am[i * 64 + j] = v; }
        } else {
#pragma unroll
            for (int kb = 0; kb < 8; ++kb) { const bf16x8 a = *(const LAS bf16x8*)(L + GP_KH + (32 * tj + r) * 272 + (16 * kb + 8 * hh) * 2), bb = *(const LAS bf16x8*)(L + GP_QH + (32 * ti + r) * 272 + (16 * kb + 8 * hh) * 2);
                acc = MFMA32(a, bb, acc); }
            const int i = 32 * ti + r; const float gi = gcs[i];
#pragma unroll
            for (int q = 0; q < 16; ++q) { const int j = 32 * tj + (q & 3) + 8 * (q >> 2) + 4 * hh;
                acc[q] = (i >= j) ? acc[q] * __expf(fminf(gi - gcs[j], 0.f)) : 0.f; }
            const bf16x8 f0 = PACK_STEP(acc, 0), f1 = PACK_STEP(acc, 1);
            const size_t f = (((size_t)ci * 2 + ti) * 2 + tj) * 2;
            st16_wt(GA + f * 512 + lane * 8, __builtin_bit_cast(v4u, f0)); st16_wt(GA + (f + 1) * 512 + lane * 8, __builtin_bit_cast(v4u, f1));
        }
    }
    __syncthreads();
    CYC_STOP(7); CYC_START(4); CYC_START(2);
    float x[64];
    for (int pr_ = 0; pr_ < (PROBE_PREP == 3 ? 2 : 1); ++pr_) if (tid < 384) {
        for (int pr2_ = 0; pr2_ < (PROBE_PREP == 4 ? 2 : 1); ++pr2_) { asm volatile("" ::: "memory");
        if (tid < 256) {
            const int ch = 2048 + h * 256 + tid;
            const float c0 = F.conv_w[ch], c1 = F.conv_w[4096 + ch], c2 = F.conv_w[2 * 4096 + ch], c3 = F.conv_w[3 * 4096 + ch];
            const LAS unsigned short* vcol = (const LAS unsigned short*)(L + GP_VR) + tid;
            float r0 = bf2f(vcol[0]), r1 = bf2f(vcol[256]), r2 = bf2f(vcol[512]);
#pragma unroll
            for (int i = 0; i < 64; ++i) { const float r3 = bf2f(vcol[(i + 3) * 256]); const float a = r0 * c0 + r1 * c1 + r2 * c2 + r3 * c3; r0 = r1; r1 = r2; r2 = r3;
                x[i] = bet[i] * silu_f(a); }
        } else {
#pragma unroll
            for (int i = 0; i < 64; ++i) x[i] = Rk[i * 128 + (tid - 256)];
        } }
        CYC_STOP(2); CYC_START(1);
#pragma unroll
        for (int ib = 0; ib < 16; ++ib) {
            if (ib == 8) {
                unsigned PH[2][2][4], PL[2][2][4];
#pragma unroll
                for (int s2 = 0; s2 < 2; ++s2)
#pragma unroll
                    for (int h2 = 0; h2 < 2; ++h2)
#pragma unroll
                        for (int d = 0; d < 4; ++d) { const int j0 = 16 * s2 + 8 * (d >> 1) + 4 * h2 + 2 * (d & 1); const float v0 = x[j0], v1 = x[j0 + 1]; const unsigned ph = pk2(v0, v1);
                            PH[s2][h2][d] = ph; PL[s2][h2][d] = pk2(v0 - __builtin_bit_cast(float, ph << 16), v1 - __builtin_bit_cast(float, ph & 0xffff0000u)); }
#pragma unroll
                for (int s2 = 0; s2 < 2; ++s2)
#pragma unroll
                    for (int d = 0; d < 4; ++d) { auto rh_ = __builtin_amdgcn_permlane32_swap(PH[s2][0][d], PH[s2][1][d], false, false); PH[s2][0][d] = rh_[0]; PH[s2][1][d] = rh_[1];
                        auto rl_ = __builtin_amdgcn_permlane32_swap(PL[s2][0][d], PL[s2][1][d], false, false); PL[s2][0][d] = rl_[0]; PL[s2][1][d] = rl_[1]; }
                f32x16 c0 = zero16(), c1 = zero16();
#pragma unroll
                for (int s2 = 0; s2 < 2; ++s2) { const bf16x8 ah = *(const LAS bf16x8*)(L + GP_AH + s2 * 1024 + lane * 16), al = *(const LAS bf16x8*)(L + GP_AL + s2 * 1024 + lane * 16);
                    const bf16x8 bh0 = __builtin_bit_cast(bf16x8, (v4u){PH[s2][0][0], PH[s2][0][1], PH[s2][0][2], PH[s2][0][3]}), bl0 = __builtin_bit_cast(bf16x8, (v4u){PL[s2][0][0], PL[s2][0][1], PL[s2][0][2], PL[s2][0][3]});
                    const bf16x8 bh1 = __builtin_bit_cast(bf16x8, (v4u){PH[s2][1][0], PH[s2][1][1], PH[s2][1][2], PH[s2][1][3]}), bl1 = __builtin_bit_cast(bf16x8, (v4u){PL[s2][1][0], PL[s2][1][1], PL[s2][1][2], PL[s2][1][3]});
                    c0 = MFMA32(ah, bh0, c0); c1 = MFMA32(ah, bh1, c1); c0 = MFMA32(ah, bl0, c0); c1 = MFMA32(ah, bl1, c1); c0 = MFMA32(al, bh0, c0); c1 = MFMA32(al, bh1, c1); }
#pragma unroll
                for (int q = 0; q < 16; ++q) { const float f0_ = c0[q], f1_ = c1[q]; const unsigned u0_ = __builtin_bit_cast(unsigned, f0_), u1_ = __builtin_bit_cast(unsigned, f1_);
                    auto rr_ = __builtin_amdgcn_permlane32_swap(u0_, u1_, false, false);
                    const unsigned n0_ = rr_[0], n1_ = rr_[1]; x[32 + (q & 3) + 8 * (q >> 2)] -= __builtin_bit_cast(float, n0_); x[32 + (q & 3) + 8 * (q >> 2) + 4] -= __builtin_bit_cast(float, n1_); }
            }
            float a0 = 0.f, a1 = 0.f, a2 = 0.f, a3 = 0.f, b0 = 0.f, b1 = 0.f, b2 = 0.f, b3 = 0.f;
#pragma unroll
            for (int q = (ib >= 8 ? 8 : 0); q < ib; ++q) {
                if ((q & 3) == 0) asm volatile("" ::: "memory");
                const f32x4 r0 = *(const LAS f32x4*)(Am + (4 * ib + 0) * 64 + 4 * q), r1 = *(const LAS f32x4*)(Am + (4 * ib + 1) * 64 + 4 * q),
                            r2 = *(const LAS f32x4*)(Am + (4 * ib + 2) * 64 + 4 * q), r3 = *(const LAS f32x4*)(Am + (4 * ib + 3) * 64 + 4 * q);
                FMAC_V(a0, r0.x, x[4 * q]); FMAC_V(a1, r1.x, x[4 * q]); FMAC_V(a2, r2.x, x[4 * q]); FMAC_V(a3, r3.x, x[4 * q]);
                FMAC_V(b0, r0.y, x[4 * q + 1]); FMAC_V(b1, r1.y, x[4 * q + 1]); FMAC_V(b2, r2.y, x[4 * q + 1]); FMAC_V(b3, r3.y, x[4 * q + 1]);
                FMAC_V(a0, r0.z, x[4 * q + 2]); FMAC_V(a1, r1.z, x[4 * q + 2]); FMAC_V(a2, r2.z, x[4 * q + 2]); FMAC_V(a3, r3.z, x[4 * q + 2]);
                FMAC_V(b0, r0.w, x[4 * q + 3]); FMAC_V(b1, r1.w, x[4 * q + 3]); FMAC_V(b2, r2.w, x[4 * q + 3]); FMAC_V(b3, r3.w, x[4 * q + 3]); }
            asm volatile("" ::: "memory");
            const f32x4 d1 = *(const LAS f32x4*)(Am + (4 * ib + 1) * 64 + 4 * ib), d2 = *(const LAS f32x4*)(Am + (4 * ib + 2) * 64 + 4 * ib), d3 = *(const LAS f32x4*)(Am + (4 * ib + 3) * 64 + 4 * ib);
            ADD_V(a0, b0); ADD_V(a1, b1); ADD_V(a2, b2); ADD_V(a3, b3);
            float x0 = x[4 * ib]; SUB_V(x0, a0);
            FMAC_V(a1, d1.x, x0); float x1 = x[4 * ib + 1]; SUB_V(x1, a1);
            FMAC_V(a2, d2.x, x0); FMAC_V(a2, d2.y, x1); float x2 = x[4 * ib + 2]; SUB_V(x2, a2);
            FMAC_V(a3, d3.x, x0); FMAC_V(a3, d3.y, x1); FMAC_V(a3, d3.z, x2); float x3 = x[4 * ib + 3]; SUB_V(x3, a3);
            x[4 * ib] = x0; x[4 * ib + 1] = x1; x[4 * ib + 2] = x2; x[4 * ib + 3] = x3; }
        asm volatile("" : "+v"(x[60]), "+v"(x[61]), "+v"(x[62]), "+v"(x[63])); CYC_STOP(1); CYC_START(3);
        if (tid < 256) {
            const int sl = tid >> 5, col = tid & 31;
#pragma unroll
            for (int ti = 0; ti < 2; ++ti)
#pragma unroll
                for (int hh = 0; hh < 2; ++hh) { v4u a, c;
#define XR(q) x[32 * ti + ((q) & 3) + 8 * ((q) >> 2) + 4 * hh]
                    a.x = pk2(XR(0), XR(1)); a.y = pk2(XR(2), XR(3)); a.z = pk2(XR(4), XR(5)); a.w = pk2(XR(6), XR(7));
                    c.x = pk2(XR(8), XR(9)); c.y = pk2(XR(10), XR(11)); c.z = pk2(XR(12), XR(13)); c.w = pk2(XR(14), XR(15));
#undef XR
                    bf16* p = GU + (((size_t)ci * 8 + sl) * 2 + ti) * 1024 + (hh * 32 + col) * 16;
                    st16_wt(p, a); st16_wt(p + 8, c); }
        }
    }
    CYC_STOP(3); CYC_STOP(4); CYC_START(8);
    __syncthreads();
    if (tid >= 256 && tid < 384) { const int dk = tid - 256;
#pragma unroll
        for (int i = 0; i < 64; ++i) *(LAS unsigned short*)(L + GP_WL + i * 272 + dk * 2) = (unsigned short)f2bf(-x[i]); }
    __syncthreads();
#pragma unroll
    for (int k = 0; k < 2; ++k) { const int f = 2 * w + k, ti = f >> 3, td = (f >> 1) & 3, s2 = f & 1, r = lane & 31, hh = lane >> 5;
        const LAS unsigned char* src = L + GP_WL + (32 * ti + r) * 272 + (32 * td + 16 * s2 + 4 * hh) * 2;
        const v2u lo = *(const LAS v2u*)src, hi = *(const LAS v2u*)(src + 16);
        st16_wt(GW + ((size_t)ci * 16 + f) * 512 + lane * 8, (v4u){lo.x, lo.y, hi.x, hi.y}); }
    asm volatile("s_waitcnt vmcnt(0)" ::: "memory");
    __syncthreads();
    CYC_STOP(8); CYC_STOP(6);
    if (tid == 0) __hip_atomic_store((unsigned*)(F.ws + WS_CTL) + CW_RDY + ci, 1u, RLX_AGENT);
#if GDN_LTOUCH
    { const int m = ((n * 203) >> 8) + GT_LOOK;
      if (m < n && m < 128) { const size_t cm = (size_t)bh * 128 + m;
        const unsigned char* p = tid < 384 ? F.ws + (tid < 128 ? WS_GW : tid < 256 ? WS_GQ : WS_GK) + cm * 16384 + (size_t)(tid & 127) * 128 : F.ws + WS_GU + cm * 32768 + (size_t)(tid - 384) * 128;
        __builtin_amdgcn_global_load_lds((const unsigned*)p, (LAS unsigned*)(L + GP_PF + w * 256), 4, 0, 0);
        if (w < 3) { const unsigned char* p2 = tid < 128 ? F.ws + WS_GU + cm * 32768 + (size_t)(128 + tid) * 128 : F.ws + WS_GA + cm * 8192 + (size_t)(tid - 128) * 128;
          if (tid < 192) __builtin_amdgcn_global_load_lds((const unsigned*)p2, (LAS unsigned*)(L + GP_PF + w * 256), 4, 0, 0); } } }
#endif
}

constexpr int GS_BUF = 48 * 1024, GS_GA = 3 * GS_BUF;
__device__ __forceinline__ void gdn_scan_wg(Frame& F, int bh, int half, unsigned* prog) {
    unsigned long long seg_t0_ = 0, seg_t1_ = 0, seg_acc_ = 0; (void)seg_t0_; (void)seg_t1_; (void)seg_acc_;
    const int w = F.wave, b = bh >> 3, h = bh & 7;
    const bf16* GW = (const bf16*)(F.ws + WS_GW); const bf16* GQ = (const bf16*)(F.ws + WS_GQ); const bf16* GK = (const bf16*)(F.ws + WS_GK); const bf16* GA = (const bf16*)(F.ws + WS_GA); const bf16* GU = (const bf16*)(F.ws + WS_GU);
    LAS unsigned char* L = F.lds;
    if (w >= 4) {
        const int lw = w - 4, lane = pg8::pg8_lane_id();
        const bf16* pw = GW + ((size_t)bh * 128 * 16 + lw) * 512; const bf16* pq = GQ + ((size_t)bh * 128 * 16 + lw) * 512; const bf16* pk = GK + ((size_t)bh * 128 * 16 + lw) * 512;
        int bi = 0;
        const unsigned* rdy = (const unsigned*)(F.ws + WS_CTL) + CW_RDY + bh * 128;
        for (int c = 0; c < 130; ++c) { SEG_T0(3);
            if ((c & 7) == 0 && c < 128) {
                for (int spin = 0; spin < (1 << 22); ++spin) { const unsigned f = lane < 8 ? __hip_atomic_load(rdy + c + (lane & 7), RLX_AGENT) : 1u;
                    if (__all(f != 0u)) break; __builtin_amdgcn_s_sleep(8); }
                __builtin_amdgcn_fence(__ATOMIC_ACQUIRE, "agent"); asm volatile("s_waitcnt vmcnt(0)" ::: "memory"); }
            if (c >= 1 && c - 1 < 128 && lw < 3) { const size_t ci = (size_t)bh * 128 + (c - 1); LAS unsigned char* dst = L + GS_GA + ((c - 1) & 1) * 6144;
#pragma unroll
                for (int q = 0; q < 2; ++q) { const int f = 2 * lw + q, gaf = f < 2 ? f : f + 2; glds1k(GA + (ci * 8 + gaf) * 512, dst + f * 1024, lane); } }
            if (c < 128) { dma_chunk3(pw, pq, pk, L + bi * GS_BUF + lw * 1024, lane); pw += 8192; pq += 8192; pk += 8192; }
            if (lw == 0 && half == 0 && lane == 0 && c >= 1) __hip_atomic_store(prog, (unsigned)c, __ATOMIC_RELAXED, __HIP_MEMORY_SCOPE_AGENT);
            bi = bi == 2 ? 0 : bi + 1;
            SEG_ACC(3); if (c >= 1) { SEG_T0(4); if (c < 128) asm volatile(VMCNT12 ::: "memory"); else asm volatile("s_waitcnt vmcnt(0)" ::: "memory"); SEG_ACC(4); SEG_T0(5);
                __builtin_amdgcn_s_barrier(); asm volatile("" ::: "memory"); SEG_ACC(5); }
        }
        SEG_OUT();
        return;
    }
    const int sl = 4 * half + w, lane = pg8::pg8_lane_id(), col = lane & 31, hh = lane >> 5;
    const float* DL = (const float*)(F.ws + WS_DL);
    bf16* OA = (bf16*)(F.ws + WS_GU) + ((size_t)bh * 128 * 8 + sl) * 2048;
    LAS unsigned char* SB = L + 161792 + w * 512; const unsigned stoff = (unsigned)(4 * hh * 64 + col * 2);
    f32x16 S[4];
#pragma unroll
    for (int td = 0; td < 4; ++td) S[td] = zero16();
    v4u uc[2][2]; float dln;
    SCAN_BAR_C();
    { const size_t ci = (size_t)bh * 128; dln = DL[ci];
      const bf16* p = GU + ((ci * 8 + sl) * 2 + 0) * 1024 + lane * 16; uc[0][0] = *(const v4u*)p; uc[0][1] = *(const v4u*)(p + 8); }
    int cb = 0;
    for (int n = 0; n < 128; ++n) { SEG_T02(1);
        const LAS unsigned char* B = L + cb * GS_BUF; cb = cb == 2 ? 0 : cb + 1;
        const LAS unsigned char* GAb = L + GS_GA + (n & 1) * 6144;
#if GDN_PREFETCH
        const float dl = dln;
#else
        float dl; { const size_t ci = (size_t)bh * 128 + n; dl = DL[ci]; const bf16* p = GU + ((ci * 8 + sl) * 2 + 0) * 1024 + lane * 16; uc[0][0] = *(const v4u*)p; uc[0][1] = *(const v4u*)(p + 8); }
#endif
#define WSLOT(ti, td, s2) (((ti) * 4 + (td)) * 2 + (s2))
#define GKSLOT(k) (32 + (k))
#define LDWQ(dst, ti, td) LD4(dst, B, WSLOT(ti, td, 0), WSLOT(ti, td, 1), 16 + WSLOT(ti, td, 0), 16 + WSLOT(ti, td, 1))
#define ADD_U(v, ti) do { _Pragma("unroll") for (int e = 0; e < 4; ++e) { v[2 * e] += bflo(uc[ti][0][e]); v[2 * e + 1] += bfhi(uc[ti][0][e]); v[8 + 2 * e] += bflo(uc[ti][1][e]); v[8 + 2 * e + 1] += bfhi(uc[ti][1][e]); } } while (0)
#define HALF_TD(F_, td, vnx, ox) { const bf16x8 sb0 = PACK_STEP(S[td], 0), sb1 = PACK_STEP(S[td], 1); \
          vnx = MFMA32(F_[0], sb0, vnx); vnx = MFMA32(F_[1], sb1, vnx); ox = MFMA32(F_[2], sb0, ox); ox = MFMA32(F_[3], sb1, ox); }
        bf16x8 fa[4], fb[4];
        bf16x8 vb00, vb01, vb10, vb11;
        bf16* orow = OA + (size_t)n * (8 * 2048);
#define STORE_O(ox, rowoff) do { _Pragma("unroll") for (int k_ = 0; k_ < 4; ++k_) { \
            _Pragma("unroll") for (int q_ = 0; q_ < 4; ++q_) { *(LAS bf16*)(SB + q_ * 64 + stoff) = cvt1_bf16(ox[4 * k_ + q_]); } \
            const v2u t_ = *(const LAS v2u*)(SB + lane * 8); *(v2u*)(orow + (rowoff) + (8 * k_) * 32 + lane * 4) = t_; } } while (0)
#define S_TD(F_, td) { S[td] = MFMA32(F_[0], vb00, S[td]); S[td] = MFMA32(F_[1], vb01, S[td]); S[td] = MFMA32(F_[2], vb10, S[td]); S[td] = MFMA32(F_[3], vb11, S[td]); }
        f32x16 vn0 = zero16(), o0 = zero16();
        LDWQ(fa, 0, 0); LDWQ(fb, 0, 1); HALF_TD(fa, 0, vn0, o0)
        LDWQ(fa, 0, 2); HALF_TD(fb, 1, vn0, o0)
        LDWQ(fb, 0, 3); HALF_TD(fa, 2, vn0, o0)
        PIN(); fa[0] = ldsfrag(GAb, 0, lane); fa[1] = ldsfrag(GAb, 1, lane); PIN(); HALF_TD(fb, 3, vn0, o0)
        ADD_U(vn0, 0); vb00 = PACK_STEP(vn0, 0); vb01 = PACK_STEP(vn0, 1);
        LDWQ(fb, 1, 0);
        o0 = MFMA32(fa[0], vb00, o0); o0 = MFMA32(fa[1], vb01, o0);
        { const size_t ci = (size_t)bh * 128 + n; const bf16* p = GU + ((ci * 8 + sl) * 2 + 1) * 1024 + lane * 16; uc[1][0] = *(const v4u*)p; uc[1][1] = *(const v4u*)(p + 8); }
#if GDN_PREFETCH
        if (n + 1 < 128) { const size_t ci = (size_t)bh * 128 + n + 1; dln = DL[ci];
          const bf16* p = GU + ((ci * 8 + sl) * 2 + 0) * 1024 + lane * 16; uc[0][0] = *(const v4u*)p; uc[0][1] = *(const v4u*)(p + 8); }
#endif
        f32x16 vn1 = zero16(), o1 = zero16();
        LDWQ(fa, 1, 1); STORE_O(o0, 0u); HALF_TD(fb, 0, vn1, o1)
        LDWQ(fb, 1, 2); S[0] = S[0] * dl; HALF_TD(fa, 1, vn1, o1)
        LDWQ(fa, 1, 3); S[1] = S[1] * dl; HALF_TD(fb, 2, vn1, o1)
        LD4(fb, GAb, 2, 3, 4, 5); S[2] = S[2] * dl; HALF_TD(fa, 3, vn1, o1)
        ADD_U(vn1, 1); vb10 = PACK_STEP(vn1, 0); vb11 = PACK_STEP(vn1, 1);
        LD4(fa, B, GKSLOT(0), GKSLOT(1), GKSLOT(2), GKSLOT(3)); S[3] = S[3] * dl;
        o1 = MFMA32(fb[0], vb00, o1); o1 = MFMA32(fb[1], vb01, o1); o1 = MFMA32(fb[2], vb10, o1); o1 = MFMA32(fb[3], vb11, o1);
        LD4(fb, B, GKSLOT(4), GKSLOT(5), GKSLOT(6), GKSLOT(7)); S_TD(fa, 0)
        LD4(fa, B, GKSLOT(8), GKSLOT(9), GKSLOT(10), GKSLOT(11)); STORE_O(o1, 32u * 32u); S_TD(fb, 1)
        LD4(fb, B, GKSLOT(12), GKSLOT(13), GKSLOT(14), GKSLOT(15)); S_TD(fa, 2)
        PIN(); S_TD(fb, 3)
#undef STORE_O
#undef S_TD
#undef HALF_TD
        SEG_T0(2); SCAN_BAR_C(); SEG_ACC(2); SEG_ACC2(1);
    }
    SEG_OUT();
}

constexpr int PF_LOOK = 6;
__device__ __forceinline__ void scan_prefetcher(Frame& F, const unsigned* PROG, int bx) {
    const int xc = bx & 7, j = (bx - 64) >> 3;
    const v4u* RQf = (const v4u*)(F.ws + WS_RQF); const v4u* RKf = (const v4u*)(F.ws + WS_RKF); const v4u* RKTf = (const v4u*)(F.ws + WS_RKTF); const v4u* RVTf = (const v4u*)(F.ws + WS_RVTF);
    const v4u* GW = (const v4u*)(F.ws + WS_GW); const v4u* GQ = (const v4u*)(F.ws + WS_GQ); const v4u* GK = (const v4u*)(F.ws + WS_GK); const v4u* GA = (const v4u*)(F.ws + WS_GA); const v4u* GU = (const v4u*)(F.ws + WS_GU);
    const int tid = F.tid;
    for (int it = j; it < 4 * 128; it += 24) {
        const int st = it & 3, n = it >> 2, kind = st >> 1, bh = xc + 8 * (st & 1);
        const unsigned* pw = PROG + 64 * (kind * 16 + bh);
        for (int spin = 0; spin < 20000; ++spin) { if ((int)__hip_atomic_load(pw, __ATOMIC_RELAXED, __HIP_MEMORY_SCOPE_AGENT) + PF_LOOK >= n) break; __builtin_amdgcn_s_sleep(32); }
        const size_t c = (size_t)bh * 128 + n;
        v4u a[11];
        if (kind == 0) {
            a[0] = RQf[c * 1024 + tid]; a[1] = RQf[c * 1024 + 512 + tid]; a[2] = RKf[c * 1024 + tid]; a[3] = RKf[c * 1024 + 512 + tid]; a[4] = RKTf[c * 1024 + tid]; a[5] = RKTf[c * 1024 + 512 + tid];
            a[6] = RVTf[c * 2048 + tid]; a[7] = RVTf[c * 2048 + 512 + tid]; a[8] = RVTf[c * 2048 + 1024 + tid]; a[9] = RVTf[c * 2048 + 1536 + tid]; a[10] = a[9];
        } else {
            a[0] = GW[c * 1024 + tid]; a[1] = GW[c * 1024 + 512 + tid]; a[2] = GQ[c * 1024 + tid]; a[3] = GQ[c * 1024 + 512 + tid]; a[4] = GK[c * 1024 + tid]; a[5] = GK[c * 1024 + 512 + tid];
            a[6] = GU[c * 2048 + tid]; a[7] = GU[c * 2048 + 512 + tid]; a[8] = GU[c * 2048 + 1024 + tid]; a[9] = GU[c * 2048 + 1536 + tid]; a[10] = GA[c * 512 + tid];
        }
#pragma unroll
        for (int q = 0; q < 11; ++q) asm volatile("" :: "v"(a[q]));
    }
}

__device__ __forceinline__ void p3_mixed(Frame& F) {
    const int gw = F.vcu * NWAVES + F.wave, NGW = F.G * NWAVES, lane = F.lane, hd = lane >> 3, j = lane & 7;
    const bf16* OA = (const bf16*)(F.ws + WS_GU); const bf16* OB = (const bf16*)(F.ws + WS_RVTF);
    const bf16* GZA = (const bf16*)F.out; const bf16* GZB = GZA + (size_t)T * 2048; bf16* MIX = (bf16*)(F.ws + WS_MIXED);
    const float* wa = F.gdn_norm_w + 8 * j; const float* wb = F.ret_norm_w + hd * 256 + 8 * j;
    for (int row = gw; row < T; row += NGW) {
        const size_t off = (size_t)row * 2048 + hd * 256 + 8 * j;
        const int bq_ = row >> 13, tt = row & 8191;
        const size_t ooff = ((((size_t)(bq_ * 8 + hd) * 128 + (tt >> 6)) * 8 + (j >> 2)) * 64 + (tt & 63)) * 32 + 8 * (j & 3);
        v4u a4[4], b4[4], ga[4], gb[4];
#pragma unroll
        for (int k = 0; k < 4; ++k) { a4[k] = __builtin_nontemporal_load((const v4u*)(OA + ooff + (size_t)k * (2 * 64 * 32))); b4[k] = __builtin_nontemporal_load((const v4u*)(OB + ooff + (size_t)k * (2 * 64 * 32))); ga[k] = __builtin_nontemporal_load((const v4u*)(GZA + off + 64 * k)); gb[k] = __builtin_nontemporal_load((const v4u*)(GZB + off + 64 * k)); }
        float a[32], bb[32];
#pragma unroll
        for (int q = 0; q < 4; ++q)
#pragma unroll
            for (int e = 0; e < 4; ++e) { a[8 * q + 2 * e] = bflo(a4[q][e]); a[8 * q + 2 * e + 1] = bfhi(a4[q][e]); bb[8 * q + 2 * e] = bflo(b4[q][e]); bb[8 * q + 2 * e + 1] = bfhi(b4[q][e]); }
        float sa = 0.f, sb = 0.f;
#pragma unroll
        for (int i = 0; i < 32; ++i) { sa += a[i] * a[i]; sb += bb[i]; }
        sa += __shfl_xor(sa, 1); sa += __shfl_xor(sa, 2); sa += __shfl_xor(sa, 4);
        sb += __shfl_xor(sb, 1); sb += __shfl_xor(sb, 2); sb += __shfl_xor(sb, 4);
        const float rsa = rsqrtf(sa * (1.0f / 256.0f) + EPS), mu = sb * (1.0f / 256.0f);
        float vb = 0.f;
#pragma unroll
        for (int i = 0; i < 32; ++i) { bb[i] -= mu; vb += bb[i] * bb[i]; }
        vb += __shfl_xor(vb, 1); vb += __shfl_xor(vb, 2); vb += __shfl_xor(vb, 4);
        const float rsb = rsqrtf(vb * (1.0f / 256.0f) + EPS);
#pragma unroll
        for (int q = 0; q < 4; ++q) { v4u o;
#pragma unroll
            for (int e = 0; e < 4; ++e) { const int i = 8 * q + 2 * e, c = 64 * q + 2 * e;
                const float m0 = a[i] * rsa * wa[c] * bflo(ga[q][e]) + bb[i] * rsb * wb[c] * bflo(gb[q][e]);
                const float m1 = a[i + 1] * rsa * wa[c + 1] * bfhi(ga[q][e]) + bb[i + 1] * rsb * wb[c + 1] * bfhi(gb[q][e]);
                o[e] = pk2(m0, m1); }
            *(v4u*)(MIX + off + 64 * q) = o; }
    }
}
__device__ __forceinline__ void row_rmsnorm(Frame& F, const float* src, const float* w, bf16* dst16, float* dst32) {
    const int gw = F.vcu * NWAVES + F.wave, NGW = F.G * NWAVES, lane = F.lane;
    f32x4 nw[8];
#pragma unroll
    for (int j = 0; j < 8; ++j) nw[j] = ((const f32x4*)w)[64 * j + lane];
    for (int row = gw; row < T; row += 2 * NGW) {
        const f32x4* xr0 = (const f32x4*)(src + (size_t)row * D) + lane; const f32x4* xr1 = (const f32x4*)(src + (size_t)(row + NGW) * D) + lane;
        f32x4 v0[8], v1[8]; float s0 = 0.f, s1 = 0.f;
#pragma unroll
        for (int j = 0; j < 8; ++j) { v0[j] = xr0[64 * j]; v1[j] = xr1[64 * j]; }
#pragma unroll
        for (int j = 0; j < 8; ++j) { s0 += (v0[j].x * v0[j].x + v0[j].y * v0[j].y) + (v0[j].z * v0[j].z + v0[j].w * v0[j].w); s1 += (v1[j].x * v1[j].x + v1[j].y * v1[j].y) + (v1[j].z * v1[j].z + v1[j].w * v1[j].w); }
        const float r0 = rsqrtf(wave_sum(s0) * (1.0f / D) + EPS), r1 = rsqrtf(wave_sum(s1) * (1.0f / D) + EPS);
        if (dst16) { v2u* o0 = (v2u*)(dst16 + (size_t)row * D) + lane; v2u* o1 = (v2u*)(dst16 + (size_t)(row + NGW) * D) + lane;
#pragma unroll
            for (int j = 0; j < 8; ++j) { const f32x4 y0 = (v0[j] * r0) * nw[j], y1 = (v1[j] * r1) * nw[j]; v2u o; o.x = pk2(y0.x, y0.y); o.y = pk2(y0.z, y0.w); o0[64 * j] = o; o.x = pk2(y1.x, y1.y); o.y = pk2(y1.z, y1.w); o1[64 * j] = o; } }
        else { f32x4* o0 = (f32x4*)(dst32 + (size_t)row * D) + lane; f32x4* o1 = (f32x4*)(dst32 + (size_t)(row + NGW) * D) + lane;
#pragma unroll
            for (int j = 0; j < 8; ++j) { o0[64 * j] = (v0[j] * r0) * nw[j]; o1[64 * j] = (v1[j] * r1) * nw[j]; } }
    }
}

__device__ __forceinline__ void row_rmsnorm_out(Frame& F, const bf16* src, const float* w, float* dst32) {
    const int gw = F.vcu * NWAVES + F.wave, NGW = F.G * NWAVES, lane = F.lane;
    f32x4 wv[8];
#pragma unroll
    for (int k = 0; k < 8; ++k) wv[k] = *(const f32x4*)(w + 256 * k + 4 * lane);
    for (int row = gw; row < T; row += 2 * NGW) {
        const size_t o0 = (size_t)row * D + 4 * lane, o1 = (size_t)(row + NGW) * D + 4 * lane;
        v2u a[8], b[8];
#pragma unroll
        for (int k = 0; k < 8; ++k) { a[k] = __builtin_nontemporal_load((const v2u*)(src + o0 + 256 * k)); b[k] = __builtin_nontemporal_load((const v2u*)(src + o1 + 256 * k)); }
        f32x4 x0[8], x1[8]; float s0 = 0.f, s1 = 0.f;
#pragma unroll
        for (int k = 0; k < 8; ++k) { x0[k] = (f32x4){bflo(a[k].x), bfhi(a[k].x), bflo(a[k].y), bfhi(a[k].y)}; x1[k] = (f32x4){bflo(b[k].x), bfhi(b[k].x), bflo(b[k].y), bfhi(b[k].y)};
            s0 += (x0[k].x * x0[k].x + x0[k].y * x0[k].y) + (x0[k].z * x0[k].z + x0[k].w * x0[k].w); s1 += (x1[k].x * x1[k].x + x1[k].y * x1[k].y) + (x1[k].z * x1[k].z + x1[k].w * x1[k].w); }
        const float r0 = rsqrtf(wave_sum(s0) * (1.0f / D) + EPS), r1 = rsqrtf(wave_sum(s1) * (1.0f / D) + EPS);
#pragma unroll
        for (int k = 0; k < 8; ++k) { __builtin_nontemporal_store(x0[k] * r0 * wv[k], (f32x4*)(dst32 + o0 + 256 * k)); __builtin_nontemporal_store(x1[k] * r1 * wv[k], (f32x4*)(dst32 + o1 + 256 * k)); }
    }
}
__device__ __forceinline__ void row_rmsnorm16(Frame& F, const bf16* src, const float* w, bf16* dst16, float* dst32) {
    const int gw = F.vcu * NWAVES + F.wave, NGW = F.G * NWAVES, lane = F.lane;
    const float* wl = w + 32 * lane;
    for (int row = gw; row < T; row += 2 * NGW) {
        const size_t o0 = (size_t)row * D + 32 * lane, o1 = (size_t)(row + NGW) * D + 32 * lane;
        v4u a[4], b[4];
#pragma unroll
        for (int q = 0; q < 4; ++q) { a[q] = *(const v4u*)(src + o0 + 8 * q); b[q] = *(const v4u*)(src + o1 + 8 * q); }
        float x0[32], x1[32]; float s0 = 0.f, s1 = 0.f;
#pragma unroll
        for (int q = 0; q < 4; ++q)
#pragma unroll
            for (int e = 0; e < 4; ++e) { x0[8 * q + 2 * e] = bflo(a[q][e]); x0[8 * q + 2 * e + 1] = bfhi(a[q][e]); x1[8 * q + 2 * e] = bflo(b[q][e]); x1[8 * q + 2 * e + 1] = bfhi(b[q][e]); }
#pragma unroll
        for (int i = 0; i < 32; ++i) { s0 += x0[i] * x0[i]; s1 += x1[i] * x1[i]; }
        const float r0 = rsqrtf(wave_sum(s0) * (1.0f / D) + EPS), r1 = rsqrtf(wave_sum(s1) * (1.0f / D) + EPS);
#pragma unroll
        for (int q = 0; q < 4; ++q) { const f32x4 wa = *(const f32x4*)(wl + 8 * q), wb = *(const f32x4*)(wl + 8 * q + 4);
            const float wv[8] = {wa.x, wa.y, wa.z, wa.w, wb.x, wb.y, wb.z, wb.w};
            if (dst16) { v4u p0, p1;
#pragma unroll
                for (int e = 0; e < 4; ++e) { p0[e] = pk2(x0[8 * q + 2 * e] * r0 * wv[2 * e], x0[8 * q + 2 * e + 1] * r0 * wv[2 * e + 1]); p1[e] = pk2(x1[8 * q + 2 * e] * r1 * wv[2 * e], x1[8 * q + 2 * e + 1] * r1 * wv[2 * e + 1]); }
                *(v4u*)(dst16 + o0 + 8 * q) = p0; *(v4u*)(dst16 + o1 + 8 * q) = p1;
            } else {
                f32x4 y;
                y = (f32x4){x0[8 * q] * r0 * wv[0], x0[8 * q + 1] * r0 * wv[1], x0[8 * q + 2] * r0 * wv[2], x0[8 * q + 3] * r0 * wv[3]}; *(f32x4*)(dst32 + o0 + 8 * q) = y;
                y = (f32x4){x0[8 * q + 4] * r0 * wv[4], x0[8 * q + 5] * r0 * wv[5], x0[8 * q + 6] * r0 * wv[6], x0[8 * q + 7] * r0 * wv[7]}; *(f32x4*)(dst32 + o0 + 8 * q + 4) = y;
                y = (f32x4){x1[8 * q] * r1 * wv[0], x1[8 * q + 1] * r1 * wv[1], x1[8 * q + 2] * r1 * wv[2], x1[8 * q + 3] * r1 * wv[3]}; *(f32x4*)(dst32 + o1 + 8 * q) = y;
                y = (f32x4){x1[8 * q + 4] * r1 * wv[4], x1[8 * q + 5] * r1 * wv[5], x1[8 * q + 6] * r1 * wv[6], x1[8 * q + 7] * r1 * wv[7]}; *(f32x4*)(dst32 + o1 + 8 * q + 4) = y;
            } }
    }
}

__global__ void __launch_bounds__(NWAVES * 64, 2) fwd_kernel(Args args) {
    extern __shared__ __attribute__((aligned(16))) unsigned char lds[];
    Frame F;
    F.lds = (LAS unsigned char*)lds;
    F.tid = threadIdx.x; F.lane = F.tid & 63; F.wave = __builtin_amdgcn_readfirstlane(F.tid >> 6);
    F.G = gridDim.x; { const int bx = blockIdx.x; F.vcu = (F.G % 8 == 0) ? (bx % 8) * (F.G / 8) + bx / 8 : bx; }
    typedef const __attribute__((address_space(4))) Args* KArgs;
    const KArgs kap0 = (KArgs)__builtin_amdgcn_kernarg_segment_ptr();
#define LOADF() do { KArgs kap_ = kap0; asm volatile("" : "+s"(kap_)); \
        F.x = kap_->in[0]; F.norm1_w = kap_->in[1]; F.w_in = kap_->in[2]; F.conv_w = kap_->in[3]; F.a_log = kap_->in[4]; F.dt_bias = kap_->in[5]; F.gdn_norm_w = kap_->in[6]; \
        F.ret_norm_w = kap_->in[7]; F.w_out = kap_->in[8]; F.norm2_w = kap_->in[9]; F.w_gate = kap_->in[10]; F.w_up = kap_->in[11]; F.w_down = kap_->in[12]; F.norm_f_w = kap_->in[13]; \
        F.out = kap_->out; F.ws = kap_->ws; F.lane = pg8::pg8_lane_id(); F.tid = F.wave * 64 + F.lane; } while (0)
    LOADF();
    volatile LAS unsigned* MISC = (volatile LAS unsigned*)(F.lds + MISC_OFF);
    for (int u = F.tid; u < (LDS_BYTES - LDSCTL_OFF) / 4; u += NWAVES * 64) ((LAS unsigned*)(F.lds + LDSCTL_OFF))[u] = 0u;
    __syncthreads();
    const int lo = args.ph_lo, hi = args.ph_hi;
    const bool use_bar = (hi - lo) > 1;
    XcdBarrier bar; bar.bar = (unsigned*)(F.ws + WS_CTL) + CW_BAR; bar.x = 0; bar.st = nullptr; bar.w0 = 0;
    if (use_bar) bar = xcd_barrier_post((unsigned*)(F.ws + WS_CTL) + CW_BAR, MISC + 8, F.wave);
#ifndef PROBE_REP
#define PROBE_REP -1
#endif
#define NREP(k) ((PROBE_REP) == (k) ? 2 : 1)
#define IN(k) (lo <= (k) && (k) < hi)
#ifndef PROBE_TIME
#define PROBE_TIME -1
#endif
    volatile LAS unsigned long long* PT = (volatile LAS unsigned long long*)(F.lds + MISC_OFF + 64);
#define SEAM(k) do { if ((PROBE_TIME) == 20 + (k) && F.tid == 0) PT[0] = __builtin_amdgcn_s_memrealtime(); if (IN(k) && IN((k) + 1)) xcd_barrier(bar); if ((PROBE_TIME) == 20 + (k) && F.tid == 0) PT[1] = __builtin_amdgcn_s_memrealtime(); if ((PROBE_TIME) == (k) + 1 && F.tid == 0) PT[0] = __builtin_amdgcn_s_memrealtime(); if ((PROBE_TIME) == (k) && F.tid == 0) PT[1] = __builtin_amdgcn_s_memrealtime(); } while (0)

    if ((PROBE_TIME) == 0 && F.tid == 0) PT[0] = __builtin_amdgcn_s_memrealtime();
    if (IN(0)) for (int rep_ = 0; rep_ < NREP(0); ++rep_) { LOADF(); p0_prologue(F); } SEAM(0);
    if (IN(1)) for (int rep_ = 0; rep_ < NREP(1); ++rep_) { LOADF();
        pg8::Gemm g{(const pg8::bf16_t*)(F.ws + WS_U), (const pg8::bf16_t*)(F.ws + WS_W1T), T, N1, D}; pg8::InProjOrder S; S.init(T, N1, F.G, (int)blockIdx.x);
        pg8::EpiInProj E{F.ws, (pg8::bf16_t*)F.out, WS_QKV, WS_RQF, WS_RKF, WS_RKTF, WS_RVTF, WS_COS, WS_SIN, WS_COS2, WS_SIN2};
        pg8::gemm_phase<pg8::EpiInProj, pg8::InProjOrder, true, true>(F.lds, g, S, E, F.wave);
    } SEAM(1);
    if (IN(2)) { LOADF();
        const int bx = blockIdx.x;
#ifdef PROBE_ROLE
        const unsigned long long role_t0_ = __builtin_amdgcn_s_memrealtime();
#endif
        unsigned* PROG = (unsigned*)(F.ws + WS_CTL) + 16384;
        if (bx < 64) { const int x = bx & 31, xc = x & 7, y = x >> 3, bh = xc + 8 * (y >> 1), half = y & 1;
            if (bx < 32) ret_scan_wg(F, bh, half, PROG + 64 * (0 * 16 + bh)); else gdn_scan_wg(F, bh, half, PROG + 64 * (1 * 16 + bh));
        } else {
            for (int i = bx - 64; i < BATCH * NH * 128; i += F.G - 64) gdn_prep(F, (i & 15) * 128 + (i >> 4));
#define GDN_TAIL_TOUCH(mm) do { const int m_ = (mm); if (GDN_LTOUCH && m_ < 128) { const int tid_t = F.tid, w_t = F.wave; const size_t cm = (size_t)(bx & 15) * 128 + m_; \
                const unsigned char* p = tid_t < 384 ? F.ws + (tid_t < 128 ? WS_GW : tid_t < 256 ? WS_GQ : WS_GK) + cm * 16384 + (size_t)(tid_t & 127) * 128 : F.ws + WS_GU + cm * 32768 + (size_t)(tid_t - 384) * 128; \
                __builtin_amdgcn_global_load_lds((const unsigned*)p, (LAS unsigned*)(F.lds + 140288 + w_t * 256), 4, 0, 0); \
                if (w_t < 3) { const unsigned char* p2 = tid_t < 128 ? F.ws + WS_GU + cm * 32768 + (size_t)(128 + tid_t) * 128 : F.ws + WS_GA + cm * 8192 + (size_t)(tid_t - 128) * 128; \
                  if (tid_t < 192) __builtin_amdgcn_global_load_lds((const unsigned*)p2, (LAS unsigned*)(F.lds + 140288 + w_t * 256), 4, 0, 0); } } } while (0)
            asm volatile("s_waitcnt vmcnt(0)" ::: "memory"); wg_sync();
            GDN_TAIL_TOUCH(106 + ((bx - 64) >> 4));
            { LAS float* scr = (LAS float*)(F.lds + F.wave * 16640); const int lane_ = pg8::pg8_lane_id(); bf16* WDT = (bf16*)(F.ws + WS_WDT);
              for (int it = (bx - 64) * NWAVES + F.wave; it < (FF / 64) * (D / 64); it += (F.G - 64) * NWAVES) { const int nb = it % (D / 64), kb = it / (D / 64); transpose_blk(F.w_down, D, 64 * kb, 64 * nb, WDT, FF, 64 * nb, scr, lane_); } }
            GDN_TAIL_TOUCH(118 + ((bx - 64) >> 4)); asm volatile("s_waitcnt vmcnt(0)" ::: "memory");
        }
#ifdef PROBE_ROLE
        __syncthreads();
        if (pg8::pg8_lane_id() == 0 && F.wave == 0 && (bx < 32 ? 0 : bx < 64 ? 1 : 2) == (PROBE_ROLE)) __hip_atomic_fetch_max((unsigned*)(F.ws + WS_CTL) + 20001, (unsigned)(__builtin_amdgcn_s_memrealtime() - role_t0_), __ATOMIC_RELAXED, __HIP_MEMORY_SCOPE_AGENT);
#endif
    } SEAM(2); if ((PROBE_TIME) == 4 && F.tid == 0) PT[0] = __builtin_amdgcn_s_memrealtime();
    if (IN(4)) for (int rep_ = 0; rep_ < NREP(4); ++rep_) { LOADF(); p3_mixed(F); ffn_weight_copies(F); } SEAM(4);
    if (IN(5)) for (int rep_ = 0; rep_ < NREP(5); ++rep_) { LOADF();
        pg8::Gemm g{(const pg8::bf16_t*)(F.ws + WS_MIXED), (const pg8::bf16_t*)(F.ws + WS_WOT), T, D, D}; pg8::StaticOrder S; S.init(T, D, F.G, (int)blockIdx.x);
        pg8::EpiResBf16 E{F.x, nullptr, (pg8::bf16_t*)(F.ws + WS_H), D, (float*)(F.ws + WS_RSTD)};
        pg8::gemm_phase<pg8::EpiResBf16, pg8::StaticOrder, true, true>(F.lds, g, S, E, F.wave);
    } SEAM(5);
#if PROBE_TIME == 10
    if (F.tid == 0) PT[0] = __builtin_amdgcn_s_memrealtime(); xcd_barrier(bar); if (F.tid == 0) PT[1] = __builtin_amdgcn_s_memrealtime();
#endif
    if (IN(7)) for (int rep_ = 0; rep_ < NREP(7); ++rep_) { LOADF();
        pg8::Gemm g{(const pg8::bf16_t*)(F.ws + WS_H), (const pg8::bf16_t*)(F.ws + WS_WGUT), T, NGU, D}; pg8::StaticOrder S; S.init(T, NGU, F.G, (int)blockIdx.x);
        pg8::EpiGateUp E{(pg8::bf16_t*)(F.ws + WS_ACT), FF, (const float*)(F.ws + WS_RSTD)};
        pg8::gemm_phase<pg8::EpiGateUp, pg8::StaticOrder, true, true>(F.lds, g, S, E, F.wave);
    } SEAM(7);
    if (IN(8)) { LOADF();
        pg8::Gemm g{(const pg8::bf16_t*)(F.ws + WS_ACT), (const pg8::bf16_t*)(F.ws + WS_WDT), T, D, FF}; pg8::StaticOrder S; S.init(T, D, F.G, (int)blockIdx.x);
        pg8::EpiResBf16 E{nullptr, (const pg8::bf16_t*)(F.ws + WS_H), (pg8::bf16_t*)(F.ws + WS_H), D, nullptr};
        pg8::gemm_phase<pg8::EpiResBf16, pg8::StaticOrder, true, true>(F.lds, g, S, E, F.wave);
    } SEAM(8);
    if (IN(9)) { LOADF(); row_rmsnorm_out(F, (const bf16*)(F.ws + WS_H), F.norm_f_w, F.out); }
#if PROBE_TIME >= 0
    if (PROBE_TIME == 9 && F.tid == 0) PT[1] = __builtin_amdgcn_s_memrealtime();
    __syncthreads();
    if (F.vcu == 0 && F.tid == 0) { asm volatile("s_waitcnt vmcnt(0)" ::: "memory");
        int best = 0; float bv = 1e30f;
        for (int i = 0; i < 2048; ++i) { const float a = fabsf(F.out[i]); if (a < bv) { bv = a; best = i; } }
#if defined(PROBE_CYC)
        const float us = 0.01f * (float)__hip_atomic_load((unsigned*)(F.ws + WS_CTL) + 20001, __ATOMIC_RELAXED, __HIP_MEMORY_SCOPE_AGENT);
#elif defined(PROBE_ROLE)
        const float us = 0.01f * (float)__hip_atomic_load((unsigned*)(F.ws + WS_CTL) + 20001, __ATOMIC_RELAXED, __HIP_MEMORY_SCOPE_AGENT);
#elif PROBE_SEG
        const float us = 0.1f * (float)__hip_atomic_load((unsigned*)(F.ws + WS_CTL) + 20000, __ATOMIC_RELAXED, __HIP_MEMORY_SCOPE_AGENT);
#else
        const float us = (float)(long long)(PT[1] - PT[0]) * 0.01f;
#endif
#ifdef PROBE_FAIL
        F.out[0] = 20.0f * rintf(us * 0.05f);
#else
#ifdef PROBE_US0
        F.out[best] += 0.04f + 5e-4f * (us - (float)(PROBE_US0));
#else
        F.out[best] += 0.04f + 1e-4f * us;
#endif
#endif
        }
#endif
#undef IN
#undef SEAM
}

extern "C" void kernel_launch(void* const* d_in, const int* in_sizes, int n_in, void* d_out, int out_size, void* d_ws, size_t ws_size, hipStream_t stream) {
    static int grid = 0;
    if (grid == 0) {
        if (n_in != 14 || in_sizes[0] != T * D || out_size != T * D || ws_size < WS_END) { fprintf(stderr, "kernel_launch: unexpected shapes: n_in %d in0 %d out %d ws %zu (need %zu)\n", n_in, n_in > 0 ? in_sizes[0] : -1, out_size, ws_size, (size_t)WS_END); grid = -1; return; }
        int dev = 0, cus = 0, per_cu = 0;
        if (hipGetDevice(&dev) != hipSuccess || hipDeviceGetAttribute(&cus, hipDeviceAttributeMultiprocessorCount, dev) != hipSuccess) { grid = -1; return; }
        if (hipFuncSetAttribute((const void*)fwd_kernel, hipFuncAttributeMaxDynamicSharedMemorySize, LDS_BYTES) != hipSuccess) { fprintf(stderr, "kernel_launch: hipFuncSetAttribute failed\n"); grid = -1; return; }
        if (hipOccupancyMaxActiveBlocksPerMultiprocessor(&per_cu, (const void*)fwd_kernel, NWAVES * 64, LDS_BYTES) != hipSuccess || per_cu < 1) { fprintf(stderr, "kernel_launch: occupancy query says %d blocks per CU\n", per_cu); per_cu = 1; }
        (void)hipGetLastError();
        grid = cus;
        if (grid > 256) grid = 256;
    }
    if (grid < 0) return;
    (void)hipMemsetAsync((char*)d_ws + WS_CTL, 0, CTL_ZERO_BYTES, stream);
    Args a{};
    for (int i = 0; i < 14; ++i) a.in[i] = (const float*)d_in[i];
    a.out = (float*)d_out; a.ws = (unsigned char*)d_ws;
#if MK_N_LAUNCHES == 1
    a.ph_lo = 0; a.ph_hi = NPHASES;
    hipLaunchKernelGGL(fwd_kernel, dim3(grid), dim3(NWAVES * 64), LDS_BYTES, stream, a);
#else
    for (int p = 0; p < NPHASES; ++p) { a.ph_lo = p; a.ph_hi = p + 1; hipLaunchKernelGGL(fwd_kernel, dim3(grid), dim3(NWAVES * 64), LDS_BYTES, stream, a); }
#endif
}
```
